# Optimizing an MI355X kernel written in HIP

```python
import math
import jax
import jax.numpy as jnp
from jax import lax
import numpy as np

D_MODEL = 1024
BATCH = 8
SEQ = 4096
DEPTH = 4

GRID_W = 64
CTX_LEN = 256
N_MOD = 9
D_FF = 256 * ((8 * D_MODEL // 3 + 255) // 256)
DN_HEAD_DIM = 128
DN_WIDTH = D_MODEL // 2
DN_HEADS = DN_WIDTH // DN_HEAD_DIM
CONV_W = 3
CHUNK = 64
POOL_WINDOWS = (2, 4, 8, 16)
POOL_GROUPS = len(POOL_WINDOWS)
POOL_WIDTH = D_MODEL // 4
POOL_GROUP_DIM = POOL_WIDTH // POOL_GROUPS
FOURIER_GROUPS = 4
FOURIER_WIDTH = D_MODEL // 4
FOURIER_GROUP_DIM = FOURIER_WIDTH // FOURIER_GROUPS
N_BRANCH = 3
PROJ_SIZES = (3 * DN_WIDTH, DN_WIDTH, 2 * DN_HEADS, 2 * DN_HEADS, POOL_WIDTH, FOURIER_WIDTH, N_BRANCH * D_MODEL)
D_PROJ = sum(PROJ_SIZES)
RMS_EPS = 1e-6
L2_EPS = 1e-6

kernel_name = 'hybrid_deltanet_pool_fourier_prefix_dit'


def _rms(x, g):
    xf = x.astype(jnp.float32)
    y = xf * lax.rsqrt(jnp.mean(xf * xf, axis=-1, keepdims=True) + RMS_EPS)
    return (y * g.astype(jnp.float32)).astype(x.dtype)


def _half_ffn(x, gain, shift, scale, gate, w_gu, w_down):
    h = _rms(x, gain) * (1 + scale) + shift
    a, u = jnp.split(h @ w_gu, 2, axis=-1)
    return x + 0.5 * gate * ((jax.nn.silu(a) * u) @ w_down)


def _short_conv(u, w):
    pad = CONV_W // 2
    t = u.shape[1]
    up = jnp.pad(u, ((0, 0), (pad, pad), (0, 0)))
    return sum(up[:, j:j + t] * w[j] for j in range(CONV_W))


def _l2n(a):
    return a * lax.rsqrt(jnp.sum(a * a, axis=-1, keepdims=True) + L2_EPS)


def _project(h, w_in, conv_w):
    b, t, _ = h.shape
    cuts = [sum(PROJ_SIZES[:i + 1]) for i in range(len(PROJ_SIZES) - 1)]
    qkv, z, beta_raw, alpha_raw, pool_in, four_in, gates = jnp.split(h @ w_in, cuts, axis=-1)
    qkv = jax.nn.silu(_short_conv(qkv, conv_w)).astype(jnp.float32)
    qkv = qkv.reshape(b, t, 3, DN_HEADS, DN_HEAD_DIM)
    q = _l2n(qkv[:, :, 0]) * (DN_HEAD_DIM ** -0.5)
    k = _l2n(qkv[:, :, 1])
    v = qkv[:, :, 2]
    return q, k, v, beta_raw, alpha_raw, z, pool_in, four_in, gates


def _decay(beta_raw, alpha_raw, a_log_d, dt_bias_d, d):
    sl = slice(d * DN_HEADS, (d + 1) * DN_HEADS)
    beta = jax.nn.sigmoid(beta_raw[..., sl].astype(jnp.float32))
    g = -jnp.exp(a_log_d.astype(jnp.float32)) * jax.nn.softplus(
        alpha_raw[..., sl].astype(jnp.float32) + dt_bias_d.astype(jnp.float32))
    return beta, g


def _chunk_gated_delta(q, k, v, beta, g, s0):
    b, t, h, _ = q.shape
    dv = v.shape[-1]
    n = t // CHUNK

    def blocks(a):
        a = a.reshape((b, n, CHUNK, h) + a.shape[3:])
        return jnp.moveaxis(a, (1, 3), (0, 2))

    qb, kb, vb, betab, gb = blocks(q), blocks(k), blocks(v), blocks(beta), blocks(g)
    gc = jnp.cumsum(gb, axis=-1)
    idx = jnp.arange(CHUNK)
    incl = idx[:, None] >= idx[None, :]
    strict = idx[:, None] > idx[None, :]
    decay = jnp.exp(jnp.where(incl, gc[..., :, None] - gc[..., None, :], -jnp.inf))
    kbeta = kb * betab[..., None]
    a_mat = jnp.where(strict, jnp.einsum('nbhik,nbhjk->nbhij', kbeta, kb) * decay, 0.0)
    eye = jnp.eye(CHUNK, dtype=jnp.float32)
    rhs = jnp.concatenate([vb * betab[..., None], kbeta * jnp.exp(gc)[..., None]], axis=-1)
    sol = lax.linalg.triangular_solve(eye + a_mat, rhs, left_side=True, lower=True, unit_diagonal=True)
    u, w = sol[..., :dv], sol[..., dv:]
    attn = jnp.einsum('nbhik,nbhjk->nbhij', qb, kb) * decay
    q_dec = qb * jnp.exp(gc)[..., None]
    k_tail = kb * jnp.exp(gc[..., -1:] - gc)[..., None]
    c_dec = jnp.exp(gc[..., -1])

    def step(s, xs):
        u_i, w_i, a_i, qd_i, kt_i, cd_i = xs
        v_new = u_i - jnp.einsum('bhck,bhkv->bhcv', w_i, s)
        o_i = jnp.einsum('bhck,bhkv->bhcv', qd_i, s) + jnp.einsum('bhij,bhjv->bhiv', a_i, v_new)
        s = s * cd_i[..., None, None] + jnp.einsum('bhck,bhcv->bhkv', kt_i, v_new)
        return s, o_i

    s_fin, o = lax.scan(step, s0, (u, w, attn, q_dec, k_tail, c_dec))
    o = jnp.moveaxis(o, (0, 2), (1, 3)).reshape(b, t, h, dv)
    return o, s_fin


def _scan_dir(q, k, v, beta, g, s0, reverse):
    if reverse:
        q, k, v, beta, g = (jnp.flip(a, axis=1) for a in (q, k, v, beta, g))
    o, s = _chunk_gated_delta(q, k, v, beta, g, s0)
    if reverse:
        o = jnp.flip(o, axis=1)
    return o, s


def _bounds(n, win):
    i = jnp.arange(n)
    s = jnp.clip(i - win // 2, 0, n)
    e = jnp.clip(i - win // 2 + win, 0, n)
    return s, e


def _pool_grid(u, win):
    rows = u.shape[1]
    sat = jnp.pad(jnp.cumsum(jnp.cumsum(u, axis=1), axis=2), ((0, 0), (1, 0), (1, 0), (0, 0)))
    sr, er = _bounds(rows, win)
    sc, ec = _bounds(GRID_W, win)
    top, bot = sat[:, sr], sat[:, er]
    box = bot[:, :, ec] - bot[:, :, sc] - top[:, :, ec] + top[:, :, sc]
    cnt = ((er - sr)[:, None] * (ec - sc)[None, :]).astype(u.dtype)
    return box / cnt[None, :, :, None] - u


def _pool_seq(u, win):
    t = u.shape[1]
    cs = jnp.pad(jnp.cumsum(u, axis=1), ((0, 0), (1, 0), (0, 0)))
    s, e = _bounds(t, win)
    return (cs[:, e] - cs[:, s]) / (e - s).astype(u.dtype)[None, :, None] - u


def _pool_branch(u, w_b, pool_scale, grid):
    b, t, _ = u.shape
    uf = u.astype(jnp.float32).reshape(b, t, POOL_GROUPS, POOL_GROUP_DIM)
    outs = []
    for gi, win in enumerate(POOL_WINDOWS):
        ug = uf[:, :, gi]
        if grid:
            rows = t // GRID_W
            pooled = _pool_grid(ug.reshape(b, rows, GRID_W, POOL_GROUP_DIM), win).reshape(b, t, POOL_GROUP_DIM)
        else:
            pooled = _pool_seq(ug, win)
        outs.append(pooled)
    p = jnp.stack(outs, axis=2).astype(u.dtype)
    y = jnp.einsum('btgc,gcd->btgd', p, w_b).reshape(b, t, D_MODEL)
    return y * pool_scale


def _fourier_branch(u, w_c):
    b, t, _ = u.shape
    uf = u.astype(jnp.float32).reshape(b, t, FOURIER_GROUPS, FOURIER_GROUP_DIM)
    f = jnp.fft.fftn(uf, axes=(1, 3), norm='ortho').real
    return f.astype(u.dtype).reshape(b, t, FOURIER_WIDTH) @ w_c


def _merge(o, z, pool_in, four_in, gates, o_gain, w_a, w_b, pool_scale, w_c, w_out, grid):
    b, t = z.shape[:2]
    of = o * lax.rsqrt(jnp.mean(o * o, axis=-1, keepdims=True) + RMS_EPS) * o_gain.astype(jnp.float32)
    of = of * jax.nn.silu(z.astype(jnp.float32).reshape(b, t, DN_HEADS, DN_HEAD_DIM))
    y_a = of.reshape(b, t, DN_WIDTH).astype(z.dtype) @ w_a
    y_b = _pool_branch(pool_in, w_b, pool_scale, grid)
    y_c = _fourier_branch(four_in, w_c)
    g_a, g_b, g_c = jnp.split(jax.nn.sigmoid(gates), N_BRANCH, axis=-1)
    return (g_a * y_a + g_b * y_b + g_c * y_c) @ w_out


def _mixer(hx, hc, w_in, conv_w, a_log, dt_bias, o_gain, w_a, w_b, pool_scale, w_c, w_out, need_ctx):
    lq, lk, lv, lbeta, lalpha, lz, lpool, lfour, lgates = _project(hx, w_in, conv_w)
    cq, ck, cv, cbeta, calpha, cz, cpool, cfour, cgates = _project(hc, w_in, conv_w)
    o_lat, o_ctx = 0.0, 0.0
    for d in range(2):
        rev = d == 1
        beta_c, g_c = _decay(cbeta, calpha, a_log[d], dt_bias[d], d)
        s0 = jnp.zeros((hc.shape[0], DN_HEADS, DN_HEAD_DIM, DN_HEAD_DIM), jnp.float32)
        oc, s_ctx = _scan_dir(cq, ck, cv, beta_c, g_c, s0, rev)
        beta_l, g_l = _decay(lbeta, lalpha, a_log[d], dt_bias[d], d)
        ol, _ = _scan_dir(lq, lk, lv, beta_l, g_l, s_ctx, rev)
        o_lat = o_lat + ol
        o_ctx = o_ctx + oc
    y_lat = _merge(o_lat, lz, lpool, lfour, lgates, o_gain, w_a, w_b, pool_scale, w_c, w_out, True)
    y_ctx = _merge(o_ctx, cz, cpool, cfour, cgates, o_gain, w_a, w_b, pool_scale, w_c, w_out, False) if need_ctx else None
    return y_lat, y_ctx


def setup_inputs(seed: int = 0) -> dict:
    key = jax.random.key(seed)
    ks = jax.random.split(key, 24)
    f32 = jnp.float32

    def nrm(k, shape, scale):
        return jax.random.normal(k, shape, f32) * scale

    dt = jnp.exp(jax.random.uniform(ks[13], (DEPTH, 2, DN_HEADS), f32, math.log(1e-3), math.log(0.1)))
    return {
        'x': nrm(ks[0], (BATCH, SEQ, D_MODEL), 1.0),
        'c': nrm(ks[1], (BATCH, D_MODEL), 1.0),
        'ctx': nrm(ks[2], (BATCH, CTX_LEN, D_MODEL), 1.0),
        'c_ctx': nrm(ks[3], (D_MODEL,), 1.0),
        'w_ada': nrm(ks[4], (DEPTH, D_MODEL, N_MOD * D_MODEL), 0.5 * D_MODEL ** -0.5),
        'b_ada': nrm(ks[5], (DEPTH, N_MOD * D_MODEL), 0.02),
        'norm_gain': 1.0 + nrm(ks[6], (DEPTH, 3, D_MODEL), 0.02),
        'w_ffn1_gu': nrm(ks[7], (DEPTH, D_MODEL, 2 * D_FF), D_MODEL ** -0.5),
        'w_ffn1_down': nrm(ks[8], (DEPTH, D_FF, D_MODEL), D_FF ** -0.5),
        'w_ffn2_gu': nrm(ks[9], (DEPTH, D_MODEL, 2 * D_FF), D_MODEL ** -0.5),
        'w_ffn2_down': nrm(ks[10], (DEPTH, D_FF, D_MODEL), D_FF ** -0.5),
        'w_in': nrm(ks[11], (DEPTH, D_MODEL, D_PROJ), D_MODEL ** -0.5),
        'conv_w': nrm(ks[12], (DEPTH, CONV_W, 3 * DN_WIDTH), CONV_W ** -0.5),
        'a_log': jnp.log(jax.random.uniform(ks[14], (DEPTH, 2, DN_HEADS), f32, 1.0, 16.0)),
        'dt_bias': dt + jnp.log(-jnp.expm1(-dt)),
        'o_gain': 1.0 + nrm(ks[15], (DEPTH, DN_HEAD_DIM), 0.02),
        'w_a': nrm(ks[16], (DEPTH, DN_WIDTH, D_MODEL), DN_WIDTH ** -0.5),
        'w_b': nrm(ks[17], (DEPTH, POOL_GROUPS, POOL_GROUP_DIM, D_MODEL // POOL_GROUPS), POOL_GROUP_DIM ** -0.5),
        'pool_scale': 1.0 + nrm(ks[18], (DEPTH, D_MODEL), 0.1),
        'w_c': nrm(ks[19], (DEPTH, FOURIER_WIDTH, D_MODEL), FOURIER_WIDTH ** -0.5),
        'w_out': nrm(ks[20], (DEPTH, D_MODEL, D_MODEL), D_MODEL ** -0.5),
        'final_gain': 1.0 + nrm(ks[21], (D_MODEL,), 0.02),
    }


def reference(x, c, ctx, c_ctx, w_ada, b_ada, norm_gain, w_ffn1_gu, w_ffn1_down, w_ffn2_gu, w_ffn2_down,
              w_in, conv_w, a_log, dt_bias, o_gain, w_a, w_b, pool_scale, w_c, w_out, final_gain):
    xc = ctx
    for l in range(DEPTH):
        last = l == DEPTH - 1
        m_lat = [m[:, None, :] for m in jnp.split(jax.nn.silu(c) @ w_ada[l] + b_ada[l], N_MOD, axis=-1)]
        m_ctx = jnp.split(jax.nn.silu(c_ctx) @ w_ada[l] + b_ada[l], N_MOD, axis=-1)
        x = _half_ffn(x, norm_gain[l, 0], m_lat[0], m_lat[1], m_lat[2], w_ffn1_gu[l], w_ffn1_down[l])
        xc = _half_ffn(xc, norm_gain[l, 0], m_ctx[0], m_ctx[1], m_ctx[2], w_ffn1_gu[l], w_ffn1_down[l])
        hx = _rms(x, norm_gain[l, 1]) * (1 + m_lat[4]) + m_lat[3]
        hc = _rms(xc, norm_gain[l, 1]) * (1 + m_ctx[4]) + m_ctx[3]
        y, yc = _mixer(hx, hc, w_in[l], conv_w[l], a_log[l], dt_bias[l], o_gain[l], w_a[l], w_b[l],
                       pool_scale[l], w_c[l], w_out[l], not last)
        x = x + m_lat[5] * y
        x = _half_ffn(x, norm_gain[l, 2], m_lat[6], m_lat[7], m_lat[8], w_ffn2_gu[l], w_ffn2_down[l])
        if not last:
            xc = xc + m_ctx[5] * yc
            xc = _half_ffn(xc, norm_gain[l, 2], m_ctx[6], m_ctx[7], m_ctx[8], w_ffn2_gu[l], w_ffn2_down[l])
    return _rms(x, final_gain)
```

```cpp
#include <hip/hip_runtime.h>
#include <hip/hip_cooperative_groups.h>
#include <cstdio>

namespace cg = cooperative_groups;

#define LAS __attribute__((address_space(3)))
typedef LAS unsigned char* ldsp;
typedef unsigned short bf16_t;
typedef short bf16x8 __attribute__((ext_vector_type(8)));
typedef float f32x4 __attribute__((ext_vector_type(4)));
typedef unsigned u32x4 __attribute__((ext_vector_type(4)));
typedef unsigned u32x2 __attribute__((ext_vector_type(2)));

constexpr int DM = 1024, NB = 8, SEQ = 4096, CTX = 256, DEPTH = 4;
constexpr int RLAT = NB * SEQ, ROWS = RLAT + NB * CTX;
constexpr int DFF = 2816, NMOD = 9, DPROJ = 5648;
constexpr int NCH = ROWS / 64;
constexpr int NINP = 2816;
constexpr int LDS_BYTES = 163840;
constexpr int NTHR = 512;

constexpr size_t al256(size_t x) { return (x + 255) & ~(size_t)255; }
constexpr size_t O_X = 0;
constexpr size_t O_MOD = O_X + (size_t)ROWS * DM * 4;
constexpr size_t O_DFT = al256(O_MOD + (size_t)DEPTH * 9 * 9216 * 4);
constexpr size_t O_WGU = O_DFT + (size_t)4096 * 4096 * 2;
constexpr size_t O_WD = O_WGU + (size_t)5632 * 1024 * 2;
constexpr size_t O_WIN = O_WD + (size_t)1024 * 2816 * 2;
constexpr size_t O_WG = O_WIN + (size_t)NINP * 1024 * 2;
constexpr size_t O_WCAT = O_WG + (size_t)3072 * 1024 * 2;
constexpr size_t O_WOUT = O_WCAT + (size_t)1024 * 1024 * 2;
constexpr size_t O_R = O_WOUT + (size_t)1024 * 1024 * 2;
constexpr size_t SZ_H = (size_t)ROWS * 1024 * 2;
constexpr size_t SZ_Q = (size_t)ROWS * 512 * 2;
constexpr size_t O_HN = O_R;
constexpr size_t O_ACT = O_R + SZ_H;
constexpr size_t O_QN = O_R;
constexpr size_t O_KN = O_R + SZ_Q;
constexpr size_t O_QKV = O_R + SZ_H;
constexpr size_t O_O = O_QKV;
constexpr size_t O_SCR = O_QKV;
constexpr size_t O_Z = O_QKV + (size_t)ROWS * 1536 * 2;
constexpr size_t O_PI = O_Z + SZ_Q;
constexpr size_t O_FI = O_PI + (size_t)ROWS * 256 * 2;
constexpr size_t O_AB = O_FI + (size_t)ROWS * 256 * 2;
constexpr size_t O_KNT = al256(O_AB + (size_t)ROWS * 16 * 4);
constexpr size_t O_VNT = O_KNT + SZ_Q;
constexpr size_t O_MRG = O_KNT;
constexpr size_t O_TT = O_VNT + SZ_Q;
constexpr size_t O_OF = O_TT;
constexpr size_t O_GC = O_TT + SZ_H;
constexpr size_t O_FBT = al256(O_GC + (size_t)NCH * 4 * 2 * 64 * 4);
constexpr size_t O_UCS = O_FBT + (size_t)NB * 256 * 4096 * 2;
constexpr size_t O_PPF = al256(O_UCS + (size_t)NB * CTX * 512 * 4);
constexpr size_t WS_NEED = O_PPF + SZ_Q;
static_assert(O_SCR + (size_t)256 * 2 * 262144 <= O_PI, "merge scratch overlaps");

struct Params {
  const float *x, *c, *ctx, *c_ctx, *w_ada, *b_ada, *norm_gain, *w1gu, *w1d, *w2gu, *w2d, *w_in, *conv_w, *a_log, *dt_bias, *o_gain, *w_a, *w_b,
      *pool_scale, *w_c, *w_out, *final_gain;
  float* out;
  unsigned char* ws;
};

typedef float f32x2_ __attribute__((ext_vector_type(2)));
typedef __bf16 bf16x2_ __attribute__((ext_vector_type(2)));
__device__ __forceinline__ unsigned cvt_pk_bf16(float lo, float hi) { const f32x2_ v = {lo, hi}; const bf16x2_ b = __builtin_convertvector(v, bf16x2_); return __builtin_bit_cast(unsigned, b); }
__device__ __forceinline__ float bflo(unsigned w) { return __uint_as_float(w << 16); }
__device__ __forceinline__ float bfhi(unsigned w) { return __uint_as_float(w & 0xffff0000u); }
__device__ __forceinline__ float sigmoidf_(float x) { return 1.0f / (1.0f + __expf(-x)); }
__device__ __forceinline__ float siluf_(float x) { return x / (1.0f + __expf(-x)); }
template <class T> __device__ __forceinline__ T ldsld(ldsp b, int off) { return *(const LAS T*)(b + off); }
template <class T> __device__ __forceinline__ void ldsst(ldsp b, int off, T v) { *(LAS T*)(b + off) = v; }
__device__ __forceinline__ f32x4 mma(bf16x8 a, bf16x8 b, f32x4 c) { return __builtin_amdgcn_mfma_f32_16x16x32_bf16(a, b, c, 0, 0, 0); }
__device__ __forceinline__ u32x2 pack4(f32x4 v) { u32x2 r; r.x = cvt_pk_bf16(v[0], v[1]); r.y = cvt_pk_bf16(v[2], v[3]); return r; }
__device__ __forceinline__ int otid() { int t = threadIdx.x; asm volatile("" : "+v"(t)); return t; }
__device__ __forceinline__ unsigned char* lws(unsigned char* q) { asm volatile("" : "+s"(q)); return q; }
__device__ __forceinline__ int modidx(int pm) { return pm < 128 ? (pm >> 4) : 8; }

namespace pg8 {
constexpr int BM = 256, BK = 64, HALF = 128, HTB = HALF * BK * 2, NXCD = 8, WGM = 8;
__device__ __forceinline__ int lds_byte(int r, int c) { const int st = (r >> 4) * 2 + (c >> 5), rr = r & 15, cc = c & 31, ob = rr * 64 + cc * 2; return st * 1024 + (ob ^ (((ob >> 9) & 1) << 5)); }
__device__ __forceinline__ void stage_rc(int b, int& R, int& C) { const int st = b / 1024, sb = b % 1024, swz = sb ^ (((sb >> 9) & 1) << 5); R = (st >> 1) * 16 + swz / 64; C = (st & 1) * 32 + (swz % 64) / 2; }
__device__ __forceinline__ int perm32(int rho) { const int n = rho >> 4, i = rho & 15; return 8 * (i >> 2) + 4 * n + (i & 3); }

struct Unit { const char* A; const char* B; int lda, ldb, nt, pm, pn, seg; };

__device__ __forceinline__ bool tile_of(int nM, int nN, int G, int c, int i, int& pm, int& pn) {
  const int nwg = nM * nN; const long Lq = (long)i * G + c; if (Lq >= nwg) return false;
  int wgid = (int)Lq; { const int q = nwg / NXCD, r = nwg % NXCD, xcd = wgid % NXCD, off = wgid / NXCD; wgid = (xcd < r ? xcd * (q + 1) : r * (q + 1) + (xcd - r) * q) + off; }
  const int nig = WGM * nN, gid = wgid / nig, fm = gid * WGM, gsz = (nM - fm) < WGM ? (nM - fm) : WGM;
  pm = fm + ((wgid % nig) % gsz); pn = (wgid % nig) / gsz; return true;
}
struct PlainSched {
  static constexpr bool VARLDA = false;
  const char* A; const char* B; int lda, ldb, nt, nM, nN, G, c;
  __device__ __forceinline__ bool next(int i, Unit& u) const {
    int pm, pn; if (!tile_of(nM, nN, G, c, i, pm, pn)) return false;
    u.A = A + (size_t)pm * 256 * lda; u.B = B + (size_t)pn * 256 * ldb; u.lda = lda; u.ldb = ldb; u.nt = nt; u.pm = pm; u.pn = pn; u.seg = 0; return true;
  }
};

template <class Epi, class Sched>
__device__ __forceinline__ void gemm_phase(ldsp lds, const Sched& S, const Epi& E) {
  const int tid = otid(), wid = __builtin_amdgcn_readfirstlane(tid >> 6), lane = tid & 63, wr = wid >> 2, wc = wid & 3, fr = lane & 15, fq = lane >> 4;
  unsigned rA[2], rB[2], c2[2];
#pragma unroll
  for (int i = 0; i < 2; ++i) { int R, C; stage_rc(tid * 16 + i * 8192, R, C); rA[i] = (unsigned)R; rB[i] = (unsigned)(Epi::PERM ? ((R & ~31) + perm32(R & 31)) : R); c2[i] = (unsigned)C * 2u; }
  const size_t kstep = (size_t)(BK * 2);
  const unsigned ldsw = (unsigned)wid * 1024u;
  const int aoff = lds_byte(wr * 64 + fr, fq * 8), boff = lds_byte(wc * 32 + fr, fq * 8);
#define PG8_SA(b, h) (((b) * 2 + (h)) * HTB)
#define PG8_SB(b, h) ((4 + (b) * 2 + (h)) * HTB)
#define PG8_STAGE(bufoff, gbase, voff) do { _Pragma("unroll") for (int _i = 0; _i < 2; ++_i) \
    __builtin_amdgcn_global_load_lds((const unsigned*)((const char*)(gbase) + (voff)[_i]), (LAS unsigned*)(lds + (bufoff) + ldsw + _i * 8192), 16, 0, 0); } while (0)
#define PG8_LDA(dst, b, h) do { _Pragma("unroll") for (int m = 0; m < 4; ++m) _Pragma("unroll") for (int k = 0; k < 2; ++k) dst[m][k] = *(const LAS bf16x8*)(lds + PG8_SA(b, h) + aoff + m * 2048 + k * 1024); } while (0)
#define PG8_LDB(dst, b, h) do { _Pragma("unroll") for (int n = 0; n < 2; ++n) _Pragma("unroll") for (int k = 0; k < 2; ++k) dst[n][k] = *(const LAS bf16x8*)(lds + PG8_SB(b, h) + boff + n * 2048 + k * 1024); } while (0)
#define PG8_MMA(ai, bj, At, Bt) do { __builtin_amdgcn_s_setprio(1); _Pragma("unroll") for (int m = 0; m < 4; ++m) _Pragma("unroll") for (int n = 0; n < 2; ++n) _Pragma("unroll") for (int k = 0; k < 2; ++k) \
    acc[ai][bj][m][n] = __builtin_amdgcn_mfma_f32_16x16x32_bf16(Bt[n][k], At[m][k], acc[ai][bj][m][n], 0, 0, 0); __builtin_amdgcn_s_setprio(0); } while (0)
#define PG8_WAIT_V(n) asm volatile("s_waitcnt vmcnt(" #n ")" ::: "memory")
#define PG8_WAIT_L(n) asm volatile("s_waitcnt lgkmcnt(" #n ")" ::: "memory")
#define PG8_BAR __builtin_amdgcn_s_barrier()
#define PG8_SCHED __builtin_amdgcn_sched_barrier(0)
  Unit cur, nxt; int ui = 0;
  if (!S.next(0, cur)) return;
  f32x4 acc[2][2][4][2];
#pragma unroll
  for (int a = 0; a < 2; ++a)
#pragma unroll
    for (int b = 0; b < 2; ++b)
#pragma unroll
      for (int m = 0; m < 4; ++m)
#pragma unroll
        for (int n = 0; n < 2; ++n) acc[a][b][m][n] = (f32x4){0.f, 0.f, 0.f, 0.f};
  bf16x8 At[4][2], B0[2][2], B1[2][2];
  const char* cA = cur.A; const char* cB = cur.B; int ldA = cur.lda; const int ldB = cur.ldb;
  unsigned voffA[2], voffB[2];
#pragma unroll
  for (int i = 0; i < 2; ++i) { voffA[i] = rA[i] * (unsigned)ldA + c2[i]; voffB[i] = rB[i] * (unsigned)ldB + c2[i]; }
  const size_t hB = (size_t)HALF * ldB;
  {
    const size_t hA = (size_t)HALF * ldA;
    PG8_STAGE(PG8_SB(0, 0), cB, voffB); PG8_STAGE(PG8_SA(0, 0), cA, voffA); PG8_STAGE(PG8_SB(0, 1), cB + hB, voffB); PG8_STAGE(PG8_SA(0, 1), cA + hA, voffA);
    if (wr == 1) PG8_BAR;
    PG8_WAIT_V(4); PG8_BAR;
    PG8_STAGE(PG8_SB(1, 0), cB + kstep, voffB); PG8_STAGE(PG8_SA(1, 0), cA + kstep, voffA); PG8_STAGE(PG8_SB(1, 1), cB + hB + kstep, voffB);
    PG8_WAIT_V(6); PG8_BAR;
  }
  for (;;) {
    const bool has_next = S.next(ui + 1, nxt);
    const char* nA = has_next ? nxt.A : cA; const char* nB = has_next ? nxt.B : cB;
    const int nldA = has_next ? nxt.lda : ldA;
    const int nt = cur.nt;
    const size_t hA = (size_t)HALF * ldA;
    for (int t = 0; t < nt; t += 2) {
      const bool last = (t == nt - 2);
      const char* a1 = cA + (size_t)(t + 1) * kstep;
      const char* a2 = last ? nA : cA + (size_t)(t + 2) * kstep; const char* b2 = last ? nB : cB + (size_t)(t + 2) * kstep;
      const size_t h2A = (size_t)HALF * (last ? nldA : ldA);
      const char* a3 = a2 + kstep; const char* b3 = b2 + kstep;
      PG8_LDB(B0, 0, 0); PG8_SCHED; PG8_LDA(At, 0, 0); PG8_STAGE(PG8_SA(1, 1), a1 + hA, voffA);
      if (Sched::VARLDA) { if (last) {
#pragma unroll
        for (int i = 0; i < 2; ++i) voffA[i] = rA[i] * (unsigned)nldA + c2[i]; } }
      PG8_WAIT_L(8); PG8_BAR; PG8_WAIT_L(0); PG8_MMA(0, 0, At, B0); PG8_BAR; PG8_SCHED;
      PG8_LDB(B1, 0, 1); PG8_STAGE(PG8_SB(0, 0), b2, voffB);
      PG8_BAR; PG8_WAIT_L(0); PG8_MMA(0, 1, At, B1); PG8_BAR;
      PG8_LDA(At, 0, 1); PG8_STAGE(PG8_SA(0, 0), a2, voffA);
      PG8_BAR; PG8_WAIT_L(0); PG8_MMA(1, 0, At, B0); PG8_BAR; PG8_SCHED;
      PG8_STAGE(PG8_SB(0, 1), b2 + hB, voffB);
      PG8_WAIT_V(6); PG8_BAR; PG8_MMA(1, 1, At, B1); PG8_BAR;
      PG8_LDB(B0, 1, 0); PG8_SCHED; PG8_LDA(At, 1, 0); PG8_STAGE(PG8_SA(0, 1), a2 + h2A, voffA);
      PG8_WAIT_L(8); PG8_BAR; PG8_WAIT_L(0); PG8_MMA(0, 0, At, B0); PG8_BAR; PG8_SCHED;
      PG8_LDB(B1, 1, 1); PG8_STAGE(PG8_SB(1, 0), b3, voffB);
      PG8_BAR; PG8_WAIT_L(0); PG8_MMA(0, 1, At, B1); PG8_BAR;
      PG8_LDA(At, 1, 1); PG8_STAGE(PG8_SA(1, 0), a3, voffA);
      PG8_BAR; PG8_WAIT_L(0); PG8_MMA(1, 0, At, B0); PG8_BAR; PG8_SCHED;
      PG8_STAGE(PG8_SB(1, 1), b3 + hB, voffB);
      PG8_WAIT_V(6); PG8_BAR; PG8_MMA(1, 1, At, B1); PG8_BAR;
    }
    E(acc, cur, wr, wc, fr, fq);
    if (!has_next) break;
#pragma unroll
    for (int a = 0; a < 2; ++a)
#pragma unroll
      for (int b = 0; b < 2; ++b)
#pragma unroll
        for (int m = 0; m < 4; ++m)
#pragma unroll
          for (int n = 0; n < 2; ++n) acc[a][b][m][n] = (f32x4){0.f, 0.f, 0.f, 0.f};
    cur = nxt; cA = nA; cB = nB; ldA = nldA; ++ui;
  }
  PG8_WAIT_V(0);
  if (wr == 0) PG8_BAR;
  PG8_BAR;
#undef PG8_SA
#undef PG8_SB
#undef PG8_STAGE
#undef PG8_LDA
#undef PG8_LDB
#undef PG8_MMA
#undef PG8_WAIT_V
#undef PG8_WAIT_L
#undef PG8_BAR
#undef PG8_SCHED
}
}
using pg8::Unit;
typedef f32x4 AccT[2][2][4][2];

struct EpiUp {
  static constexpr bool PERM = true;
  bf16_t* act;
  __device__ __forceinline__ void operator()(const AccT& acc, const Unit& u, int wr, int wc, int fr, int fq) const {
    const int row0 = u.pm * 256 + wr * 64 + fr, col0 = u.pn * 128 + wc * 32 + 8 * fq;
#pragma unroll
    for (int ai = 0; ai < 2; ++ai)
#pragma unroll
      for (int m = 0; m < 4; ++m) {
        const f32x4 a0 = acc[ai][0][m][0], a1 = acc[ai][0][m][1], u0 = acc[ai][1][m][0], u1 = acc[ai][1][m][1];
        u32x4 w;
        w.x = cvt_pk_bf16(siluf_(a0[0]) * u0[0], siluf_(a0[1]) * u0[1]); w.y = cvt_pk_bf16(siluf_(a0[2]) * u0[2], siluf_(a0[3]) * u0[3]);
        w.z = cvt_pk_bf16(siluf_(a1[0]) * u1[0], siluf_(a1[1]) * u1[1]); w.w = cvt_pk_bf16(siluf_(a1[2]) * u1[2], siluf_(a1[3]) * u1[3]);
        *(u32x4*)(act + (size_t)(row0 + ai * 128 + m * 16) * DFF + col0) = w;
      }
  }
};
struct EpiRes {
  static constexpr bool PERM = false;
  float* X; const float* modl; int gidx; float scale;
  __device__ __forceinline__ void operator()(const AccT& acc, const Unit& u, int wr, int wc, int fr, int fq) const {
    const int row0 = u.pm * 256 + wr * 64 + fr, col0 = u.pn * 256 + wc * 32 + 4 * fq;
    const float* g = modl + (size_t)(modidx(u.pm) * 9 + gidx) * 1024 + col0;
    f32x4 gv[2][2];
#pragma unroll
    for (int bj = 0; bj < 2; ++bj)
#pragma unroll
      for (int n = 0; n < 2; ++n) gv[bj][n] = *(const f32x4*)(g + bj * 128 + n * 16) * scale;
#pragma unroll
    for (int ai = 0; ai < 2; ++ai)
#pragma unroll
      for (int m = 0; m < 4; ++m) {
        float* rowp = X + (size_t)(row0 + ai * 128 + m * 16) * DM + col0;
#pragma unroll
        for (int bj = 0; bj < 2; ++bj)
#pragma unroll
          for (int n = 0; n < 2; ++n) { f32x4* q = (f32x4*)(rowp + bj * 128 + n * 16); *q = *q + gv[bj][n] * acc[ai][bj][m][n]; }
      }
  }
};
struct EpiIn {
  static constexpr bool PERM = true;
  bf16_t *qkv, *z, *pi, *fi; float* ab;
  __device__ __forceinline__ void operator()(const AccT& acc, const Unit& u, int wr, int wc, int fr, int fq) const {
    const int row0 = u.pm * 256 + wr * 64 + fr;
    if (u.pn == 10) {
      if (wc == 0 && fq < 2) {
#pragma unroll
        for (int ai = 0; ai < 2; ++ai)
#pragma unroll
          for (int m = 0; m < 4; ++m) {
            float* rp = ab + (size_t)(row0 + ai * 128 + m * 16) * 16 + 8 * fq;
            *(f32x4*)(rp) = acc[ai][0][m][0]; *(f32x4*)(rp + 4) = acc[ai][0][m][1];
          }
      }
      return;
    }
    bf16_t* base; int ld, ct;
    if (u.pn < 6) { base = qkv; ld = 1536; ct = u.pn * 256; } else if (u.pn < 8) { base = z; ld = 512; ct = (u.pn - 6) * 256; } else if (u.pn == 8) { base = pi; ld = 256; ct = 0; } else { base = fi; ld = 256; ct = 0; }
    const int col0 = ct + wc * 32 + 8 * fq;
#pragma unroll
    for (int ai = 0; ai < 2; ++ai)
#pragma unroll
      for (int m = 0; m < 4; ++m) {
        bf16_t* rowp = base + (size_t)(row0 + ai * 128 + m * 16) * ld + col0;
#pragma unroll
        for (int bj = 0; bj < 2; ++bj) { const f32x4 v0 = acc[ai][bj][m][0], v1 = acc[ai][bj][m][1]; u32x4 w; w.x = cvt_pk_bf16(v0[0], v0[1]); w.y = cvt_pk_bf16(v0[2], v0[3]); w.z = cvt_pk_bf16(v1[0], v1[1]); w.w = cvt_pk_bf16(v1[2], v1[3]);
          *(u32x4*)(rowp + bj * 128) = w; }
      }
  }
};
struct EpiBf {
  static constexpr bool PERM = true;
  bf16_t* O; int ld;
  __device__ __forceinline__ void operator()(const AccT& acc, const Unit& u, int wr, int wc, int fr, int fq) const {
    const int row0 = u.pm * 256 + wr * 64 + fr, col0 = u.pn * 256 + wc * 32 + 8 * fq;
#pragma unroll
    for (int ai = 0; ai < 2; ++ai)
#pragma unroll
      for (int m = 0; m < 4; ++m) {
        bf16_t* rowp = O + (size_t)(row0 + ai * 128 + m * 16) * ld + col0;
#pragma unroll
        for (int bj = 0; bj < 2; ++bj) { const f32x4 v0 = acc[ai][bj][m][0], v1 = acc[ai][bj][m][1]; u32x4 w; w.x = cvt_pk_bf16(v0[0], v0[1]); w.y = cvt_pk_bf16(v0[2], v0[3]); w.z = cvt_pk_bf16(v1[0], v1[1]); w.w = cvt_pk_bf16(v1[2], v1[3]);
          *(u32x4*)(rowp + bj * 128) = w; }
      }
  }
};
struct EpiMerge {
  static constexpr bool PERM = true;
  float* scr;
  bf16_t* mrg;
  __device__ __forceinline__ void operator()(const AccT& acc, const Unit& u, int wr, int wc, int fr, int fq) const {
    const int tid_ = otid(); f32x4* S1 = (f32x4*)scr + tid_; f32x4* Mx = (f32x4*)scr + 32 * 512 + tid_;
    const int seg = u.seg;
    if ((seg & 1) == 0) {
#pragma unroll
      for (int ai = 0; ai < 2; ++ai)
#pragma unroll
        for (int bj = 0; bj < 2; ++bj)
#pragma unroll
          for (int m = 0; m < 4; ++m)
#pragma unroll
            for (int n = 0; n < 2; ++n) { const f32x4 v = acc[ai][bj][m][n]; f32x4 s; s[0] = sigmoidf_(v[0]); s[1] = sigmoidf_(v[1]); s[2] = sigmoidf_(v[2]); s[3] = sigmoidf_(v[3]);
              S1[(((ai * 2 + bj) * 4 + m) * 2 + n) * 512] = s; }
    } else if (seg < 5) {
#pragma unroll
      for (int ai = 0; ai < 2; ++ai)
#pragma unroll
        for (int bj = 0; bj < 2; ++bj)
#pragma unroll
          for (int m = 0; m < 4; ++m)
#pragma unroll
            for (int n = 0; n < 2; ++n) { const int ix = (((ai * 2 + bj) * 4 + m) * 2 + n) * 512; f32x4 t = S1[ix] * acc[ai][bj][m][n]; if (seg == 3) t = t + Mx[ix]; Mx[ix] = t; }
    } else {
      const int row0 = u.pm * 256 + wr * 64 + fr, col0 = u.pn * 256 + wc * 32 + 8 * fq;
#pragma unroll
      for (int ai = 0; ai < 2; ++ai)
#pragma unroll
        for (int m = 0; m < 4; ++m) {
          bf16_t* rowp = mrg + (size_t)(row0 + ai * 128 + m * 16) * DM + col0;
#pragma unroll
          for (int bj = 0; bj < 2; ++bj) {
            const int i0 = (((ai * 2 + bj) * 4 + m) * 2 + 0) * 512, i1 = i0 + 512;
            const f32x4 v0 = S1[i0] * acc[ai][bj][m][0] + Mx[i0], v1 = S1[i1] * acc[ai][bj][m][1] + Mx[i1];
            u32x4 w; w.x = cvt_pk_bf16(v0[0], v0[1]); w.y = cvt_pk_bf16(v0[2], v0[3]); w.z = cvt_pk_bf16(v1[0], v1[1]); w.w = cvt_pk_bf16(v1[2], v1[3]);
            *(u32x4*)(rowp + bj * 128) = w;
          }
        }
    }
  }
};
struct MergeSched {
  static constexpr bool VARLDA = true;
  const char *hn, *of, *ppf, *wg, *wcat; int G, c;
  __device__ __forceinline__ bool next(int i, Unit& u) const {
    const int round = i / 6, seg = i - round * 6; int pm, pn; if (!pg8::tile_of(ROWS / 256, 4, G, c, round, pm, pn)) return false;
    const int br = seg >> 1;
    u.pm = pm; u.pn = pn; u.seg = seg; u.ldb = 2048;
    if ((seg & 1) == 0) { u.A = hn + (size_t)pm * 256 * 2048; u.lda = 2048; u.B = wg + (size_t)(br * 1024 + pn * 256) * 2048; u.nt = 16; }
    else {
      u.lda = 1024;
      if (br == 0) { u.A = of + (size_t)pm * 256 * 1024; u.B = wcat + (size_t)pn * 256 * 2048; u.nt = 8; }
      else if (br == 1) { u.A = ppf + (size_t)pm * 256 * 1024; u.B = wcat + (size_t)pn * 256 * 2048 + 512 * 2; u.nt = 4; }
      else { u.A = ppf + (size_t)pm * 256 * 1024 + 256 * 2; u.B = wcat + (size_t)pn * 256 * 2048 + 768 * 2; u.nt = 4; }
    }
    return true;
  }
};
struct FourSched {
  static constexpr bool VARLDA = false;
  const char *dft, *fbt; int c;
  __device__ __forceinline__ bool next(int i, Unit& u) const {
    if (i > 0) return false;
    const int b = c >> 4, pm = c & 15;
    u.A = dft + (size_t)pm * 256 * 8192; u.B = fbt + (size_t)b * 256 * 8192; u.lda = 8192; u.ldb = 8192; u.nt = 64; u.pm = b * 16 + pm; u.pn = 0; u.seg = 0; return true;
  }
};

template <class F>
__device__ __forceinline__ void convT(const float* W, int ldw, int K, int nrows, bf16_t* dst, int ldd, int k0d, F srccol, ldsp L, int& cursor) {
  const int tid = otid(), ntk = K >> 6, ntiles = (nrows >> 6) * ntk;
  for (int t = 0; t < ntiles; ++t) {
    if (((cursor + t) % (int)gridDim.x) != (int)blockIdx.x) continue;
    const int tr = t / ntk, tk = t - tr * ntk, r0 = tr * 64, kk0 = tk * 64;
    const int i = tid & 63, sc = srccol(r0 + i);
#pragma unroll
    for (int it = 0; it < 8; ++it) { const int kk = (tid >> 6) + 8 * it; const float v = sc >= 0 ? W[(size_t)(kk0 + kk) * ldw + sc] : 0.f; ldsst<float>(L, (kk * 65 + i) * 4, v); }
    __syncthreads();
    { const int ii = tid >> 3, kv = (tid & 7) * 8; float v[8];
#pragma unroll
      for (int e = 0; e < 8; ++e) v[e] = ldsld<float>(L, ((kv + e) * 65 + ii) * 4);
      u32x4 w; w.x = cvt_pk_bf16(v[0], v[1]); w.y = cvt_pk_bf16(v[2], v[3]); w.z = cvt_pk_bf16(v[4], v[5]); w.w = cvt_pk_bf16(v[6], v[7]);
      *(u32x4*)(dst + (size_t)(r0 + ii) * ldd + k0d + kk0 + kv) = w; }
    __syncthreads();
  }
  cursor += ntiles;
}

__device__ void convert_ffn(const Params& p, const float* wgu, const float* wd, ldsp L) {
  int cur = 0;
  convT(wgu, 2 * DFF, 1024, 2 * DFF, (bf16_t*)(lws(p.ws) + O_WGU), 1024, 0, [](int r) { const int t = r >> 8, q = r & 255; return q < 128 ? t * 128 + q : DFF + t * 128 + (q - 128); }, L, cur);
  convT(wd, 1024, DFF, 1024, (bf16_t*)(lws(p.ws) + O_WD), DFF, 0, [](int r) { return r; }, L, cur);
}
__device__ void convert_mixer(const Params& p, int l, ldsp L) {
  int cur = 0;
  const float* win = p.w_in + (size_t)l * 1024 * DPROJ;
  convT(win, DPROJ, 1024, NINP, (bf16_t*)(lws(p.ws) + O_WIN), 1024, 0, [](int r) { return r < 2048 ? r : (r < 2560 ? r + 16 : (r < 2576 ? r - 512 : -1)); }, L, cur);
  convT(win, DPROJ, 1024, 3072, (bf16_t*)(lws(p.ws) + O_WG), 1024, 0, [](int r) { return 2576 + r; }, L, cur);
  convT(p.w_a + (size_t)l * 512 * 1024, 1024, 512, 1024, (bf16_t*)(lws(p.ws) + O_WCAT), 1024, 0, [](int r) { return r; }, L, cur);
  convT(p.w_c + (size_t)l * 256 * 1024, 1024, 256, 1024, (bf16_t*)(lws(p.ws) + O_WCAT), 1024, 768, [](int r) { return r; }, L, cur);
  convT(p.w_out + (size_t)l * 1024 * 1024, 1024, 1024, 1024, (bf16_t*)(lws(p.ws) + O_WOUT), 1024, 0, [](int r) { return r; }, L, cur);
  const float* wb = p.w_b + (size_t)l * 4 * 64 * 256; const float* ps = p.pool_scale + (size_t)l * 1024; bf16_t* wcat = (bf16_t*)(lws(p.ws) + O_WCAT);
  for (int idx = blockIdx.x * NTHR + otid(); idx < 1024 * 256; idx += gridDim.x * NTHR) {
    const int row = idx & 1023, kk = idx >> 10, g = row >> 8;
    const float v = ((kk >> 6) == g) ? wb[((size_t)g * 64 + (kk & 63)) * 256 + (row & 255)] * ps[row] : 0.f;
    wcat[(size_t)row * 1024 + 512 + kk] = (bf16_t)(cvt_pk_bf16(v, 0.f) & 0xffffu);
  }
}

__device__ void norm_phase(const float* X, bf16_t* Hn, const float* gain, const float* modl, int ishift, int iscale) {
  const int tid_ = otid(), lane = tid_ & 63, gw = blockIdx.x * 8 + (tid_ >> 6), nw = gridDim.x * 8;
  for (int r = gw; r < ROWS; r += nw) {
    const int j = r < RLAT ? (r >> 12) : 8;
    const float* sh = modl + (size_t)(j * 9 + ishift) * 1024; const float* sc = modl + (size_t)(j * 9 + iscale) * 1024;
    const float* xr = X + (size_t)r * DM;
    f32x4 v[4]; float ss = 0.f;
#pragma unroll
    for (int i = 0; i < 2; ++i) { v[2 * i] = *(const f32x4*)(xr + lane * 8 + 512 * i); v[2 * i + 1] = *(const f32x4*)(xr + lane * 8 + 512 * i + 4); }
#pragma unroll
    for (int i = 0; i < 4; ++i) ss += v[i][0] * v[i][0] + v[i][1] * v[i][1] + v[i][2] * v[i][2] + v[i][3] * v[i][3];
#pragma unroll
    for (int o = 32; o >= 1; o >>= 1) ss += __shfl_xor(ss, o);
    const float rstd = rsqrtf(ss * (1.0f / 1024.0f) + 1e-6f);
#pragma unroll
    for (int i = 0; i < 2; ++i) {
      const int c0 = lane * 8 + 512 * i; float o[8];
#pragma unroll
      for (int hh = 0; hh < 2; ++hh) { const f32x4 g = *(const f32x4*)(gain + c0 + 4 * hh), s1 = *(const f32x4*)(sc + c0 + 4 * hh), s0 = *(const f32x4*)(sh + c0 + 4 * hh); const f32x4 y = v[2 * i + hh] * rstd * g * (s1 + 1.0f) + s0;
        o[4 * hh] = y[0]; o[4 * hh + 1] = y[1]; o[4 * hh + 2] = y[2]; o[4 * hh + 3] = y[3]; }
      u32x4 w; w.x = cvt_pk_bf16(o[0], o[1]); w.y = cvt_pk_bf16(o[2], o[3]); w.z = cvt_pk_bf16(o[4], o[5]); w.w = cvt_pk_bf16(o[6], o[7]);
      *(u32x4*)(Hn + (size_t)r * DM + c0) = w;
    }
  }
}
__device__ void final_norm(const float* X, float* out, const float* gain) {
  const int tid_ = otid(), lane = tid_ & 63, gw = blockIdx.x * 8 + (tid_ >> 6), nw = gridDim.x * 8;
  for (int r = gw; r < RLAT; r += nw) {
    const float* xr = X + (size_t)r * DM; f32x4 v[4]; float ss = 0.f;
#pragma unroll
    for (int i = 0; i < 4; ++i) { v[i] = *(const f32x4*)(xr + lane * 4 + 256 * i); ss += v[i][0] * v[i][0] + v[i][1] * v[i][1] + v[i][2] * v[i][2] + v[i][3] * v[i][3]; }
#pragma unroll
    for (int o = 32; o >= 1; o >>= 1) ss += __shfl_xor(ss, o);
    const float rstd = rsqrtf(ss * (1.0f / 1024.0f) + 1e-6f);
#pragma unroll
    for (int i = 0; i < 4; ++i) { const f32x4 g = *(const f32x4*)(gain + lane * 4 + 256 * i); *(f32x4*)(out + (size_t)r * DM + lane * 4 + 256 * i) = v[i] * rstd * g; }
  }
}

__device__ void phase0(const Params& p, ldsp L) {
  const int tid = otid(); const size_t gt = (size_t)blockIdx.x * NTHR + tid, gs = (size_t)gridDim.x * NTHR;
  { f32x4* X = (f32x4*)(lws(p.ws) + O_X); const f32x4* xs = (const f32x4*)p.x; const f32x4* cs = (const f32x4*)p.ctx; const size_t n1 = (size_t)RLAT * DM / 4, n2 = (size_t)ROWS * DM / 4;
    for (size_t i = gt; i < n2; i += gs) X[i] = i < n1 ? xs[i] : cs[i - n1]; }
  { bf16_t* D = (bf16_t*)(lws(p.ws) + O_DFT);
    for (size_t v = gt; v < (size_t)4096 * 512; v += gs) { const int k = (int)(v >> 9), j0 = (int)(v & 511) * 8; float o[8];
#pragma unroll
      for (int e = 0; e < 8; ++e) { const int j = j0 + e; const bool cs_ = j <= 2048; const int t = cs_ ? j : j - 2048; const int r = (k * t) & 4095; const float a = (float)r * (1.0f / 2048.0f);
        o[e] = cs_ ? cospif(a) * (1.0f / 64.0f) : -sinpif(a) * (1.0f / 64.0f); }
      u32x4 w; w.x = cvt_pk_bf16(o[0], o[1]); w.y = cvt_pk_bf16(o[2], o[3]); w.z = cvt_pk_bf16(o[4], o[5]); w.w = cvt_pk_bf16(o[6], o[7]);
      *(u32x4*)(D + (size_t)k * 4096 + j0) = w; } }
  for (int idx = tid; idx < 9 * 1024; idx += NTHR) { const int j = idx >> 10, k = idx & 1023; const float v = j < 8 ? p.c[j * 1024 + k] : p.c_ctx[k]; ldsst<float>(L, idx * 4, siluf_(v)); }
  __syncthreads();
  float* MOD = (float*)(lws(p.ws) + O_MOD);
  for (int item = blockIdx.x; item < DEPTH * 144; item += gridDim.x) {
    const int l = item / 144, n0 = (item - l * 144) * 64, ks = tid >> 6, cn = tid & 63;
    float acc[9];
#pragma unroll
    for (int j = 0; j < 9; ++j) acc[j] = 0.f;
    const float* wp = p.w_ada + ((size_t)l * 1024 + ks * 128) * 9216 + n0 + cn;
#pragma unroll 4
    for (int k = 0; k < 128; ++k) { const float w = wp[(size_t)k * 9216];
#pragma unroll
      for (int j = 0; j < 9; ++j) acc[j] += ldsld<float>(L, (j * 1024 + ks * 128 + k) * 4) * w; }
#pragma unroll
    for (int j = 0; j < 9; ++j) ldsst<float>(L, 36864 + ((ks * 9 + j) * 64 + cn) * 4, acc[j]);
    __syncthreads();
    for (int o = tid; o < 576; o += NTHR) { const int j = o >> 6, c = o & 63; float s = p.b_ada[(size_t)l * 9216 + n0 + c];
#pragma unroll
      for (int q = 0; q < 8; ++q) s += ldsld<float>(L, 36864 + ((q * 9 + j) * 64 + c) * 4);
      MOD[((size_t)l * 9 + j) * 9216 + n0 + c] = s; }
    __syncthreads();
  }
}

__device__ void prep_phase(const Params& p, int l, ldsp L) {
  const int tid = otid(), lane = tid & 63, wid = tid >> 6, fr = lane & 15, fq = lane >> 4;
  constexpr int KSB = 0, KTL = 17408, VTL = 35840, GL = 54272, AL = 71680, GCL = 104448, BTL = 104960, TOL = 105472;
  const bf16_t* QKV = (const bf16_t*)(lws(p.ws) + O_QKV); const float* AB = (const float*)(lws(p.ws) + O_AB);
  bf16_t* QN = (bf16_t*)(lws(p.ws) + O_QN); bf16_t* KN = (bf16_t*)(lws(p.ws) + O_KN); bf16_t* KNT = (bf16_t*)(lws(p.ws) + O_KNT); bf16_t* VNT = (bf16_t*)(lws(p.ws) + O_VNT);
  bf16_t* TT = (bf16_t*)(lws(p.ws) + O_TT); float* GC = (float*)(lws(p.ws) + O_GC);
  const float* cw = p.conv_w + (size_t)l * 3 * 1536;
  for (int item = blockIdx.x; item < NCH * 4; item += gridDim.x) {
    const int n = item >> 2, h = item & 3, R0 = n * 64;
    { const int row = tid >> 3, cs = tid & 7, r = R0 + row, c0 = cs * 16;
      const int t = r < RLAT ? (r & 4095) : ((r - RLAT) & 255), Ls = r < RLAT ? 4096 : 256;
      const bool hp = t > 0, hn = t < Ls - 1;
#pragma unroll
      for (int mtx = 0; mtx < 3; ++mtx) {
        const int cc = mtx * 512 + h * 128 + c0; const bf16_t* bp = QKV + (size_t)r * 1536 + cc;
        u32x4 a0 = {0, 0, 0, 0}, a1 = {0, 0, 0, 0}, c0v = {0, 0, 0, 0}, c1v = {0, 0, 0, 0};
        const u32x4 b0 = *(const u32x4*)(bp), b1 = *(const u32x4*)(bp + 8);
        if (hp) { a0 = *(const u32x4*)(bp - 1536); a1 = *(const u32x4*)(bp - 1536 + 8); }
        if (hn) { c0v = *(const u32x4*)(bp + 1536); c1v = *(const u32x4*)(bp + 1536 + 8); }
        float val[16]; float ss = 0.f;
#pragma unroll
        for (int e = 0; e < 16; ++e) {
          const unsigned wa = e < 8 ? a0[e >> 1] : a1[(e - 8) >> 1], wb = e < 8 ? b0[e >> 1] : b1[(e - 8) >> 1], wc_ = e < 8 ? c0v[e >> 1] : c1v[(e - 8) >> 1];
          const float xa = (e & 1) ? bfhi(wa) : bflo(wa), xb = (e & 1) ? bfhi(wb) : bflo(wb), xc = (e & 1) ? bfhi(wc_) : bflo(wc_);
          const float y = xa * cw[cc + e] + xb * cw[1536 + cc + e] + xc * cw[3072 + cc + e];
          val[e] = siluf_(y); ss += val[e] * val[e];
        }
        if (mtx < 2) { ss += __shfl_xor(ss, 1); ss += __shfl_xor(ss, 2); ss += __shfl_xor(ss, 4); const float sc = rsqrtf(ss + 1e-6f) * (mtx == 0 ? 0.08838834764831845f : 1.0f);
#pragma unroll
          for (int e = 0; e < 16; ++e) val[e] *= sc; }
        u32x4 w0, w1; w0.x = cvt_pk_bf16(val[0], val[1]); w0.y = cvt_pk_bf16(val[2], val[3]); w0.z = cvt_pk_bf16(val[4], val[5]); w0.w = cvt_pk_bf16(val[6], val[7]);
        w1.x = cvt_pk_bf16(val[8], val[9]); w1.y = cvt_pk_bf16(val[10], val[11]); w1.z = cvt_pk_bf16(val[12], val[13]); w1.w = cvt_pk_bf16(val[14], val[15]);
        if (mtx == 0) { bf16_t* o = QN + (size_t)r * 512 + h * 128 + c0; *(u32x4*)o = w0; *(u32x4*)(o + 8) = w1; }
        else if (mtx == 1) { bf16_t* o = KN + (size_t)r * 512 + h * 128 + c0; *(u32x4*)o = w0; *(u32x4*)(o + 8) = w1;
          ldsst<u32x4>(L, KSB + row * 272 + c0 * 2, w0); ldsst<u32x4>(L, KSB + row * 272 + c0 * 2 + 16, w1);
#pragma unroll
          for (int e = 0; e < 16; ++e) { const unsigned wv = e < 8 ? w0[e >> 1] : w1[(e - 8) >> 1]; ldsst<bf16_t>(L, KTL + (c0 + e) * 144 + row * 2, (bf16_t)((e & 1) ? (wv >> 16) : (wv & 0xffffu))); } }
        else {
#pragma unroll
          for (int e = 0; e < 16; ++e) { const unsigned wv = e < 8 ? w0[e >> 1] : w1[(e - 8) >> 1]; ldsst<bf16_t>(L, VTL + (c0 + e) * 144 + row * 2, (bf16_t)((e & 1) ? (wv >> 16) : (wv & 0xffffu))); } }
      }
    }
    if (wid < 2) {
      const int d = wid, r = R0 + lane;
      const float braw = AB[(size_t)r * 16 + d * 4 + h], araw = AB[(size_t)r * 16 + 8 + d * 4 + h];
      const float beta = sigmoidf_(braw);
      const float xs = araw + p.dt_bias[(l * 2 + d) * 4 + h];
      const float sp = fmaxf(xs, 0.f) + log1pf(__expf(-fabsf(xs)));
      const float g = -__expf(p.a_log[(l * 2 + d) * 4 + h]) * sp;
      float pre = g;
#pragma unroll
      for (int o = 1; o < 64; o <<= 1) { const float t2 = __shfl_up(pre, o); if (lane >= o) pre += t2; }
      const float tot = __shfl(pre, 63);
      const float gc = d == 0 ? pre : (tot - pre + g);
      ldsst<float>(L, GCL + (d * 64 + lane) * 4, gc); ldsst<float>(L, BTL + (d * 64 + lane) * 4, beta);
      GC[((size_t)item * 2 + d) * 64 + lane] = gc;
    }
    __syncthreads();
    { const int ti = wid >> 1;
#pragma unroll
      for (int q = 0; q < 2; ++q) { const int tj = 2 * (wid & 1) + q; f32x4 a = {0.f, 0.f, 0.f, 0.f};
#pragma unroll
        for (int kk = 0; kk < 4; ++kk) a = mma(ldsld<bf16x8>(L, KSB + (16 * tj + fr) * 272 + kk * 64 + fq * 16), ldsld<bf16x8>(L, KSB + (16 * ti + fr) * 272 + kk * 64 + fq * 16), a);
        ldsst<f32x4>(L, GL + ((16 * ti + fr) * 68 + 16 * tj + 4 * fq) * 4, a); }
    }
    {
#pragma unroll
      for (int it = 0; it < 2; ++it) { const int v = tid + 512 * it, c = v >> 3, sg = (v & 7) * 8;
        *(u32x4*)(KNT + (size_t)item * 8192 + c * 64 + sg) = ldsld<u32x4>(L, KTL + c * 144 + sg * 2);
        *(u32x4*)(VNT + (size_t)item * 8192 + c * 64 + sg) = ldsld<u32x4>(L, VTL + c * 144 + sg * 2); } }
    __syncthreads();
    { const int d = tid >> 8, a = (tid & 255) >> 2, jq = tid & 3;
      const int pi_ = d ? 63 - a : a; const float bi = ldsld<float>(L, BTL + (d * 64 + pi_) * 4), gi = ldsld<float>(L, GCL + (d * 64 + pi_) * 4);
#pragma unroll
      for (int e = 0; e < 16; ++e) { const int bb = jq * 16 + e, pr = d ? 63 - bb : bb;
        float v = 0.f;
        if (a > bb) v = bi * ldsld<float>(L, GL + (pi_ * 68 + pr) * 4) * __expf(gi - ldsld<float>(L, GCL + (d * 64 + pr) * 4));
        ldsst<float>(L, AL + ((d * 64 + a) * 64 + bb) * 4, v); } }
    __syncthreads();
    if (wid < 2) {
      const int d = wid, c = lane; constexpr int XL = 0;
#pragma unroll 1
      for (int bi = 0; bi < 4; ++bi) {
        float sv[16];
#pragma unroll
        for (int ii = 0; ii < 16; ++ii) sv[ii] = (16 * bi + ii == c) ? 1.f : 0.f;
#pragma unroll 1
        for (int j = 0; j < 16 * bi; j += 4) {
          float xj[4];
#pragma unroll
          for (int e = 0; e < 4; ++e) xj[e] = ldsld<float>(L, XL + ((d * 64 + j + e) * 64 + c) * 4);
#pragma unroll
          for (int ii = 0; ii < 16; ++ii) { const f32x4 av = ldsld<f32x4>(L, AL + ((d * 64 + 16 * bi + ii) * 64 + j) * 4); sv[ii] -= av[0] * xj[0] + av[1] * xj[1] + av[2] * xj[2] + av[3] * xj[3]; }
        }
        float xb[16];
#pragma unroll
        for (int ii = 0; ii < 16; ++ii) {
          float t = sv[ii];
#pragma unroll
          for (int j4 = 0; j4 < (ii + 3) / 4; ++j4) { const f32x4 av = ldsld<f32x4>(L, AL + ((d * 64 + 16 * bi + ii) * 64 + 16 * bi + j4 * 4) * 4);
#pragma unroll
            for (int e = 0; e < 4; ++e) if (j4 * 4 + e < ii) t -= av[e] * xb[j4 * 4 + e]; }
          xb[ii] = t;
          ldsst<float>(L, XL + ((d * 64 + 16 * bi + ii) * 64 + c) * 4, t);
        }
      }
      const int pr = d ? 63 - c : c; const float bc = ldsld<float>(L, BTL + (d * 64 + pr) * 4), fw = bc * __expf(ldsld<float>(L, GCL + (d * 64 + pr) * 4));
#pragma unroll 4
      for (int i = 0; i < 64; ++i) { const int pp = d ? 63 - i : i; const float xi = ldsld<float>(L, XL + ((d * 64 + i) * 64 + c) * 4);
        ldsst<bf16_t>(L, TOL + ((d * 2 + 0) * 64 + pp) * 144 + pr * 2, (bf16_t)(cvt_pk_bf16(xi * fw, 0.f) & 0xffffu));
        ldsst<bf16_t>(L, TOL + ((d * 2 + 1) * 64 + pp) * 144 + pr * 2, (bf16_t)(cvt_pk_bf16(xi * bc, 0.f) & 0xffffu)); }
    }
    __syncthreads();
#pragma unroll
    for (int it = 0; it < 4; ++it) { const int v = tid + 512 * it, mtx = v >> 9, row = (v >> 3) & 63, sg = (v & 7) * 8;
      *(u32x4*)(TT + ((size_t)item * 4 + mtx) * 4096 + row * 64 + sg) = ldsld<u32x4>(L, TOL + (mtx * 64 + row) * 144 + sg * 2); }
    __syncthreads();
  }
}

__device__ void fourier_prep(const Params& p, ldsp L) {
  const int tid = otid(), lane = tid & 63, wid = tid >> 6, fr = lane & 15, fq = lane >> 4;
  constexpr int UA = 0, UB = 33792, DC = 67584;
  const bf16_t* FI = (const bf16_t*)(lws(p.ws) + O_FI); bf16_t* FBT = (bf16_t*)(lws(p.ws) + O_FBT); float* UCS = (float*)(lws(p.ws) + O_UCS);
  for (int idx = tid; idx < 128 * 64; idx += NTHR) { const int rr = idx >> 6, c = idx & 63, m = rr & 63; const float a = (float)((m * c) & 63) * (1.0f / 32.0f);
    const float v = (rr < 64 ? cospif(a) : sinpif(a)) * 0.125f; ldsst<bf16_t>(L, DC + rr * 144 + c * 2, (bf16_t)(cvt_pk_bf16(v, 0.f) & 0xffffu)); }
  __syncthreads();
  for (int item = blockIdx.x; item < 288; item += gridDim.x) {
    const bool lat = item < 256; const int b = lat ? item >> 5 : 0, jb = item & 31;
#pragma unroll
    for (int it = 0; it < 4; ++it) { const int v = tid + 512 * it, row = v >> 5, sg = (v & 31) * 8;
      int ra, rb;
      if (lat) { const int t = 64 * jb + row; ra = b * 4096 + t; rb = b * 4096 + (t == 0 ? 2048 : 4096 - t); } else { ra = RLAT + (item - 256) * 64 + row; rb = ra; }
      ldsst<u32x4>(L, UA + row * 528 + sg * 2, *(const u32x4*)(FI + (size_t)ra * 256 + sg));
      ldsst<u32x4>(L, UB + row * 528 + sg * 2, *(const u32x4*)(FI + (size_t)rb * 256 + sg)); }
    __syncthreads();
    for (int q = 0; q < 8; ++q) {
      const int combo = wid * 8 + q, g = combo >> 4, ti = (combo >> 2) & 3, tm = combo & 3;
      f32x4 ac = {0.f, 0.f, 0.f, 0.f}, as = ac, bc = ac, bs = ac;
#pragma unroll
      for (int kk = 0; kk < 2; ++kk) {
        const bf16x8 xa = ldsld<bf16x8>(L, UA + (16 * ti + fr) * 528 + (g * 64 + kk * 32 + fq * 8) * 2), xb = ldsld<bf16x8>(L, UB + (16 * ti + fr) * 528 + (g * 64 + kk * 32 + fq * 8) * 2);
        const bf16x8 yc = ldsld<bf16x8>(L, DC + (16 * tm + fr) * 144 + kk * 64 + fq * 16), ys = ldsld<bf16x8>(L, DC + (64 + 16 * tm + fr) * 144 + kk * 64 + fq * 16);
        ac = mma(xa, yc, ac); as = mma(xa, ys, as); bc = mma(xb, yc, bc); bs = mma(xb, ys, bs);
      }
      const int mp = g * 64 + 16 * tm + fr, i0 = 16 * ti + 4 * fq;
      if (lat) {
        f32x4 cv = ac + bc, sv = as - bs;
        if (jb == 0 && i0 == 0) { cv[0] = ac[0]; sv[0] = bc[0]; }
        bf16_t* o = FBT + ((size_t)b * 256 + mp) * 4096 + 64 * jb + i0;
        *(u32x2*)o = pack4(cv); *(u32x2*)(o + 2048) = pack4(sv);
      } else {
#pragma unroll
        for (int e = 0; e < 4; ++e) { float* o = UCS + (size_t)((item - 256) * 64 + i0 + e) * 512; o[mp] = ac[e]; o[256 + mp] = as[e]; }
      }
    }
    __syncthreads();
  }
}

__device__ void ctx_fourier(const Params& p, ldsp L, int wg, int nwg) {
  const int tid = otid(); const float* UCS = (const float*)(lws(p.ws) + O_UCS); bf16_t* PPF = (bf16_t*)(lws(p.ws) + O_PPF);
  for (int idx = tid; idx < 256; idx += NTHR) { const float a = (float)idx * (1.0f / 128.0f); ldsst<float>(L, idx * 4, cospif(a) * (1.0f / 16.0f)); ldsst<float>(L, 1024 + idx * 4, sinpif(a) * (1.0f / 16.0f)); }
  __syncthreads();
  for (int o = wg * NTHR + tid; o < NB * 256 * 256; o += nwg * NTHR) {
    const int mp = o & 255, k = (o >> 8) & 255, b = o >> 16; const float* u = UCS + (size_t)b * 256 * 512 + mp; float s = 0.f;
#pragma unroll 4
    for (int t = 0; t < 256; ++t) { const int r = (k * t) & 255; s += ldsld<float>(L, r * 4) * u[(size_t)t * 512] - ldsld<float>(L, 1024 + r * 4) * u[(size_t)t * 512 + 256]; }
    PPF[(size_t)(RLAT + b * 256 + k) * 512 + 256 + mp] = (bf16_t)(cvt_pk_bf16(s, 0.f) & 0xffffu);
  }
  __syncthreads();
}
__device__ void pool_phase(const Params& p, int wg, int nwg) {
  const int tid_ = otid(), lane = tid_ & 63, gw = wg * 8 + (tid_ >> 6), nw = nwg * 8;
  const bf16_t* PI = (const bf16_t*)(lws(p.ws) + O_PI); bf16_t* PPF = (bf16_t*)(lws(p.ws) + O_PPF);
  for (int r = gw; r < ROWS; r += nw) {
    const bool lat = r < RLAT; const int base = lat ? (r & ~4095) : (r & ~255), t = r - base;
    const int nr = lat ? 64 : 1, ncl = lat ? 64 : 256, ri = lat ? t >> 6 : 0, ci = lat ? t & 63 : t;
#pragma unroll
    for (int g = 0; g < 4; ++g) {
      const int win = 2 << g, hw = win >> 1;
      const int sr = max(ri - hw, 0), er = min(ri - hw + win, nr), sc = max(ci - hw, 0), ec = min(ci - hw + win, ncl);
      float s = 0.f;
      for (int rr = sr; rr < er; ++rr) for (int c = sc; c < ec; ++c) s += __uint_as_float((unsigned)PI[(size_t)(base + rr * ncl + c) * 256 + g * 64 + lane] << 16);
      const float self = __uint_as_float((unsigned)PI[(size_t)r * 256 + g * 64 + lane] << 16);
      const float v = s / (float)((er - sr) * (ec - sc)) - self;
      PPF[(size_t)r * 512 + g * 64 + lane] = (bf16_t)(cvt_pk_bf16(v, 0.f) & 0xffffu);
    }
  }
}

__device__ void scan_phase(const Params& p, ldsp L, int item) {
  const int tid = otid(), lane = tid & 63, wid = tid >> 6, fr = lane & 15, fq = lane >> 4;
  const int es = item & 1, d = (item >> 1) & 1, h = (item >> 2) & 3, b = item >> 4;
  const int ti = wid >> 1, half = wid & 1;
  constexpr int QS = 0, KS = 17408, KTS = 34816, VTS = 53248, TW = 62464, TU = 71680, AT = 80896, WL = 90112, VNT_ = 107520, VNS = 116736, STL = 125952, GCL = 143360;
  const bf16_t* QN = (const bf16_t*)(lws(p.ws) + O_QN); const bf16_t* KN = (const bf16_t*)(lws(p.ws) + O_KN); const bf16_t* KNT = (const bf16_t*)(lws(p.ws) + O_KNT); const bf16_t* VNT = (const bf16_t*)(lws(p.ws) + O_VNT);
  const bf16_t* TT = (const bf16_t*)(lws(p.ws) + O_TT); const float* GC = (const float*)(lws(p.ws) + O_GC); bf16_t* O = (bf16_t*)(lws(p.ws) + O_O) + (size_t)d * ROWS * 512;
  for (int o = tid * 16; o < 17408; o += NTHR * 16) ldsst<u32x4>(L, STL + o, (u32x4){0, 0, 0, 0});
  f32x4 accS[4];
#pragma unroll
  for (int q = 0; q < 4; ++q) accS[q] = (f32x4){0.f, 0.f, 0.f, 0.f};
  u32x4 rq[2], rk[2], rkt[2], rvt, rtw, rtu; float rgc = 0.f;
#define SCAN_CHUNK(s) ((s) < 4 ? (NB * 64 + b * 4 + (d ? 3 - (s) : (s))) : (b * 64 + (d ? 67 - (s) : (s) - 4)))
#define SCAN_GLOAD(s) do { const int n_ = SCAN_CHUNK(s), it2_ = n_ * 4 + h; \
    _Pragma("unroll") for (int it = 0; it < 2; ++it) { const int v = tid + 512 * it; \
      rq[it] = *(const u32x4*)(QN + (size_t)(64 * n_ + (v >> 4)) * 512 + h * 128 + (v & 15) * 8); rk[it] = *(const u32x4*)(KN + (size_t)(64 * n_ + (v >> 4)) * 512 + h * 128 + (v & 15) * 8); \
      rkt[it] = *(const u32x4*)(KNT + (size_t)it2_ * 8192 + (v >> 3) * 64 + (v & 7) * 8); } \
    rvt = *(const u32x4*)(VNT + (size_t)it2_ * 8192 + (es * 64 + (tid >> 3)) * 64 + (tid & 7) * 8); \
    rtw = *(const u32x4*)(TT + ((size_t)it2_ * 4 + d * 2 + 0) * 4096 + (tid >> 3) * 64 + (tid & 7) * 8); rtu = *(const u32x4*)(TT + ((size_t)it2_ * 4 + d * 2 + 1) * 4096 + (tid >> 3) * 64 + (tid & 7) * 8); \
    if (tid < 64) rgc = GC[((size_t)it2_ * 2 + d) * 64 + tid]; } while (0)
#define SCAN_LSTORE() do { \
    _Pragma("unroll") for (int it = 0; it < 2; ++it) { const int v = tid + 512 * it; \
      ldsst<u32x4>(L, QS + (v >> 4) * 272 + (v & 15) * 16, rq[it]); ldsst<u32x4>(L, KS + (v >> 4) * 272 + (v & 15) * 16, rk[it]); ldsst<u32x4>(L, KTS + (v >> 3) * 144 + (v & 7) * 16, rkt[it]); } \
    ldsst<u32x4>(L, VTS + (tid >> 3) * 144 + (tid & 7) * 16, rvt); ldsst<u32x4>(L, TW + (tid >> 3) * 144 + (tid & 7) * 16, rtw); ldsst<u32x4>(L, TU + (tid >> 3) * 144 + (tid & 7) * 16, rtu); \
    if (tid < 64) ldsst<float>(L, GCL + tid * 4, rgc); } while (0)
  SCAN_GLOAD(0); SCAN_LSTORE(); __syncthreads();
  for (int s = 0; s < 68; ++s) {
    const int n = SCAN_CHUNK(s);
    if (s + 1 < 68) SCAN_GLOAD(s + 1);
    const float gtot = ldsld<float>(L, GCL + (d ? 0 : 63) * 4);
    f32x4 uacc[2], qacc[2];
#pragma unroll
    for (int q = 0; q < 2; ++q) {
      const int tj = 2 * half + q; f32x4 a = {0.f, 0.f, 0.f, 0.f};
#pragma unroll
      for (int kk = 0; kk < 4; ++kk) a = mma(ldsld<bf16x8>(L, KS + (16 * tj + fr) * 272 + kk * 64 + fq * 16), ldsld<bf16x8>(L, QS + (16 * ti + fr) * 272 + kk * 64 + fq * 16), a);
      const int i = 16 * ti + fr, j0 = 16 * tj + 4 * fq; const float gi = ldsld<float>(L, GCL + i * 4);
#pragma unroll
      for (int e = 0; e < 4; ++e) { const int j = j0 + e; const bool keep = d ? (i <= j) : (i >= j); const float ar = keep ? gi - ldsld<float>(L, GCL + j * 4) : 0.f; a[e] = keep ? a[e] * __expf(ar) : 0.f; }
      ldsst<u32x2>(L, AT + i * 144 + j0 * 2, pack4(a));
    }
#pragma unroll
    for (int q = 0; q < 4; ++q) {
      const int tc = 4 * half + q; f32x4 a = {0.f, 0.f, 0.f, 0.f};
#pragma unroll
      for (int kk = 0; kk < 2; ++kk) a = mma(ldsld<bf16x8>(L, KTS + (16 * tc + fr) * 144 + kk * 64 + fq * 16), ldsld<bf16x8>(L, TW + (16 * ti + fr) * 144 + kk * 64 + fq * 16), a);
      ldsst<u32x2>(L, WL + (16 * ti + fr) * 272 + (16 * tc + 4 * fq) * 2, pack4(a));
    }
#pragma unroll
    for (int q = 0; q < 2; ++q) {
      const int te = 2 * half + q; f32x4 a = {0.f, 0.f, 0.f, 0.f}, c = a;
#pragma unroll
      for (int kk = 0; kk < 2; ++kk) a = mma(ldsld<bf16x8>(L, TU + (16 * ti + fr) * 144 + kk * 64 + fq * 16), ldsld<bf16x8>(L, VTS + (16 * te + fr) * 144 + kk * 64 + fq * 16), a);
#pragma unroll
      for (int kk = 0; kk < 4; ++kk) c = mma(ldsld<bf16x8>(L, STL + (16 * te + fr) * 272 + kk * 64 + fq * 16), ldsld<bf16x8>(L, QS + (16 * ti + fr) * 272 + kk * 64 + fq * 16), c);
      uacc[q] = a; qacc[q] = c;
    }
    __syncthreads();
#pragma unroll
    for (int q = 0; q < 2; ++q) {
      const int te = 2 * half + q; f32x4 a = {0.f, 0.f, 0.f, 0.f};
#pragma unroll
      for (int kk = 0; kk < 4; ++kk) a = mma(ldsld<bf16x8>(L, WL + (16 * ti + fr) * 272 + kk * 64 + fq * 16), ldsld<bf16x8>(L, STL + (16 * te + fr) * 272 + kk * 64 + fq * 16), a);
      const f32x4 vn = uacc[q] - a; f32x4 vs;
      const int i0 = 16 * ti + 4 * fq;
#pragma unroll
      for (int e = 0; e < 4; ++e) vs[e] = vn[e] * __expf(gtot - ldsld<float>(L, GCL + (i0 + e) * 4));
      ldsst<u32x2>(L, VNT_ + (16 * te + fr) * 144 + i0 * 2, pack4(vn)); ldsst<u32x2>(L, VNS + (16 * te + fr) * 144 + i0 * 2, pack4(vs));
    }
    __syncthreads();
#pragma unroll
    for (int q = 0; q < 2; ++q) {
      const int te = 2 * half + q; f32x4 a = {0.f, 0.f, 0.f, 0.f};
#pragma unroll
      for (int kk = 0; kk < 2; ++kk) a = mma(ldsld<bf16x8>(L, VNT_ + (16 * te + fr) * 144 + kk * 64 + fq * 16), ldsld<bf16x8>(L, AT + (16 * ti + fr) * 144 + kk * 64 + fq * 16), a);
      const int i = 16 * ti + fr; const float eg = __expf(ldsld<float>(L, GCL + i * 4));
      const f32x4 ov = qacc[q] * eg + a;
      *(u32x2*)(O + (size_t)(64 * n + i) * 512 + h * 128 + es * 64 + 16 * te + 4 * fq) = pack4(ov);
    }
    { const float cd = __expf(gtot);
#pragma unroll
      for (int q = 0; q < 4; ++q) {
        const int tc = 4 * half + q; f32x4 a = accS[q] * cd;
#pragma unroll
        for (int kk = 0; kk < 2; ++kk) a = mma(ldsld<bf16x8>(L, KTS + (16 * tc + fr) * 144 + kk * 64 + fq * 16), ldsld<bf16x8>(L, VNS + (16 * ti + fr) * 144 + kk * 64 + fq * 16), a);
        accS[q] = a;
      }
    }
    __syncthreads();
#pragma unroll
    for (int q = 0; q < 4; ++q) ldsst<u32x2>(L, STL + (16 * ti + fr) * 272 + (16 * (4 * half + q) + 4 * fq) * 2, pack4(accS[q]));
    if (s + 1 < 68) SCAN_LSTORE();
    __syncthreads();
  }
#undef SCAN_CHUNK
#undef SCAN_GLOAD
#undef SCAN_LSTORE
}

__device__ void ofprep_phase(const Params& p, int l) {
  const int tid_ = otid(), lane = tid_ & 63, gw = blockIdx.x * 8 + (tid_ >> 6), nw = gridDim.x * 8;
  const bf16_t* O0 = (const bf16_t*)(lws(p.ws) + O_O); const bf16_t* O1 = O0 + (size_t)ROWS * 512; const bf16_t* Z = (const bf16_t*)(lws(p.ws) + O_Z); bf16_t* OF = (bf16_t*)(lws(p.ws) + O_OF);
  const float* og = p.o_gain + (size_t)l * 128 + (lane & 15) * 8;
  for (int r = gw; r < ROWS; r += nw) {
    const u32x4 a = *(const u32x4*)(O0 + (size_t)r * 512 + lane * 8), bq = *(const u32x4*)(O1 + (size_t)r * 512 + lane * 8), zq = *(const u32x4*)(Z + (size_t)r * 512 + lane * 8);
    float o[8]; float ss = 0.f;
#pragma unroll
    for (int e = 0; e < 4; ++e) { o[2 * e] = bflo(a[e]) + bflo(bq[e]); o[2 * e + 1] = bfhi(a[e]) + bfhi(bq[e]); ss += o[2 * e] * o[2 * e] + o[2 * e + 1] * o[2 * e + 1]; }
    ss += __shfl_xor(ss, 1); ss += __shfl_xor(ss, 2); ss += __shfl_xor(ss, 4); ss += __shfl_xor(ss, 8);
    const float rstd = rsqrtf(ss * (1.0f / 128.0f) + 1e-6f);
    float y[8];
#pragma unroll
    for (int e = 0; e < 4; ++e) { y[2 * e] = o[2 * e] * rstd * og[2 * e] * siluf_(bflo(zq[e])); y[2 * e + 1] = o[2 * e + 1] * rstd * og[2 * e + 1] * siluf_(bfhi(zq[e])); }
    u32x4 w; w.x = cvt_pk_bf16(y[0], y[1]); w.y = cvt_pk_bf16(y[2], y[3]); w.z = cvt_pk_bf16(y[4], y[5]); w.w = cvt_pk_bf16(y[6], y[7]);
    *(u32x4*)(OF + (size_t)r * 512 + lane * 8) = w;
  }
}


__device__ __forceinline__ float rdb(const bf16_t* s_, size_t n, size_t i) { float a = 0.f; for (size_t j = i; j < n; j += (size_t)RLAT * DM) a += __uint_as_float((unsigned)s_[j] << 16); return a; }
__device__ __forceinline__ float rdf(const float* s_, size_t n, size_t i) { float a = 0.f; for (size_t j = i; j < n; j += (size_t)RLAT * DM) a += s_[j]; return a; }
__device__ void dump_phase(const Params& p, int which) {
  const size_t NO = (size_t)RLAT * DM; unsigned char* ws = lws(p.ws);
  for (size_t i = (size_t)blockIdx.x * NTHR + otid(); i < NO; i += (size_t)gridDim.x * NTHR) {
    float a = 0.f;
    if (which == 1) { a = rdb((const bf16_t*)(ws + O_QKV), (size_t)ROWS * 1536, i) + rdb((const bf16_t*)(ws + O_Z), (size_t)ROWS * 512, i) + rdb((const bf16_t*)(ws + O_PI), (size_t)ROWS * 256, i) + rdb((const bf16_t*)(ws + O_FI), (size_t)ROWS * 256, i) + rdf((const float*)(ws + O_AB), (size_t)ROWS * 16, i); }
    if (which == 2) { a = rdb((const bf16_t*)(ws + O_QN), (size_t)ROWS * 512, i) + rdb((const bf16_t*)(ws + O_KN), (size_t)ROWS * 512, i) + rdb((const bf16_t*)(ws + O_KNT), (size_t)ROWS * 512, i) + rdb((const bf16_t*)(ws + O_VNT), (size_t)ROWS * 512, i) + rdb((const bf16_t*)(ws + O_TT), (size_t)ROWS * 1024, i) + rdf((const float*)(ws + O_GC), (size_t)NCH * 4 * 2 * 64, i)
          + rdb((const bf16_t*)(ws + O_FBT), (size_t)NB * 256 * 4096, i) + rdf((const float*)(ws + O_UCS), (size_t)NB * CTX * 512, i); }
    if (which == 3) { a = rdb((const bf16_t*)(ws + O_O), (size_t)ROWS * 1024, i); }
    if (which == 4) { a = rdb((const bf16_t*)(ws + O_OF), (size_t)ROWS * 512, i) + rdb((const bf16_t*)(ws + O_HN), (size_t)ROWS * 1024, i); }
    if (which == 5) { a = rdb((const bf16_t*)(ws + O_MRG), (size_t)ROWS * 1024, i); }
    if ((__float_as_uint(a) & 0xffff0000u) == 0xaaaa0000u) a = 1234.5f;
    if (!(a == a) || fabsf(a) > 1e30f) a = 777.0f;
    a = a * 0.5f + 0.12345678f;
    p.out[i] = a;
  }
}
__global__ void __launch_bounds__(NTHR) fwd_megakernel(Params p) {
  extern __shared__ __attribute__((aligned(16))) unsigned char shm[];
  ldsp L = (ldsp)shm;
  cg::grid_group grid = cg::this_grid();
#define GSYNC() do { asm volatile("s_waitcnt vmcnt(0) lgkmcnt(0)" ::: "memory"); __builtin_amdgcn_fence(__ATOMIC_RELEASE, "agent"); grid.sync(); __builtin_amdgcn_fence(__ATOMIC_ACQUIRE, "agent"); } while (0)
  const int G = gridDim.x, c = blockIdx.x;
#define X ((float*)(lws(p.ws) + O_X))
#define MOD ((const float*)(lws(p.ws) + O_MOD))
#define Hn ((bf16_t*)(lws(p.ws) + O_HN))
#ifndef NO_P0
  phase0(p, L);
#endif
  GSYNC();
  for (int l = 0; l < DEPTH; ++l) {
    const float* modl = MOD + (size_t)l * 9 * 9216; const float* ng = p.norm_gain + (size_t)l * 3 * 1024;
    convert_ffn(p, p.w1gu + (size_t)l * 1024 * 2 * DFF, p.w1d + (size_t)l * DFF * 1024, L);
    convert_mixer(p, l, L);
    norm_phase(X, Hn, ng, modl, 0, 1);
    GSYNC();
    { pg8::PlainSched S{(const char*)Hn, (const char*)(lws(p.ws) + O_WGU), 2048, 2048, 16, ROWS / 256, 22, G, c}; EpiUp E{(bf16_t*)(lws(p.ws) + O_ACT)}; pg8::gemm_phase(L, S, E); }
    GSYNC();
    { pg8::PlainSched S{(const char*)(lws(p.ws) + O_ACT), (const char*)(lws(p.ws) + O_WD), DFF * 2, DFF * 2, DFF / 64, ROWS / 256, 4, G, c}; EpiRes E{X, modl, 2, 0.5f}; pg8::gemm_phase(L, S, E); }
    GSYNC();
#ifndef NO_MIXER
    norm_phase(X, Hn, ng + 1024, modl, 3, 4);
    GSYNC();
    { pg8::PlainSched S{(const char*)Hn, (const char*)(lws(p.ws) + O_WIN), 2048, 2048, 16, ROWS / 256, NINP / 256, G, c};
      EpiIn E{(bf16_t*)(lws(p.ws) + O_QKV), (bf16_t*)(lws(p.ws) + O_Z), (bf16_t*)(lws(p.ws) + O_PI), (bf16_t*)(lws(p.ws) + O_FI), (float*)(lws(p.ws) + O_AB)}; pg8::gemm_phase(L, S, E); }
    GSYNC();
#ifndef NO_PREP
    prep_phase(p, l, L);
#endif
#ifndef NO_FPREP
    fourier_prep(p, L);
#endif
    GSYNC();
#if defined(DUMP) && DUMP == 2
    dump_phase(p, 2); return;
#endif
#ifndef NO_SCAN
    if (c < 128) scan_phase(p, L, c);
#else
    if (c < 128) {}
#endif
    else {
      { FourSched S{(const char*)(lws(p.ws) + O_DFT), (const char*)(lws(p.ws) + O_FBT), c - 128}; EpiBf E{(bf16_t*)(lws(p.ws) + O_PPF) + 256, 512}; pg8::gemm_phase(L, S, E); }
      __syncthreads();
      ctx_fourier(p, L, c - 128, G - 128);
      pool_phase(p, c - 128, G - 128);
    }
    GSYNC();
#if defined(DUMP) && DUMP == 3
    dump_phase(p, 3); return;
#endif
    ofprep_phase(p, l);
    norm_phase(X, Hn, ng + 1024, modl, 3, 4);
    GSYNC();
#if defined(DUMP) && DUMP == 4
    dump_phase(p, 4); return;
#endif
    { MergeSched S{(const char*)Hn, (const char*)(lws(p.ws) + O_OF), (const char*)(lws(p.ws) + O_PPF), (const char*)(lws(p.ws) + O_WG), (const char*)(lws(p.ws) + O_WCAT), G, c};
      EpiMerge E{(float*)(lws(p.ws) + O_SCR) + (size_t)c * 2 * 65536, (bf16_t*)(lws(p.ws) + O_MRG)}; pg8::gemm_phase(L, S, E); }
    GSYNC();
#if defined(DUMP) && DUMP == 5
    dump_phase(p, 5); return;
#endif
    { pg8::PlainSched S{(const char*)(lws(p.ws) + O_MRG), (const char*)(lws(p.ws) + O_WOUT), 2048, 2048, 16, ROWS / 256, 4, G, c}; EpiRes E{X, modl, 5, 1.0f}; pg8::gemm_phase(L, S, E); }
    GSYNC();
#endif
    convert_ffn(p, p.w2gu + (size_t)l * 1024 * 2 * DFF, p.w2d + (size_t)l * DFF * 1024, L);
    norm_phase(X, Hn, ng + 2048, modl, 6, 7);
    GSYNC();
    { pg8::PlainSched S{(const char*)Hn, (const char*)(lws(p.ws) + O_WGU), 2048, 2048, 16, ROWS / 256, 22, G, c}; EpiUp E{(bf16_t*)(lws(p.ws) + O_ACT)}; pg8::gemm_phase(L, S, E); }
    GSYNC();
    { pg8::PlainSched S{(const char*)(lws(p.ws) + O_ACT), (const char*)(lws(p.ws) + O_WD), DFF * 2, DFF * 2, DFF / 64, ROWS / 256, 4, G, c}; EpiRes E{X, modl, 8, 0.5f}; pg8::gemm_phase(L, S, E); }
    GSYNC();
  }
  final_norm(X, p.out, p.final_gain);
}

extern "C" void kernel_launch(void* const* d_in, const int* in_sizes, int n_in, void* d_out, int out_size, void* d_ws, size_t ws_size, hipStream_t stream) {
  (void)in_sizes; (void)n_in; (void)out_size;
  if (ws_size < WS_NEED) { fprintf(stderr, "workspace too small: %zu < %zu\n", ws_size, (size_t)WS_NEED); return; }
  static int grid_blocks = 0;
  if (!grid_blocks) {
    (void)hipFuncSetAttribute((const void*)fwd_megakernel, hipFuncAttributeMaxDynamicSharedMemorySize, LDS_BYTES);
    int dev = 0, cus = 0, per_cu = 0; (void)hipGetDevice(&dev); (void)hipDeviceGetAttribute(&cus, hipDeviceAttributeMultiprocessorCount, dev);
    (void)hipOccupancyMaxActiveBlocksPerMultiprocessor(&per_cu, fwd_megakernel, NTHR, LDS_BYTES);
    grid_blocks = cus * (per_cu > 0 ? 1 : 0);
    if (grid_blocks != 256) fprintf(stderr, "unexpected grid %d (cus %d per_cu %d)\n", grid_blocks, cus, per_cu);
  }
  Params p{};
  const float** f = (const float**)&p;
  for (int i = 0; i < 22; ++i) f[i] = (const float*)d_in[i];
  p.out = (float*)d_out; p.ws = (unsigned char*)d_ws;
  void* args[] = {&p};
  hipError_t e = hipLaunchCooperativeKernel((void*)fwd_megakernel, dim3(grid_blocks), dim3(NTHR), args, LDS_BYTES, stream);
  if (e != hipSuccess) fprintf(stderr, "cooperative launch failed: %s (grid %d)\n", hipGetErrorString(e), grid_blocks);
}
```

```cpp
#include <hip/hip_runtime.h>
#include <hip/hip_cooperative_groups.h>
#include <cstdio>

namespace cg = cooperative_groups;

#define LAS __attribute__((address_space(3)))
typedef LAS unsigned char* ldsp;
typedef unsigned short bf16_t;
typedef short bf16x8 __attribute__((ext_vector_type(8)));
typedef float f32x4 __attribute__((ext_vector_type(4)));
typedef unsigned u32x4 __attribute__((ext_vector_type(4)));
typedef unsigned u32x2 __attribute__((ext_vector_type(2)));

constexpr int DM = 1024, NB = 8, SEQ = 4096, CTX = 256, DEPTH = 4;
constexpr int RLAT = NB * SEQ, ROWS = RLAT + NB * CTX;
constexpr int DFF = 2816, NMOD = 9, DPROJ = 5648;
constexpr int NCH = ROWS / 64;
constexpr int NINP = 2816;
constexpr int LDS_BYTES = 163840;
constexpr int NTHR = 512;

constexpr size_t al256(size_t x) { return (x + 255) & ~(size_t)255; }
constexpr size_t O_X = 0;
constexpr size_t O_MOD = O_X + (size_t)ROWS * DM * 4;
constexpr size_t O_DFT = al256(O_MOD + (size_t)DEPTH * 9 * 9216 * 4);
constexpr size_t O_WGU = O_DFT + (size_t)4096 * 4096 * 2;
constexpr size_t O_WD = O_WGU + (size_t)5632 * 1024 * 2;
constexpr size_t O_WIN = O_WD + (size_t)1024 * 2816 * 2;
constexpr size_t O_WG = O_WIN + (size_t)NINP * 1024 * 2;
constexpr size_t O_WCAT = O_WG + (size_t)3072 * 1024 * 2;
constexpr size_t O_WOUT = O_WCAT + (size_t)1024 * 1024 * 2;
constexpr size_t O_R = O_WOUT + (size_t)1024 * 1024 * 2;
constexpr size_t SZ_H = (size_t)ROWS * 1024 * 2;
constexpr size_t SZ_Q = (size_t)ROWS * 512 * 2;
constexpr size_t O_HN = O_R;
constexpr size_t O_ACT = O_R + SZ_H;
constexpr size_t O_QN = O_R;
constexpr size_t O_KN = O_R + SZ_Q;
constexpr size_t O_QKV = O_R + SZ_H;
constexpr size_t O_O = O_QKV;
constexpr size_t O_SCR = O_QKV;
constexpr size_t O_Z = O_QKV + (size_t)ROWS * 1536 * 2;
constexpr size_t O_PI = O_Z + SZ_Q;
constexpr size_t O_FI = O_PI + (size_t)ROWS * 256 * 2;
constexpr size_t O_AB = O_FI + (size_t)ROWS * 256 * 2;
constexpr size_t O_KNT = al256(O_AB + (size_t)ROWS * 16 * 4);
constexpr size_t O_VNT = O_KNT + SZ_Q;
constexpr size_t O_MRG = O_KNT;
constexpr size_t O_TT = O_VNT + SZ_Q;
constexpr size_t O_OF = O_TT;
constexpr size_t O_GC = O_TT + SZ_H;
constexpr size_t O_FBT = al256(O_GC + (size_t)NCH * 4 * 2 * 64 * 4);
constexpr size_t O_UCS = O_FBT + (size_t)NB * 256 * 4096 * 2;
constexpr size_t O_PPF = al256(O_UCS + (size_t)NB * CTX * 512 * 4);
constexpr size_t O_BAR = al256(O_PPF + SZ_Q);
constexpr size_t WS_NEED = O_BAR + 16384;
static_assert(O_SCR + (size_t)256 * 2 * 262144 <= O_PI, "merge scratch overlaps");

struct Params {
  const float *x, *c, *ctx, *c_ctx, *w_ada, *b_ada, *norm_gain, *w1gu, *w1d, *w2gu, *w2d, *w_in, *conv_w, *a_log, *dt_bias, *o_gain, *w_a, *w_b,
      *pool_scale, *w_c, *w_out, *final_gain;
  float* out;
  unsigned char* ws;
};

typedef float f32x2_ __attribute__((ext_vector_type(2)));
typedef __bf16 bf16x2_ __attribute__((ext_vector_type(2)));
__device__ __forceinline__ unsigned cvt_pk_bf16(float lo, float hi) { const f32x2_ v = {lo, hi}; const bf16x2_ b = __builtin_convertvector(v, bf16x2_); return __builtin_bit_cast(unsigned, b); }
__device__ __forceinline__ float bflo(unsigned w) { return __uint_as_float(w << 16); }
__device__ __forceinline__ float bfhi(unsigned w) { return __uint_as_float(w & 0xffff0000u); }
__device__ __forceinline__ float sigmoidf_(float x) { return 1.0f / (1.0f + __expf(-x)); }
__device__ __forceinline__ float siluf_(float x) { return x / (1.0f + __expf(-x)); }
template <class T> __device__ __forceinline__ T ldsld(ldsp b, int off) { return *(const LAS T*)(b + off); }
template <class T> __device__ __forceinline__ void ldsst(ldsp b, int off, T v) { *(LAS T*)(b + off) = v; }
__device__ __forceinline__ f32x4 mma(bf16x8 a, bf16x8 b, f32x4 c) { return __builtin_amdgcn_mfma_f32_16x16x32_bf16(a, b, c, 0, 0, 0); }
__device__ __forceinline__ u32x2 pack4(f32x4 v) { u32x2 r; r.x = cvt_pk_bf16(v[0], v[1]); r.y = cvt_pk_bf16(v[2], v[3]); return r; }
__device__ __forceinline__ int otid() { int t = threadIdx.x; asm volatile("" : "+v"(t)); return t; }
__device__ __forceinline__ unsigned char* lws(unsigned char* q) { asm volatile("" : "+s"(q)); return q; }
__device__ __forceinline__ int modidx(int pm) { return pm < 128 ? (pm >> 4) : 8; }

namespace pg8 {
constexpr int BM = 256, BK = 64, HALF = 128, HTB = HALF * BK * 2, NXCD = 8, WGM = 8;
__device__ __forceinline__ int lds_byte(int r, int c) { const int st = (r >> 4) * 2 + (c >> 5), rr = r & 15, cc = c & 31, ob = rr * 64 + cc * 2; return st * 1024 + (ob ^ (((ob >> 9) & 1) << 5)); }
__device__ __forceinline__ void stage_rc(int b, int& R, int& C) { const int st = b / 1024, sb = b % 1024, swz = sb ^ (((sb >> 9) & 1) << 5); R = (st >> 1) * 16 + swz / 64; C = (st & 1) * 32 + (swz % 64) / 2; }
__device__ __forceinline__ int perm32(int rho) { const int n = rho >> 4, i = rho & 15; return 8 * (i >> 2) + 4 * n + (i & 3); }

struct Unit { const char* A; const char* B; int lda, ldb, nt, pm, pn, seg; };

__device__ __forceinline__ bool tile_of(int nM, int nN, int G, int c, int i, int& pm, int& pn) {
  const int nwg = nM * nN; const long Lq = (long)i * G + c; if (Lq >= nwg) return false;
  int wgid = (int)Lq; { const int q = nwg / NXCD, r = nwg % NXCD, xcd = wgid % NXCD, off = wgid / NXCD; wgid = (xcd < r ? xcd * (q + 1) : r * (q + 1) + (xcd - r) * q) + off; }
  const int nig = WGM * nN, gid = wgid / nig, fm = gid * WGM, gsz = (nM - fm) < WGM ? (nM - fm) : WGM;
  pm = fm + ((wgid % nig) % gsz); pn = (wgid % nig) / gsz; return true;
}
struct PlainSched {
  static constexpr bool VARLDA = false;
  const char* A; const char* B; int lda, ldb, nt, nM, nN, G, c;
  __device__ __forceinline__ bool next(int i, Unit& u) const {
    int pm, pn; if (!tile_of(nM, nN, G, c, i, pm, pn)) return false;
    u.A = A + (size_t)pm * 256 * lda; u.B = B + (size_t)pn * 256 * ldb; u.lda = lda; u.ldb = ldb; u.nt = nt; u.pm = pm; u.pn = pn; u.seg = 0; return true;
  }
};

template <class Epi, class Sched>
__device__ __forceinline__ void gemm_phase(ldsp lds, const Sched& S, const Epi& E) {
  const int tid = otid(), wid = __builtin_amdgcn_readfirstlane(tid >> 6), lane = tid & 63, wr = wid >> 2, wc = wid & 3, fr = lane & 15, fq = lane >> 4;
  unsigned rA[2], rB[2], c2[2];
#pragma unroll
  for (int i = 0; i < 2; ++i) { int R, C; stage_rc(tid * 16 + i * 8192, R, C); rA[i] = (unsigned)R; rB[i] = (unsigned)(Epi::PERM ? ((R & ~31) + perm32(R & 31)) : R); c2[i] = (unsigned)C * 2u; }
  const size_t kstep = (size_t)(BK * 2);
  const unsigned ldsw = (unsigned)wid * 1024u;
  const int aoff = lds_byte(wr * 64 + fr, fq * 8), boff = lds_byte(wc * 32 + fr, fq * 8);
#define PG8_SA(b, h) (((b) * 2 + (h)) * HTB)
#define PG8_SB(b, h) ((4 + (b) * 2 + (h)) * HTB)
#define PG8_STAGE(bufoff, gbase, voff) do { _Pragma("unroll") for (int _i = 0; _i < 2; ++_i) \
    __builtin_amdgcn_global_load_lds((const unsigned*)((const char*)(gbase) + (voff)[_i]), (LAS unsigned*)(lds + (bufoff) + ldsw + _i * 8192), 16, 0, 0); } while (0)
#define PG8_LDA(dst, b, h) do { _Pragma("unroll") for (int m = 0; m < 4; ++m) _Pragma("unroll") for (int k = 0; k < 2; ++k) dst[m][k] = *(const LAS bf16x8*)(lds + PG8_SA(b, h) + aoff + m * 2048 + k * 1024); } while (0)
#define PG8_LDB(dst, b, h) do { _Pragma("unroll") for (int n = 0; n < 2; ++n) _Pragma("unroll") for (int k = 0; k < 2; ++k) dst[n][k] = *(const LAS bf16x8*)(lds + PG8_SB(b, h) + boff + n * 2048 + k * 1024); } while (0)
#define PG8_MMA(ai, bj, At, Bt) do { __builtin_amdgcn_s_setprio(1); _Pragma("unroll") for (int m = 0; m < 4; ++m) _Pragma("unroll") for (int n = 0; n < 2; ++n) _Pragma("unroll") for (int k = 0; k < 2; ++k) \
    acc[ai][bj][m][n] = __builtin_amdgcn_mfma_f32_16x16x32_bf16(Bt[n][k], At[m][k], acc[ai][bj][m][n], 0, 0, 0); __builtin_amdgcn_s_setprio(0); } while (0)
#define PG8_WAIT_V(n) asm volatile("s_waitcnt vmcnt(" #n ")" ::: "memory")
#define PG8_WAIT_L(n) asm volatile("s_waitcnt lgkmcnt(" #n ")" ::: "memory")
#define PG8_BAR __builtin_amdgcn_s_barrier()
#define PG8_SCHED __builtin_amdgcn_sched_barrier(0)
  Unit cur, nxt; int ui = 0;
  if (!S.next(0, cur)) return;
  f32x4 acc[2][2][4][2];
#pragma unroll
  for (int a = 0; a < 2; ++a)
#pragma unroll
    for (int b = 0; b < 2; ++b)
#pragma unroll
      for (int m = 0; m < 4; ++m)
#pragma unroll
        for (int n = 0; n < 2; ++n) acc[a][b][m][n] = (f32x4){0.f, 0.f, 0.f, 0.f};
  bf16x8 At[4][2], B0[2][2], B1[2][2];
  const char* cA = cur.A; const char* cB = cur.B; int ldA = cur.lda; const int ldB = cur.ldb;
  unsigned voffA[2], voffB[2];
#pragma unroll
  for (int i = 0; i < 2; ++i) { voffA[i] = rA[i] * (unsigned)ldA + c2[i]; voffB[i] = rB[i] * (unsigned)ldB + c2[i]; }
  const size_t hB = (size_t)HALF * ldB;
  {
    const size_t hA = (size_t)HALF * ldA;
    PG8_STAGE(PG8_SB(0, 0), cB, voffB); PG8_STAGE(PG8_SA(0, 0), cA, voffA); PG8_STAGE(PG8_SB(0, 1), cB + hB, voffB); PG8_STAGE(PG8_SA(0, 1), cA + hA, voffA);
    if (wr == 1) PG8_BAR;
    PG8_WAIT_V(4); PG8_BAR;
    PG8_STAGE(PG8_SB(1, 0), cB + kstep, voffB); PG8_STAGE(PG8_SA(1, 0), cA + kstep, voffA); PG8_STAGE(PG8_SB(1, 1), cB + hB + kstep, voffB);
    PG8_WAIT_V(6); PG8_BAR;
  }
  for (;;) {
    const bool has_next = S.next(ui + 1, nxt);
    const char* nA = has_next ? nxt.A : cA; const char* nB = has_next ? nxt.B : cB;
    const int nldA = has_next ? nxt.lda : ldA;
    const int nt = cur.nt;
    const size_t hA = (size_t)HALF * ldA;
    for (int t = 0; t < nt; t += 2) {
      const bool last = (t == nt - 2);
      const char* a1 = cA + (size_t)(t + 1) * kstep;
      const char* a2 = last ? nA : cA + (size_t)(t + 2) * kstep; const char* b2 = last ? nB : cB + (size_t)(t + 2) * kstep;
      const size_t h2A = (size_t)HALF * (last ? nldA : ldA);
      const char* a3 = a2 + kstep; const char* b3 = b2 + kstep;
      PG8_LDB(B0, 0, 0); PG8_SCHED; PG8_LDA(At, 0, 0); PG8_STAGE(PG8_SA(1, 1), a1 + hA, voffA);
      if (Sched::VARLDA) { if (last) {
#pragma unroll
        for (int i = 0; i < 2; ++i) voffA[i] = rA[i] * (unsigned)nldA + c2[i]; } }
      PG8_WAIT_L(8); PG8_BAR; PG8_WAIT_L(0); PG8_MMA(0, 0, At, B0); PG8_BAR; PG8_SCHED;
      PG8_LDB(B1, 0, 1); PG8_STAGE(PG8_SB(0, 0), b2, voffB);
      PG8_BAR; PG8_WAIT_L(0); PG8_MMA(0, 1, At, B1); PG8_BAR;
      PG8_LDA(At, 0, 1); PG8_STAGE(PG8_SA(0, 0), a2, voffA);
      PG8_BAR; PG8_WAIT_L(0); PG8_MMA(1, 0, At, B0); PG8_BAR; PG8_SCHED;
      PG8_STAGE(PG8_SB(0, 1), b2 + hB, voffB);
      PG8_WAIT_V(6); PG8_BAR; PG8_MMA(1, 1, At, B1); PG8_BAR;
      PG8_LDB(B0, 1, 0); PG8_SCHED; PG8_LDA(At, 1, 0); PG8_STAGE(PG8_SA(0, 1), a2 + h2A, voffA);
      PG8_WAIT_L(8); PG8_BAR; PG8_WAIT_L(0); PG8_MMA(0, 0, At, B0); PG8_BAR; PG8_SCHED;
      PG8_LDB(B1, 1, 1); PG8_STAGE(PG8_SB(1, 0), b3, voffB);
      PG8_BAR; PG8_WAIT_L(0); PG8_MMA(0, 1, At, B1); PG8_BAR;
      PG8_LDA(At, 1, 1); PG8_STAGE(PG8_SA(1, 0), a3, voffA);
      PG8_BAR; PG8_WAIT_L(0); PG8_MMA(1, 0, At, B0); PG8_BAR; PG8_SCHED;
      PG8_STAGE(PG8_SB(1, 1), b3 + hB, voffB);
      PG8_WAIT_V(6); PG8_BAR; PG8_MMA(1, 1, At, B1); PG8_BAR;
    }
    E(acc, cur, wr, wc, fr, fq);
    if (!has_next) break;
#pragma unroll
    for (int a = 0; a < 2; ++a)
#pragma unroll
      for (int b = 0; b < 2; ++b)
#pragma unroll
        for (int m = 0; m < 4; ++m)
#pragma unroll
          for (int n = 0; n < 2; ++n) acc[a][b][m][n] = (f32x4){0.f, 0.f, 0.f, 0.f};
    cur = nxt; cA = nA; cB = nB; ldA = nldA; ++ui;
  }
  PG8_WAIT_V(0);
  if (wr == 0) PG8_BAR;
  PG8_BAR;
#undef PG8_SA
#undef PG8_SB
#undef PG8_STAGE
#undef PG8_LDA
#undef PG8_LDB
#undef PG8_MMA
#undef PG8_WAIT_V
#undef PG8_WAIT_L
#undef PG8_BAR
#undef PG8_SCHED
}
}
using pg8::Unit;
typedef f32x4 AccT[2][2][4][2];

struct EpiUp {
  static constexpr bool PERM = true;
  bf16_t* act;
  __device__ __forceinline__ void operator()(const AccT& acc, const Unit& u, int wr, int wc, int fr, int fq) const {
    const int row0 = u.pm * 256 + wr * 64 + fr, col0 = u.pn * 128 + wc * 32 + 8 * fq;
#pragma unroll
    for (int ai = 0; ai < 2; ++ai)
#pragma unroll
      for (int m = 0; m < 4; ++m) {
        const f32x4 a0 = acc[ai][0][m][0], a1 = acc[ai][0][m][1], u0 = acc[ai][1][m][0], u1 = acc[ai][1][m][1];
        u32x4 w;
        w.x = cvt_pk_bf16(siluf_(a0[0]) * u0[0], siluf_(a0[1]) * u0[1]); w.y = cvt_pk_bf16(siluf_(a0[2]) * u0[2], siluf_(a0[3]) * u0[3]);
        w.z = cvt_pk_bf16(siluf_(a1[0]) * u1[0], siluf_(a1[1]) * u1[1]); w.w = cvt_pk_bf16(siluf_(a1[2]) * u1[2], siluf_(a1[3]) * u1[3]);
        *(u32x4*)(act + (size_t)(row0 + ai * 128 + m * 16) * DFF + col0) = w;
      }
  }
};
struct EpiRes {
  static constexpr bool PERM = false;
  float* X; const float* modl; int gidx; float scale;
  __device__ __forceinline__ void operator()(const AccT& acc, const Unit& u, int wr, int wc, int fr, int fq) const {
    const int row0 = u.pm * 256 + wr * 64 + fr, col0 = u.pn * 256 + wc * 32 + 4 * fq;
    const float* g = modl + (size_t)(modidx(u.pm) * 9 + gidx) * 1024 + col0;
    f32x4 gv[2][2];
#pragma unroll
    for (int bj = 0; bj < 2; ++bj)
#pragma unroll
      for (int n = 0; n < 2; ++n) gv[bj][n] = *(const f32x4*)(g + bj * 128 + n * 16) * scale;
#pragma unroll
    for (int ai = 0; ai < 2; ++ai)
#pragma unroll
      for (int m = 0; m < 4; ++m) {
        float* rowp = X + (size_t)(row0 + ai * 128 + m * 16) * DM + col0;
#pragma unroll
        for (int bj = 0; bj < 2; ++bj)
#pragma unroll
          for (int n = 0; n < 2; ++n) { f32x4* q = (f32x4*)(rowp + bj * 128 + n * 16); *q = *q + gv[bj][n] * acc[ai][bj][m][n]; }
      }
  }
};
struct EpiIn {
  static constexpr bool PERM = true;
  bf16_t *qkv, *z, *pi, *fi; float* ab;
  __device__ __forceinline__ void operator()(const AccT& acc, const Unit& u, int wr, int wc, int fr, int fq) const {
    const int row0 = u.pm * 256 + wr * 64 + fr;
    if (u.pn == 10) {
      if (wc == 0 && fq < 2) {
#pragma unroll
        for (int ai = 0; ai < 2; ++ai)
#pragma unroll
          for (int m = 0; m < 4; ++m) {
            float* rp = ab + (size_t)(row0 + ai * 128 + m * 16) * 16 + 8 * fq;
            *(f32x4*)(rp) = acc[ai][0][m][0]; *(f32x4*)(rp + 4) = acc[ai][0][m][1];
          }
      }
      return;
    }
    bf16_t* base; int ld, ct;
    if (u.pn < 6) { base = qkv; ld = 1536; ct = u.pn * 256; } else if (u.pn < 8) { base = z; ld = 512; ct = (u.pn - 6) * 256; } else if (u.pn == 8) { base = pi; ld = 256; ct = 0; } else { base = fi; ld = 256; ct = 0; }
    const int col0 = ct + wc * 32 + 8 * fq;
#pragma unroll
    for (int ai = 0; ai < 2; ++ai)
#pragma unroll
      for (int m = 0; m < 4; ++m) {
        bf16_t* rowp = base + (size_t)(row0 + ai * 128 + m * 16) * ld + col0;
#pragma unroll
        for (int bj = 0; bj < 2; ++bj) { const f32x4 v0 = acc[ai][bj][m][0], v1 = acc[ai][bj][m][1]; u32x4 w; w.x = cvt_pk_bf16(v0[0], v0[1]); w.y = cvt_pk_bf16(v0[2], v0[3]); w.z = cvt_pk_bf16(v1[0], v1[1]); w.w = cvt_pk_bf16(v1[2], v1[3]);
          *(u32x4*)(rowp + bj * 128) = w; }
      }
  }
};
struct EpiBf {
  static constexpr bool PERM = true;
  bf16_t* O; int ld;
  __device__ __forceinline__ void operator()(const AccT& acc, const Unit& u, int wr, int wc, int fr, int fq) const {
    const int row0 = u.pm * 256 + wr * 64 + fr, col0 = u.pn * 256 + wc * 32 + 8 * fq;
#pragma unroll
    for (int ai = 0; ai < 2; ++ai)
#pragma unroll
      for (int m = 0; m < 4; ++m) {
        bf16_t* rowp = O + (size_t)(row0 + ai * 128 + m * 16) * ld + col0;
#pragma unroll
        for (int bj = 0; bj < 2; ++bj) { const f32x4 v0 = acc[ai][bj][m][0], v1 = acc[ai][bj][m][1]; u32x4 w; w.x = cvt_pk_bf16(v0[0], v0[1]); w.y = cvt_pk_bf16(v0[2], v0[3]); w.z = cvt_pk_bf16(v1[0], v1[1]); w.w = cvt_pk_bf16(v1[2], v1[3]);
          *(u32x4*)(rowp + bj * 128) = w; }
      }
  }
};
struct EpiMerge {
  static constexpr bool PERM = true;
  float* scr;
  bf16_t* mrg;
  __device__ __forceinline__ void operator()(const AccT& acc, const Unit& u, int wr, int wc, int fr, int fq) const {
    const int tid_ = otid(); f32x4* S1 = (f32x4*)scr + tid_; f32x4* Mx = (f32x4*)scr + 32 * 512 + tid_;
    const int seg = u.seg;
    if ((seg & 1) == 0) {
#pragma unroll
      for (int ai = 0; ai < 2; ++ai)
#pragma unroll
        for (int bj = 0; bj < 2; ++bj)
#pragma unroll
          for (int m = 0; m < 4; ++m)
#pragma unroll
            for (int n = 0; n < 2; ++n) { const f32x4 v = acc[ai][bj][m][n]; f32x4 s; s[0] = sigmoidf_(v[0]); s[1] = sigmoidf_(v[1]); s[2] = sigmoidf_(v[2]); s[3] = sigmoidf_(v[3]);
              S1[(((ai * 2 + bj) * 4 + m) * 2 + n) * 512] = s; }
    } else if (seg < 5) {
#pragma unroll
      for (int ai = 0; ai < 2; ++ai)
#pragma unroll
        for (int bj = 0; bj < 2; ++bj)
#pragma unroll
          for (int m = 0; m < 4; ++m)
#pragma unroll
            for (int n = 0; n < 2; ++n) { const int ix = (((ai * 2 + bj) * 4 + m) * 2 + n) * 512; f32x4 t = S1[ix] * acc[ai][bj][m][n]; if (seg == 3) t = t + Mx[ix]; Mx[ix] = t; }
    } else {
      const int row0 = u.pm * 256 + wr * 64 + fr, col0 = u.pn * 256 + wc * 32 + 8 * fq;
#pragma unroll
      for (int ai = 0; ai < 2; ++ai)
#pragma unroll
        for (int m = 0; m < 4; ++m) {
          bf16_t* rowp = mrg + (size_t)(row0 + ai * 128 + m * 16) * DM + col0;
#pragma unroll
          for (int bj = 0; bj < 2; ++bj) {
            const int i0 = (((ai * 2 + bj) * 4 + m) * 2 + 0) * 512, i1 = i0 + 512;
            const f32x4 v0 = S1[i0] * acc[ai][bj][m][0] + Mx[i0], v1 = S1[i1] * acc[ai][bj][m][1] + Mx[i1];
            u32x4 w; w.x = cvt_pk_bf16(v0[0], v0[1]); w.y = cvt_pk_bf16(v0[2], v0[3]); w.z = cvt_pk_bf16(v1[0], v1[1]); w.w = cvt_pk_bf16(v1[2], v1[3]);
            *(u32x4*)(rowp + bj * 128) = w;
          }
        }
    }
  }
};
struct MergeSched {
  static constexpr bool VARLDA = true;
  const char *hn, *of, *ppf, *wg, *wcat; int G, c;
  __device__ __forceinline__ bool next(int i, Unit& u) const {
    const int round = i / 6, seg = i - round * 6; int pm, pn; if (!pg8::tile_of(ROWS / 256, 4, G, c, round, pm, pn)) return false;
    const int br = seg >> 1;
    u.pm = pm; u.pn = pn; u.seg = seg; u.ldb = 2048;
    if ((seg & 1) == 0) { u.A = hn + (size_t)pm * 256 * 2048; u.lda = 2048; u.B = wg + (size_t)(br * 1024 + pn * 256) * 2048; u.nt = 16; }
    else {
      u.lda = 1024;
      if (br == 0) { u.A = of + (size_t)pm * 256 * 1024; u.B = wcat + (size_t)pn * 256 * 2048; u.nt = 8; }
      else if (br == 1) { u.A = ppf + (size_t)pm * 256 * 1024; u.B = wcat + (size_t)pn * 256 * 2048 + 512 * 2; u.nt = 4; }
      else { u.A = ppf + (size_t)pm * 256 * 1024 + 256 * 2; u.B = wcat + (size_t)pn * 256 * 2048 + 768 * 2; u.nt = 4; }
    }
    return true;
  }
};
struct FourSched {
  static constexpr bool VARLDA = false;
  const char *dft, *fbt; int c;
  __device__ __forceinline__ bool next(int i, Unit& u) const {
    if (i > 0) return false;
    const int b = c >> 4, pm = c & 15;
    u.A = dft + (size_t)pm * 256 * 8192; u.B = fbt + (size_t)b * 256 * 8192; u.lda = 8192; u.ldb = 8192; u.nt = 64; u.pm = b * 16 + pm; u.pn = 0; u.seg = 0; return true;
  }
};

template <class F>
__device__ __forceinline__ void convT(const float* W, int ldw, int K, int nrows, bf16_t* dst, int ldd, int k0d, F srccol, ldsp L, int& cursor) {
  const int tid = otid(), ntk = K >> 6, ntiles = (nrows >> 6) * ntk;
  for (int t = 0; t < ntiles; ++t) {
    if (((cursor + t) % (int)gridDim.x) != (int)blockIdx.x) continue;
    const int tr = t / ntk, tk = t - tr * ntk, r0 = tr * 64, kk0 = tk * 64;
    const int i = tid & 63, sc = srccol(r0 + i);
#pragma unroll
    for (int it = 0; it < 8; ++it) { const int kk = (tid >> 6) + 8 * it; const float v = sc >= 0 ? W[(size_t)(kk0 + kk) * ldw + sc] : 0.f; ldsst<float>(L, (kk * 65 + i) * 4, v); }
    __syncthreads();
    { const int ii = tid >> 3, kv = (tid & 7) * 8; float v[8];
#pragma unroll
      for (int e = 0; e < 8; ++e) v[e] = ldsld<float>(L, ((kv + e) * 65 + ii) * 4);
      u32x4 w; w.x = cvt_pk_bf16(v[0], v[1]); w.y = cvt_pk_bf16(v[2], v[3]); w.z = cvt_pk_bf16(v[4], v[5]); w.w = cvt_pk_bf16(v[6], v[7]);
      *(u32x4*)(dst + (size_t)(r0 + ii) * ldd + k0d + kk0 + kv) = w; }
    __syncthreads();
  }
  cursor += ntiles;
}

__device__ void convert_ffn(const Params& p, const float* wgu, const float* wd, ldsp L) {
  int cur = 0;
  convT(wgu, 2 * DFF, 1024, 2 * DFF, (bf16_t*)(lws(p.ws) + O_WGU), 1024, 0, [](int r) { const int t = r >> 8, q = r & 255; return q < 128 ? t * 128 + q : DFF + t * 128 + (q - 128); }, L, cur);
  convT(wd, 1024, DFF, 1024, (bf16_t*)(lws(p.ws) + O_WD), DFF, 0, [](int r) { return r; }, L, cur);
}
__device__ void convert_mixer(const Params& p, int l, ldsp L) {
  int cur = 0;
  const float* win = p.w_in + (size_t)l * 1024 * DPROJ;
  convT(win, DPROJ, 1024, NINP, (bf16_t*)(lws(p.ws) + O_WIN), 1024, 0, [](int r) { return r < 2048 ? r : (r < 2560 ? r + 16 : (r < 2576 ? r - 512 : -1)); }, L, cur);
  convT(win, DPROJ, 1024, 3072, (bf16_t*)(lws(p.ws) + O_WG), 1024, 0, [](int r) { return 2576 + r; }, L, cur);
  convT(p.w_a + (size_t)l * 512 * 1024, 1024, 512, 1024, (bf16_t*)(lws(p.ws) + O_WCAT), 1024, 0, [](int r) { return r; }, L, cur);
  convT(p.w_c + (size_t)l * 256 * 1024, 1024, 256, 1024, (bf16_t*)(lws(p.ws) + O_WCAT), 1024, 768, [](int r) { return r; }, L, cur);
  convT(p.w_out + (size_t)l * 1024 * 1024, 1024, 1024, 1024, (bf16_t*)(lws(p.ws) + O_WOUT), 1024, 0, [](int r) { return r; }, L, cur);
  const float* wb = p.w_b + (size_t)l * 4 * 64 * 256; const float* ps = p.pool_scale + (size_t)l * 1024; bf16_t* wcat = (bf16_t*)(lws(p.ws) + O_WCAT);
  for (int idx = blockIdx.x * NTHR + otid(); idx < 1024 * 256; idx += gridDim.x * NTHR) {
    const int row = idx & 1023, kk = idx >> 10, g = row >> 8;
    const float v = ((kk >> 6) == g) ? wb[((size_t)g * 64 + (kk & 63)) * 256 + (row & 255)] * ps[row] : 0.f;
    wcat[(size_t)row * 1024 + 512 + kk] = (bf16_t)(cvt_pk_bf16(v, 0.f) & 0xffffu);
  }
}

__device__ void norm_phase(const float* X, bf16_t* Hn, const float* gain, const float* modl, int ishift, int iscale) {
  const int tid_ = otid(), lane = tid_ & 63, gw = blockIdx.x * 8 + (tid_ >> 6), nw = gridDim.x * 8;
  for (int r = gw; r < ROWS; r += nw) {
    const int j = r < RLAT ? (r >> 12) : 8;
    const float* sh = modl + (size_t)(j * 9 + ishift) * 1024; const float* sc = modl + (size_t)(j * 9 + iscale) * 1024;
    const float* xr = X + (size_t)r * DM;
    f32x4 v[4]; float ss = 0.f;
#pragma unroll
    for (int i = 0; i < 2; ++i) { v[2 * i] = *(const f32x4*)(xr + lane * 8 + 512 * i); v[2 * i + 1] = *(const f32x4*)(xr + lane * 8 + 512 * i + 4); }
#pragma unroll
    for (int i = 0; i < 4; ++i) ss += v[i][0] * v[i][0] + v[i][1] * v[i][1] + v[i][2] * v[i][2] + v[i][3] * v[i][3];
#pragma unroll
    for (int o = 32; o >= 1; o >>= 1) ss += __shfl_xor(ss, o);
    const float rstd = rsqrtf(ss * (1.0f / 1024.0f) + 1e-6f);
#pragma unroll
    for (int i = 0; i < 2; ++i) {
      const int c0 = lane * 8 + 512 * i; float o[8];
#pragma unroll
      for (int hh = 0; hh < 2; ++hh) { const f32x4 g = *(const f32x4*)(gain + c0 + 4 * hh), s1 = *(const f32x4*)(sc + c0 + 4 * hh), s0 = *(const f32x4*)(sh + c0 + 4 * hh); const f32x4 y = v[2 * i + hh] * rstd * g * (s1 + 1.0f) + s0;
        o[4 * hh] = y[0]; o[4 * hh + 1] = y[1]; o[4 * hh + 2] = y[2]; o[4 * hh + 3] = y[3]; }
      u32x4 w; w.x = cvt_pk_bf16(o[0], o[1]); w.y = cvt_pk_bf16(o[2], o[3]); w.z = cvt_pk_bf16(o[4], o[5]); w.w = cvt_pk_bf16(o[6], o[7]);
      *(u32x4*)(Hn + (size_t)r * DM + c0) = w;
    }
  }
}
__device__ void final_norm(const float* X, float* out, const float* gain) {
  const int tid_ = otid(), lane = tid_ & 63, gw = blockIdx.x * 8 + (tid_ >> 6), nw = gridDim.x * 8;
  for (int r = gw; r < RLAT; r += nw) {
    const float* xr = X + (size_t)r * DM; f32x4 v[4]; float ss = 0.f;
#pragma unroll
    for (int i = 0; i < 4; ++i) { v[i] = *(const f32x4*)(xr + lane * 4 + 256 * i); ss += v[i][0] * v[i][0] + v[i][1] * v[i][1] + v[i][2] * v[i][2] + v[i][3] * v[i][3]; }
#pragma unroll
    for (int o = 32; o >= 1; o >>= 1) ss += __shfl_xor(ss, o);
    const float rstd = rsqrtf(ss * (1.0f / 1024.0f) + 1e-6f);
#pragma unroll
    for (int i = 0; i < 4; ++i) { const f32x4 g = *(const f32x4*)(gain + lane * 4 + 256 * i); *(f32x4*)(out + (size_t)r * DM + lane * 4 + 256 * i) = v[i] * rstd * g; }
  }
}

__device__ void phase0(const Params& p, ldsp L) {
  const int tid = otid(); const size_t gt = (size_t)blockIdx.x * NTHR + tid, gs = (size_t)gridDim.x * NTHR;
  { f32x4* X = (f32x4*)(lws(p.ws) + O_X); const f32x4* xs = (const f32x4*)p.x; const f32x4* cs = (const f32x4*)p.ctx; const size_t n1 = (size_t)RLAT * DM / 4, n2 = (size_t)ROWS * DM / 4;
    for (size_t i = gt; i < n2; i += gs) X[i] = i < n1 ? xs[i] : cs[i - n1]; }
  { bf16_t* D = (bf16_t*)(lws(p.ws) + O_DFT);
    for (size_t v = gt; v < (size_t)4096 * 512; v += gs) { const int k = (int)(v >> 9), j0 = (int)(v & 511) * 8; float o[8];
#pragma unroll
      for (int e = 0; e < 8; ++e) { const int j = j0 + e; const bool cs_ = j <= 2048; const int t = cs_ ? j : j - 2048; const int r = (k * t) & 4095; const float a = (float)r * (1.0f / 2048.0f);
        o[e] = cs_ ? cospif(a) * (1.0f / 64.0f) : -sinpif(a) * (1.0f / 64.0f); }
      u32x4 w; w.x = cvt_pk_bf16(o[0], o[1]); w.y = cvt_pk_bf16(o[2], o[3]); w.z = cvt_pk_bf16(o[4], o[5]); w.w = cvt_pk_bf16(o[6], o[7]);
      *(u32x4*)(D + (size_t)k * 4096 + j0) = w; } }
  for (int idx = tid; idx < 9 * 1024; idx += NTHR) { const int j = idx >> 10, k = idx & 1023; const float v = j < 8 ? p.c[j * 1024 + k] : p.c_ctx[k]; ldsst<float>(L, idx * 4, siluf_(v)); }
  __syncthreads();
  float* MOD = (float*)(lws(p.ws) + O_MOD);
  for (int item = blockIdx.x; item < DEPTH * 144; item += gridDim.x) {
    const int l = item / 144, n0 = (item - l * 144) * 64, ks = tid >> 6, cn = tid & 63;
    float acc[9];
#pragma unroll
    for (int j = 0; j < 9; ++j) acc[j] = 0.f;
    const float* wp = p.w_ada + ((size_t)l * 1024 + ks * 128) * 9216 + n0 + cn;
#pragma unroll 4
    for (int k = 0; k < 128; ++k) { const float w = wp[(size_t)k * 9216];
#pragma unroll
      for (int j = 0; j < 9; ++j) acc[j] += ldsld<float>(L, (j * 1024 + ks * 128 + k) * 4) * w; }
#pragma unroll
    for (int j = 0; j < 9; ++j) ldsst<float>(L, 36864 + ((ks * 9 + j) * 64 + cn) * 4, acc[j]);
    __syncthreads();
    for (int o = tid; o < 576; o += NTHR) { const int j = o >> 6, c = o & 63; float s = p.b_ada[(size_t)l * 9216 + n0 + c];
#pragma unroll
      for (int q = 0; q < 8; ++q) s += ldsld<float>(L, 36864 + ((q * 9 + j) * 64 + c) * 4);
      MOD[((size_t)l * 9 + j) * 9216 + n0 + c] = s; }
    __syncthreads();
  }
}

__device__ void prep_phase(const Params& p, int l, ldsp L) {
  const int tid = otid(), lane = tid & 63, wid = tid >> 6, fr = lane & 15, fq = lane >> 4;
  constexpr int KSB = 0, KTL = 17408, VTL = 35840, GL = 54272, AL = 71680, GCL = 104448, BTL = 104960, TOL = 105472;
  const bf16_t* QKV = (const bf16_t*)(lws(p.ws) + O_QKV); const float* AB = (const float*)(lws(p.ws) + O_AB);
  bf16_t* QN = (bf16_t*)(lws(p.ws) + O_QN); bf16_t* KN = (bf16_t*)(lws(p.ws) + O_KN); bf16_t* KNT = (bf16_t*)(lws(p.ws) + O_KNT); bf16_t* VNT = (bf16_t*)(lws(p.ws) + O_VNT);
  bf16_t* TT = (bf16_t*)(lws(p.ws) + O_TT); float* GC = (float*)(lws(p.ws) + O_GC);
  const float* cw = p.conv_w + (size_t)l * 3 * 1536;
  for (int item = blockIdx.x; item < NCH * 4; item += gridDim.x) {
    const int n = item >> 2, h = item & 3, R0 = n * 64;
    { const int row = tid >> 3, cs = tid & 7, r = R0 + row, c0 = cs * 16;
      const int t = r < RLAT ? (r & 4095) : ((r - RLAT) & 255), Ls = r < RLAT ? 4096 : 256;
      const bool hp = t > 0, hn = t < Ls - 1;
#pragma unroll
      for (int mtx = 0; mtx < 3; ++mtx) {
        const int cc = mtx * 512 + h * 128 + c0; const bf16_t* bp = QKV + (size_t)r * 1536 + cc;
        u32x4 a0 = {0, 0, 0, 0}, a1 = {0, 0, 0, 0}, c0v = {0, 0, 0, 0}, c1v = {0, 0, 0, 0};
        const u32x4 b0 = *(const u32x4*)(bp), b1 = *(const u32x4*)(bp + 8);
        if (hp) { a0 = *(const u32x4*)(bp - 1536); a1 = *(const u32x4*)(bp - 1536 + 8); }
        if (hn) { c0v = *(const u32x4*)(bp + 1536); c1v = *(const u32x4*)(bp + 1536 + 8); }
        float val[16]; float ss = 0.f;
#pragma unroll
        for (int e = 0; e < 16; ++e) {
          const unsigned wa = e < 8 ? a0[e >> 1] : a1[(e - 8) >> 1], wb = e < 8 ? b0[e >> 1] : b1[(e - 8) >> 1], wc_ = e < 8 ? c0v[e >> 1] : c1v[(e - 8) >> 1];
          const float xa = (e & 1) ? bfhi(wa) : bflo(wa), xb = (e & 1) ? bfhi(wb) : bflo(wb), xc = (e & 1) ? bfhi(wc_) : bflo(wc_);
          const float y = xa * cw[cc + e] + xb * cw[1536 + cc + e] + xc * cw[3072 + cc + e];
          val[e] = siluf_(y); ss += val[e] * val[e];
        }
        if (mtx < 2) { ss += __shfl_xor(ss, 1); ss += __shfl_xor(ss, 2); ss += __shfl_xor(ss, 4); const float sc = rsqrtf(ss + 1e-6f) * (mtx == 0 ? 0.08838834764831845f : 1.0f);
#pragma unroll
          for (int e = 0; e < 16; ++e) val[e] *= sc; }
        u32x4 w0, w1; w0.x = cvt_pk_bf16(val[0], val[1]); w0.y = cvt_pk_bf16(val[2], val[3]); w0.z = cvt_pk_bf16(val[4], val[5]); w0.w = cvt_pk_bf16(val[6], val[7]);
        w1.x = cvt_pk_bf16(val[8], val[9]); w1.y = cvt_pk_bf16(val[10], val[11]); w1.z = cvt_pk_bf16(val[12], val[13]); w1.w = cvt_pk_bf16(val[14], val[15]);
        if (mtx == 0) { bf16_t* o = QN + (size_t)r * 512 + h * 128 + c0; *(u32x4*)o = w0; *(u32x4*)(o + 8) = w1; }
        else if (mtx == 1) { bf16_t* o = KN + (size_t)r * 512 + h * 128 + c0; *(u32x4*)o = w0; *(u32x4*)(o + 8) = w1;
          ldsst<u32x4>(L, KSB + row * 272 + c0 * 2, w0); ldsst<u32x4>(L, KSB + row * 272 + c0 * 2 + 16, w1);
#pragma unroll
          for (int e = 0; e < 16; ++e) { const unsigned wv = e < 8 ? w0[e >> 1] : w1[(e - 8) >> 1]; ldsst<bf16_t>(L, KTL + (c0 + e) * 144 + row * 2, (bf16_t)((e & 1) ? (wv >> 16) : (wv & 0xffffu))); } }
        else {
#pragma unroll
          for (int e = 0; e < 16; ++e) { const unsigned wv = e < 8 ? w0[e >> 1] : w1[(e - 8) >> 1]; ldsst<bf16_t>(L, VTL + (c0 + e) * 144 + row * 2, (bf16_t)((e & 1) ? (wv >> 16) : (wv & 0xffffu))); } }
      }
    }
    if (wid < 2) {
      const int d = wid, r = R0 + lane;
      const float braw = AB[(size_t)r * 16 + d * 4 + h], araw = AB[(size_t)r * 16 + 8 + d * 4 + h];
      const float beta = sigmoidf_(braw);
      const float xs = araw + p.dt_bias[(l * 2 + d) * 4 + h];
      const float sp = fmaxf(xs, 0.f) + log1pf(__expf(-fabsf(xs)));
      const float g = -__expf(p.a_log[(l * 2 + d) * 4 + h]) * sp;
      float pre = g;
#pragma unroll
      for (int o = 1; o < 64; o <<= 1) { const float t2 = __shfl_up(pre, o); if (lane >= o) pre += t2; }
      const float tot = __shfl(pre, 63);
      const float gc = d == 0 ? pre : (tot - pre + g);
      ldsst<float>(L, GCL + (d * 64 + lane) * 4, gc); ldsst<float>(L, BTL + (d * 64 + lane) * 4, beta);
      GC[((size_t)item * 2 + d) * 64 + lane] = gc;
    }
    __syncthreads();
    { const int ti = wid >> 1;
#pragma unroll
      for (int q = 0; q < 2; ++q) { const int tj = 2 * (wid & 1) + q; f32x4 a = {0.f, 0.f, 0.f, 0.f};
#pragma unroll
        for (int kk = 0; kk < 4; ++kk) a = mma(ldsld<bf16x8>(L, KSB + (16 * tj + fr) * 272 + kk * 64 + fq * 16), ldsld<bf16x8>(L, KSB + (16 * ti + fr) * 272 + kk * 64 + fq * 16), a);
        ldsst<f32x4>(L, GL + ((16 * ti + fr) * 68 + 16 * tj + 4 * fq) * 4, a); }
    }
    {
#pragma unroll
      for (int it = 0; it < 2; ++it) { const int v = tid + 512 * it, c = v >> 3, sg = (v & 7) * 8;
        *(u32x4*)(KNT + (size_t)item * 8192 + c * 64 + sg) = ldsld<u32x4>(L, KTL + c * 144 + sg * 2);
        *(u32x4*)(VNT + (size_t)item * 8192 + c * 64 + sg) = ldsld<u32x4>(L, VTL + c * 144 + sg * 2); } }
    __syncthreads();
    { const int d = tid >> 8, a = (tid & 255) >> 2, jq = tid & 3;
      const int pi_ = d ? 63 - a : a; const float bi = ldsld<float>(L, BTL + (d * 64 + pi_) * 4), gi = ldsld<float>(L, GCL + (d * 64 + pi_) * 4);
#pragma unroll
      for (int e = 0; e < 16; ++e) { const int bb = jq * 16 + e, pr = d ? 63 - bb : bb;
        float v = 0.f;
        if (a > bb) v = bi * ldsld<float>(L, GL + (pi_ * 68 + pr) * 4) * __expf(gi - ldsld<float>(L, GCL + (d * 64 + pr) * 4));
        ldsst<float>(L, AL + ((d * 64 + a) * 64 + bb) * 4, v); } }
    __syncthreads();
    if (wid < 2) {
      const int d = wid, c = lane; constexpr int XL = 0;
#pragma unroll 1
      for (int bi = 0; bi < 4; ++bi) {
        float sv[16];
#pragma unroll
        for (int ii = 0; ii < 16; ++ii) sv[ii] = (16 * bi + ii == c) ? 1.f : 0.f;
#pragma unroll 1
        for (int j = 0; j < 16 * bi; j += 4) {
          float xj[4];
#pragma unroll
          for (int e = 0; e < 4; ++e) xj[e] = ldsld<float>(L, XL + ((d * 64 + j + e) * 64 + c) * 4);
#pragma unroll
          for (int ii = 0; ii < 16; ++ii) { const f32x4 av = ldsld<f32x4>(L, AL + ((d * 64 + 16 * bi + ii) * 64 + j) * 4); sv[ii] -= av[0] * xj[0] + av[1] * xj[1] + av[2] * xj[2] + av[3] * xj[3]; }
        }
        float xb[16];
#pragma unroll
        for (int ii = 0; ii < 16; ++ii) {
          float t = sv[ii];
#pragma unroll
          for (int j4 = 0; j4 < (ii + 3) / 4; ++j4) { const f32x4 av = ldsld<f32x4>(L, AL + ((d * 64 + 16 * bi + ii) * 64 + 16 * bi + j4 * 4) * 4);
#pragma unroll
            for (int e = 0; e < 4; ++e) if (j4 * 4 + e < ii) t -= av[e] * xb[j4 * 4 + e]; }
          xb[ii] = t;
          ldsst<float>(L, XL + ((d * 64 + 16 * bi + ii) * 64 + c) * 4, t);
        }
      }
      const int pr = d ? 63 - c : c; const float bc = ldsld<float>(L, BTL + (d * 64 + pr) * 4), fw = bc * __expf(ldsld<float>(L, GCL + (d * 64 + pr) * 4));
#pragma unroll 4
      for (int i = 0; i < 64; ++i) { const int pp = d ? 63 - i : i; const float xi = ldsld<float>(L, XL + ((d * 64 + i) * 64 + c) * 4);
        ldsst<bf16_t>(L, TOL + ((d * 2 + 0) * 64 + pp) * 144 + pr * 2, (bf16_t)(cvt_pk_bf16(xi * fw, 0.f) & 0xffffu));
        ldsst<bf16_t>(L, TOL + ((d * 2 + 1) * 64 + pp) * 144 + pr * 2, (bf16_t)(cvt_pk_bf16(xi * bc, 0.f) & 0xffffu)); }
    }
    __syncthreads();
#pragma unroll
    for (int it = 0; it < 4; ++it) { const int v = tid + 512 * it, mtx = v >> 9, row = (v >> 3) & 63, sg = (v & 7) * 8;
      *(u32x4*)(TT + ((size_t)item * 4 + mtx) * 4096 + row * 64 + sg) = ldsld<u32x4>(L, TOL + (mtx * 64 + row) * 144 + sg * 2); }
    __syncthreads();
  }
}

__device__ void fourier_prep(const Params& p, ldsp L) {
  const int tid = otid(), lane = tid & 63, wid = tid >> 6, fr = lane & 15, fq = lane >> 4;
  constexpr int UA = 0, UB = 33792, DC = 67584;
  const bf16_t* FI = (const bf16_t*)(lws(p.ws) + O_FI); bf16_t* FBT = (bf16_t*)(lws(p.ws) + O_FBT); float* UCS = (float*)(lws(p.ws) + O_UCS);
  for (int idx = tid; idx < 128 * 64; idx += NTHR) { const int rr = idx >> 6, c = idx & 63, m = rr & 63; const float a = (float)((m * c) & 63) * (1.0f / 32.0f);
    const float v = (rr < 64 ? cospif(a) : sinpif(a)) * 0.125f; ldsst<bf16_t>(L, DC + rr * 144 + c * 2, (bf16_t)(cvt_pk_bf16(v, 0.f) & 0xffffu)); }
  __syncthreads();
  for (int item = blockIdx.x; item < 288; item += gridDim.x) {
    const bool lat = item < 256; const int b = lat ? item >> 5 : 0, jb = item & 31;
#pragma unroll
    for (int it = 0; it < 4; ++it) { const int v = tid + 512 * it, row = v >> 5, sg = (v & 31) * 8;
      int ra, rb;
      if (lat) { const int t = 64 * jb + row; ra = b * 4096 + t; rb = b * 4096 + (t == 0 ? 2048 : 4096 - t); } else { ra = RLAT + (item - 256) * 64 + row; rb = ra; }
      ldsst<u32x4>(L, UA + row * 528 + sg * 2, *(const u32x4*)(FI + (size_t)ra * 256 + sg));
      ldsst<u32x4>(L, UB + row * 528 + sg * 2, *(const u32x4*)(FI + (size_t)rb * 256 + sg)); }
    __syncthreads();
    for (int q = 0; q < 8; ++q) {
      const int combo = wid * 8 + q, g = combo >> 4, ti = (combo >> 2) & 3, tm = combo & 3;
      f32x4 ac = {0.f, 0.f, 0.f, 0.f}, as = ac, bc = ac, bs = ac;
#pragma unroll
      for (int kk = 0; kk < 2; ++kk) {
        const bf16x8 xa = ldsld<bf16x8>(L, UA + (16 * ti + fr) * 528 + (g * 64 + kk * 32 + fq * 8) * 2), xb = ldsld<bf16x8>(L, UB + (16 * ti + fr) * 528 + (g * 64 + kk * 32 + fq * 8) * 2);
        const bf16x8 yc = ldsld<bf16x8>(L, DC + (16 * tm + fr) * 144 + kk * 64 + fq * 16), ys = ldsld<bf16x8>(L, DC + (64 + 16 * tm + fr) * 144 + kk * 64 + fq * 16);
        ac = mma(xa, yc, ac); as = mma(xa, ys, as); bc = mma(xb, yc, bc); bs = mma(xb, ys, bs);
      }
      const int mp = g * 64 + 16 * tm + fr, i0 = 16 * ti + 4 * fq;
      if (lat) {
        f32x4 cv = ac + bc, sv = as - bs;
        if (jb == 0 && i0 == 0) { cv[0] = ac[0]; sv[0] = bc[0]; }
        bf16_t* o = FBT + ((size_t)b * 256 + mp) * 4096 + 64 * jb + i0;
        *(u32x2*)o = pack4(cv); *(u32x2*)(o + 2048) = pack4(sv);
      } else {
#pragma unroll
        for (int e = 0; e < 4; ++e) { float* o = UCS + (size_t)((item - 256) * 64 + i0 + e) * 512; o[mp] = ac[e]; o[256 + mp] = as[e]; }
      }
    }
    __syncthreads();
  }
}

__device__ void ctx_fourier(const Params& p, ldsp L, int wg, int nwg) {
  const int tid = otid(); const float* UCS = (const float*)(lws(p.ws) + O_UCS); bf16_t* PPF = (bf16_t*)(lws(p.ws) + O_PPF);
  for (int idx = tid; idx < 256; idx += NTHR) { const float a = (float)idx * (1.0f / 128.0f); ldsst<float>(L, idx * 4, cospif(a) * (1.0f / 16.0f)); ldsst<float>(L, 1024 + idx * 4, sinpif(a) * (1.0f / 16.0f)); }
  __syncthreads();
  for (int o = wg * NTHR + tid; o < NB * 256 * 256; o += nwg * NTHR) {
    const int mp = o & 255, k = (o >> 8) & 255, b = o >> 16; const float* u = UCS + (size_t)b * 256 * 512 + mp; float s = 0.f;
#pragma unroll 4
    for (int t = 0; t < 256; ++t) { const int r = (k * t) & 255; s += ldsld<float>(L, r * 4) * u[(size_t)t * 512] - ldsld<float>(L, 1024 + r * 4) * u[(size_t)t * 512 + 256]; }
    PPF[(size_t)(RLAT + b * 256 + k) * 512 + 256 + mp] = (bf16_t)(cvt_pk_bf16(s, 0.f) & 0xffffu);
  }
  __syncthreads();
}
__device__ void pool_phase(const Params& p, ldsp L, int wg, int nwg) {
  const int tid_ = otid(), lane = tid_ & 63, wv = tid_ >> 6, gw = wg * 8 + wv, nw = nwg * 8;
  const bf16_t* PI = (const bf16_t*)(lws(p.ws) + O_PI); bf16_t* PPF = (bf16_t*)(lws(p.ws) + O_PPF);
  const int LP = wv * 16640;
  for (int idx = gw; idx < 2048; idx += nw) {
    const int g = 3 - (idx >> 9), b = (idx >> 6) & 7, r = idx & 63;
    const int win = 2 << g, hw = win >> 1, sr = max(r - hw, 0), er = min(r - hw + win, 64);
    const bf16_t* base = PI + (size_t)b * 4096 * 256 + g * 64 + lane;
    float run = 0.f;
    ldsst<float>(L, LP + lane * 4, 0.f);
    for (int c0 = 0; c0 < 64; c0 += 4) {
      float v0 = 0.f, v1 = 0.f, v2 = 0.f, v3 = 0.f;
      for (int rr = sr; rr < er; ++rr) { const bf16_t* q = base + (size_t)(rr * 64 + c0) * 256;
        v0 += __uint_as_float((unsigned)q[0] << 16); v1 += __uint_as_float((unsigned)q[256] << 16); v2 += __uint_as_float((unsigned)q[512] << 16); v3 += __uint_as_float((unsigned)q[768] << 16); }
      run += v0; ldsst<float>(L, LP + ((c0 + 1) * 64 + lane) * 4, run); run += v1; ldsst<float>(L, LP + ((c0 + 2) * 64 + lane) * 4, run);
      run += v2; ldsst<float>(L, LP + ((c0 + 3) * 64 + lane) * 4, run); run += v3; ldsst<float>(L, LP + ((c0 + 4) * 64 + lane) * 4, run);
    }
    const float rinv = 1.0f / (float)(er - sr);
#pragma unroll 4
    for (int c = 0; c < 64; ++c) {
      const int sc = max(c - hw, 0), ec = min(c - hw + win, 64);
      const float box = ldsld<float>(L, LP + (ec * 64 + lane) * 4) - ldsld<float>(L, LP + (sc * 64 + lane) * 4);
      const size_t rowi = (size_t)b * 4096 + r * 64 + c;
      const float self = __uint_as_float((unsigned)PI[rowi * 256 + g * 64 + lane] << 16);
      PPF[rowi * 512 + g * 64 + lane] = (bf16_t)(cvt_pk_bf16(box * rinv / (float)(ec - sc) - self, 0.f) & 0xffffu);
    }
  }
  for (int r = RLAT + gw; r < ROWS; r += nw) {
    const int base = r & ~255, t = r - base;
#pragma unroll
    for (int g = 0; g < 4; ++g) {
      const int win = 2 << g, hw = win >> 1, sc = max(t - hw, 0), ec = min(t - hw + win, 256);
      float s_ = 0.f;
      for (int c = sc; c < ec; ++c) s_ += __uint_as_float((unsigned)PI[(size_t)(base + c) * 256 + g * 64 + lane] << 16);
      const float self = __uint_as_float((unsigned)PI[(size_t)r * 256 + g * 64 + lane] << 16);
      PPF[(size_t)r * 512 + g * 64 + lane] = (bf16_t)(cvt_pk_bf16(s_ / (float)(ec - sc) - self, 0.f) & 0xffffu);
    }
  }
}

__device__ void scan_phase(const Params& p, ldsp L, int item) {
  const int tid = otid(), lane = tid & 63, wid = tid >> 6, fr = lane & 15, fq = lane >> 4;
  const int es = item & 1, d = (item >> 1) & 1, h = (item >> 2) & 3, b = item >> 4;
  const int ti = wid >> 1, half = wid & 1;
  constexpr int QS = 0, KS = 17408, KTS = 34816, VTS = 53248, TW = 62464, TU = 71680, AT = 80896, WL = 90112, VNT_ = 107520, VNS = 116736, STL = 125952, GCL = 143360;
  const bf16_t* QN = (const bf16_t*)(lws(p.ws) + O_QN); const bf16_t* KN = (const bf16_t*)(lws(p.ws) + O_KN); const bf16_t* KNT = (const bf16_t*)(lws(p.ws) + O_KNT); const bf16_t* VNT = (const bf16_t*)(lws(p.ws) + O_VNT);
  const bf16_t* TT = (const bf16_t*)(lws(p.ws) + O_TT); const float* GC = (const float*)(lws(p.ws) + O_GC); bf16_t* O = (bf16_t*)(lws(p.ws) + O_O) + (size_t)d * ROWS * 512;
  for (int o = tid * 16; o < 17408; o += NTHR * 16) ldsst<u32x4>(L, STL + o, (u32x4){0, 0, 0, 0});
  f32x4 accS[4];
#pragma unroll
  for (int q = 0; q < 4; ++q) accS[q] = (f32x4){0.f, 0.f, 0.f, 0.f};
  u32x4 rq[2], rk[2], rkt[2], rvt, rtw, rtu; float rgc = 0.f;
#define SCAN_CHUNK(s) ((s) < 4 ? (NB * 64 + b * 4 + (d ? 3 - (s) : (s))) : (b * 64 + (d ? 67 - (s) : (s) - 4)))
#define SCAN_GLOAD(s) do { const int n_ = SCAN_CHUNK(s), it2_ = n_ * 4 + h; \
    _Pragma("unroll") for (int it = 0; it < 2; ++it) { const int v = tid + 512 * it; \
      rq[it] = *(const u32x4*)(QN + (size_t)(64 * n_ + (v >> 4)) * 512 + h * 128 + (v & 15) * 8); rk[it] = *(const u32x4*)(KN + (size_t)(64 * n_ + (v >> 4)) * 512 + h * 128 + (v & 15) * 8); \
      rkt[it] = *(const u32x4*)(KNT + (size_t)it2_ * 8192 + (v >> 3) * 64 + (v & 7) * 8); } \
    rvt = *(const u32x4*)(VNT + (size_t)it2_ * 8192 + (es * 64 + (tid >> 3)) * 64 + (tid & 7) * 8); \
    rtw = *(const u32x4*)(TT + ((size_t)it2_ * 4 + d * 2 + 0) * 4096 + (tid >> 3) * 64 + (tid & 7) * 8); rtu = *(const u32x4*)(TT + ((size_t)it2_ * 4 + d * 2 + 1) * 4096 + (tid >> 3) * 64 + (tid & 7) * 8); \
    if (tid < 64) rgc = GC[((size_t)it2_ * 2 + d) * 64 + tid]; } while (0)
#define SCAN_LSTORE() do { \
    _Pragma("unroll") for (int it = 0; it < 2; ++it) { const int v = tid + 512 * it; \
      ldsst<u32x4>(L, QS + (v >> 4) * 272 + (v & 15) * 16, rq[it]); ldsst<u32x4>(L, KS + (v >> 4) * 272 + (v & 15) * 16, rk[it]); ldsst<u32x4>(L, KTS + (v >> 3) * 144 + (v & 7) * 16, rkt[it]); } \
    ldsst<u32x4>(L, VTS + (tid >> 3) * 144 + (tid & 7) * 16, rvt); ldsst<u32x4>(L, TW + (tid >> 3) * 144 + (tid & 7) * 16, rtw); ldsst<u32x4>(L, TU + (tid >> 3) * 144 + (tid & 7) * 16, rtu); \
    if (tid < 64) ldsst<float>(L, GCL + tid * 4, rgc); } while (0)
  SCAN_GLOAD(0); SCAN_LSTORE(); __syncthreads();
  for (int s = 0; s < 68; ++s) {
    const int n = SCAN_CHUNK(s);
    if (s + 1 < 68) SCAN_GLOAD(s + 1);
    const float gtot = ldsld<float>(L, GCL + (d ? 0 : 63) * 4);
    f32x4 uacc[2], qacc[2];
#pragma unroll
    for (int q = 0; q < 2; ++q) {
      const int tj = 2 * half + q; f32x4 a = {0.f, 0.f, 0.f, 0.f};
#pragma unroll
      for (int kk = 0; kk < 4; ++kk) a = mma(ldsld<bf16x8>(L, KS + (16 * tj + fr) * 272 + kk * 64 + fq * 16), ldsld<bf16x8>(L, QS + (16 * ti + fr) * 272 + kk * 64 + fq * 16), a);
      const int i = 16 * ti + fr, j0 = 16 * tj + 4 * fq; const float gi = ldsld<float>(L, GCL + i * 4);
#pragma unroll
      for (int e = 0; e < 4; ++e) { const int j = j0 + e; const bool keep = d ? (i <= j) : (i >= j); const float ar = keep ? gi - ldsld<float>(L, GCL + j * 4) : 0.f; a[e] = keep ? a[e] * __expf(ar) : 0.f; }
      ldsst<u32x2>(L, AT + i * 144 + j0 * 2, pack4(a));
    }
#pragma unroll
    for (int q = 0; q < 4; ++q) {
      const int tc = 4 * half + q; f32x4 a = {0.f, 0.f, 0.f, 0.f};
#pragma unroll
      for (int kk = 0; kk < 2; ++kk) a = mma(ldsld<bf16x8>(L, KTS + (16 * tc + fr) * 144 + kk * 64 + fq * 16), ldsld<bf16x8>(L, TW + (16 * ti + fr) * 144 + kk * 64 + fq * 16), a);
      ldsst<u32x2>(L, WL + (16 * ti + fr) * 272 + (16 * tc + 4 * fq) * 2, pack4(a));
    }
#pragma unroll
    for (int q = 0; q < 2; ++q) {
      const int te = 2 * half + q; f32x4 a = {0.f, 0.f, 0.f, 0.f}, c = a;
#pragma unroll
      for (int kk = 0; kk < 2; ++kk) a = mma(ldsld<bf16x8>(L, TU + (16 * ti + fr) * 144 + kk * 64 + fq * 16), ldsld<bf16x8>(L, VTS + (16 * te + fr) * 144 + kk * 64 + fq * 16), a);
#pragma unroll
      for (int kk = 0; kk < 4; ++kk) c = mma(ldsld<bf16x8>(L, STL + (16 * te + fr) * 272 + kk * 64 + fq * 16), ldsld<bf16x8>(L, QS + (16 * ti + fr) * 272 + kk * 64 + fq * 16), c);
      uacc[q] = a; qacc[q] = c;
    }
    __syncthreads();
#pragma unroll
    for (int q = 0; q < 2; ++q) {
      const int te = 2 * half + q; f32x4 a = {0.f, 0.f, 0.f, 0.f};
#pragma unroll
      for (int kk = 0; kk < 4; ++kk) a = mma(ldsld<bf16x8>(L, WL + (16 * ti + fr) * 272 + kk * 64 + fq * 16), ldsld<bf16x8>(L, STL + (16 * te + fr) * 272 + kk * 64 + fq * 16), a);
      const f32x4 vn = uacc[q] - a; f32x4 vs;
      const int i0 = 16 * ti + 4 * fq;
#pragma unroll
      for (int e = 0; e < 4; ++e) vs[e] = vn[e] * __expf(gtot - ldsld<float>(L, GCL + (i0 + e) * 4));
      ldsst<u32x2>(L, VNT_ + (16 * te + fr) * 144 + i0 * 2, pack4(vn)); ldsst<u32x2>(L, VNS + (16 * te + fr) * 144 + i0 * 2, pack4(vs));
    }
    __syncthreads();
#pragma unroll
    for (int q = 0; q < 2; ++q) {
      const int te = 2 * half + q; f32x4 a = {0.f, 0.f, 0.f, 0.f};
#pragma unroll
      for (int kk = 0; kk < 2; ++kk) a = mma(ldsld<bf16x8>(L, VNT_ + (16 * te + fr) * 144 + kk * 64 + fq * 16), ldsld<bf16x8>(L, AT + (16 * ti + fr) * 144 + kk * 64 + fq * 16), a);
      const int i = 16 * ti + fr; const float eg = __expf(ldsld<float>(L, GCL + i * 4));
      const f32x4 ov = qacc[q] * eg + a;
      *(u32x2*)(O + (size_t)(64 * n + i) * 512 + h * 128 + es * 64 + 16 * te + 4 * fq) = pack4(ov);
    }
    { const float cd = __expf(gtot);
#pragma unroll
      for (int q = 0; q < 4; ++q) {
        const int tc = 4 * half + q; f32x4 a = accS[q] * cd;
#pragma unroll
        for (int kk = 0; kk < 2; ++kk) a = mma(ldsld<bf16x8>(L, KTS + (16 * tc + fr) * 144 + kk * 64 + fq * 16), ldsld<bf16x8>(L, VNS + (16 * ti + fr) * 144 + kk * 64 + fq * 16), a);
        accS[q] = a;
      }
    }
    __syncthreads();
#pragma unroll
    for (int q = 0; q < 4; ++q) ldsst<u32x2>(L, STL + (16 * ti + fr) * 272 + (16 * (4 * half + q) + 4 * fq) * 2, pack4(accS[q]));
    if (s + 1 < 68) SCAN_LSTORE();
    __syncthreads();
  }
#undef SCAN_CHUNK
#undef SCAN_GLOAD
#undef SCAN_LSTORE
}

__device__ void ofprep_phase(const Params& p, int l) {
  const int tid_ = otid(), lane = tid_ & 63, gw = blockIdx.x * 8 + (tid_ >> 6), nw = gridDim.x * 8;
  const bf16_t* O0 = (const bf16_t*)(lws(p.ws) + O_O); const bf16_t* O1 = O0 + (size_t)ROWS * 512; const bf16_t* Z = (const bf16_t*)(lws(p.ws) + O_Z); bf16_t* OF = (bf16_t*)(lws(p.ws) + O_OF);
  const float* og = p.o_gain + (size_t)l * 128 + (lane & 15) * 8;
  for (int r = gw; r < ROWS; r += nw) {
    const u32x4 a = *(const u32x4*)(O0 + (size_t)r * 512 + lane * 8), bq = *(const u32x4*)(O1 + (size_t)r * 512 + lane * 8), zq = *(const u32x4*)(Z + (size_t)r * 512 + lane * 8);
    float o[8]; float ss = 0.f;
#pragma unroll
    for (int e = 0; e < 4; ++e) { o[2 * e] = bflo(a[e]) + bflo(bq[e]); o[2 * e + 1] = bfhi(a[e]) + bfhi(bq[e]); ss += o[2 * e] * o[2 * e] + o[2 * e + 1] * o[2 * e + 1]; }
    ss += __shfl_xor(ss, 1); ss += __shfl_xor(ss, 2); ss += __shfl_xor(ss, 4); ss += __shfl_xor(ss, 8);
    const float rstd = rsqrtf(ss * (1.0f / 128.0f) + 1e-6f);
    float y[8];
#pragma unroll
    for (int e = 0; e < 4; ++e) { y[2 * e] = o[2 * e] * rstd * og[2 * e] * siluf_(bflo(zq[e])); y[2 * e + 1] = o[2 * e + 1] * rstd * og[2 * e + 1] * siluf_(bfhi(zq[e])); }
    u32x4 w; w.x = cvt_pk_bf16(y[0], y[1]); w.y = cvt_pk_bf16(y[2], y[3]); w.z = cvt_pk_bf16(y[4], y[5]); w.w = cvt_pk_bf16(y[6], y[7]);
    *(u32x4*)(OF + (size_t)r * 512 + lane * 8) = w;
  }
}


#define XB_TMO      128
#define XB_XCNT(j)  (256  + 64 * (j))
#define XB_XSUB(j)  (1280 + 64 * (j))
#define XB_XGEN(j)  (2304 + 64 * (j))
#define XB_TOP      3328
#define XB_TOPGEN   3392
#define XCD_BAR_WORDS 3456
#define XB_SPIN_CAP (1u << 18)

__device__ __forceinline__ unsigned xb_ld(unsigned* p)              { return __hip_atomic_load(p, __ATOMIC_RELAXED, __HIP_MEMORY_SCOPE_AGENT); }
__device__ __forceinline__ unsigned xb_add(unsigned* p, unsigned v) { return __hip_atomic_fetch_add(p, v, __ATOMIC_RELAXED, __HIP_MEMORY_SCOPE_AGENT); }
__device__ __forceinline__ unsigned xb_xcc_id() { return (unsigned)__builtin_amdgcn_s_getreg((3 << 11) | 20) & 0xFu; }
#define XB_SPIN(cond, bar) do { unsigned _sp = 0; while (cond) { __builtin_amdgcn_s_sleep(1); \
    if ((++_sp & 255u) == 0u) { if (xb_ld(&(bar)[XB_TMO])) break; if (_sp > XB_SPIN_CAP) { atomicAdd(&(bar)[XB_TMO], 1u); break; } } } } while (0)

struct XcdBarrier {
    unsigned* bar; unsigned x;
    volatile LAS unsigned* st;
};

__device__ __forceinline__ XcdBarrier xcd_barrier_post(unsigned* bar, volatile LAS unsigned* st) {
    XcdBarrier b; b.bar = bar; b.x = xb_xcc_id(); b.st = st;
    if (threadIdx.x == 0) (void)xb_add(&bar[XB_XCNT(b.x)], 1u);
    return b;
}
__device__ __forceinline__ void xcd_barrier_complete(unsigned* bar, unsigned x, unsigned& nloc, unsigned& nx) {
    const unsigned G = gridDim.x * gridDim.y * gridDim.z;
    unsigned sum, cnt, mine, sp = 0u;
    for (;;) {
        sum = 0u; cnt = 0u; mine = 0u;
#pragma unroll
        for (unsigned j = 0; j < 16; ++j) { const unsigned c = xb_ld(&bar[XB_XCNT(j)]); sum += c; cnt += (c > 0u) ? 1u : 0u; mine = (j == x) ? c : mine; }
        if (sum == G) break;
        __builtin_amdgcn_s_sleep(1);
        if ((++sp & 255u) == 0u) { if (xb_ld(&bar[XB_TMO])) break; if (sp > XB_SPIN_CAP) { atomicAdd(&bar[XB_TMO], 1u); break; } }
    }
    nloc = mine > 0u ? mine : 1u; nx = cnt > 0u ? cnt : 1u;
}

__device__ __forceinline__ void xcd_barrier(const XcdBarrier& b) {
    asm volatile("s_waitcnt vmcnt(0)" ::: "memory");
    __syncthreads();
    if (threadIdx.x == 0) {
        unsigned* bar = b.bar;
        __builtin_amdgcn_s_waitcnt(0);
        unsigned nloc = b.st[0], nx = b.st[1];
        if (nloc == 0u) { xcd_barrier_complete(bar, b.x, nloc, nx); b.st[0] = nloc; b.st[1] = nx; }
        const unsigned old = xb_add(&bar[XB_XSUB(b.x)], 1u);
        const unsigned gen = old / nloc;
        if (old + 1u == (gen + 1u) * nloc) {
            __builtin_amdgcn_fence(__ATOMIC_RELEASE, "agent");
            asm volatile("s_waitcnt vmcnt(0)" ::: "memory");
            const unsigned og = xb_add(&bar[XB_TOP], 1u);
            const unsigned tg = og / nx;
            if (og + 1u == (tg + 1u) * nx) xb_add(&bar[XB_TOPGEN], 1u);
            else XB_SPIN(xb_ld(&bar[XB_TOPGEN]) == tg, bar);
            __builtin_amdgcn_fence(__ATOMIC_ACQUIRE, "agent");
            xb_add(&bar[XB_XGEN(b.x)], 1u);
            asm volatile("s_waitcnt vmcnt(0)" ::: "memory");
        } else {
            XB_SPIN(xb_ld(&bar[XB_XGEN(b.x)]) == gen, bar);
            __builtin_amdgcn_fence(__ATOMIC_ACQUIRE, "agent");
            asm volatile("s_waitcnt vmcnt(0)" ::: "memory");
        }
    }
    __syncthreads();
}


__device__ __forceinline__ float rdb(const bf16_t* s_, size_t n, size_t i) { float a = 0.f; for (size_t j = i; j < n; j += (size_t)RLAT * DM) a += __uint_as_float((unsigned)s_[j] << 16); return a; }
__device__ __forceinline__ float rdf(const float* s_, size_t n, size_t i) { float a = 0.f; for (size_t j = i; j < n; j += (size_t)RLAT * DM) a += s_[j]; return a; }
__device__ void dump_phase(const Params& p, int which) {
  const size_t NO = (size_t)RLAT * DM; unsigned char* ws = lws(p.ws);
  for (size_t i = (size_t)blockIdx.x * NTHR + otid(); i < NO; i += (size_t)gridDim.x * NTHR) {
    float a = 0.f;
    if (which == 1) { a = rdb((const bf16_t*)(ws + O_QKV), (size_t)ROWS * 1536, i) + rdb((const bf16_t*)(ws + O_Z), (size_t)ROWS * 512, i) + rdb((const bf16_t*)(ws + O_PI), (size_t)ROWS * 256, i) + rdb((const bf16_t*)(ws + O_FI), (size_t)ROWS * 256, i) + rdf((const float*)(ws + O_AB), (size_t)ROWS * 16, i); }
    if (which == 2) { a = rdb((const bf16_t*)(ws + O_QN), (size_t)ROWS * 512, i) + rdb((const bf16_t*)(ws + O_KN), (size_t)ROWS * 512, i) + rdb((const bf16_t*)(ws + O_KNT), (size_t)ROWS * 512, i) + rdb((const bf16_t*)(ws + O_VNT), (size_t)ROWS * 512, i) + rdb((const bf16_t*)(ws + O_TT), (size_t)ROWS * 1024, i) + rdf((const float*)(ws + O_GC), (size_t)NCH * 4 * 2 * 64, i)
          + rdb((const bf16_t*)(ws + O_FBT), (size_t)NB * 256 * 4096, i) + rdf((const float*)(ws + O_UCS), (size_t)NB * CTX * 512, i); }
    if (which == 3) { a = rdb((const bf16_t*)(ws + O_O), (size_t)ROWS * 1024, i); }
    if (which == 4) { a = rdb((const bf16_t*)(ws + O_OF), (size_t)ROWS * 512, i) + rdb((const bf16_t*)(ws + O_HN), (size_t)ROWS * 1024, i); }
    if (which == 5) { a = rdb((const bf16_t*)(ws + O_MRG), (size_t)ROWS * 1024, i); }
    if ((__float_as_uint(a) & 0xffff0000u) == 0xaaaa0000u) a = 1234.5f;
    if (!(a == a) || fabsf(a) > 1e30f) a = 777.0f;
    a = a * 0.5f + 0.12345678f;
    p.out[i] = a;
  }
}
__global__ void __launch_bounds__(NTHR) fwd_megakernel(Params p) {
  extern __shared__ __attribute__((aligned(16))) unsigned char shm[];
  ldsp L = (ldsp)shm;
  cg::grid_group grid = cg::this_grid();
  volatile LAS unsigned* xst = (volatile LAS unsigned*)(L + LDS_BYTES - 16);
  if (threadIdx.x < 4) xst[threadIdx.x] = 0u;
  __syncthreads();
  XcdBarrier xbar = xcd_barrier_post((unsigned*)(p.ws + O_BAR), xst);
#define GSYNC0() do { asm volatile("s_waitcnt vmcnt(0) lgkmcnt(0)" ::: "memory"); __builtin_amdgcn_fence(__ATOMIC_RELEASE, "agent"); grid.sync(); __builtin_amdgcn_fence(__ATOMIC_ACQUIRE, "agent"); } while (0)
#define GSYNC() xcd_barrier(xbar)
  const int G = gridDim.x, c = blockIdx.x;
#define X ((float*)(lws(p.ws) + O_X))
#define MOD ((const float*)(lws(p.ws) + O_MOD))
#define Hn ((bf16_t*)(lws(p.ws) + O_HN))
#ifndef NO_P0
  phase0(p, L);
#endif
  GSYNC0();
  for (int l = 0; l < DEPTH; ++l) {
    const float* modl = MOD + (size_t)l * 9 * 9216; const float* ng = p.norm_gain + (size_t)l * 3 * 1024;
    convert_ffn(p, p.w1gu + (size_t)l * 1024 * 2 * DFF, p.w1d + (size_t)l * DFF * 1024, L);
    convert_mixer(p, l, L);
    norm_phase(X, Hn, ng, modl, 0, 1);
    GSYNC();
    { pg8::PlainSched S{(const char*)Hn, (const char*)(lws(p.ws) + O_WGU), 2048, 2048, 16, ROWS / 256, 22, G, c}; EpiUp E{(bf16_t*)(lws(p.ws) + O_ACT)}; pg8::gemm_phase(L, S, E); }
    GSYNC();
    { pg8::PlainSched S{(const char*)(lws(p.ws) + O_ACT), (const char*)(lws(p.ws) + O_WD), DFF * 2, DFF * 2, DFF / 64, ROWS / 256, 4, G, c}; EpiRes E{X, modl, 2, 0.5f}; pg8::gemm_phase(L, S, E); }
    GSYNC();
#ifndef NO_MIXER
    norm_phase(X, Hn, ng + 1024, modl, 3, 4);
    GSYNC();
    { pg8::PlainSched S{(const char*)Hn, (const char*)(lws(p.ws) + O_WIN), 2048, 2048, 16, ROWS / 256, NINP / 256, G, c};
      EpiIn E{(bf16_t*)(lws(p.ws) + O_QKV), (bf16_t*)(lws(p.ws) + O_Z), (bf16_t*)(lws(p.ws) + O_PI), (bf16_t*)(lws(p.ws) + O_FI), (float*)(lws(p.ws) + O_AB)}; pg8::gemm_phase(L, S, E); }
    GSYNC();
#ifndef NO_PREP
    prep_phase(p, l, L);
#endif
#ifndef NO_FPREP
    fourier_prep(p, L);
#endif
    GSYNC();
#if defined(DUMP) && DUMP == 2
    dump_phase(p, 2); return;
#endif
#ifndef NO_SCAN
    if (c < 128) scan_phase(p, L, c);
#else
    if (c < 128) {}
#endif
    else {
      { FourSched S{(const char*)(lws(p.ws) + O_DFT), (const char*)(lws(p.ws) + O_FBT), c - 128}; EpiBf E{(bf16_t*)(lws(p.ws) + O_PPF) + 256, 512}; pg8::gemm_phase(L, S, E); }
      __syncthreads();
      ctx_fourier(p, L, c - 128, G - 128);
      pool_phase(p, L, c - 128, G - 128);
    }
    GSYNC();
#if defined(DUMP) && DUMP == 3
    dump_phase(p, 3); return;
#endif
    ofprep_phase(p, l);
    norm_phase(X, Hn, ng + 1024, modl, 3, 4);
    GSYNC();
#if defined(DUMP) && DUMP == 4
    dump_phase(p, 4); return;
#endif
    { MergeSched S{(const char*)Hn, (const char*)(lws(p.ws) + O_OF), (const char*)(lws(p.ws) + O_PPF), (const char*)(lws(p.ws) + O_WG), (const char*)(lws(p.ws) + O_WCAT), G, c};
      EpiMerge E{(float*)(lws(p.ws) + O_SCR) + (size_t)c * 2 * 65536, (bf16_t*)(lws(p.ws) + O_MRG)}; pg8::gemm_phase(L, S, E); }
    GSYNC();
#if defined(DUMP) && DUMP == 5
    dump_phase(p, 5); return;
#endif
    { pg8::PlainSched S{(const char*)(lws(p.ws) + O_MRG), (const char*)(lws(p.ws) + O_WOUT), 2048, 2048, 16, ROWS / 256, 4, G, c}; EpiRes E{X, modl, 5, 1.0f}; pg8::gemm_phase(L, S, E); }
    GSYNC();
#endif
    convert_ffn(p, p.w2gu + (size_t)l * 1024 * 2 * DFF, p.w2d + (size_t)l * DFF * 1024, L);
    norm_phase(X, Hn, ng + 2048, modl, 6, 7);
    GSYNC();
    { pg8::PlainSched S{(const char*)Hn, (const char*)(lws(p.ws) + O_WGU), 2048, 2048, 16, ROWS / 256, 22, G, c}; EpiUp E{(bf16_t*)(lws(p.ws) + O_ACT)}; pg8::gemm_phase(L, S, E); }
    GSYNC();
    { pg8::PlainSched S{(const char*)(lws(p.ws) + O_ACT), (const char*)(lws(p.ws) + O_WD), DFF * 2, DFF * 2, DFF / 64, ROWS / 256, 4, G, c}; EpiRes E{X, modl, 8, 0.5f}; pg8::gemm_phase(L, S, E); }
    GSYNC();
  }
  final_norm(X, p.out, p.final_gain);
}

extern "C" void kernel_launch(void* const* d_in, const int* in_sizes, int n_in, void* d_out, int out_size, void* d_ws, size_t ws_size, hipStream_t stream) {
  (void)in_sizes; (void)n_in; (void)out_size;
  if (ws_size < WS_NEED) { fprintf(stderr, "workspace too small: %zu < %zu\n", ws_size, (size_t)WS_NEED); return; }
  static int grid_blocks = 0;
  if (!grid_blocks) {
    (void)hipFuncSetAttribute((const void*)fwd_megakernel, hipFuncAttributeMaxDynamicSharedMemorySize, LDS_BYTES);
    int dev = 0, cus = 0, per_cu = 0; (void)hipGetDevice(&dev); (void)hipDeviceGetAttribute(&cus, hipDeviceAttributeMultiprocessorCount, dev);
    (void)hipOccupancyMaxActiveBlocksPerMultiprocessor(&per_cu, fwd_megakernel, NTHR, LDS_BYTES);
    grid_blocks = cus * (per_cu > 0 ? 1 : 0);
    if (grid_blocks != 256) fprintf(stderr, "unexpected grid %d (cus %d per_cu %d)\n", grid_blocks, cus, per_cu);
  }
  Params p{};
  const float** f = (const float**)&p;
  for (int i = 0; i < 22; ++i) f[i] = (const float*)d_in[i];
  p.out = (float*)d_out; p.ws = (unsigned char*)d_ws;
  (void)hipMemsetAsync((unsigned char*)d_ws + O_BAR, 0, 16384, stream);
  void* args[] = {&p};
  hipError_t e = hipLaunchCooperativeKernel((void*)fwd_megakernel, dim3(grid_blocks), dim3(NTHR), args, LDS_BYTES, stream);
  if (e != hipSuccess) fprintf(stderr, "cooperative launch failed: %s (grid %d)\n", hipGetErrorString(e), grid_blocks);
}
```

```cpp
#include <hip/hip_runtime.h>
#include <hip/hip_cooperative_groups.h>
#include <cstdio>

namespace cg = cooperative_groups;

#define LAS __attribute__((address_space(3)))
typedef LAS unsigned char* ldsp;
typedef unsigned short bf16_t;
typedef short bf16x8 __attribute__((ext_vector_type(8)));
typedef float f32x4 __attribute__((ext_vector_type(4)));
typedef unsigned u32x4 __attribute__((ext_vector_type(4)));
typedef unsigned u32x2 __attribute__((ext_vector_type(2)));

constexpr int DM = 1024, NB = 8, SEQ = 4096, CTX = 256, DEPTH = 4;
constexpr int RLAT = NB * SEQ, ROWS = RLAT + NB * CTX;
constexpr int DFF = 2816, NMOD = 9, DPROJ = 5648;
constexpr int NCH = ROWS / 64;
constexpr int NINP = 2816;
constexpr int LDS_BYTES = 163840;
constexpr int NTHR = 512;

constexpr size_t al256(size_t x) { return (x + 255) & ~(size_t)255; }
constexpr size_t O_X = 0;
constexpr size_t O_MOD = O_X + (size_t)ROWS * DM * 4;
constexpr size_t O_DFT = al256(O_MOD + (size_t)DEPTH * 9 * 9216 * 4);
constexpr size_t O_WGU = O_DFT + (size_t)4096 * 4096 * 2;
constexpr size_t O_WD = O_WGU + (size_t)5632 * 1024 * 2;
constexpr size_t O_WIN = O_WD + (size_t)1024 * 2816 * 2;
constexpr size_t O_WG = O_WIN + (size_t)NINP * 1024 * 2;
constexpr size_t O_WCAT = O_WG + (size_t)3072 * 1024 * 2;
constexpr size_t O_WOUT = O_WCAT + (size_t)1024 * 1024 * 2;
constexpr size_t O_R = O_WOUT + (size_t)1024 * 1024 * 2;
constexpr size_t SZ_H = (size_t)ROWS * 1024 * 2;
constexpr size_t SZ_Q = (size_t)ROWS * 512 * 2;
constexpr size_t O_HN = O_R;
constexpr size_t O_ACT = O_R + SZ_H;
constexpr size_t O_QN = O_R;
constexpr size_t O_KN = O_R + SZ_Q;
constexpr size_t O_QKV = O_R + SZ_H;
constexpr size_t O_O = O_QKV;
constexpr size_t O_SCR = O_QKV;
constexpr size_t O_Z = O_QKV + (size_t)ROWS * 1536 * 2;
constexpr size_t O_PI = O_Z + SZ_Q;
constexpr size_t O_FI = O_PI + (size_t)ROWS * 256 * 2;
constexpr size_t O_AB = O_FI + (size_t)ROWS * 256 * 2;
constexpr size_t O_KNT = al256(O_AB + (size_t)ROWS * 16 * 4);
constexpr size_t O_VNT = O_KNT + SZ_Q;
constexpr size_t O_MRG = O_KNT;
constexpr size_t O_TT = O_VNT + SZ_Q;
constexpr size_t O_OF = O_TT;
constexpr size_t O_GC = O_TT + SZ_H;
constexpr size_t O_FBT = al256(O_GC + (size_t)NCH * 4 * 2 * 64 * 4);
constexpr size_t O_UCS = O_FBT + (size_t)NB * 256 * 4096 * 2;
constexpr size_t O_PPF = al256(O_UCS + (size_t)NB * CTX * 512 * 4);
constexpr size_t O_BAR = al256(O_PPF + SZ_Q);
constexpr size_t WS_NEED = O_BAR + 16384;
static_assert(O_SCR + (size_t)256 * 2 * 262144 <= O_PI, "merge scratch overlaps");

struct Params {
  const float *x, *c, *ctx, *c_ctx, *w_ada, *b_ada, *norm_gain, *w1gu, *w1d, *w2gu, *w2d, *w_in, *conv_w, *a_log, *dt_bias, *o_gain, *w_a, *w_b,
      *pool_scale, *w_c, *w_out, *final_gain;
  float* out;
  unsigned char* ws;
};

typedef float f32x2_ __attribute__((ext_vector_type(2)));
typedef __bf16 bf16x2_ __attribute__((ext_vector_type(2)));
__device__ __forceinline__ unsigned cvt_pk_bf16(float lo, float hi) { const f32x2_ v = {lo, hi}; const bf16x2_ b = __builtin_convertvector(v, bf16x2_); return __builtin_bit_cast(unsigned, b); }
__device__ __forceinline__ float bflo(unsigned w) { return __uint_as_float(w << 16); }
__device__ __forceinline__ float bfhi(unsigned w) { return __uint_as_float(w & 0xffff0000u); }
__device__ __forceinline__ float sigmoidf_(float x) { return 1.0f / (1.0f + __expf(-x)); }
__device__ __forceinline__ float siluf_(float x) { return x / (1.0f + __expf(-x)); }
template <class T> __device__ __forceinline__ T ldsld(ldsp b, int off) { return *(const LAS T*)(b + off); }
template <class T> __device__ __forceinline__ void ldsst(ldsp b, int off, T v) { *(LAS T*)(b + off) = v; }
__device__ __forceinline__ f32x4 mma(bf16x8 a, bf16x8 b, f32x4 c) { return __builtin_amdgcn_mfma_f32_16x16x32_bf16(a, b, c, 0, 0, 0); }
__device__ __forceinline__ u32x2 pack4(f32x4 v) { u32x2 r; r.x = cvt_pk_bf16(v[0], v[1]); r.y = cvt_pk_bf16(v[2], v[3]); return r; }
__device__ __forceinline__ int otid() { int t = threadIdx.x; asm volatile("" : "+v"(t)); return t; }
__device__ __forceinline__ unsigned char* lws(unsigned char* q) { asm volatile("" : "+s"(q)); return q; }
__device__ __forceinline__ int modidx(int pm) { return pm < 128 ? (pm >> 4) : 8; }

namespace pg8 {
constexpr int BM = 256, BK = 64, HALF = 128, HTB = HALF * BK * 2, NXCD = 8, WGM = 8;
__device__ __forceinline__ int lds_byte(int r, int c) { const int st = (r >> 4) * 2 + (c >> 5), rr = r & 15, cc = c & 31, ob = rr * 64 + cc * 2; return st * 1024 + (ob ^ (((ob >> 9) & 1) << 5)); }
__device__ __forceinline__ void stage_rc(int b, int& R, int& C) { const int st = b / 1024, sb = b % 1024, swz = sb ^ (((sb >> 9) & 1) << 5); R = (st >> 1) * 16 + swz / 64; C = (st & 1) * 32 + (swz % 64) / 2; }
__device__ __forceinline__ int perm32(int rho) { const int n = rho >> 4, i = rho & 15; return 8 * (i >> 2) + 4 * n + (i & 3); }

struct Unit { const char* A; const char* B; int lda, ldb, nt, pm, pn, seg; };

__device__ __forceinline__ bool tile_of(int nM, int nN, int G, int c, int i, int& pm, int& pn) {
  const int nwg = nM * nN; const long Lq = (long)i * G + c; if (Lq >= nwg) return false;
  int wgid = (int)Lq; { const int q = nwg / NXCD, r = nwg % NXCD, xcd = wgid % NXCD, off = wgid / NXCD; wgid = (xcd < r ? xcd * (q + 1) : r * (q + 1) + (xcd - r) * q) + off; }
  const int nig = WGM * nN, gid = wgid / nig, fm = gid * WGM, gsz = (nM - fm) < WGM ? (nM - fm) : WGM;
  pm = fm + ((wgid % nig) % gsz); pn = (wgid % nig) / gsz; return true;
}
struct PlainSched {
  static constexpr bool VARLDA = false;
  const char* A; const char* B; int lda, ldb, nt, nM, nN, G, c;
  __device__ __forceinline__ bool next(int i, Unit& u) const {
    int pm, pn; if (!tile_of(nM, nN, G, c, i, pm, pn)) return false;
    u.A = A + (size_t)pm * 256 * lda; u.B = B + (size_t)pn * 256 * ldb; u.lda = lda; u.ldb = ldb; u.nt = nt; u.pm = pm; u.pn = pn; u.seg = 0; return true;
  }
};

template <class Epi, class Sched>
__device__ __forceinline__ void gemm_phase(ldsp lds, const Sched& S, const Epi& E) {
  const int tid = otid(), wid = __builtin_amdgcn_readfirstlane(tid >> 6), lane = tid & 63, wr = wid >> 2, wc = wid & 3, fr = lane & 15, fq = lane >> 4;
  unsigned rA[2], rB[2], c2[2];
#pragma unroll
  for (int i = 0; i < 2; ++i) { int R, C; stage_rc(tid * 16 + i * 8192, R, C); rA[i] = (unsigned)R; rB[i] = (unsigned)(Epi::PERM ? ((R & ~31) + perm32(R & 31)) : R); c2[i] = (unsigned)C * 2u; }
  const size_t kstep = (size_t)(BK * 2);
  const unsigned ldsw = (unsigned)wid * 1024u;
  const int aoff = lds_byte(wr * 64 + fr, fq * 8), boff = lds_byte(wc * 32 + fr, fq * 8);
#define PG8_SA(b, h) (((b) * 2 + (h)) * HTB)
#define PG8_SB(b, h) ((4 + (b) * 2 + (h)) * HTB)
#define PG8_STAGE(bufoff, gbase, voff) do { _Pragma("unroll") for (int _i = 0; _i < 2; ++_i) \
    __builtin_amdgcn_global_load_lds((const unsigned*)((const char*)(gbase) + (voff)[_i]), (LAS unsigned*)(lds + (bufoff) + ldsw + _i * 8192), 16, 0, 0); } while (0)
#define PG8_LDA(dst, b, h) do { _Pragma("unroll") for (int m = 0; m < 4; ++m) _Pragma("unroll") for (int k = 0; k < 2; ++k) dst[m][k] = *(const LAS bf16x8*)(lds + PG8_SA(b, h) + aoff + m * 2048 + k * 1024); } while (0)
#define PG8_LDB(dst, b, h) do { _Pragma("unroll") for (int n = 0; n < 2; ++n) _Pragma("unroll") for (int k = 0; k < 2; ++k) dst[n][k] = *(const LAS bf16x8*)(lds + PG8_SB(b, h) + boff + n * 2048 + k * 1024); } while (0)
#define PG8_MMA(ai, bj, At, Bt) do { __builtin_amdgcn_s_setprio(1); _Pragma("unroll") for (int m = 0; m < 4; ++m) _Pragma("unroll") for (int n = 0; n < 2; ++n) _Pragma("unroll") for (int k = 0; k < 2; ++k) \
    acc[ai][bj][m][n] = __builtin_amdgcn_mfma_f32_16x16x32_bf16(Bt[n][k], At[m][k], acc[ai][bj][m][n], 0, 0, 0); __builtin_amdgcn_s_setprio(0); } while (0)
#define PG8_WAIT_V(n) asm volatile("s_waitcnt vmcnt(" #n ")" ::: "memory")
#define PG8_WAIT_L(n) asm volatile("s_waitcnt lgkmcnt(" #n ")" ::: "memory")
#define PG8_BAR __builtin_amdgcn_s_barrier()
#define PG8_SCHED __builtin_amdgcn_sched_barrier(0)
  Unit cur, nxt; int ui = 0;
  if (!S.next(0, cur)) return;
  f32x4 acc[2][2][4][2];
#pragma unroll
  for (int a = 0; a < 2; ++a)
#pragma unroll
    for (int b = 0; b < 2; ++b)
#pragma unroll
      for (int m = 0; m < 4; ++m)
#pragma unroll
        for (int n = 0; n < 2; ++n) acc[a][b][m][n] = (f32x4){0.f, 0.f, 0.f, 0.f};
  bf16x8 At[4][2], B0[2][2], B1[2][2];
  const char* cA = cur.A; const char* cB = cur.B; int ldA = cur.lda; const int ldB = cur.ldb;
  unsigned voffA[2], voffB[2];
#pragma unroll
  for (int i = 0; i < 2; ++i) { voffA[i] = rA[i] * (unsigned)ldA + c2[i]; voffB[i] = rB[i] * (unsigned)ldB + c2[i]; }
  const size_t hB = (size_t)HALF * ldB;
  {
    const size_t hA = (size_t)HALF * ldA;
    PG8_STAGE(PG8_SB(0, 0), cB, voffB); PG8_STAGE(PG8_SA(0, 0), cA, voffA); PG8_STAGE(PG8_SB(0, 1), cB + hB, voffB); PG8_STAGE(PG8_SA(0, 1), cA + hA, voffA);
    if (wr == 1) PG8_BAR;
    PG8_WAIT_V(4); PG8_BAR;
    PG8_STAGE(PG8_SB(1, 0), cB + kstep, voffB); PG8_STAGE(PG8_SA(1, 0), cA + kstep, voffA); PG8_STAGE(PG8_SB(1, 1), cB + hB + kstep, voffB);
    PG8_WAIT_V(6); PG8_BAR;
  }
  for (;;) {
    const bool has_next = S.next(ui + 1, nxt);
    const char* nA = has_next ? nxt.A : cA; const char* nB = has_next ? nxt.B : cB;
    const int nldA = has_next ? nxt.lda : ldA;
    const int nt = cur.nt;
    const size_t hA = (size_t)HALF * ldA;
    for (int t = 0; t < nt; t += 2) {
      const bool last = (t == nt - 2);
      const char* a1 = cA + (size_t)(t + 1) * kstep;
      const char* a2 = last ? nA : cA + (size_t)(t + 2) * kstep; const char* b2 = last ? nB : cB + (size_t)(t + 2) * kstep;
      const size_t h2A = (size_t)HALF * (last ? nldA : ldA);
      const char* a3 = a2 + kstep; const char* b3 = b2 + kstep;
      PG8_LDB(B0, 0, 0); PG8_SCHED; PG8_LDA(At, 0, 0); PG8_STAGE(PG8_SA(1, 1), a1 + hA, voffA);
      if (Sched::VARLDA) { if (last) {
#pragma unroll
        for (int i = 0; i < 2; ++i) voffA[i] = rA[i] * (unsigned)nldA + c2[i]; } }
      PG8_WAIT_L(8); PG8_BAR; PG8_WAIT_L(0); PG8_MMA(0, 0, At, B0); PG8_BAR; PG8_SCHED;
      PG8_LDB(B1, 0, 1); PG8_STAGE(PG8_SB(0, 0), b2, voffB);
      PG8_BAR; PG8_WAIT_L(0); PG8_MMA(0, 1, At, B1); PG8_BAR;
      PG8_LDA(At, 0, 1); PG8_STAGE(PG8_SA(0, 0), a2, voffA);
      PG8_BAR; PG8_WAIT_L(0); PG8_MMA(1, 0, At, B0); PG8_BAR; PG8_SCHED;
      PG8_STAGE(PG8_SB(0, 1), b2 + hB, voffB);
      PG8_WAIT_V(6); PG8_BAR; PG8_MMA(1, 1, At, B1); PG8_BAR;
      PG8_LDB(B0, 1, 0); PG8_SCHED; PG8_LDA(At, 1, 0); PG8_STAGE(PG8_SA(0, 1), a2 + h2A, voffA);
      PG8_WAIT_L(8); PG8_BAR; PG8_WAIT_L(0); PG8_MMA(0, 0, At, B0); PG8_BAR; PG8_SCHED;
      PG8_LDB(B1, 1, 1); PG8_STAGE(PG8_SB(1, 0), b3, voffB);
      PG8_BAR; PG8_WAIT_L(0); PG8_MMA(0, 1, At, B1); PG8_BAR;
      PG8_LDA(At, 1, 1); PG8_STAGE(PG8_SA(1, 0), a3, voffA);
      PG8_BAR; PG8_WAIT_L(0); PG8_MMA(1, 0, At, B0); PG8_BAR; PG8_SCHED;
      PG8_STAGE(PG8_SB(1, 1), b3 + hB, voffB);
      PG8_WAIT_V(6); PG8_BAR; PG8_MMA(1, 1, At, B1); PG8_BAR;
    }
    E(acc, cur, wr, wc, fr, fq);
    if (!has_next) break;
#pragma unroll
    for (int a = 0; a < 2; ++a)
#pragma unroll
      for (int b = 0; b < 2; ++b)
#pragma unroll
        for (int m = 0; m < 4; ++m)
#pragma unroll
          for (int n = 0; n < 2; ++n) acc[a][b][m][n] = (f32x4){0.f, 0.f, 0.f, 0.f};
    cur = nxt; cA = nA; cB = nB; ldA = nldA; ++ui;
  }
  PG8_WAIT_V(0);
  if (wr == 0) PG8_BAR;
  PG8_BAR;
#undef PG8_SA
#undef PG8_SB
#undef PG8_STAGE
#undef PG8_LDA
#undef PG8_LDB
#undef PG8_MMA
#undef PG8_WAIT_V
#undef PG8_WAIT_L
#undef PG8_BAR
#undef PG8_SCHED
}
}
using pg8::Unit;
typedef f32x4 AccT[2][2][4][2];

struct EpiUp {
  static constexpr bool PERM = true;
  bf16_t* act;
  __device__ __forceinline__ void operator()(const AccT& acc, const Unit& u, int wr, int wc, int fr, int fq) const {
    const int row0 = u.pm * 256 + wr * 64 + fr, col0 = u.pn * 128 + wc * 32 + 8 * fq;
#pragma unroll
    for (int ai = 0; ai < 2; ++ai)
#pragma unroll
      for (int m = 0; m < 4; ++m) {
        const f32x4 a0 = acc[ai][0][m][0], a1 = acc[ai][0][m][1], u0 = acc[ai][1][m][0], u1 = acc[ai][1][m][1];
        u32x4 w;
        w.x = cvt_pk_bf16(siluf_(a0[0]) * u0[0], siluf_(a0[1]) * u0[1]); w.y = cvt_pk_bf16(siluf_(a0[2]) * u0[2], siluf_(a0[3]) * u0[3]);
        w.z = cvt_pk_bf16(siluf_(a1[0]) * u1[0], siluf_(a1[1]) * u1[1]); w.w = cvt_pk_bf16(siluf_(a1[2]) * u1[2], siluf_(a1[3]) * u1[3]);
        *(u32x4*)(act + (size_t)(row0 + ai * 128 + m * 16) * DFF + col0) = w;
      }
  }
};
struct EpiRes {
  static constexpr bool PERM = false;
  float* X; const float* modl; int gidx; float scale;
  __device__ __forceinline__ void operator()(const AccT& acc, const Unit& u, int wr, int wc, int fr, int fq) const {
    const int row0 = u.pm * 256 + wr * 64 + fr, col0 = u.pn * 256 + wc * 32 + 4 * fq;
    const float* g = modl + (size_t)(modidx(u.pm) * 9 + gidx) * 1024 + col0;
    f32x4 gv[2][2];
#pragma unroll
    for (int bj = 0; bj < 2; ++bj)
#pragma unroll
      for (int n = 0; n < 2; ++n) gv[bj][n] = *(const f32x4*)(g + bj * 128 + n * 16) * scale;
#pragma unroll
    for (int ai = 0; ai < 2; ++ai)
#pragma unroll
      for (int m = 0; m < 4; ++m) {
        float* rowp = X + (size_t)(row0 + ai * 128 + m * 16) * DM + col0;
#pragma unroll
        for (int bj = 0; bj < 2; ++bj)
#pragma unroll
          for (int n = 0; n < 2; ++n) { f32x4* q = (f32x4*)(rowp + bj * 128 + n * 16); *q = *q + gv[bj][n] * acc[ai][bj][m][n]; }
      }
  }
};
struct EpiIn {
  static constexpr bool PERM = true;
  bf16_t *qkv, *z, *pi, *fi; float* ab;
  __device__ __forceinline__ void operator()(const AccT& acc, const Unit& u, int wr, int wc, int fr, int fq) const {
    const int row0 = u.pm * 256 + wr * 64 + fr;
    if (u.pn == 10) {
      if (wc == 0 && fq < 2) {
#pragma unroll
        for (int ai = 0; ai < 2; ++ai)
#pragma unroll
          for (int m = 0; m < 4; ++m) {
            float* rp = ab + (size_t)(row0 + ai * 128 + m * 16) * 16 + 8 * fq;
            *(f32x4*)(rp) = acc[ai][0][m][0]; *(f32x4*)(rp + 4) = acc[ai][0][m][1];
          }
      }
      return;
    }
    bf16_t* base; int ld, ct;
    if (u.pn < 6) { base = qkv; ld = 1536; ct = u.pn * 256; } else if (u.pn < 8) { base = z; ld = 512; ct = (u.pn - 6) * 256; } else if (u.pn == 8) { base = pi; ld = 256; ct = 0; } else { base = fi; ld = 256; ct = 0; }
    const int col0 = ct + wc * 32 + 8 * fq;
#pragma unroll
    for (int ai = 0; ai < 2; ++ai)
#pragma unroll
      for (int m = 0; m < 4; ++m) {
        bf16_t* rowp = base + (size_t)(row0 + ai * 128 + m * 16) * ld + col0;
#pragma unroll
        for (int bj = 0; bj < 2; ++bj) { const f32x4 v0 = acc[ai][bj][m][0], v1 = acc[ai][bj][m][1]; u32x4 w; w.x = cvt_pk_bf16(v0[0], v0[1]); w.y = cvt_pk_bf16(v0[2], v0[3]); w.z = cvt_pk_bf16(v1[0], v1[1]); w.w = cvt_pk_bf16(v1[2], v1[3]);
          *(u32x4*)(rowp + bj * 128) = w; }
      }
  }
};
struct EpiBf {
  static constexpr bool PERM = true;
  bf16_t* O; int ld;
  __device__ __forceinline__ void operator()(const AccT& acc, const Unit& u, int wr, int wc, int fr, int fq) const {
    const int row0 = u.pm * 256 + wr * 64 + fr, col0 = u.pn * 256 + wc * 32 + 8 * fq;
#pragma unroll
    for (int ai = 0; ai < 2; ++ai)
#pragma unroll
      for (int m = 0; m < 4; ++m) {
        bf16_t* rowp = O + (size_t)(row0 + ai * 128 + m * 16) * ld + col0;
#pragma unroll
        for (int bj = 0; bj < 2; ++bj) { const f32x4 v0 = acc[ai][bj][m][0], v1 = acc[ai][bj][m][1]; u32x4 w; w.x = cvt_pk_bf16(v0[0], v0[1]); w.y = cvt_pk_bf16(v0[2], v0[3]); w.z = cvt_pk_bf16(v1[0], v1[1]); w.w = cvt_pk_bf16(v1[2], v1[3]);
          *(u32x4*)(rowp + bj * 128) = w; }
      }
  }
};
struct EpiMerge {
  static constexpr bool PERM = true;
  float* scr;
  bf16_t* mrg;
  __device__ __forceinline__ void operator()(const AccT& acc, const Unit& u, int wr, int wc, int fr, int fq) const {
    const int tid_ = otid(); f32x4* S1 = (f32x4*)scr + tid_; f32x4* Mx = (f32x4*)scr + 32 * 512 + tid_;
    const int seg = u.seg;
    if ((seg & 1) == 0) {
#pragma unroll
      for (int ai = 0; ai < 2; ++ai)
#pragma unroll
        for (int bj = 0; bj < 2; ++bj)
#pragma unroll
          for (int m = 0; m < 4; ++m)
#pragma unroll
            for (int n = 0; n < 2; ++n) { const f32x4 v = acc[ai][bj][m][n]; f32x4 s; s[0] = sigmoidf_(v[0]); s[1] = sigmoidf_(v[1]); s[2] = sigmoidf_(v[2]); s[3] = sigmoidf_(v[3]);
              S1[(((ai * 2 + bj) * 4 + m) * 2 + n) * 512] = s; }
    } else if (seg < 5) {
#pragma unroll
      for (int ai = 0; ai < 2; ++ai)
#pragma unroll
        for (int bj = 0; bj < 2; ++bj)
#pragma unroll
          for (int m = 0; m < 4; ++m)
#pragma unroll
            for (int n = 0; n < 2; ++n) { const int ix = (((ai * 2 + bj) * 4 + m) * 2 + n) * 512; f32x4 t = S1[ix] * acc[ai][bj][m][n]; if (seg == 3) t = t + Mx[ix]; Mx[ix] = t; }
    } else {
      const int row0 = u.pm * 256 + wr * 64 + fr, col0 = u.pn * 256 + wc * 32 + 8 * fq;
#pragma unroll
      for (int ai = 0; ai < 2; ++ai)
#pragma unroll
        for (int m = 0; m < 4; ++m) {
          bf16_t* rowp = mrg + (size_t)(row0 + ai * 128 + m * 16) * DM + col0;
#pragma unroll
          for (int bj = 0; bj < 2; ++bj) {
            const int i0 = (((ai * 2 + bj) * 4 + m) * 2 + 0) * 512, i1 = i0 + 512;
            const f32x4 v0 = S1[i0] * acc[ai][bj][m][0] + Mx[i0], v1 = S1[i1] * acc[ai][bj][m][1] + Mx[i1];
            u32x4 w; w.x = cvt_pk_bf16(v0[0], v0[1]); w.y = cvt_pk_bf16(v0[2], v0[3]); w.z = cvt_pk_bf16(v1[0], v1[1]); w.w = cvt_pk_bf16(v1[2], v1[3]);
            *(u32x4*)(rowp + bj * 128) = w;
          }
        }
    }
  }
};
struct MergeSched {
  static constexpr bool VARLDA = true;
  const char *hn, *of, *ppf, *wg, *wcat; int G, c;
  __device__ __forceinline__ bool next(int i, Unit& u) const {
    const int round = i / 6, seg = i - round * 6; int pm, pn; if (!pg8::tile_of(ROWS / 256, 4, G, c, round, pm, pn)) return false;
    const int br = seg >> 1;
    u.pm = pm; u.pn = pn; u.seg = seg; u.ldb = 2048;
    if ((seg & 1) == 0) { u.A = hn + (size_t)pm * 256 * 2048; u.lda = 2048; u.B = wg + (size_t)(br * 1024 + pn * 256) * 2048; u.nt = 16; }
    else {
      u.lda = 1024;
      if (br == 0) { u.A = of + (size_t)pm * 256 * 1024; u.B = wcat + (size_t)pn * 256 * 2048; u.nt = 8; }
      else if (br == 1) { u.A = ppf + (size_t)pm * 256 * 1024; u.B = wcat + (size_t)pn * 256 * 2048 + 512 * 2; u.nt = 4; }
      else { u.A = ppf + (size_t)pm * 256 * 1024 + 256 * 2; u.B = wcat + (size_t)pn * 256 * 2048 + 768 * 2; u.nt = 4; }
    }
    return true;
  }
};
struct FourSched {
  static constexpr bool VARLDA = false;
  const char *dft, *fbt; int c;
  __device__ __forceinline__ bool next(int i, Unit& u) const {
    if (i > 0) return false;
    const int b = c >> 4, pm = c & 15;
    u.A = dft + (size_t)pm * 256 * 8192; u.B = fbt + (size_t)b * 256 * 8192; u.lda = 8192; u.ldb = 8192; u.nt = 64; u.pm = b * 16 + pm; u.pn = 0; u.seg = 0; return true;
  }
};

template <class F>
__device__ __forceinline__ void convT(const float* W, int ldw, int K, int nrows, bf16_t* dst, int ldd, int k0d, F srccol, ldsp L, int& cursor) {
  const int tid = otid(), ntk = K >> 6, ntiles = (nrows >> 6) * ntk;
  for (int t = 0; t < ntiles; ++t) {
    if (((cursor + t) % (int)gridDim.x) != (int)blockIdx.x) continue;
    const int tr = t / ntk, tk = t - tr * ntk, r0 = tr * 64, kk0 = tk * 64;
    const int i = tid & 63, sc = srccol(r0 + i);
#pragma unroll
    for (int it = 0; it < 8; ++it) { const int kk = (tid >> 6) + 8 * it; const float v = sc >= 0 ? W[(size_t)(kk0 + kk) * ldw + sc] : 0.f; ldsst<float>(L, (kk * 65 + i) * 4, v); }
    __syncthreads();
    { const int ii = tid >> 3, kv = (tid & 7) * 8; float v[8];
#pragma unroll
      for (int e = 0; e < 8; ++e) v[e] = ldsld<float>(L, ((kv + e) * 65 + ii) * 4);
      u32x4 w; w.x = cvt_pk_bf16(v[0], v[1]); w.y = cvt_pk_bf16(v[2], v[3]); w.z = cvt_pk_bf16(v[4], v[5]); w.w = cvt_pk_bf16(v[6], v[7]);
      *(u32x4*)(dst + (size_t)(r0 + ii) * ldd + k0d + kk0 + kv) = w; }
    __syncthreads();
  }
  cursor += ntiles;
}

__device__ void convert_ffn(const Params& p, const float* wgu, const float* wd, ldsp L) {
  int cur = 0;
  convT(wgu, 2 * DFF, 1024, 2 * DFF, (bf16_t*)(lws(p.ws) + O_WGU), 1024, 0, [](int r) { const int t = r >> 8, q = r & 255; return q < 128 ? t * 128 + q : DFF + t * 128 + (q - 128); }, L, cur);
  convT(wd, 1024, DFF, 1024, (bf16_t*)(lws(p.ws) + O_WD), DFF, 0, [](int r) { return r; }, L, cur);
}
__device__ void convert_mixer(const Params& p, int l, ldsp L) {
  int cur = 0;
  const float* win = p.w_in + (size_t)l * 1024 * DPROJ;
  convT(win, DPROJ, 1024, NINP, (bf16_t*)(lws(p.ws) + O_WIN), 1024, 0, [](int r) { return r < 2048 ? r : (r < 2560 ? r + 16 : (r < 2576 ? r - 512 : -1)); }, L, cur);
  convT(win, DPROJ, 1024, 3072, (bf16_t*)(lws(p.ws) + O_WG), 1024, 0, [](int r) { return 2576 + r; }, L, cur);
  convT(p.w_a + (size_t)l * 512 * 1024, 1024, 512, 1024, (bf16_t*)(lws(p.ws) + O_WCAT), 1024, 0, [](int r) { return r; }, L, cur);
  convT(p.w_c + (size_t)l * 256 * 1024, 1024, 256, 1024, (bf16_t*)(lws(p.ws) + O_WCAT), 1024, 768, [](int r) { return r; }, L, cur);
  convT(p.w_out + (size_t)l * 1024 * 1024, 1024, 1024, 1024, (bf16_t*)(lws(p.ws) + O_WOUT), 1024, 0, [](int r) { return r; }, L, cur);
  const float* wb = p.w_b + (size_t)l * 4 * 64 * 256; const float* ps = p.pool_scale + (size_t)l * 1024; bf16_t* wcat = (bf16_t*)(lws(p.ws) + O_WCAT);
  for (int idx = blockIdx.x * NTHR + otid(); idx < 1024 * 256; idx += gridDim.x * NTHR) {
    const int row = idx & 1023, kk = idx >> 10, g = row >> 8;
    const float v = ((kk >> 6) == g) ? wb[((size_t)g * 64 + (kk & 63)) * 256 + (row & 255)] * ps[row] : 0.f;
    wcat[(size_t)row * 1024 + 512 + kk] = (bf16_t)(cvt_pk_bf16(v, 0.f) & 0xffffu);
  }
}

__device__ void norm_phase(const float* X, bf16_t* Hn, const float* gain, const float* modl, int ishift, int iscale) {
  const int tid_ = otid(), lane = tid_ & 63, gw = blockIdx.x * 8 + (tid_ >> 6), nw = gridDim.x * 8;
  for (int r = gw; r < ROWS; r += nw) {
    const int j = r < RLAT ? (r >> 12) : 8;
    const float* sh = modl + (size_t)(j * 9 + ishift) * 1024; const float* sc = modl + (size_t)(j * 9 + iscale) * 1024;
    const float* xr = X + (size_t)r * DM;
    f32x4 v[4]; float ss = 0.f;
#pragma unroll
    for (int i = 0; i < 2; ++i) { v[2 * i] = *(const f32x4*)(xr + lane * 8 + 512 * i); v[2 * i + 1] = *(const f32x4*)(xr + lane * 8 + 512 * i + 4); }
#pragma unroll
    for (int i = 0; i < 4; ++i) ss += v[i][0] * v[i][0] + v[i][1] * v[i][1] + v[i][2] * v[i][2] + v[i][3] * v[i][3];
#pragma unroll
    for (int o = 32; o >= 1; o >>= 1) ss += __shfl_xor(ss, o);
    const float rstd = rsqrtf(ss * (1.0f / 1024.0f) + 1e-6f);
#pragma unroll
    for (int i = 0; i < 2; ++i) {
      const int c0 = lane * 8 + 512 * i; float o[8];
#pragma unroll
      for (int hh = 0; hh < 2; ++hh) { const f32x4 g = *(const f32x4*)(gain + c0 + 4 * hh), s1 = *(const f32x4*)(sc + c0 + 4 * hh), s0 = *(const f32x4*)(sh + c0 + 4 * hh); const f32x4 y = v[2 * i + hh] * rstd * g * (s1 + 1.0f) + s0;
        o[4 * hh] = y[0]; o[4 * hh + 1] = y[1]; o[4 * hh + 2] = y[2]; o[4 * hh + 3] = y[3]; }
      u32x4 w; w.x = cvt_pk_bf16(o[0], o[1]); w.y = cvt_pk_bf16(o[2], o[3]); w.z = cvt_pk_bf16(o[4], o[5]); w.w = cvt_pk_bf16(o[6], o[7]);
      *(u32x4*)(Hn + (size_t)r * DM + c0) = w;
    }
  }
}
__device__ void final_norm(const float* X, float* out, const float* gain) {
  const int tid_ = otid(), lane = tid_ & 63, gw = blockIdx.x * 8 + (tid_ >> 6), nw = gridDim.x * 8;
  for (int r = gw; r < RLAT; r += nw) {
    const float* xr = X + (size_t)r * DM; f32x4 v[4]; float ss = 0.f;
#pragma unroll
    for (int i = 0; i < 4; ++i) { v[i] = *(const f32x4*)(xr + lane * 4 + 256 * i); ss += v[i][0] * v[i][0] + v[i][1] * v[i][1] + v[i][2] * v[i][2] + v[i][3] * v[i][3]; }
#pragma unroll
    for (int o = 32; o >= 1; o >>= 1) ss += __shfl_xor(ss, o);
    const float rstd = rsqrtf(ss * (1.0f / 1024.0f) + 1e-6f);
#pragma unroll
    for (int i = 0; i < 4; ++i) { const f32x4 g = *(const f32x4*)(gain + lane * 4 + 256 * i); *(f32x4*)(out + (size_t)r * DM + lane * 4 + 256 * i) = v[i] * rstd * g; }
  }
}

__device__ void phase0(const Params& p, ldsp L) {
  const int tid = otid(); const size_t gt = (size_t)blockIdx.x * NTHR + tid, gs = (size_t)gridDim.x * NTHR;
  { f32x4* X = (f32x4*)(lws(p.ws) + O_X); const f32x4* xs = (const f32x4*)p.x; const f32x4* cs = (const f32x4*)p.ctx; const size_t n1 = (size_t)RLAT * DM / 4, n2 = (size_t)ROWS * DM / 4;
    for (size_t i = gt; i < n2; i += gs) X[i] = i < n1 ? xs[i] : cs[i - n1]; }
  { bf16_t* D = (bf16_t*)(lws(p.ws) + O_DFT);
    for (size_t v = gt; v < (size_t)4096 * 512; v += gs) { const int k = (int)(v >> 9), j0 = (int)(v & 511) * 8; float o[8];
#pragma unroll
      for (int e = 0; e < 8; ++e) { const int j = j0 + e; const bool cs_ = j <= 2048; const int t = cs_ ? j : j - 2048; const int r = (k * t) & 4095; const float a = (float)r * (1.0f / 2048.0f);
        o[e] = cs_ ? cospif(a) * (1.0f / 64.0f) : -sinpif(a) * (1.0f / 64.0f); }
      u32x4 w; w.x = cvt_pk_bf16(o[0], o[1]); w.y = cvt_pk_bf16(o[2], o[3]); w.z = cvt_pk_bf16(o[4], o[5]); w.w = cvt_pk_bf16(o[6], o[7]);
      *(u32x4*)(D + (size_t)k * 4096 + j0) = w; } }
  for (int idx = tid; idx < 9 * 1024; idx += NTHR) { const int j = idx >> 10, k = idx & 1023; const float v = j < 8 ? p.c[j * 1024 + k] : p.c_ctx[k]; ldsst<float>(L, idx * 4, siluf_(v)); }
  __syncthreads();
  float* MOD = (float*)(lws(p.ws) + O_MOD);
  for (int item = blockIdx.x; item < DEPTH * 144; item += gridDim.x) {
    const int l = item / 144, n0 = (item - l * 144) * 64, ks = tid >> 6, cn = tid & 63;
    float acc[9];
#pragma unroll
    for (int j = 0; j < 9; ++j) acc[j] = 0.f;
    const float* wp = p.w_ada + ((size_t)l * 1024 + ks * 128) * 9216 + n0 + cn;
#pragma unroll 4
    for (int k = 0; k < 128; ++k) { const float w = wp[(size_t)k * 9216];
#pragma unroll
      for (int j = 0; j < 9; ++j) acc[j] += ldsld<float>(L, (j * 1024 + ks * 128 + k) * 4) * w; }
#pragma unroll
    for (int j = 0; j < 9; ++j) ldsst<float>(L, 36864 + ((ks * 9 + j) * 64 + cn) * 4, acc[j]);
    __syncthreads();
    for (int o = tid; o < 576; o += NTHR) { const int j = o >> 6, c = o & 63; float s = p.b_ada[(size_t)l * 9216 + n0 + c];
#pragma unroll
      for (int q = 0; q < 8; ++q) s += ldsld<float>(L, 36864 + ((q * 9 + j) * 64 + c) * 4);
      MOD[((size_t)l * 9 + j) * 9216 + n0 + c] = s; }
    __syncthreads();
  }
}

__device__ void prep_phase(const Params& p, int l, ldsp L) {
  const int tid = otid(), lane = tid & 63, wid = tid >> 6, fr = lane & 15, fq = lane >> 4;
  constexpr int KSB = 0, KTL = 17408, VTL = 35840, GL = 54272, AL = 71680, GCL = 104448, BTL = 104960, TOL = 105472;
  const bf16_t* QKV = (const bf16_t*)(lws(p.ws) + O_QKV); const float* AB = (const float*)(lws(p.ws) + O_AB);
  bf16_t* QN = (bf16_t*)(lws(p.ws) + O_QN); bf16_t* KN = (bf16_t*)(lws(p.ws) + O_KN); bf16_t* KNT = (bf16_t*)(lws(p.ws) + O_KNT); bf16_t* VNT = (bf16_t*)(lws(p.ws) + O_VNT);
  bf16_t* TT = (bf16_t*)(lws(p.ws) + O_TT); float* GC = (float*)(lws(p.ws) + O_GC);
  const float* cw = p.conv_w + (size_t)l * 3 * 1536;
  for (int item = blockIdx.x; item < NCH * 4; item += gridDim.x) {
    const int n = item >> 2, h = item & 3, R0 = n * 64;
    { const int row = tid >> 3, cs = tid & 7, r = R0 + row, c0 = cs * 16;
      const int t = r < RLAT ? (r & 4095) : ((r - RLAT) & 255), Ls = r < RLAT ? 4096 : 256;
      const bool hp = t > 0, hn = t < Ls - 1;
#pragma unroll
      for (int mtx = 0; mtx < 3; ++mtx) {
        const int cc = mtx * 512 + h * 128 + c0; const bf16_t* bp = QKV + (size_t)r * 1536 + cc;
        u32x4 a0 = {0, 0, 0, 0}, a1 = {0, 0, 0, 0}, c0v = {0, 0, 0, 0}, c1v = {0, 0, 0, 0};
        const u32x4 b0 = *(const u32x4*)(bp), b1 = *(const u32x4*)(bp + 8);
        if (hp) { a0 = *(const u32x4*)(bp - 1536); a1 = *(const u32x4*)(bp - 1536 + 8); }
        if (hn) { c0v = *(const u32x4*)(bp + 1536); c1v = *(const u32x4*)(bp + 1536 + 8); }
        float val[16]; float ss = 0.f;
#pragma unroll
        for (int e = 0; e < 16; ++e) {
          const unsigned wa = e < 8 ? a0[e >> 1] : a1[(e - 8) >> 1], wb = e < 8 ? b0[e >> 1] : b1[(e - 8) >> 1], wc_ = e < 8 ? c0v[e >> 1] : c1v[(e - 8) >> 1];
          const float xa = (e & 1) ? bfhi(wa) : bflo(wa), xb = (e & 1) ? bfhi(wb) : bflo(wb), xc = (e & 1) ? bfhi(wc_) : bflo(wc_);
          const float y = xa * cw[cc + e] + xb * cw[1536 + cc + e] + xc * cw[3072 + cc + e];
          val[e] = siluf_(y); ss += val[e] * val[e];
        }
        if (mtx < 2) { ss += __shfl_xor(ss, 1); ss += __shfl_xor(ss, 2); ss += __shfl_xor(ss, 4); const float sc = rsqrtf(ss + 1e-6f) * (mtx == 0 ? 0.08838834764831845f : 1.0f);
#pragma unroll
          for (int e = 0; e < 16; ++e) val[e] *= sc; }
        u32x4 w0, w1; w0.x = cvt_pk_bf16(val[0], val[1]); w0.y = cvt_pk_bf16(val[2], val[3]); w0.z = cvt_pk_bf16(val[4], val[5]); w0.w = cvt_pk_bf16(val[6], val[7]);
        w1.x = cvt_pk_bf16(val[8], val[9]); w1.y = cvt_pk_bf16(val[10], val[11]); w1.z = cvt_pk_bf16(val[12], val[13]); w1.w = cvt_pk_bf16(val[14], val[15]);
        if (mtx == 0) { bf16_t* o = QN + (size_t)r * 512 + h * 128 + c0; *(u32x4*)o = w0; *(u32x4*)(o + 8) = w1; }
        else if (mtx == 1) { bf16_t* o = KN + (size_t)r * 512 + h * 128 + c0; *(u32x4*)o = w0; *(u32x4*)(o + 8) = w1;
          ldsst<u32x4>(L, KSB + row * 272 + c0 * 2, w0); ldsst<u32x4>(L, KSB + row * 272 + c0 * 2 + 16, w1);
#pragma unroll
          for (int e = 0; e < 16; ++e) { const unsigned wv = e < 8 ? w0[e >> 1] : w1[(e - 8) >> 1]; ldsst<bf16_t>(L, KTL + (c0 + e) * 144 + row * 2, (bf16_t)((e & 1) ? (wv >> 16) : (wv & 0xffffu))); } }
        else {
#pragma unroll
          for (int e = 0; e < 16; ++e) { const unsigned wv = e < 8 ? w0[e >> 1] : w1[(e - 8) >> 1]; ldsst<bf16_t>(L, VTL + (c0 + e) * 144 + row * 2, (bf16_t)((e & 1) ? (wv >> 16) : (wv & 0xffffu))); } }
      }
    }
    if (wid < 2) {
      const int d = wid, r = R0 + lane;
      const float braw = AB[(size_t)r * 16 + d * 4 + h], araw = AB[(size_t)r * 16 + 8 + d * 4 + h];
      const float beta = sigmoidf_(braw);
      const float xs = araw + p.dt_bias[(l * 2 + d) * 4 + h];
      const float sp = fmaxf(xs, 0.f) + log1pf(__expf(-fabsf(xs)));
      const float g = -__expf(p.a_log[(l * 2 + d) * 4 + h]) * sp;
      float pre = g;
#pragma unroll
      for (int o = 1; o < 64; o <<= 1) { const float t2 = __shfl_up(pre, o); if (lane >= o) pre += t2; }
      const float tot = __shfl(pre, 63);
      const float gc = d == 0 ? pre : (tot - pre + g);
      ldsst<float>(L, GCL + (d * 64 + lane) * 4, gc); ldsst<float>(L, BTL + (d * 64 + lane) * 4, beta);
      GC[((size_t)item * 2 + d) * 64 + lane] = gc;
    }
    __syncthreads();
    { const int ti = wid >> 1;
#pragma unroll
      for (int q = 0; q < 2; ++q) { const int tj = 2 * (wid & 1) + q; f32x4 a = {0.f, 0.f, 0.f, 0.f};
#pragma unroll
        for (int kk = 0; kk < 4; ++kk) a = mma(ldsld<bf16x8>(L, KSB + (16 * tj + fr) * 272 + kk * 64 + fq * 16), ldsld<bf16x8>(L, KSB + (16 * ti + fr) * 272 + kk * 64 + fq * 16), a);
        ldsst<f32x4>(L, GL + ((16 * ti + fr) * 68 + 16 * tj + 4 * fq) * 4, a); }
    }
    {
#pragma unroll
      for (int it = 0; it < 2; ++it) { const int v = tid + 512 * it, c = v >> 3, sg = (v & 7) * 8;
        *(u32x4*)(KNT + (size_t)item * 8192 + c * 64 + sg) = ldsld<u32x4>(L, KTL + c * 144 + sg * 2);
        *(u32x4*)(VNT + (size_t)item * 8192 + c * 64 + sg) = ldsld<u32x4>(L, VTL + c * 144 + sg * 2); } }
    __syncthreads();
    { const int d = tid >> 8, a = (tid & 255) >> 2, jq = tid & 3;
      const int pi_ = d ? 63 - a : a; const float bi = ldsld<float>(L, BTL + (d * 64 + pi_) * 4), gi = ldsld<float>(L, GCL + (d * 64 + pi_) * 4);
#pragma unroll
      for (int e = 0; e < 16; ++e) { const int bb = jq * 16 + e, pr = d ? 63 - bb : bb;
        float v = 0.f;
        if (a > bb) v = bi * ldsld<float>(L, GL + (pi_ * 68 + pr) * 4) * __expf(gi - ldsld<float>(L, GCL + (d * 64 + pr) * 4));
        ldsst<float>(L, AL + ((d * 64 + a) * 64 + bb) * 4, v); } }
    __syncthreads();
    if (wid < 2) {
      const int d = wid, c = lane; constexpr int XL = 0;
#pragma unroll 1
      for (int bi = 0; bi < 4; ++bi) {
        float sv[16];
#pragma unroll
        for (int ii = 0; ii < 16; ++ii) sv[ii] = (16 * bi + ii == c) ? 1.f : 0.f;
#pragma unroll 1
        for (int j = 0; j < 16 * bi; j += 4) {
          float xj[4];
#pragma unroll
          for (int e = 0; e < 4; ++e) xj[e] = ldsld<float>(L, XL + ((d * 64 + j + e) * 64 + c) * 4);
#pragma unroll
          for (int ii = 0; ii < 16; ++ii) { const f32x4 av = ldsld<f32x4>(L, AL + ((d * 64 + 16 * bi + ii) * 64 + j) * 4); sv[ii] -= av[0] * xj[0] + av[1] * xj[1] + av[2] * xj[2] + av[3] * xj[3]; }
        }
        float xb[16];
#pragma unroll
        for (int ii = 0; ii < 16; ++ii) {
          float t = sv[ii];
#pragma unroll
          for (int j4 = 0; j4 < (ii + 3) / 4; ++j4) { const f32x4 av = ldsld<f32x4>(L, AL + ((d * 64 + 16 * bi + ii) * 64 + 16 * bi + j4 * 4) * 4);
#pragma unroll
            for (int e = 0; e < 4; ++e) if (j4 * 4 + e < ii) t -= av[e] * xb[j4 * 4 + e]; }
          xb[ii] = t;
          ldsst<float>(L, XL + ((d * 64 + 16 * bi + ii) * 64 + c) * 4, t);
        }
      }
      const int pr = d ? 63 - c : c; const float bc = ldsld<float>(L, BTL + (d * 64 + pr) * 4), fw = bc * __expf(ldsld<float>(L, GCL + (d * 64 + pr) * 4));
#pragma unroll 4
      for (int i = 0; i < 64; ++i) { const int pp = d ? 63 - i : i; const float xi = ldsld<float>(L, XL + ((d * 64 + i) * 64 + c) * 4);
        ldsst<bf16_t>(L, TOL + ((d * 2 + 0) * 64 + pp) * 144 + pr * 2, (bf16_t)(cvt_pk_bf16(xi * fw, 0.f) & 0xffffu));
        ldsst<bf16_t>(L, TOL + ((d * 2 + 1) * 64 + pp) * 144 + pr * 2, (bf16_t)(cvt_pk_bf16(xi * bc, 0.f) & 0xffffu)); }
    }
    __syncthreads();
#pragma unroll
    for (int it = 0; it < 4; ++it) { const int v = tid + 512 * it, mtx = v >> 9, row = (v >> 3) & 63, sg = (v & 7) * 8;
      *(u32x4*)(TT + ((size_t)item * 4 + mtx) * 4096 + row * 64 + sg) = ldsld<u32x4>(L, TOL + (mtx * 64 + row) * 144 + sg * 2); }
    __syncthreads();
  }
}

__device__ void fourier_prep(const Params& p, ldsp L) {
  const int tid = otid(), lane = tid & 63, wid = tid >> 6, fr = lane & 15, fq = lane >> 4;
  constexpr int UA = 0, UB = 33792, DC = 67584;
  const bf16_t* FI = (const bf16_t*)(lws(p.ws) + O_FI); bf16_t* FBT = (bf16_t*)(lws(p.ws) + O_FBT); float* UCS = (float*)(lws(p.ws) + O_UCS);
  for (int idx = tid; idx < 128 * 64; idx += NTHR) { const int rr = idx >> 6, c = idx & 63, m = rr & 63; const float a = (float)((m * c) & 63) * (1.0f / 32.0f);
    const float v = (rr < 64 ? cospif(a) : sinpif(a)) * 0.125f; ldsst<bf16_t>(L, DC + rr * 144 + c * 2, (bf16_t)(cvt_pk_bf16(v, 0.f) & 0xffffu)); }
  __syncthreads();
  for (int item = blockIdx.x; item < 288; item += gridDim.x) {
    const bool lat = item < 256; const int b = lat ? item >> 5 : 0, jb = item & 31;
#pragma unroll
    for (int it = 0; it < 4; ++it) { const int v = tid + 512 * it, row = v >> 5, sg = (v & 31) * 8;
      int ra, rb;
      if (lat) { const int t = 64 * jb + row; ra = b * 4096 + t; rb = b * 4096 + (t == 0 ? 2048 : 4096 - t); } else { ra = RLAT + (item - 256) * 64 + row; rb = ra; }
      ldsst<u32x4>(L, UA + row * 528 + sg * 2, *(const u32x4*)(FI + (size_t)ra * 256 + sg));
      ldsst<u32x4>(L, UB + row * 528 + sg * 2, *(const u32x4*)(FI + (size_t)rb * 256 + sg)); }
    __syncthreads();
    for (int q = 0; q < 8; ++q) {
      const int combo = wid * 8 + q, g = combo >> 4, ti = (combo >> 2) & 3, tm = combo & 3;
      f32x4 ac = {0.f, 0.f, 0.f, 0.f}, as = ac, bc = ac, bs = ac;
#pragma unroll
      for (int kk = 0; kk < 2; ++kk) {
        const bf16x8 xa = ldsld<bf16x8>(L, UA + (16 * ti + fr) * 528 + (g * 64 + kk * 32 + fq * 8) * 2), xb = ldsld<bf16x8>(L, UB + (16 * ti + fr) * 528 + (g * 64 + kk * 32 + fq * 8) * 2);
        const bf16x8 yc = ldsld<bf16x8>(L, DC + (16 * tm + fr) * 144 + kk * 64 + fq * 16), ys = ldsld<bf16x8>(L, DC + (64 + 16 * tm + fr) * 144 + kk * 64 + fq * 16);
        ac = mma(xa, yc, ac); as = mma(xa, ys, as); bc = mma(xb, yc, bc); bs = mma(xb, ys, bs);
      }
      const int mp = g * 64 + 16 * tm + fr, i0 = 16 * ti + 4 * fq;
      if (lat) {
        f32x4 cv = ac + bc, sv = as - bs;
        if (jb == 0 && i0 == 0) { cv[0] = ac[0]; sv[0] = bc[0]; }
        bf16_t* o = FBT + ((size_t)b * 256 + mp) * 4096 + 64 * jb + i0;
        *(u32x2*)o = pack4(cv); *(u32x2*)(o + 2048) = pack4(sv);
      } else {
#pragma unroll
        for (int e = 0; e < 4; ++e) { float* o = UCS + (size_t)((item - 256) * 64 + i0 + e) * 512; o[mp] = ac[e]; o[256 + mp] = as[e]; }
      }
    }
    __syncthreads();
  }
}

__device__ void ctx_fourier(const Params& p, ldsp L, int wg, int nwg) {
  const int tid = otid(); const float* UCS = (const float*)(lws(p.ws) + O_UCS); bf16_t* PPF = (bf16_t*)(lws(p.ws) + O_PPF);
  for (int idx = tid; idx < 256; idx += NTHR) { const float a = (float)idx * (1.0f / 128.0f); ldsst<float>(L, idx * 4, cospif(a) * (1.0f / 16.0f)); ldsst<float>(L, 1024 + idx * 4, sinpif(a) * (1.0f / 16.0f)); }
  __syncthreads();
  for (int o = wg * NTHR + tid; o < NB * 64 * 256; o += nwg * NTHR) {
    const int mp = o & 255, kq = (o >> 8) & 63, b = o >> 14; const float* u = UCS + (size_t)b * 256 * 512 + mp; float s4[4] = {0.f, 0.f, 0.f, 0.f};
#pragma unroll 8
    for (int t = 0; t < 256; ++t) { const float uc = u[(size_t)t * 512], us = u[(size_t)t * 512 + 256];
#pragma unroll
      for (int e = 0; e < 4; ++e) { const int r = ((4 * kq + e) * t) & 255; s4[e] += ldsld<float>(L, r * 4) * uc - ldsld<float>(L, 1024 + r * 4) * us; } }
#pragma unroll
    for (int e = 0; e < 4; ++e) PPF[(size_t)(RLAT + b * 256 + 4 * kq + e) * 512 + 256 + mp] = (bf16_t)(cvt_pk_bf16(s4[e], 0.f) & 0xffffu);
  }
  __syncthreads();
}
__device__ void pool_phase(const Params& p, ldsp L, int wg, int nwg) {
  const int tid_ = otid(), lane = tid_ & 63, wv = tid_ >> 6, gw = wg * 8 + wv, nw = nwg * 8;
  const bf16_t* PI = (const bf16_t*)(lws(p.ws) + O_PI); bf16_t* PPF = (bf16_t*)(lws(p.ws) + O_PPF);
  const int LP = wv * 16640;
  for (int idx = gw; idx < 2048; idx += nw) {
    const int g = 3 - (idx >> 9), b = (idx >> 6) & 7, r = idx & 63;
    const int win = 2 << g, hw = win >> 1, sr = max(r - hw, 0), er = min(r - hw + win, 64);
    const bf16_t* base = PI + (size_t)b * 4096 * 256 + g * 64 + lane;
    ldsst<float>(L, LP + lane * 4, 0.f);
    { const int ci = lane >> 3, ch0 = (lane & 7) * 8;
      const bf16_t* bq = PI + (size_t)b * 4096 * 256 + g * 64 + ch0;
#pragma unroll 2
      for (int cb = 0; cb < 8; ++cb) {
        const int cc = cb * 8 + ci; float ac[8];
#pragma unroll
        for (int e = 0; e < 8; ++e) ac[e] = 0.f;
#pragma unroll 4
        for (int rr = sr; rr < er; ++rr) { const u32x4 v = *(const u32x4*)(bq + (size_t)(rr * 64 + cc) * 256);
#pragma unroll
          for (int e = 0; e < 4; ++e) { ac[2 * e] += bflo(v[e]); ac[2 * e + 1] += bfhi(v[e]); } }
        ldsst<f32x4>(L, LP + ((cc + 1) * 64 + ch0) * 4, (f32x4){ac[0], ac[1], ac[2], ac[3]}); ldsst<f32x4>(L, LP + ((cc + 1) * 64 + ch0 + 4) * 4, (f32x4){ac[4], ac[5], ac[6], ac[7]});
      }
      float run = 0.f;
#pragma unroll 8
      for (int cc = 1; cc <= 64; ++cc) { run += ldsld<float>(L, LP + (cc * 64 + lane) * 4); ldsst<float>(L, LP + (cc * 64 + lane) * 4, run); }
    }
    const float rinv = 1.0f / (float)(er - sr);
#pragma unroll 4
    for (int c = 0; c < 64; ++c) {
      const int sc = max(c - hw, 0), ec = min(c - hw + win, 64);
      const float box = ldsld<float>(L, LP + (ec * 64 + lane) * 4) - ldsld<float>(L, LP + (sc * 64 + lane) * 4);
      const size_t rowi = (size_t)b * 4096 + r * 64 + c;
      const float self = __uint_as_float((unsigned)PI[rowi * 256 + g * 64 + lane] << 16);
      PPF[rowi * 512 + g * 64 + lane] = (bf16_t)(cvt_pk_bf16(box * rinv / (float)(ec - sc) - self, 0.f) & 0xffffu);
    }
  }
  for (int r = RLAT + gw; r < ROWS; r += nw) {
    const int base = r & ~255, t = r - base;
#pragma unroll
    for (int g = 0; g < 4; ++g) {
      const int win = 2 << g, hw = win >> 1, sc = max(t - hw, 0), ec = min(t - hw + win, 256);
      float s_ = 0.f;
      for (int c = sc; c < ec; ++c) s_ += __uint_as_float((unsigned)PI[(size_t)(base + c) * 256 + g * 64 + lane] << 16);
      const float self = __uint_as_float((unsigned)PI[(size_t)r * 256 + g * 64 + lane] << 16);
      PPF[(size_t)r * 512 + g * 64 + lane] = (bf16_t)(cvt_pk_bf16(s_ / (float)(ec - sc) - self, 0.f) & 0xffffu);
    }
  }
}

__device__ void scan_phase(const Params& p, ldsp L, int item) {
  const int tid = otid(), lane = tid & 63, wid = tid >> 6, fr = lane & 15, fq = lane >> 4;
  const int es = item & 1, d = (item >> 1) & 1, h = (item >> 2) & 3, b = item >> 4;
  const int ti = wid >> 1, half = wid & 1;
  constexpr int QS = 0, KS = 17408, KTS = 34816, VTS = 53248, TW = 62464, TU = 71680, AT = 80896, WL = 90112, VNT_ = 107520, VNS = 116736, STL = 125952, GCL = 143360;
  const bf16_t* QN = (const bf16_t*)(lws(p.ws) + O_QN); const bf16_t* KN = (const bf16_t*)(lws(p.ws) + O_KN); const bf16_t* KNT = (const bf16_t*)(lws(p.ws) + O_KNT); const bf16_t* VNT = (const bf16_t*)(lws(p.ws) + O_VNT);
  const bf16_t* TT = (const bf16_t*)(lws(p.ws) + O_TT); const float* GC = (const float*)(lws(p.ws) + O_GC); bf16_t* O = (bf16_t*)(lws(p.ws) + O_O) + (size_t)d * ROWS * 512;
  for (int o = tid * 16; o < 17408; o += NTHR * 16) ldsst<u32x4>(L, STL + o, (u32x4){0, 0, 0, 0});
  f32x4 accS[4];
#pragma unroll
  for (int q = 0; q < 4; ++q) accS[q] = (f32x4){0.f, 0.f, 0.f, 0.f};
  u32x4 rq[2], rk[2], rkt[2], rvt, rtw, rtu; float rgc = 0.f;
#define SCAN_CHUNK(s) ((s) < 4 ? (NB * 64 + b * 4 + (d ? 3 - (s) : (s))) : (b * 64 + (d ? 67 - (s) : (s) - 4)))
#define SCAN_GLOAD(s) do { const int n_ = SCAN_CHUNK(s), it2_ = n_ * 4 + h; \
    _Pragma("unroll") for (int it = 0; it < 2; ++it) { const int v = tid + 512 * it; \
      rq[it] = *(const u32x4*)(QN + (size_t)(64 * n_ + (v >> 4)) * 512 + h * 128 + (v & 15) * 8); rk[it] = *(const u32x4*)(KN + (size_t)(64 * n_ + (v >> 4)) * 512 + h * 128 + (v & 15) * 8); \
      rkt[it] = *(const u32x4*)(KNT + (size_t)it2_ * 8192 + (v >> 3) * 64 + (v & 7) * 8); } \
    rvt = *(const u32x4*)(VNT + (size_t)it2_ * 8192 + (es * 64 + (tid >> 3)) * 64 + (tid & 7) * 8); \
    rtw = *(const u32x4*)(TT + ((size_t)it2_ * 4 + d * 2 + 0) * 4096 + (tid >> 3) * 64 + (tid & 7) * 8); rtu = *(const u32x4*)(TT + ((size_t)it2_ * 4 + d * 2 + 1) * 4096 + (tid >> 3) * 64 + (tid & 7) * 8); \
    if (tid < 64) rgc = GC[((size_t)it2_ * 2 + d) * 64 + tid]; } while (0)
#define SCAN_LSTORE() do { \
    _Pragma("unroll") for (int it = 0; it < 2; ++it) { const int v = tid + 512 * it; \
      ldsst<u32x4>(L, QS + (v >> 4) * 272 + (v & 15) * 16, rq[it]); ldsst<u32x4>(L, KS + (v >> 4) * 272 + (v & 15) * 16, rk[it]); ldsst<u32x4>(L, KTS + (v >> 3) * 144 + (v & 7) * 16, rkt[it]); } \
    ldsst<u32x4>(L, VTS + (tid >> 3) * 144 + (tid & 7) * 16, rvt); ldsst<u32x4>(L, TW + (tid >> 3) * 144 + (tid & 7) * 16, rtw); ldsst<u32x4>(L, TU + (tid >> 3) * 144 + (tid & 7) * 16, rtu); \
    if (tid < 64) ldsst<float>(L, GCL + tid * 4, rgc); } while (0)
  SCAN_GLOAD(0); SCAN_LSTORE(); __syncthreads();
  for (int s = 0; s < 68; ++s) {
    const int n = SCAN_CHUNK(s);
    if (s + 1 < 68) SCAN_GLOAD(s + 1);
    const float gtot = ldsld<float>(L, GCL + (d ? 0 : 63) * 4);
    f32x4 uacc[2], qacc[2];
    bf16x8 sf[2][4];
    {
      bf16x8 qf[4], kf[2][4], twf[2], tuf[2], vtf[2][2], ktf[4][2];
#pragma unroll
      for (int kk = 0; kk < 4; ++kk) qf[kk] = ldsld<bf16x8>(L, QS + (16 * ti + fr) * 272 + kk * 64 + fq * 16);
#pragma unroll
      for (int q = 0; q < 2; ++q)
#pragma unroll
        for (int kk = 0; kk < 4; ++kk) { kf[q][kk] = ldsld<bf16x8>(L, KS + (16 * (2 * half + q) + fr) * 272 + kk * 64 + fq * 16); sf[q][kk] = ldsld<bf16x8>(L, STL + (16 * (2 * half + q) + fr) * 272 + kk * 64 + fq * 16); }
#pragma unroll
      for (int kk = 0; kk < 2; ++kk) { twf[kk] = ldsld<bf16x8>(L, TW + (16 * ti + fr) * 144 + kk * 64 + fq * 16); tuf[kk] = ldsld<bf16x8>(L, TU + (16 * ti + fr) * 144 + kk * 64 + fq * 16); }
#pragma unroll
      for (int q = 0; q < 4; ++q)
#pragma unroll
        for (int kk = 0; kk < 2; ++kk) ktf[q][kk] = ldsld<bf16x8>(L, KTS + (16 * (4 * half + q) + fr) * 144 + kk * 64 + fq * 16);
#pragma unroll
      for (int q = 0; q < 2; ++q)
#pragma unroll
        for (int kk = 0; kk < 2; ++kk) vtf[q][kk] = ldsld<bf16x8>(L, VTS + (16 * (2 * half + q) + fr) * 144 + kk * 64 + fq * 16);
      f32x4 at[2], wv[4];
#pragma unroll
      for (int q = 0; q < 2; ++q) { at[q] = (f32x4){0.f, 0.f, 0.f, 0.f}; qacc[q] = at[q]; uacc[q] = at[q]; }
#pragma unroll
      for (int q = 0; q < 4; ++q) wv[q] = (f32x4){0.f, 0.f, 0.f, 0.f};
#pragma unroll
      for (int kk = 0; kk < 4; ++kk)
#pragma unroll
        for (int q = 0; q < 2; ++q) { at[q] = mma(kf[q][kk], qf[kk], at[q]); qacc[q] = mma(sf[q][kk], qf[kk], qacc[q]); }
#pragma unroll
      for (int kk = 0; kk < 2; ++kk) {
#pragma unroll
        for (int q = 0; q < 4; ++q) wv[q] = mma(ktf[q][kk], twf[kk], wv[q]);
#pragma unroll
        for (int q = 0; q < 2; ++q) uacc[q] = mma(tuf[kk], vtf[q][kk], uacc[q]);
      }
      const int i = 16 * ti + fr; const float gi = ldsld<float>(L, GCL + i * 4);
#pragma unroll
      for (int q = 0; q < 2; ++q) {
        const int j0 = 16 * (2 * half + q) + 4 * fq; f32x4 a = at[q];
#pragma unroll
        for (int e = 0; e < 4; ++e) { const int j = j0 + e; const bool keep = d ? (i <= j) : (i >= j); const float ar = keep ? gi - ldsld<float>(L, GCL + j * 4) : 0.f; a[e] = keep ? a[e] * __expf(ar) : 0.f; }
        ldsst<u32x2>(L, AT + i * 144 + j0 * 2, pack4(a));
      }
#pragma unroll
      for (int q = 0; q < 4; ++q) ldsst<u32x2>(L, WL + (16 * ti + fr) * 272 + (16 * (4 * half + q) + 4 * fq) * 2, pack4(wv[q]));
    }
    __syncthreads();
    {
      bf16x8 wf[4];
#pragma unroll
      for (int kk = 0; kk < 4; ++kk) wf[kk] = ldsld<bf16x8>(L, WL + (16 * ti + fr) * 272 + kk * 64 + fq * 16);
      f32x4 a[2];
#pragma unroll
      for (int q = 0; q < 2; ++q) a[q] = (f32x4){0.f, 0.f, 0.f, 0.f};
#pragma unroll
      for (int kk = 0; kk < 4; ++kk)
#pragma unroll
        for (int q = 0; q < 2; ++q) a[q] = mma(wf[kk], sf[q][kk], a[q]);
      const int i0 = 16 * ti + 4 * fq; float sc4[4];
#pragma unroll
      for (int e = 0; e < 4; ++e) sc4[e] = __expf(gtot - ldsld<float>(L, GCL + (i0 + e) * 4));
#pragma unroll
      for (int q = 0; q < 2; ++q) {
        const int te = 2 * half + q; const f32x4 vn = uacc[q] - a[q]; f32x4 vs;
#pragma unroll
        for (int e = 0; e < 4; ++e) vs[e] = vn[e] * sc4[e];
        ldsst<u32x2>(L, VNT_ + (16 * te + fr) * 144 + i0 * 2, pack4(vn)); ldsst<u32x2>(L, VNS + (16 * te + fr) * 144 + i0 * 2, pack4(vs));
      }
    }
    __syncthreads();
    {
      bf16x8 af[2], vf[2][2], nsf[2], ktf[4][2];
#pragma unroll
      for (int q = 0; q < 4; ++q)
#pragma unroll
        for (int kk = 0; kk < 2; ++kk) ktf[q][kk] = ldsld<bf16x8>(L, KTS + (16 * (4 * half + q) + fr) * 144 + kk * 64 + fq * 16);
#pragma unroll
      for (int kk = 0; kk < 2; ++kk) { af[kk] = ldsld<bf16x8>(L, AT + (16 * ti + fr) * 144 + kk * 64 + fq * 16); nsf[kk] = ldsld<bf16x8>(L, VNS + (16 * ti + fr) * 144 + kk * 64 + fq * 16);
#pragma unroll
        for (int q = 0; q < 2; ++q) vf[q][kk] = ldsld<bf16x8>(L, VNT_ + (16 * (2 * half + q) + fr) * 144 + kk * 64 + fq * 16); }
      const float cd = __expf(gtot);
      f32x4 ov[2];
#pragma unroll
      for (int q = 0; q < 2; ++q) ov[q] = (f32x4){0.f, 0.f, 0.f, 0.f};
#pragma unroll
      for (int q = 0; q < 4; ++q) accS[q] = accS[q] * cd;
#pragma unroll
      for (int kk = 0; kk < 2; ++kk) {
#pragma unroll
        for (int q = 0; q < 2; ++q) ov[q] = mma(vf[q][kk], af[kk], ov[q]);
#pragma unroll
        for (int q = 0; q < 4; ++q) accS[q] = mma(ktf[q][kk], nsf[kk], accS[q]);
      }
      const int i = 16 * ti + fr; const float eg = __expf(ldsld<float>(L, GCL + i * 4));
#pragma unroll
      for (int q = 0; q < 2; ++q) { const f32x4 o4 = qacc[q] * eg + ov[q];
        *(u32x2*)(O + (size_t)(64 * n + i) * 512 + h * 128 + es * 64 + 16 * (2 * half + q) + 4 * fq) = pack4(o4); }
    }
    __syncthreads();
#pragma unroll
    for (int q = 0; q < 4; ++q) ldsst<u32x2>(L, STL + (16 * ti + fr) * 272 + (16 * (4 * half + q) + 4 * fq) * 2, pack4(accS[q]));
    if (s + 1 < 68) SCAN_LSTORE();
    __syncthreads();
  }
#undef SCAN_CHUNK
#undef SCAN_GLOAD
#undef SCAN_LSTORE
}

__device__ void ofprep_phase(const Params& p, int l) {
  const int tid_ = otid(), lane = tid_ & 63, gw = blockIdx.x * 8 + (tid_ >> 6), nw = gridDim.x * 8;
  const bf16_t* O0 = (const bf16_t*)(lws(p.ws) + O_O); const bf16_t* O1 = O0 + (size_t)ROWS * 512; const bf16_t* Z = (const bf16_t*)(lws(p.ws) + O_Z); bf16_t* OF = (bf16_t*)(lws(p.ws) + O_OF);
  const float* og = p.o_gain + (size_t)l * 128 + (lane & 15) * 8;
  for (int r = gw; r < ROWS; r += nw) {
    const u32x4 a = *(const u32x4*)(O0 + (size_t)r * 512 + lane * 8), bq = *(const u32x4*)(O1 + (size_t)r * 512 + lane * 8), zq = *(const u32x4*)(Z + (size_t)r * 512 + lane * 8);
    float o[8]; float ss = 0.f;
#pragma unroll
    for (int e = 0; e < 4; ++e) { o[2 * e] = bflo(a[e]) + bflo(bq[e]); o[2 * e + 1] = bfhi(a[e]) + bfhi(bq[e]); ss += o[2 * e] * o[2 * e] + o[2 * e + 1] * o[2 * e + 1]; }
    ss += __shfl_xor(ss, 1); ss += __shfl_xor(ss, 2); ss += __shfl_xor(ss, 4); ss += __shfl_xor(ss, 8);
    const float rstd = rsqrtf(ss * (1.0f / 128.0f) + 1e-6f);
    float y[8];
#pragma unroll
    for (int e = 0; e < 4; ++e) { y[2 * e] = o[2 * e] * rstd * og[2 * e] * siluf_(bflo(zq[e])); y[2 * e + 1] = o[2 * e + 1] * rstd * og[2 * e + 1] * siluf_(bfhi(zq[e])); }
    u32x4 w; w.x = cvt_pk_bf16(y[0], y[1]); w.y = cvt_pk_bf16(y[2], y[3]); w.z = cvt_pk_bf16(y[4], y[5]); w.w = cvt_pk_bf16(y[6], y[7]);
    *(u32x4*)(OF + (size_t)r * 512 + lane * 8) = w;
  }
}


#define XB_TMO      128
#define XB_XCNT(j)  (256  + 64 * (j))
#define XB_XSUB(j)  (1280 + 64 * (j))
#define XB_XGEN(j)  (2304 + 64 * (j))
#define XB_TOP      3328
#define XB_TOPGEN   3392
#define XCD_BAR_WORDS 3456
#define XB_SPIN_CAP (1u << 18)

__device__ __forceinline__ unsigned xb_ld(unsigned* p)              { return __hip_atomic_load(p, __ATOMIC_RELAXED, __HIP_MEMORY_SCOPE_AGENT); }
__device__ __forceinline__ unsigned xb_add(unsigned* p, unsigned v) { return __hip_atomic_fetch_add(p, v, __ATOMIC_RELAXED, __HIP_MEMORY_SCOPE_AGENT); }
__device__ __forceinline__ unsigned xb_xcc_id() { return (unsigned)__builtin_amdgcn_s_getreg((3 << 11) | 20) & 0xFu; }
#define XB_SPIN(cond, bar) do { unsigned _sp = 0; while (cond) { __builtin_amdgcn_s_sleep(1); \
    if ((++_sp & 255u) == 0u) { if (xb_ld(&(bar)[XB_TMO])) break; if (_sp > XB_SPIN_CAP) { atomicAdd(&(bar)[XB_TMO], 1u); break; } } } } while (0)

struct XcdBarrier {
    unsigned* bar; unsigned x;
    volatile LAS unsigned* st;
};

__device__ __forceinline__ XcdBarrier xcd_barrier_post(unsigned* bar, volatile LAS unsigned* st) {
    XcdBarrier b; b.bar = bar; b.x = xb_xcc_id(); b.st = st;
    if (threadIdx.x == 0) (void)xb_add(&bar[XB_XCNT(b.x)], 1u);
    return b;
}
__device__ __forceinline__ void xcd_barrier_complete(unsigned* bar, unsigned x, unsigned& nloc, unsigned& nx) {
    const unsigned G = gridDim.x * gridDim.y * gridDim.z;
    unsigned sum, cnt, mine, sp = 0u;
    for (;;) {
        sum = 0u; cnt = 0u; mine = 0u;
#pragma unroll
        for (unsigned j = 0; j < 16; ++j) { const unsigned c = xb_ld(&bar[XB_XCNT(j)]); sum += c; cnt += (c > 0u) ? 1u : 0u; mine = (j == x) ? c : mine; }
        if (sum == G) break;
        __builtin_amdgcn_s_sleep(1);
        if ((++sp & 255u) == 0u) { if (xb_ld(&bar[XB_TMO])) break; if (sp > XB_SPIN_CAP) { atomicAdd(&bar[XB_TMO], 1u); break; } }
    }
    nloc = mine > 0u ? mine : 1u; nx = cnt > 0u ? cnt : 1u;
}

__device__ __forceinline__ void xcd_barrier(const XcdBarrier& b) {
    asm volatile("s_waitcnt vmcnt(0)" ::: "memory");
    __syncthreads();
    if (threadIdx.x == 0) {
        unsigned* bar = b.bar;
        __builtin_amdgcn_s_waitcnt(0);
        unsigned nloc = b.st[0], nx = b.st[1];
        if (nloc == 0u) { xcd_barrier_complete(bar, b.x, nloc, nx); b.st[0] = nloc; b.st[1] = nx; }
        const unsigned old = xb_add(&bar[XB_XSUB(b.x)], 1u);
        const unsigned gen = old / nloc;
        if (old + 1u == (gen + 1u) * nloc) {
            __builtin_amdgcn_fence(__ATOMIC_RELEASE, "agent");
            asm volatile("s_waitcnt vmcnt(0)" ::: "memory");
            const unsigned og = xb_add(&bar[XB_TOP], 1u);
            const unsigned tg = og / nx;
            if (og + 1u == (tg + 1u) * nx) xb_add(&bar[XB_TOPGEN], 1u);
            else XB_SPIN(xb_ld(&bar[XB_TOPGEN]) == tg, bar);
            __builtin_amdgcn_fence(__ATOMIC_ACQUIRE, "agent");
            xb_add(&bar[XB_XGEN(b.x)], 1u);
            asm volatile("s_waitcnt vmcnt(0)" ::: "memory");
        } else {
            XB_SPIN(xb_ld(&bar[XB_XGEN(b.x)]) == gen, bar);
            __builtin_amdgcn_fence(__ATOMIC_ACQUIRE, "agent");
            asm volatile("s_waitcnt vmcnt(0)" ::: "memory");
        }
    }
    __syncthreads();
}


__device__ __forceinline__ float rdb(const bf16_t* s_, size_t n, size_t i) { float a = 0.f; for (size_t j = i; j < n; j += (size_t)RLAT * DM) a += __uint_as_float((unsigned)s_[j] << 16); return a; }
__device__ __forceinline__ float rdf(const float* s_, size_t n, size_t i) { float a = 0.f; for (size_t j = i; j < n; j += (size_t)RLAT * DM) a += s_[j]; return a; }
__device__ void dump_phase(const Params& p, int which) {
  const size_t NO = (size_t)RLAT * DM; unsigned char* ws = lws(p.ws);
  for (size_t i = (size_t)blockIdx.x * NTHR + otid(); i < NO; i += (size_t)gridDim.x * NTHR) {
    float a = 0.f;
    if (which == 1) { a = rdb((const bf16_t*)(ws + O_QKV), (size_t)ROWS * 1536, i) + rdb((const bf16_t*)(ws + O_Z), (size_t)ROWS * 512, i) + rdb((const bf16_t*)(ws + O_PI), (size_t)ROWS * 256, i) + rdb((const bf16_t*)(ws + O_FI), (size_t)ROWS * 256, i) + rdf((const float*)(ws + O_AB), (size_t)ROWS * 16, i); }
    if (which == 2) { a = rdb((const bf16_t*)(ws + O_QN), (size_t)ROWS * 512, i) + rdb((const bf16_t*)(ws + O_KN), (size_t)ROWS * 512, i) + rdb((const bf16_t*)(ws + O_KNT), (size_t)ROWS * 512, i) + rdb((const bf16_t*)(ws + O_VNT), (size_t)ROWS * 512, i) + rdb((const bf16_t*)(ws + O_TT), (size_t)ROWS * 1024, i) + rdf((const float*)(ws + O_GC), (size_t)NCH * 4 * 2 * 64, i)
          + rdb((const bf16_t*)(ws + O_FBT), (size_t)NB * 256 * 4096, i) + rdf((const float*)(ws + O_UCS), (size_t)NB * CTX * 512, i); }
    if (which == 3) { a = rdb((const bf16_t*)(ws + O_O), (size_t)ROWS * 1024, i); }
    if (which == 4) { a = rdb((const bf16_t*)(ws + O_OF), (size_t)ROWS * 512, i) + rdb((const bf16_t*)(ws + O_HN), (size_t)ROWS * 1024, i); }
    if (which == 5) { a = rdb((const bf16_t*)(ws + O_MRG), (size_t)ROWS * 1024, i); }
    if ((__float_as_uint(a) & 0xffff0000u) == 0xaaaa0000u) a = 1234.5f;
    if (!(a == a) || fabsf(a) > 1e30f) a = 777.0f;
    a = a * 0.5f + 0.12345678f;
    p.out[i] = a;
  }
}
__global__ void __launch_bounds__(NTHR) fwd_megakernel(Params p) {
  extern __shared__ __attribute__((aligned(16))) unsigned char shm[];
  ldsp L = (ldsp)shm;
  cg::grid_group grid = cg::this_grid();
  volatile LAS unsigned* xst = (volatile LAS unsigned*)(L + LDS_BYTES - 16);
  if (threadIdx.x < 4) xst[threadIdx.x] = 0u;
  __syncthreads();
  XcdBarrier xbar = xcd_barrier_post((unsigned*)(p.ws + O_BAR), xst);
#define GSYNC0() do { asm volatile("s_waitcnt vmcnt(0) lgkmcnt(0)" ::: "memory"); __builtin_amdgcn_fence(__ATOMIC_RELEASE, "agent"); grid.sync(); __builtin_amdgcn_fence(__ATOMIC_ACQUIRE, "agent"); } while (0)
#define GSYNC() xcd_barrier(xbar)
  const int G = gridDim.x, c = blockIdx.x;
#define X ((float*)(lws(p.ws) + O_X))
#define MOD ((const float*)(lws(p.ws) + O_MOD))
#define Hn ((bf16_t*)(lws(p.ws) + O_HN))
#ifndef NO_P0
  phase0(p, L);
#endif
  GSYNC0();
  for (int l = 0; l < DEPTH; ++l) {
    const float* modl = MOD + (size_t)l * 9 * 9216; const float* ng = p.norm_gain + (size_t)l * 3 * 1024;
    convert_ffn(p, p.w1gu + (size_t)l * 1024 * 2 * DFF, p.w1d + (size_t)l * DFF * 1024, L);
    convert_mixer(p, l, L);
    norm_phase(X, Hn, ng, modl, 0, 1);
    GSYNC();
#ifndef PROBE_UP
#define PROBE_UP 1
#endif
    for (int rep_ = 0; rep_ < PROBE_UP; ++rep_)
    { pg8::PlainSched S{(const char*)Hn, (const char*)(lws(p.ws) + O_WGU), 2048, 2048, 16, ROWS / 256, 22, G, c}; EpiUp E{(bf16_t*)(lws(p.ws) + O_ACT)}; pg8::gemm_phase(L, S, E); }
    GSYNC();
    { pg8::PlainSched S{(const char*)(lws(p.ws) + O_ACT), (const char*)(lws(p.ws) + O_WD), DFF * 2, DFF * 2, DFF / 64, ROWS / 256, 4, G, c}; EpiRes E{X, modl, 2, 0.5f}; pg8::gemm_phase(L, S, E); }
    GSYNC();
#ifndef NO_MIXER
    norm_phase(X, Hn, ng + 1024, modl, 3, 4);
    GSYNC();
#ifndef PROBE_IN
#define PROBE_IN 1
#endif
    for (int rep_ = 0; rep_ < PROBE_IN; ++rep_)
    { pg8::PlainSched S{(const char*)Hn, (const char*)(lws(p.ws) + O_WIN), 2048, 2048, 16, ROWS / 256, NINP / 256, G, c};
      EpiIn E{(bf16_t*)(lws(p.ws) + O_QKV), (bf16_t*)(lws(p.ws) + O_Z), (bf16_t*)(lws(p.ws) + O_PI), (bf16_t*)(lws(p.ws) + O_FI), (float*)(lws(p.ws) + O_AB)}; pg8::gemm_phase(L, S, E); }
    GSYNC();
#ifndef PROBE_PREP
#define PROBE_PREP 1
#endif
    for (int rep_ = 0; rep_ < PROBE_PREP; ++rep_) {
    prep_phase(p, l, L);
    }
#ifndef NO_FPREP
    fourier_prep(p, L);
#endif
    GSYNC();
#if defined(DUMP) && DUMP == 2
    dump_phase(p, 2); return;
#endif
#ifndef PROBE_SCAN
#define PROBE_SCAN 1
#endif
#ifndef PROBE_OTHER
#define PROBE_OTHER 1
#endif
    for (int rep_ = 0; rep_ < PROBE_SCAN; ++rep_) {
#ifndef NO_SCAN
    if (c < 128) scan_phase(p, L, c);
#else
    if (c < 128) {}
#endif
    else for (int rep2_ = 0; rep2_ < PROBE_OTHER; ++rep2_) {
      __syncthreads();
      { FourSched S{(const char*)(lws(p.ws) + O_DFT), (const char*)(lws(p.ws) + O_FBT), c - 128}; EpiBf E{(bf16_t*)(lws(p.ws) + O_PPF) + 256, 512}; pg8::gemm_phase(L, S, E); }
      __syncthreads();
      ctx_fourier(p, L, c - 128, G - 128);
      pool_phase(p, L, c - 128, G - 128);
    }
    __syncthreads();
    }
    GSYNC();
#if defined(DUMP) && DUMP == 3
    dump_phase(p, 3); return;
#endif
    ofprep_phase(p, l);
    norm_phase(X, Hn, ng + 1024, modl, 3, 4);
    GSYNC();
#if defined(DUMP) && DUMP == 4
    dump_phase(p, 4); return;
#endif
#ifndef PROBE_MRG
#define PROBE_MRG 1
#endif
    for (int rep_ = 0; rep_ < PROBE_MRG; ++rep_)
    { MergeSched S{(const char*)Hn, (const char*)(lws(p.ws) + O_OF), (const char*)(lws(p.ws) + O_PPF), (const char*)(lws(p.ws) + O_WG), (const char*)(lws(p.ws) + O_WCAT), G, c};
      EpiMerge E{(float*)(lws(p.ws) + O_SCR) + (size_t)c * 2 * 65536, (bf16_t*)(lws(p.ws) + O_MRG)}; pg8::gemm_phase(L, S, E); }
    GSYNC();
#if defined(DUMP) && DUMP == 5
    dump_phase(p, 5); return;
#endif
    { pg8::PlainSched S{(const char*)(lws(p.ws) + O_MRG), (const char*)(lws(p.ws) + O_WOUT), 2048, 2048, 16, ROWS / 256, 4, G, c}; EpiRes E{X, modl, 5, 1.0f}; pg8::gemm_phase(L, S, E); }
    GSYNC();
#endif
    convert_ffn(p, p.w2gu + (size_t)l * 1024 * 2 * DFF, p.w2d + (size_t)l * DFF * 1024, L);
    norm_phase(X, Hn, ng + 2048, modl, 6, 7);
    GSYNC();
    { pg8::PlainSched S{(const char*)Hn, (const char*)(lws(p.ws) + O_WGU), 2048, 2048, 16, ROWS / 256, 22, G, c}; EpiUp E{(bf16_t*)(lws(p.ws) + O_ACT)}; pg8::gemm_phase(L, S, E); }
    GSYNC();
    { pg8::PlainSched S{(const char*)(lws(p.ws) + O_ACT), (const char*)(lws(p.ws) + O_WD), DFF * 2, DFF * 2, DFF / 64, ROWS / 256, 4, G, c}; EpiRes E{X, modl, 8, 0.5f}; pg8::gemm_phase(L, S, E); }
    GSYNC();
  }
  final_norm(X, p.out, p.final_gain);
}

extern "C" void kernel_launch(void* const* d_in, const int* in_sizes, int n_in, void* d_out, int out_size, void* d_ws, size_t ws_size, hipStream_t stream) {
  (void)in_sizes; (void)n_in; (void)out_size;
  if (ws_size < WS_NEED) { fprintf(stderr, "workspace too small: %zu < %zu\n", ws_size, (size_t)WS_NEED); return; }
  static int grid_blocks = 0;
  if (!grid_blocks) {
    (void)hipFuncSetAttribute((const void*)fwd_megakernel, hipFuncAttributeMaxDynamicSharedMemorySize, LDS_BYTES);
    int dev = 0, cus = 0, per_cu = 0; (void)hipGetDevice(&dev); (void)hipDeviceGetAttribute(&cus, hipDeviceAttributeMultiprocessorCount, dev);
    (void)hipOccupancyMaxActiveBlocksPerMultiprocessor(&per_cu, fwd_megakernel, NTHR, LDS_BYTES);
    grid_blocks = cus * (per_cu > 0 ? 1 : 0);
    if (grid_blocks != 256) fprintf(stderr, "unexpected grid %d (cus %d per_cu %d)\n", grid_blocks, cus, per_cu);
  }
  Params p{};
  const float** f = (const float**)&p;
  for (int i = 0; i < 22; ++i) f[i] = (const float*)d_in[i];
  p.out = (float*)d_out; p.ws = (unsigned char*)d_ws;
  (void)hipMemsetAsync((unsigned char*)d_ws + O_BAR, 0, 16384, stream);
  void* args[] = {&p};
  hipError_t e = hipLaunchCooperativeKernel((void*)fwd_megakernel, dim3(grid_blocks), dim3(NTHR), args, LDS_BYTES, stream);
  if (e != hipSuccess) fprintf(stderr, "cooperative launch failed: %s (grid %d)\n", hipGetErrorString(e), grid_blocks);
}
```

```cpp
#include <hip/hip_runtime.h>
#include <hip/hip_cooperative_groups.h>
#include <cstdio>
#define NO_SPLITK 1
#ifdef NO_SPLITK
#define RES_ATOMIC false
#else
#define RES_ATOMIC true
#endif

namespace cg = cooperative_groups;

#define LAS __attribute__((address_space(3)))
typedef LAS unsigned char* ldsp;
typedef unsigned short bf16_t;
typedef short bf16x8 __attribute__((ext_vector_type(8)));
typedef float f32x4 __attribute__((ext_vector_type(4)));
typedef unsigned u32x4 __attribute__((ext_vector_type(4)));
typedef unsigned u32x2 __attribute__((ext_vector_type(2)));

constexpr int DM = 1024, NB = 8, SEQ = 4096, CTX = 256, DEPTH = 4;
constexpr int RLAT = NB * SEQ, ROWS = RLAT + NB * CTX;
constexpr int DFF = 2816, NMOD = 9, DPROJ = 5648;
constexpr int NCH = ROWS / 64;
constexpr int NINP = 2816;
constexpr int LDS_BYTES = 163840;
constexpr int NTHR = 512;

constexpr size_t al256(size_t x) { return (x + 255) & ~(size_t)255; }
constexpr size_t O_X = 0;
constexpr size_t O_MOD = O_X + (size_t)ROWS * DM * 4;
constexpr size_t O_DFT = al256(O_MOD + (size_t)DEPTH * 9 * 9216 * 4);
constexpr size_t O_WGU = O_DFT + (size_t)4096 * 4096 * 2;
constexpr size_t O_WD = O_WGU + (size_t)5632 * 1024 * 2;
constexpr size_t O_WIN = O_WD + (size_t)1024 * 2816 * 2;
constexpr size_t O_WG = O_WIN + (size_t)NINP * 1024 * 2;
constexpr size_t O_WCAT = O_WG + (size_t)3072 * 1024 * 2;
constexpr size_t O_WOUT = O_WCAT + (size_t)1024 * 1024 * 2;
constexpr size_t O_R = O_WOUT + (size_t)1024 * 1024 * 2;
constexpr size_t SZ_H = (size_t)ROWS * 1024 * 2;
constexpr size_t SZ_Q = (size_t)ROWS * 512 * 2;
constexpr size_t O_HN = O_R;
constexpr size_t O_ACT = O_R + SZ_H;
constexpr size_t O_QN = O_R;
constexpr size_t O_KN = O_R + SZ_Q;
constexpr size_t O_QKV = O_R + SZ_H;
constexpr size_t O_O = O_QKV;
constexpr size_t O_SCR = O_QKV;
constexpr size_t O_Z = O_QKV + (size_t)ROWS * 1536 * 2;
constexpr size_t O_PI = O_Z + SZ_Q;
constexpr size_t O_FI = O_PI + (size_t)ROWS * 256 * 2;
constexpr size_t O_AB = O_FI + (size_t)ROWS * 256 * 2;
constexpr size_t O_KNT = al256(O_AB + (size_t)ROWS * 16 * 4);
constexpr size_t O_VNT = O_KNT + SZ_Q;
constexpr size_t O_MRG = O_KNT;
constexpr size_t O_TT = O_VNT + SZ_Q;
constexpr size_t O_OF = O_TT;
constexpr size_t O_GC = O_TT + SZ_H;
constexpr size_t O_FBT = al256(O_GC + (size_t)NCH * 4 * 2 * 64 * 4);
constexpr size_t O_UCS = O_FBT + (size_t)NB * 256 * 4096 * 2;
constexpr size_t O_PPF = al256(O_UCS + (size_t)NB * CTX * 512 * 4);
constexpr size_t O_BAR = al256(O_PPF + SZ_Q);
constexpr size_t WS_NEED = O_BAR + 16384;
static_assert(O_SCR + (size_t)256 * 2 * 262144 <= O_PI, "merge scratch overlaps");

struct Params {
  const float *x, *c, *ctx, *c_ctx, *w_ada, *b_ada, *norm_gain, *w1gu, *w1d, *w2gu, *w2d, *w_in, *conv_w, *a_log, *dt_bias, *o_gain, *w_a, *w_b,
      *pool_scale, *w_c, *w_out, *final_gain;
  float* out;
  unsigned char* ws;
};

typedef float f32x2_ __attribute__((ext_vector_type(2)));
typedef __bf16 bf16x2_ __attribute__((ext_vector_type(2)));
__device__ __forceinline__ unsigned cvt_pk_bf16(float lo, float hi) { const f32x2_ v = {lo, hi}; const bf16x2_ b = __builtin_convertvector(v, bf16x2_); return __builtin_bit_cast(unsigned, b); }
__device__ __forceinline__ float bflo(unsigned w) { return __uint_as_float(w << 16); }
__device__ __forceinline__ float bfhi(unsigned w) { return __uint_as_float(w & 0xffff0000u); }
__device__ __forceinline__ float sigmoidf_(float x) { return __builtin_amdgcn_rcpf(1.0f + __expf(-x)); }
__device__ __forceinline__ float siluf_(float x) { return x * __builtin_amdgcn_rcpf(1.0f + __expf(-x)); }
template <class T> __device__ __forceinline__ T ldsld(ldsp b, int off) { return *(const LAS T*)(b + off); }
template <class T> __device__ __forceinline__ void ldsst(ldsp b, int off, T v) { *(LAS T*)(b + off) = v; }
__device__ __forceinline__ f32x4 mma(bf16x8 a, bf16x8 b, f32x4 c) { return __builtin_amdgcn_mfma_f32_16x16x32_bf16(a, b, c, 0, 0, 0); }
__device__ __forceinline__ u32x2 pack4(f32x4 v) { u32x2 r; r.x = cvt_pk_bf16(v[0], v[1]); r.y = cvt_pk_bf16(v[2], v[3]); return r; }
__device__ __forceinline__ int otid() { int t = threadIdx.x; asm volatile("" : "+v"(t)); return t; }
__device__ __forceinline__ unsigned char* lws(unsigned char* q) { asm volatile("" : "+s"(q)); return q; }
__device__ __forceinline__ void atomic_add_f32(float* q, float v) { asm volatile("global_atomic_add_f32 %0, %1, off sc1" : : "v"(q), "v"(v) : "memory"); }
__device__ __forceinline__ int modidx(int pm) { return pm < 128 ? (pm >> 4) : 8; }

namespace pg8 {
constexpr int BM = 256, BK = 64, HALF = 128, HTB = HALF * BK * 2, NXCD = 8, WGM = 8;
__device__ __forceinline__ int lds_byte(int r, int c) { const int st = (r >> 4) * 2 + (c >> 5), rr = r & 15, cc = c & 31, ob = rr * 64 + cc * 2; return st * 1024 + (ob ^ (((ob >> 9) & 1) << 5)); }
__device__ __forceinline__ void stage_rc(int b, int& R, int& C) { const int st = b / 1024, sb = b % 1024, swz = sb ^ (((sb >> 9) & 1) << 5); R = (st >> 1) * 16 + swz / 64; C = (st & 1) * 32 + (swz % 64) / 2; }
__device__ __forceinline__ int perm32(int rho) { const int n = rho >> 4, i = rho & 15; return 8 * (i >> 2) + 4 * n + (i & 3); }

struct Unit { const char* A; const char* B; int lda, ldb, nt, pm, pn, seg; };

__device__ __forceinline__ bool tile_of(int nM, int nN, int G, int c, int i, int& pm, int& pn) {
  const int nwg = nM * nN; const long Lq = (long)i * G + c; if (Lq >= nwg) return false;
  int wgid = (int)Lq; { const int q = nwg / NXCD, r = nwg % NXCD, xcd = wgid % NXCD, off = wgid / NXCD; wgid = (xcd < r ? xcd * (q + 1) : r * (q + 1) + (xcd - r) * q) + off; }
  const int nig = WGM * nN, gid = wgid / nig, fm = gid * WGM, gsz = (nM - fm) < WGM ? (nM - fm) : WGM;
  pm = fm + ((wgid % nig) % gsz); pn = (wgid % nig) / gsz; return true;
}
struct PlainSched {
  static constexpr bool VARLDA = false;
  const char* A; const char* B; int lda, ldb, nt, nM, nN, G, c;
  __device__ __forceinline__ bool next(int i, Unit& u) const {
    int pm, pn; if (!tile_of(nM, nN, G, c, i, pm, pn)) return false;
    u.A = A + (size_t)pm * 256 * lda; u.B = B + (size_t)pn * 256 * ldb; u.lda = lda; u.ldb = ldb; u.nt = nt; u.pm = pm; u.pn = pn; u.seg = 0; return true;
  }
};

struct ResSched {
  static constexpr bool VARLDA = false;
  const char* A; const char* B; int ld, nt, G, c, mode;
  __device__ __forceinline__ bool next(int i, Unit& u) const {
    u.lda = ld; u.ldb = ld;
    if (mode == 0) { int pm, pn; if (i >= 2 || !tile_of(128, 4, G, c, i, pm, pn)) return false;
      u.A = A + (size_t)pm * 256 * ld; u.B = B + (size_t)pn * 256 * ld; u.nt = nt; u.pm = pm; u.pn = pn; u.seg = 0; return true; }
#ifdef NO_SPLITK
    if (i > 0 || c >= 32) return false;
    { const int pm = 128 + (c >> 2), pn = c & 3; u.A = A + (size_t)pm * 256 * ld; u.B = B + (size_t)pn * 256 * ld; u.nt = nt; u.pm = pm; u.pn = pn; u.seg = 0; return true; }
#endif
    if (i > 0 || c >= 256) return false;
    const int pm = 128 + (c >> 5), pn = (c >> 3) & 3, kp = c & 7;
    const int base = (nt / 16) * 2, extra = (nt - base * 8) / 2;
    const int k0 = kp * base + 2 * (kp < extra ? kp : extra), np = base + (kp < extra ? 2 : 0);
    u.A = A + (size_t)pm * 256 * ld + (size_t)k0 * 128; u.B = B + (size_t)pn * 256 * ld + (size_t)k0 * 128; u.nt = np; u.pm = pm; u.pn = pn; u.seg = 1; return true;
  }
};
template <class Epi, class Sched>
__device__ __forceinline__ void gemm_phase(ldsp lds, const Sched& S, const Epi& E) {
  const int tid = otid(), wid = __builtin_amdgcn_readfirstlane(tid >> 6), lane = tid & 63, wr = wid >> 2, wc = wid & 3, fr = lane & 15, fq = lane >> 4;
  unsigned rA[2], rB[2], c2[2];
#pragma unroll
  for (int i = 0; i < 2; ++i) { int R, C; stage_rc(tid * 16 + i * 8192, R, C); rA[i] = (unsigned)R; rB[i] = (unsigned)(Epi::PERM ? ((R & ~31) + perm32(R & 31)) : R); c2[i] = (unsigned)C * 2u; }
  const size_t kstep = (size_t)(BK * 2);
  const unsigned ldsw = (unsigned)wid * 1024u;
  const int aoff = lds_byte(wr * 64 + fr, fq * 8), boff = lds_byte(wc * 32 + fr, fq * 8);
#define PG8_SA(b, h) (((b) * 2 + (h)) * HTB)
#define PG8_SB(b, h) ((4 + (b) * 2 + (h)) * HTB)
#define PG8_STAGE(bufoff, gbase, voff) do { _Pragma("unroll") for (int _i = 0; _i < 2; ++_i) \
    __builtin_amdgcn_global_load_lds((const unsigned*)((const char*)(gbase) + (voff)[_i]), (LAS unsigned*)(lds + (bufoff) + ldsw + _i * 8192), 16, 0, 0); } while (0)
#define PG8_LDA(dst, b, h) do { _Pragma("unroll") for (int m = 0; m < 4; ++m) _Pragma("unroll") for (int k = 0; k < 2; ++k) dst[m][k] = *(const LAS bf16x8*)(lds + PG8_SA(b, h) + aoff + m * 2048 + k * 1024); } while (0)
#define PG8_LDB(dst, b, h) do { _Pragma("unroll") for (int n = 0; n < 2; ++n) _Pragma("unroll") for (int k = 0; k < 2; ++k) dst[n][k] = *(const LAS bf16x8*)(lds + PG8_SB(b, h) + boff + n * 2048 + k * 1024); } while (0)
#define PG8_MMA(ai, bj, At, Bt) do { __builtin_amdgcn_s_setprio(1); _Pragma("unroll") for (int m = 0; m < 4; ++m) _Pragma("unroll") for (int n = 0; n < 2; ++n) _Pragma("unroll") for (int k = 0; k < 2; ++k) \
    acc[ai][bj][m][n] = __builtin_amdgcn_mfma_f32_16x16x32_bf16(Bt[n][k], At[m][k], acc[ai][bj][m][n], 0, 0, 0); __builtin_amdgcn_s_setprio(0); } while (0)
#define PG8_WAIT_V(n) asm volatile("s_waitcnt vmcnt(" #n ")" ::: "memory")
#define PG8_WAIT_L(n) asm volatile("s_waitcnt lgkmcnt(" #n ")" ::: "memory")
#define PG8_BAR __builtin_amdgcn_s_barrier()
#define PG8_SCHED __builtin_amdgcn_sched_barrier(0)
  Unit cur, nxt; int ui = 0;
  if (!S.next(0, cur)) return;
  float zz_; asm volatile("v_mov_b32 %0, 0" : "=v"(zz_));
  f32x4 acc[2][2][4][2];
#pragma unroll
  for (int a = 0; a < 2; ++a)
#pragma unroll
    for (int b = 0; b < 2; ++b)
#pragma unroll
      for (int m = 0; m < 4; ++m)
#pragma unroll
        for (int n = 0; n < 2; ++n) acc[a][b][m][n] = (f32x4){zz_, zz_, zz_, zz_};
  bf16x8 At[4][2], B0[2][2], B1[2][2];
  const char* cA = cur.A; const char* cB = cur.B; int ldA = cur.lda; const int ldB = cur.ldb;
  unsigned voffA[2], voffB[2];
#pragma unroll
  for (int i = 0; i < 2; ++i) { voffA[i] = rA[i] * (unsigned)ldA + c2[i]; voffB[i] = rB[i] * (unsigned)ldB + c2[i]; }
  const size_t hB = (size_t)HALF * ldB;
  {
    const size_t hA = (size_t)HALF * ldA;
    PG8_STAGE(PG8_SB(0, 0), cB, voffB); PG8_STAGE(PG8_SA(0, 0), cA, voffA); PG8_STAGE(PG8_SB(0, 1), cB + hB, voffB); PG8_STAGE(PG8_SA(0, 1), cA + hA, voffA);
    if (wr == 1) PG8_BAR;
    PG8_WAIT_V(4); PG8_BAR;
    PG8_STAGE(PG8_SB(1, 0), cB + kstep, voffB); PG8_STAGE(PG8_SA(1, 0), cA + kstep, voffA); PG8_STAGE(PG8_SB(1, 1), cB + hB + kstep, voffB);
    PG8_WAIT_V(6); PG8_BAR;
  }
  for (;;) {
    const bool has_next = S.next(ui + 1, nxt);
    const char* nA = has_next ? nxt.A : cA; const char* nB = has_next ? nxt.B : cB;
    const int nldA = has_next ? nxt.lda : ldA;
    const int nt = cur.nt;
    const size_t hA = (size_t)HALF * ldA;
    for (int t = 0; t < nt; t += 2) {
      const bool last = (t == nt - 2);
      const char* a1 = cA + (size_t)(t + 1) * kstep;
      const char* a2 = last ? nA : cA + (size_t)(t + 2) * kstep; const char* b2 = last ? nB : cB + (size_t)(t + 2) * kstep;
      const size_t h2A = (size_t)HALF * (last ? nldA : ldA);
      const char* a3 = a2 + kstep; const char* b3 = b2 + kstep;
      PG8_LDB(B0, 0, 0); PG8_SCHED; PG8_LDA(At, 0, 0); PG8_STAGE(PG8_SA(1, 1), a1 + hA, voffA);
      if (Sched::VARLDA) { if (last) {
#pragma unroll
        for (int i = 0; i < 2; ++i) voffA[i] = rA[i] * (unsigned)nldA + c2[i]; } }
      PG8_WAIT_L(8); PG8_BAR; PG8_WAIT_L(0); PG8_MMA(0, 0, At, B0); PG8_BAR; PG8_SCHED;
      PG8_LDB(B1, 0, 1); PG8_STAGE(PG8_SB(0, 0), b2, voffB);
      PG8_BAR; PG8_WAIT_L(0); PG8_MMA(0, 1, At, B1); PG8_BAR;
      PG8_LDA(At, 0, 1); PG8_STAGE(PG8_SA(0, 0), a2, voffA);
      PG8_BAR; PG8_WAIT_L(0); PG8_MMA(1, 0, At, B0); PG8_BAR; PG8_SCHED;
      PG8_STAGE(PG8_SB(0, 1), b2 + hB, voffB);
      PG8_WAIT_V(6); PG8_BAR; PG8_MMA(1, 1, At, B1); PG8_BAR;
      PG8_LDB(B0, 1, 0); PG8_SCHED; PG8_LDA(At, 1, 0); PG8_STAGE(PG8_SA(0, 1), a2 + h2A, voffA);
      PG8_WAIT_L(8); PG8_BAR; PG8_WAIT_L(0); PG8_MMA(0, 0, At, B0); PG8_BAR; PG8_SCHED;
      PG8_LDB(B1, 1, 1); PG8_STAGE(PG8_SB(1, 0), b3, voffB);
      PG8_BAR; PG8_WAIT_L(0); PG8_MMA(0, 1, At, B1); PG8_BAR;
      PG8_LDA(At, 1, 1); PG8_STAGE(PG8_SA(1, 0), a3, voffA);
      PG8_BAR; PG8_WAIT_L(0); PG8_MMA(1, 0, At, B0); PG8_BAR; PG8_SCHED;
      PG8_STAGE(PG8_SB(1, 1), b3 + hB, voffB);
      PG8_WAIT_V(6); PG8_BAR; PG8_MMA(1, 1, At, B1); PG8_BAR;
    }
    E(acc, cur, wr, wc, fr, fq);
    if (!has_next) break;
#pragma unroll
    for (int a = 0; a < 2; ++a)
#pragma unroll
      for (int b = 0; b < 2; ++b)
#pragma unroll
        for (int m = 0; m < 4; ++m)
#pragma unroll
          for (int n = 0; n < 2; ++n) acc[a][b][m][n] = (f32x4){zz_, zz_, zz_, zz_};
    cur = nxt; cA = nA; cB = nB; ldA = nldA; ++ui;
  }
  PG8_WAIT_V(0);
  if (wr == 0) PG8_BAR;
  PG8_BAR;
#undef PG8_SA
#undef PG8_SB
#undef PG8_STAGE
#undef PG8_LDA
#undef PG8_LDB
#undef PG8_MMA
#undef PG8_WAIT_V
#undef PG8_WAIT_L
#undef PG8_BAR
#undef PG8_SCHED
}
}
using pg8::Unit;
typedef f32x4 AccT[2][2][4][2];

struct EpiUp {
  static constexpr bool PERM = true;
  bf16_t* act;
  __device__ __forceinline__ void operator()(const AccT& acc, const Unit& u, int wr, int wc, int fr, int fq) const {
    const int row0 = u.pm * 256 + wr * 64 + fr, col0 = u.pn * 128 + wc * 32 + 8 * fq;
#pragma unroll
    for (int ai = 0; ai < 2; ++ai)
#pragma unroll
      for (int m = 0; m < 4; ++m) {
        const f32x4 a0 = acc[ai][0][m][0], a1 = acc[ai][0][m][1], u0 = acc[ai][1][m][0], u1 = acc[ai][1][m][1];
        u32x4 w;
        w.x = cvt_pk_bf16(siluf_(a0[0]) * u0[0], siluf_(a0[1]) * u0[1]); w.y = cvt_pk_bf16(siluf_(a0[2]) * u0[2], siluf_(a0[3]) * u0[3]);
        w.z = cvt_pk_bf16(siluf_(a1[0]) * u1[0], siluf_(a1[1]) * u1[1]); w.w = cvt_pk_bf16(siluf_(a1[2]) * u1[2], siluf_(a1[3]) * u1[3]);
        *(u32x4*)(act + (size_t)(row0 + ai * 128 + m * 16) * DFF + col0) = w;
      }
  }
};
template <bool ATOMIC> struct EpiResT {
  static constexpr bool PERM = false;
  float* X; const float* modl; int gidx; float scale;
  __device__ __forceinline__ void operator()(const AccT& acc, const Unit& u, int wr, int wc, int fr, int fq) const {
    const int row0 = u.pm * 256 + wr * 64 + fr, col0 = u.pn * 256 + wc * 32 + 4 * fq;
    const float* g = modl + (size_t)(modidx(u.pm) * 9 + gidx) * 1024 + col0;
    f32x4 gv[2][2];
#pragma unroll
    for (int bj = 0; bj < 2; ++bj)
#pragma unroll
      for (int n = 0; n < 2; ++n) gv[bj][n] = *(const f32x4*)(g + bj * 128 + n * 16) * scale;
#pragma unroll
    for (int ai = 0; ai < 2; ++ai)
#pragma unroll
      for (int m = 0; m < 4; ++m) {
        float* rowp = X + (size_t)(row0 + ai * 128 + m * 16) * DM + col0;
#pragma unroll
        for (int bj = 0; bj < 2; ++bj)
#pragma unroll
          for (int n = 0; n < 2; ++n) { float* qf = rowp + bj * 128 + n * 16; const f32x4 t = gv[bj][n] * acc[ai][bj][m][n];
            if (ATOMIC) { atomic_add_f32(qf, t[0]); atomic_add_f32(qf + 1, t[1]); atomic_add_f32(qf + 2, t[2]); atomic_add_f32(qf + 3, t[3]); }
            else { f32x4* q = (f32x4*)qf; *q = *q + t; } }
      }
  }
};
struct EpiIn {
  static constexpr bool PERM = true;
  bf16_t *qkv, *z, *pi, *fi; float* ab;
  __device__ __forceinline__ void operator()(const AccT& acc, const Unit& u, int wr, int wc, int fr, int fq) const {
    const int row0 = u.pm * 256 + wr * 64 + fr;
    if (u.pn == 10) {
      if (wc == 0 && fq < 2) {
#pragma unroll
        for (int ai = 0; ai < 2; ++ai)
#pragma unroll
          for (int m = 0; m < 4; ++m) {
            float* rp = ab + (size_t)(row0 + ai * 128 + m * 16) * 16 + 8 * fq;
            *(f32x4*)(rp) = acc[ai][0][m][0]; *(f32x4*)(rp + 4) = acc[ai][0][m][1];
          }
      }
      return;
    }
    bf16_t* base; int ld, ct;
    if (u.pn < 6) { base = qkv; ld = 1536; ct = u.pn * 256; } else if (u.pn < 8) { base = z; ld = 512; ct = (u.pn - 6) * 256; } else if (u.pn == 8) { base = pi; ld = 256; ct = 0; } else { base = fi; ld = 256; ct = 0; }
    const int col0 = ct + wc * 32 + 8 * fq;
#pragma unroll
    for (int ai = 0; ai < 2; ++ai)
#pragma unroll
      for (int m = 0; m < 4; ++m) {
        bf16_t* rowp = base + (size_t)(row0 + ai * 128 + m * 16) * ld + col0;
#pragma unroll
        for (int bj = 0; bj < 2; ++bj) { const f32x4 v0 = acc[ai][bj][m][0], v1 = acc[ai][bj][m][1]; u32x4 w; w.x = cvt_pk_bf16(v0[0], v0[1]); w.y = cvt_pk_bf16(v0[2], v0[3]); w.z = cvt_pk_bf16(v1[0], v1[1]); w.w = cvt_pk_bf16(v1[2], v1[3]);
          *(u32x4*)(rowp + bj * 128) = w; }
      }
  }
};
struct EpiBf {
  static constexpr bool PERM = true;
  bf16_t* O; int ld;
  __device__ __forceinline__ void operator()(const AccT& acc, const Unit& u, int wr, int wc, int fr, int fq) const {
    const int row0 = u.pm * 256 + wr * 64 + fr, col0 = u.pn * 256 + wc * 32 + 8 * fq;
#pragma unroll
    for (int ai = 0; ai < 2; ++ai)
#pragma unroll
      for (int m = 0; m < 4; ++m) {
        bf16_t* rowp = O + (size_t)(row0 + ai * 128 + m * 16) * ld + col0;
#pragma unroll
        for (int bj = 0; bj < 2; ++bj) { const f32x4 v0 = acc[ai][bj][m][0], v1 = acc[ai][bj][m][1]; u32x4 w; w.x = cvt_pk_bf16(v0[0], v0[1]); w.y = cvt_pk_bf16(v0[2], v0[3]); w.z = cvt_pk_bf16(v1[0], v1[1]); w.w = cvt_pk_bf16(v1[2], v1[3]);
          *(u32x4*)(rowp + bj * 128) = w; }
      }
  }
};
struct EpiMerge {
  static constexpr bool PERM = true;
  unsigned* scr;
  bf16_t* mrg;
  __device__ __forceinline__ void operator()(const AccT& acc, const Unit& u, int wr, int wc, int fr, int fq) const {
    const int tid_ = otid(); u32x4* S1 = (u32x4*)scr + tid_; u32x4* Mx = (u32x4*)scr + 16 * 512 + tid_;
    const int seg = u.seg;
    if ((seg & 1) == 0) {
#pragma unroll
      for (int ai = 0; ai < 2; ++ai)
#pragma unroll
        for (int bj = 0; bj < 2; ++bj)
#pragma unroll
          for (int m = 0; m < 4; ++m) { const f32x4 v0 = acc[ai][bj][m][0], v1 = acc[ai][bj][m][1]; u32x4 w;
            w.x = cvt_pk_bf16(sigmoidf_(v0[0]), sigmoidf_(v0[1])); w.y = cvt_pk_bf16(sigmoidf_(v0[2]), sigmoidf_(v0[3])); w.z = cvt_pk_bf16(sigmoidf_(v1[0]), sigmoidf_(v1[1])); w.w = cvt_pk_bf16(sigmoidf_(v1[2]), sigmoidf_(v1[3]));
            S1[((ai * 2 + bj) * 4 + m) * 512] = w; }
    } else {
      const int row0 = u.pm * 256 + wr * 64 + fr, col0 = u.pn * 256 + wc * 32 + 8 * fq;
#pragma unroll
      for (int ai = 0; ai < 2; ++ai)
#pragma unroll
        for (int m = 0; m < 4; ++m) {
#pragma unroll
          for (int bj = 0; bj < 2; ++bj) {
            const int ix = ((ai * 2 + bj) * 4 + m) * 512; const u32x4 g = S1[ix]; const f32x4 v0 = acc[ai][bj][m][0], v1 = acc[ai][bj][m][1];
            float t[8] = {bflo(g.x) * v0[0], bfhi(g.x) * v0[1], bflo(g.y) * v0[2], bfhi(g.y) * v0[3], bflo(g.z) * v1[0], bfhi(g.z) * v1[1], bflo(g.w) * v1[2], bfhi(g.w) * v1[3]};
            if (seg >= 3) { const u32x4 q = Mx[ix]; t[0] += bflo(q.x); t[1] += bfhi(q.x); t[2] += bflo(q.y); t[3] += bfhi(q.y); t[4] += bflo(q.z); t[5] += bfhi(q.z); t[6] += bflo(q.w); t[7] += bfhi(q.w); }
            u32x4 w; w.x = cvt_pk_bf16(t[0], t[1]); w.y = cvt_pk_bf16(t[2], t[3]); w.z = cvt_pk_bf16(t[4], t[5]); w.w = cvt_pk_bf16(t[6], t[7]);
            if (seg < 5) Mx[ix] = w; else *(u32x4*)(mrg + (size_t)(row0 + ai * 128 + m * 16) * DM + col0 + bj * 128) = w;
          }
        }
    }
  }
};
struct MergeSched {
  static constexpr bool VARLDA = true;
  const char *hn, *of, *ppf, *wg, *wcat; int G, c, nM;
  __device__ __forceinline__ bool next(int i, Unit& u) const {
    const int round = i / 6, seg = i - round * 6; int pm, pn; if (!pg8::tile_of(nM, 4, G, c, round, pm, pn)) return false;
    const int br = seg >> 1;
    u.pm = pm; u.pn = pn; u.seg = seg; u.ldb = 2048;
    if ((seg & 1) == 0) { u.A = hn + (size_t)pm * 256 * 2048; u.lda = 2048; u.B = wg + (size_t)(br * 1024 + pn * 256) * 2048; u.nt = 16; }
    else {
      u.lda = 1024;
      if (br == 0) { u.A = of + (size_t)pm * 256 * 1024; u.B = wcat + (size_t)pn * 256 * 2048; u.nt = 8; }
      else if (br == 1) { u.A = ppf + (size_t)pm * 256 * 1024; u.B = wcat + (size_t)pn * 256 * 2048 + 512 * 2; u.nt = 4; }
      else { u.A = ppf + (size_t)pm * 256 * 1024 + 256 * 2; u.B = wcat + (size_t)pn * 256 * 2048 + 768 * 2; u.nt = 4; }
    }
    return true;
  }
};
struct FourSched {
  static constexpr bool VARLDA = false;
  const char *dft, *fbt; int c;
  __device__ __forceinline__ bool next(int i, Unit& u) const {
    if (i > 0) return false;
    const int b = c >> 4, pm = c & 15;
    u.A = dft + (size_t)pm * 256 * 8192; u.B = fbt + (size_t)b * 256 * 8192; u.lda = 8192; u.ldb = 8192; u.nt = 64; u.pm = b * 16 + pm; u.pn = 0; u.seg = 0; return true;
  }
};

template <class F>
__device__ __forceinline__ void convT(const float* W, int ldw, int K, int nrows, bf16_t* dst, int ldd, int k0d, F srccol, ldsp L, int& cursor) {
  const int tid = otid(), ntk = K >> 6, ntiles = (nrows >> 6) * ntk;
  for (int t = 0; t < ntiles; ++t) {
    if (((cursor + t) % (int)gridDim.x) != (int)blockIdx.x) continue;
    const int tr = t / ntk, tk = t - tr * ntk, r0 = tr * 64, kk0 = tk * 64;
    const int i = tid & 63, sc = srccol(r0 + i);
#pragma unroll
    for (int it = 0; it < 8; ++it) { const int kk = (tid >> 6) + 8 * it; const float v = sc >= 0 ? W[(size_t)(kk0 + kk) * ldw + sc] : 0.f; ldsst<float>(L, (kk * 65 + i) * 4, v); }
    __syncthreads();
    { const int ii = tid >> 3, kv = (tid & 7) * 8; float v[8];
#pragma unroll
      for (int e = 0; e < 8; ++e) v[e] = ldsld<float>(L, ((kv + e) * 65 + ii) * 4);
      u32x4 w; w.x = cvt_pk_bf16(v[0], v[1]); w.y = cvt_pk_bf16(v[2], v[3]); w.z = cvt_pk_bf16(v[4], v[5]); w.w = cvt_pk_bf16(v[6], v[7]);
      *(u32x4*)(dst + (size_t)(r0 + ii) * ldd + k0d + kk0 + kv) = w; }
    __syncthreads();
  }
  cursor += ntiles;
}

__device__ void convert_ffn(const Params& p, const float* wgu, const float* wd, ldsp L) {
  int cur = 0;
  convT(wgu, 2 * DFF, 1024, 2 * DFF, (bf16_t*)(lws(p.ws) + O_WGU), 1024, 0, [](int r) { const int t = r >> 8, q = r & 255; return q < 128 ? t * 128 + q : DFF + t * 128 + (q - 128); }, L, cur);
  convT(wd, 1024, DFF, 1024, (bf16_t*)(lws(p.ws) + O_WD), DFF, 0, [](int r) { return r; }, L, cur);
}
__device__ void convert_mixer(const Params& p, int l, ldsp L) {
  int cur = 0;
  const float* win = p.w_in + (size_t)l * 1024 * DPROJ;
  convT(win, DPROJ, 1024, NINP, (bf16_t*)(lws(p.ws) + O_WIN), 1024, 0, [](int r) { return r < 2048 ? r : (r < 2560 ? r + 16 : (r < 2576 ? r - 512 : -1)); }, L, cur);
  convT(win, DPROJ, 1024, 3072, (bf16_t*)(lws(p.ws) + O_WG), 1024, 0, [](int r) { return 2576 + r; }, L, cur);
  convT(p.w_a + (size_t)l * 512 * 1024, 1024, 512, 1024, (bf16_t*)(lws(p.ws) + O_WCAT), 1024, 0, [](int r) { return r; }, L, cur);
  convT(p.w_c + (size_t)l * 256 * 1024, 1024, 256, 1024, (bf16_t*)(lws(p.ws) + O_WCAT), 1024, 768, [](int r) { return r; }, L, cur);
  convT(p.w_out + (size_t)l * 1024 * 1024, 1024, 1024, 1024, (bf16_t*)(lws(p.ws) + O_WOUT), 1024, 0, [](int r) { return r; }, L, cur);
  const float* wb = p.w_b + (size_t)l * 4 * 64 * 256; const float* ps = p.pool_scale + (size_t)l * 1024; bf16_t* wcat = (bf16_t*)(lws(p.ws) + O_WCAT);
  for (int idx = blockIdx.x * NTHR + otid(); idx < 1024 * 256; idx += gridDim.x * NTHR) {
    const int row = idx & 1023, kk = idx >> 10, g = row >> 8;
    const float v = ((kk >> 6) == g) ? wb[((size_t)g * 64 + (kk & 63)) * 256 + (row & 255)] * ps[row] : 0.f;
    wcat[(size_t)row * 1024 + 512 + kk] = (bf16_t)(cvt_pk_bf16(v, 0.f) & 0xffffu);
  }
}

__device__ void norm_phase(const float* X, bf16_t* Hn, const float* gain, const float* modl, int ishift, int iscale) {
  const int tid_ = otid(), lane = tid_ & 63, gw = blockIdx.x * 8 + (tid_ >> 6), nw = gridDim.x * 8;
  for (int r = gw; r < ROWS; r += nw) {
    const int j = r < RLAT ? (r >> 12) : 8;
    const float* sh = modl + (size_t)(j * 9 + ishift) * 1024; const float* sc = modl + (size_t)(j * 9 + iscale) * 1024;
    const float* xr = X + (size_t)r * DM;
    f32x4 v[4]; float ss = 0.f;
#pragma unroll
    for (int i = 0; i < 2; ++i) { v[2 * i] = *(const f32x4*)(xr + lane * 8 + 512 * i); v[2 * i + 1] = *(const f32x4*)(xr + lane * 8 + 512 * i + 4); }
#pragma unroll
    for (int i = 0; i < 4; ++i) ss += v[i][0] * v[i][0] + v[i][1] * v[i][1] + v[i][2] * v[i][2] + v[i][3] * v[i][3];
#pragma unroll
    for (int o = 32; o >= 1; o >>= 1) ss += __shfl_xor(ss, o);
    const float rstd = rsqrtf(ss * (1.0f / 1024.0f) + 1e-6f);
#pragma unroll
    for (int i = 0; i < 2; ++i) {
      const int c0 = lane * 8 + 512 * i; float o[8];
#pragma unroll
      for (int hh = 0; hh < 2; ++hh) { const f32x4 g = *(const f32x4*)(gain + c0 + 4 * hh), s1 = *(const f32x4*)(sc + c0 + 4 * hh), s0 = *(const f32x4*)(sh + c0 + 4 * hh); const f32x4 y = v[2 * i + hh] * rstd * g * (s1 + 1.0f) + s0;
        o[4 * hh] = y[0]; o[4 * hh + 1] = y[1]; o[4 * hh + 2] = y[2]; o[4 * hh + 3] = y[3]; }
      u32x4 w; w.x = cvt_pk_bf16(o[0], o[1]); w.y = cvt_pk_bf16(o[2], o[3]); w.z = cvt_pk_bf16(o[4], o[5]); w.w = cvt_pk_bf16(o[6], o[7]);
      *(u32x4*)(Hn + (size_t)r * DM + c0) = w;
    }
  }
}
__device__ void final_norm(const float* X, float* out, const float* gain) {
  const int tid_ = otid(), lane = tid_ & 63, gw = blockIdx.x * 8 + (tid_ >> 6), nw = gridDim.x * 8;
  for (int r = gw; r < RLAT; r += nw) {
    const float* xr = X + (size_t)r * DM; f32x4 v[4]; float ss = 0.f;
#pragma unroll
    for (int i = 0; i < 4; ++i) { v[i] = *(const f32x4*)(xr + lane * 4 + 256 * i); ss += v[i][0] * v[i][0] + v[i][1] * v[i][1] + v[i][2] * v[i][2] + v[i][3] * v[i][3]; }
#pragma unroll
    for (int o = 32; o >= 1; o >>= 1) ss += __shfl_xor(ss, o);
    const float rstd = rsqrtf(ss * (1.0f / 1024.0f) + 1e-6f);
#pragma unroll
    for (int i = 0; i < 4; ++i) { const f32x4 g = *(const f32x4*)(gain + lane * 4 + 256 * i); *(f32x4*)(out + (size_t)r * DM + lane * 4 + 256 * i) = v[i] * rstd * g; }
  }
}

__device__ void phase0(const Params& p, ldsp L) {
  const int tid = otid(); const size_t gt = (size_t)blockIdx.x * NTHR + tid, gs = (size_t)gridDim.x * NTHR;
  { f32x4* X = (f32x4*)(lws(p.ws) + O_X); const f32x4* xs = (const f32x4*)p.x; const f32x4* cs = (const f32x4*)p.ctx; const size_t n1 = (size_t)RLAT * DM / 4, n2 = (size_t)ROWS * DM / 4;
    for (size_t i = gt; i < n2; i += gs) X[i] = i < n1 ? xs[i] : cs[i - n1]; }
  { bf16_t* D = (bf16_t*)(lws(p.ws) + O_DFT);
    for (size_t v = gt; v < (size_t)4096 * 512; v += gs) { const int k = (int)(v >> 9), j0 = (int)(v & 511) * 8; float o[8];
#pragma unroll
      for (int e = 0; e < 8; ++e) { const int j = j0 + e; const bool cs_ = j <= 2048; const int t = cs_ ? j : j - 2048; const int r = (k * t) & 4095; const float a = (float)r * (1.0f / 2048.0f);
        o[e] = cs_ ? cospif(a) * (1.0f / 64.0f) : -sinpif(a) * (1.0f / 64.0f); }
      u32x4 w; w.x = cvt_pk_bf16(o[0], o[1]); w.y = cvt_pk_bf16(o[2], o[3]); w.z = cvt_pk_bf16(o[4], o[5]); w.w = cvt_pk_bf16(o[6], o[7]);
      *(u32x4*)(D + (size_t)k * 4096 + j0) = w; } }
  for (int idx = tid; idx < 9 * 1024; idx += NTHR) { const int j = idx >> 10, k = idx & 1023; const float v = j < 8 ? p.c[j * 1024 + k] : p.c_ctx[k]; ldsst<float>(L, idx * 4, siluf_(v)); }
  __syncthreads();
  float* MOD = (float*)(lws(p.ws) + O_MOD);
  for (int item = blockIdx.x; item < DEPTH * 144; item += gridDim.x) {
    const int l = item / 144, n0 = (item - l * 144) * 64, ks = tid >> 6, cn = tid & 63;
    float acc[9];
#pragma unroll
    for (int j = 0; j < 9; ++j) acc[j] = 0.f;
    const float* wp = p.w_ada + ((size_t)l * 1024 + ks * 128) * 9216 + n0 + cn;
#pragma unroll 4
    for (int k = 0; k < 128; ++k) { const float w = wp[(size_t)k * 9216];
#pragma unroll
      for (int j = 0; j < 9; ++j) acc[j] += ldsld<float>(L, (j * 1024 + ks * 128 + k) * 4) * w; }
#pragma unroll
    for (int j = 0; j < 9; ++j) ldsst<float>(L, 36864 + ((ks * 9 + j) * 64 + cn) * 4, acc[j]);
    __syncthreads();
    for (int o = tid; o < 576; o += NTHR) { const int j = o >> 6, c = o & 63; float s = p.b_ada[(size_t)l * 9216 + n0 + c];
#pragma unroll
      for (int q = 0; q < 8; ++q) s += ldsld<float>(L, 36864 + ((q * 9 + j) * 64 + c) * 4);
      MOD[((size_t)l * 9 + j) * 9216 + n0 + c] = s; }
    __syncthreads();
  }
}

__device__ void prep_phase(const Params& p, int l, ldsp L) {
  const int tid = otid(), lane = tid & 63, wid = tid >> 6, fr = lane & 15, fq = lane >> 4;
  constexpr int KSB = 0, KTL = 17408, VTL = 35840, GL = 54272, AL = 71680, GCL = 104448, BTL = 104960, TOL = 105472;
  const bf16_t* QKV = (const bf16_t*)(lws(p.ws) + O_QKV); const float* AB = (const float*)(lws(p.ws) + O_AB);
  bf16_t* QN = (bf16_t*)(lws(p.ws) + O_QN); bf16_t* KN = (bf16_t*)(lws(p.ws) + O_KN); bf16_t* KNT = (bf16_t*)(lws(p.ws) + O_KNT); bf16_t* VNT = (bf16_t*)(lws(p.ws) + O_VNT);
  bf16_t* TT = (bf16_t*)(lws(p.ws) + O_TT); float* GC = (float*)(lws(p.ws) + O_GC);
  const float* cw = p.conv_w + (size_t)l * 3 * 1536;
  for (int item = blockIdx.x; item < NCH * 4; item += gridDim.x) {
    const int n = item >> 2, h = item & 3, R0 = n * 64;
    { const int row = tid >> 3, cs = tid & 7, r = R0 + row, c0 = cs * 16;
      const int t = r < RLAT ? (r & 4095) : ((r - RLAT) & 255), Ls = r < RLAT ? 4096 : 256;
      const bool hp = t > 0, hn = t < Ls - 1;
#pragma unroll
      for (int mtx = 0; mtx < 3; ++mtx) {
        const int cc = mtx * 512 + h * 128 + c0; const bf16_t* bp = QKV + (size_t)r * 1536 + cc;
        u32x4 a0 = {0, 0, 0, 0}, a1 = {0, 0, 0, 0}, c0v = {0, 0, 0, 0}, c1v = {0, 0, 0, 0};
        const u32x4 b0 = *(const u32x4*)(bp), b1 = *(const u32x4*)(bp + 8);
        if (hp) { a0 = *(const u32x4*)(bp - 1536); a1 = *(const u32x4*)(bp - 1536 + 8); }
        if (hn) { c0v = *(const u32x4*)(bp + 1536); c1v = *(const u32x4*)(bp + 1536 + 8); }
        float val[16]; float ss = 0.f;
#pragma unroll
        for (int e = 0; e < 16; ++e) {
          const unsigned wa = e < 8 ? a0[e >> 1] : a1[(e - 8) >> 1], wb = e < 8 ? b0[e >> 1] : b1[(e - 8) >> 1], wc_ = e < 8 ? c0v[e >> 1] : c1v[(e - 8) >> 1];
          const float xa = (e & 1) ? bfhi(wa) : bflo(wa), xb = (e & 1) ? bfhi(wb) : bflo(wb), xc = (e & 1) ? bfhi(wc_) : bflo(wc_);
          const float y = xa * cw[cc + e] + xb * cw[1536 + cc + e] + xc * cw[3072 + cc + e];
          val[e] = siluf_(y); ss += val[e] * val[e];
        }
        if (mtx < 2) { ss += __shfl_xor(ss, 1); ss += __shfl_xor(ss, 2); ss += __shfl_xor(ss, 4); const float sc = rsqrtf(ss + 1e-6f) * (mtx == 0 ? 0.08838834764831845f : 1.0f);
#pragma unroll
          for (int e = 0; e < 16; ++e) val[e] *= sc; }
        u32x4 w0, w1; w0.x = cvt_pk_bf16(val[0], val[1]); w0.y = cvt_pk_bf16(val[2], val[3]); w0.z = cvt_pk_bf16(val[4], val[5]); w0.w = cvt_pk_bf16(val[6], val[7]);
        w1.x = cvt_pk_bf16(val[8], val[9]); w1.y = cvt_pk_bf16(val[10], val[11]); w1.z = cvt_pk_bf16(val[12], val[13]); w1.w = cvt_pk_bf16(val[14], val[15]);
        if (mtx == 0) { bf16_t* o = QN + (size_t)r * 512 + h * 128 + c0; *(u32x4*)o = w0; *(u32x4*)(o + 8) = w1; }
        else if (mtx == 1) { bf16_t* o = KN + (size_t)r * 512 + h * 128 + c0; *(u32x4*)o = w0; *(u32x4*)(o + 8) = w1;
          ldsst<u32x4>(L, KSB + row * 272 + c0 * 2, w0); ldsst<u32x4>(L, KSB + row * 272 + c0 * 2 + 16, w1);
#pragma unroll
          for (int e = 0; e < 16; ++e) { const unsigned wv = e < 8 ? w0[e >> 1] : w1[(e - 8) >> 1]; ldsst<bf16_t>(L, KTL + (c0 + e) * 144 + row * 2, (bf16_t)((e & 1) ? (wv >> 16) : (wv & 0xffffu))); } }
        else {
#pragma unroll
          for (int e = 0; e < 16; ++e) { const unsigned wv = e < 8 ? w0[e >> 1] : w1[(e - 8) >> 1]; ldsst<bf16_t>(L, VTL + (c0 + e) * 144 + row * 2, (bf16_t)((e & 1) ? (wv >> 16) : (wv & 0xffffu))); } }
      }
    }
    if (wid < 2) {
      const int d = wid, r = R0 + lane;
      const float braw = AB[(size_t)r * 16 + d * 4 + h], araw = AB[(size_t)r * 16 + 8 + d * 4 + h];
      const float beta = sigmoidf_(braw);
      const float xs = araw + p.dt_bias[(l * 2 + d) * 4 + h];
      const float sp = fmaxf(xs, 0.f) + log1pf(__expf(-fabsf(xs)));
      const float g = -__expf(p.a_log[(l * 2 + d) * 4 + h]) * sp;
      float pre = g;
#pragma unroll
      for (int o = 1; o < 64; o <<= 1) { const float t2 = __shfl_up(pre, o); if (lane >= o) pre += t2; }
      const float tot = __shfl(pre, 63);
      const float gc = d == 0 ? pre : (tot - pre + g);
      ldsst<float>(L, GCL + (d * 64 + lane) * 4, gc); ldsst<float>(L, BTL + (d * 64 + lane) * 4, beta);
      GC[((size_t)item * 2 + d) * 64 + lane] = gc;
    }
    __syncthreads();
    { const int ti = wid >> 1;
#pragma unroll
      for (int q = 0; q < 2; ++q) { const int tj = 2 * (wid & 1) + q; f32x4 a = {0.f, 0.f, 0.f, 0.f};
#pragma unroll
        for (int kk = 0; kk < 4; ++kk) a = mma(ldsld<bf16x8>(L, KSB + (16 * tj + fr) * 272 + kk * 64 + fq * 16), ldsld<bf16x8>(L, KSB + (16 * ti + fr) * 272 + kk * 64 + fq * 16), a);
        ldsst<f32x4>(L, GL + ((16 * ti + fr) * 68 + 16 * tj + 4 * fq) * 4, a); }
    }
    {
#pragma unroll
      for (int it = 0; it < 2; ++it) { const int v = tid + 512 * it, c = v >> 3, sg = (v & 7) * 8;
        *(u32x4*)(KNT + (size_t)item * 8192 + c * 64 + sg) = ldsld<u32x4>(L, KTL + c * 144 + sg * 2);
        *(u32x4*)(VNT + (size_t)item * 8192 + c * 64 + sg) = ldsld<u32x4>(L, VTL + c * 144 + sg * 2); } }
    __syncthreads();
    { const int d = tid >> 8, a = (tid & 255) >> 2, jq = tid & 3;
      const int pi_ = d ? 63 - a : a; const float bi = ldsld<float>(L, BTL + (d * 64 + pi_) * 4), gi = ldsld<float>(L, GCL + (d * 64 + pi_) * 4);
#pragma unroll
      for (int e = 0; e < 16; ++e) { const int bb = jq * 16 + e, pr = d ? 63 - bb : bb;
        float v = 0.f;
        if (a > bb) v = bi * ldsld<float>(L, GL + (pi_ * 68 + pr) * 4) * __expf(gi - ldsld<float>(L, GCL + (d * 64 + pr) * 4));
        ldsst<float>(L, AL + ((d * 64 + a) * 64 + bb) * 4, v); } }
    __syncthreads();
    if (wid < 2) {
      const int d = wid, c = lane; constexpr int XL = 0;
#pragma unroll 1
      for (int bi = 0; bi < 4; ++bi) {
        float sv[16];
#pragma unroll
        for (int ii = 0; ii < 16; ++ii) sv[ii] = (16 * bi + ii == c) ? 1.f : 0.f;
#pragma unroll 1
        for (int j = 0; j < 16 * bi; j += 4) {
          float xj[4];
#pragma unroll
          for (int e = 0; e < 4; ++e) xj[e] = ldsld<float>(L, XL + ((d * 64 + j + e) * 64 + c) * 4);
#pragma unroll
          for (int ii = 0; ii < 16; ++ii) { const f32x4 av = ldsld<f32x4>(L, AL + ((d * 64 + 16 * bi + ii) * 64 + j) * 4); sv[ii] -= av[0] * xj[0] + av[1] * xj[1] + av[2] * xj[2] + av[3] * xj[3]; }
        }
        float xb[16];
#pragma unroll
        for (int ii = 0; ii < 16; ++ii) {
          float t = sv[ii];
#pragma unroll
          for (int j4 = 0; j4 < (ii + 3) / 4; ++j4) { const f32x4 av = ldsld<f32x4>(L, AL + ((d * 64 + 16 * bi + ii) * 64 + 16 * bi + j4 * 4) * 4);
#pragma unroll
            for (int e = 0; e < 4; ++e) if (j4 * 4 + e < ii) t -= av[e] * xb[j4 * 4 + e]; }
          xb[ii] = t;
          ldsst<float>(L, XL + ((d * 64 + 16 * bi + ii) * 64 + c) * 4, t);
        }
      }
      const int pr = d ? 63 - c : c; const float bc = ldsld<float>(L, BTL + (d * 64 + pr) * 4), fw = bc * __expf(ldsld<float>(L, GCL + (d * 64 + pr) * 4));
#pragma unroll 4
      for (int i = 0; i < 64; ++i) { const int pp = d ? 63 - i : i; const float xi = ldsld<float>(L, XL + ((d * 64 + i) * 64 + c) * 4);
        ldsst<bf16_t>(L, TOL + ((d * 2 + 0) * 64 + pp) * 144 + pr * 2, (bf16_t)(cvt_pk_bf16(xi * fw, 0.f) & 0xffffu));
        ldsst<bf16_t>(L, TOL + ((d * 2 + 1) * 64 + pp) * 144 + pr * 2, (bf16_t)(cvt_pk_bf16(xi * bc, 0.f) & 0xffffu)); }
    }
    __syncthreads();
#pragma unroll
    for (int it = 0; it < 4; ++it) { const int v = tid + 512 * it, mtx = v >> 9, row = (v >> 3) & 63, sg = (v & 7) * 8;
      *(u32x4*)(TT + ((size_t)item * 4 + mtx) * 4096 + row * 64 + sg) = ldsld<u32x4>(L, TOL + (mtx * 64 + row) * 144 + sg * 2); }
    __syncthreads();
  }
}

__device__ void fourier_prep(const Params& p, ldsp L) {
  const int tid = otid(), lane = tid & 63, wid = tid >> 6, fr = lane & 15, fq = lane >> 4;
  constexpr int UA = 0, UB = 33792, DC = 67584;
  const bf16_t* FI = (const bf16_t*)(lws(p.ws) + O_FI); bf16_t* FBT = (bf16_t*)(lws(p.ws) + O_FBT); float* UCS = (float*)(lws(p.ws) + O_UCS);
  for (int idx = tid; idx < 128 * 64; idx += NTHR) { const int rr = idx >> 6, c = idx & 63, m = rr & 63; const float a = (float)((m * c) & 63) * (1.0f / 32.0f);
    const float v = (rr < 64 ? cospif(a) : sinpif(a)) * 0.125f; ldsst<bf16_t>(L, DC + rr * 144 + c * 2, (bf16_t)(cvt_pk_bf16(v, 0.f) & 0xffffu)); }
  __syncthreads();
  for (int item = blockIdx.x; item < 288; item += gridDim.x) {
    const bool lat = item < 256; const int b = lat ? item >> 5 : 0, jb = item & 31;
#pragma unroll
    for (int it = 0; it < 4; ++it) { const int v = tid + 512 * it, row = v >> 5, sg = (v & 31) * 8;
      int ra, rb;
      if (lat) { const int t = 64 * jb + row; ra = b * 4096 + t; rb = b * 4096 + (t == 0 ? 2048 : 4096 - t); } else { ra = RLAT + (item - 256) * 64 + row; rb = ra; }
      ldsst<u32x4>(L, UA + row * 528 + sg * 2, *(const u32x4*)(FI + (size_t)ra * 256 + sg));
      ldsst<u32x4>(L, UB + row * 528 + sg * 2, *(const u32x4*)(FI + (size_t)rb * 256 + sg)); }
    __syncthreads();
    for (int q = 0; q < 8; ++q) {
      const int combo = wid * 8 + q, g = combo >> 4, ti = (combo >> 2) & 3, tm = combo & 3;
      f32x4 ac = {0.f, 0.f, 0.f, 0.f}, as = ac, bc = ac, bs = ac;
#pragma unroll
      for (int kk = 0; kk < 2; ++kk) {
        const bf16x8 xa = ldsld<bf16x8>(L, UA + (16 * ti + fr) * 528 + (g * 64 + kk * 32 + fq * 8) * 2), xb = ldsld<bf16x8>(L, UB + (16 * ti + fr) * 528 + (g * 64 + kk * 32 + fq * 8) * 2);
        const bf16x8 yc = ldsld<bf16x8>(L, DC + (16 * tm + fr) * 144 + kk * 64 + fq * 16), ys = ldsld<bf16x8>(L, DC + (64 + 16 * tm + fr) * 144 + kk * 64 + fq * 16);
        ac = mma(xa, yc, ac); as = mma(xa, ys, as); bc = mma(xb, yc, bc); bs = mma(xb, ys, bs);
      }
      const int mp = g * 64 + 16 * tm + fr, i0 = 16 * ti + 4 * fq;
      if (lat) {
        f32x4 cv = ac + bc, sv = as - bs;
        if (jb == 0 && i0 == 0) { cv[0] = ac[0]; sv[0] = bc[0]; }
        bf16_t* o = FBT + ((size_t)b * 256 + mp) * 4096 + 64 * jb + i0;
        *(u32x2*)o = pack4(cv); *(u32x2*)(o + 2048) = pack4(sv);
      } else {
#pragma unroll
        for (int e = 0; e < 4; ++e) { float* o = UCS + (size_t)((item - 256) * 64 + i0 + e) * 512; o[mp] = ac[e]; o[256 + mp] = as[e]; }
      }
    }
    __syncthreads();
  }
}

__device__ void ctx_fourier(const Params& p, ldsp L, int wg, int nwg) {
  const int tid = otid(); const float* UCS = (const float*)(lws(p.ws) + O_UCS); bf16_t* PPF = (bf16_t*)(lws(p.ws) + O_PPF);
  for (int idx = tid; idx < 256; idx += NTHR) { const float a = (float)idx * (1.0f / 128.0f); ldsst<float>(L, idx * 4, cospif(a) * (1.0f / 16.0f)); ldsst<float>(L, 1024 + idx * 4, sinpif(a) * (1.0f / 16.0f)); }
  __syncthreads();
  for (int o = wg * NTHR + tid; o < NB * 64 * 256; o += nwg * NTHR) {
    const int mp = o & 255, kq = (o >> 8) & 63, b = o >> 14; const float* u = UCS + (size_t)b * 256 * 512 + mp; float s4[4] = {0.f, 0.f, 0.f, 0.f};
#pragma unroll 8
    for (int t = 0; t < 256; ++t) { const float uc = u[(size_t)t * 512], us = u[(size_t)t * 512 + 256];
#pragma unroll
      for (int e = 0; e < 4; ++e) { const int r = ((4 * kq + e) * t) & 255; s4[e] += ldsld<float>(L, r * 4) * uc - ldsld<float>(L, 1024 + r * 4) * us; } }
#pragma unroll
    for (int e = 0; e < 4; ++e) PPF[(size_t)(RLAT + b * 256 + 4 * kq + e) * 512 + 256 + mp] = (bf16_t)(cvt_pk_bf16(s4[e], 0.f) & 0xffffu);
  }
  __syncthreads();
}
__device__ void pool_phase(const Params& p, ldsp L, int wg, int nwg) {
  const int tid_ = otid(), lane = tid_ & 63, wv = tid_ >> 6, gw = wg * 8 + wv, nw = nwg * 8;
  const bf16_t* PI = (const bf16_t*)(lws(p.ws) + O_PI); bf16_t* PPF = (bf16_t*)(lws(p.ws) + O_PPF);
  const int LP = wv * 16640;
  for (int idx = gw; idx < 2048; idx += nw) {
    const int g = 3 - (idx >> 9), b = (idx >> 6) & 7, r = idx & 63;
    const int win = 2 << g, hw = win >> 1, sr = max(r - hw, 0), er = min(r - hw + win, 64);
    const bf16_t* base = PI + (size_t)b * 4096 * 256 + g * 64 + lane;
    ldsst<float>(L, LP + lane * 4, 0.f);
    { const int ci = lane >> 3, ch0 = (lane & 7) * 8;
      const bf16_t* bq = PI + (size_t)b * 4096 * 256 + g * 64 + ch0;
#pragma unroll 2
      for (int cb = 0; cb < 8; ++cb) {
        const int cc = cb * 8 + ci; float ac[8];
#pragma unroll
        for (int e = 0; e < 8; ++e) ac[e] = 0.f;
#pragma unroll 4
        for (int rr = sr; rr < er; ++rr) { const u32x4 v = *(const u32x4*)(bq + (size_t)(rr * 64 + cc) * 256);
#pragma unroll
          for (int e = 0; e < 4; ++e) { ac[2 * e] += bflo(v[e]); ac[2 * e + 1] += bfhi(v[e]); } }
        ldsst<f32x4>(L, LP + ((cc + 1) * 64 + ch0) * 4, (f32x4){ac[0], ac[1], ac[2], ac[3]}); ldsst<f32x4>(L, LP + ((cc + 1) * 64 + ch0 + 4) * 4, (f32x4){ac[4], ac[5], ac[6], ac[7]});
      }
      float run = 0.f;
#pragma unroll 8
      for (int cc = 1; cc <= 64; ++cc) { run += ldsld<float>(L, LP + (cc * 64 + lane) * 4); ldsst<float>(L, LP + (cc * 64 + lane) * 4, run); }
    }
    const float rinv = 1.0f / (float)(er - sr);
#pragma unroll 4
    for (int c = 0; c < 64; ++c) {
      const int sc = max(c - hw, 0), ec = min(c - hw + win, 64);
      const float box = ldsld<float>(L, LP + (ec * 64 + lane) * 4) - ldsld<float>(L, LP + (sc * 64 + lane) * 4);
      const size_t rowi = (size_t)b * 4096 + r * 64 + c;
      const float self = __uint_as_float((unsigned)PI[rowi * 256 + g * 64 + lane] << 16);
      PPF[rowi * 512 + g * 64 + lane] = (bf16_t)(cvt_pk_bf16(box * rinv / (float)(ec - sc) - self, 0.f) & 0xffffu);
    }
  }
  for (int r = RLAT + gw; r < ROWS; r += nw) {
    const int base = r & ~255, t = r - base;
#pragma unroll
    for (int g = 0; g < 4; ++g) {
      const int win = 2 << g, hw = win >> 1, sc = max(t - hw, 0), ec = min(t - hw + win, 256);
      float s_ = 0.f;
      for (int c = sc; c < ec; ++c) s_ += __uint_as_float((unsigned)PI[(size_t)(base + c) * 256 + g * 64 + lane] << 16);
      const float self = __uint_as_float((unsigned)PI[(size_t)r * 256 + g * 64 + lane] << 16);
      PPF[(size_t)r * 512 + g * 64 + lane] = (bf16_t)(cvt_pk_bf16(s_ / (float)(ec - sc) - self, 0.f) & 0xffffu);
    }
  }
}

__device__ void scan_phase(const Params& p, ldsp L, int item) {
  const int tid = otid(), lane = tid & 63, wid = tid >> 6, fr = lane & 15, fq = lane >> 4;
  const int es = item & 1, d = (item >> 1) & 1, h = (item >> 2) & 3, b = item >> 4;
  const int ti = wid >> 1, half = wid & 1;
  constexpr int QS = 0, KS = 17408, KTS = 34816, VTS = 53248, TW = 62464, TU = 71680, AT = 80896, WL = 90112, VNT_ = 107520, VNS = 116736, STL = 125952, GCL = 143360;
  const bf16_t* QN = (const bf16_t*)(lws(p.ws) + O_QN); const bf16_t* KN = (const bf16_t*)(lws(p.ws) + O_KN); const bf16_t* KNT = (const bf16_t*)(lws(p.ws) + O_KNT); const bf16_t* VNT = (const bf16_t*)(lws(p.ws) + O_VNT);
  const bf16_t* TT = (const bf16_t*)(lws(p.ws) + O_TT); const float* GC = (const float*)(lws(p.ws) + O_GC); bf16_t* O = (bf16_t*)(lws(p.ws) + O_O) + (size_t)d * ROWS * 512;
  { unsigned zz_; asm volatile("v_mov_b32 %0, 0" : "=v"(zz_)); for (int o = tid * 16; o < 17408; o += NTHR * 16) ldsst<u32x4>(L, STL + o, (u32x4){zz_, zz_, zz_, zz_}); }
  f32x4 accS[4];
#pragma unroll
  for (int q = 0; q < 4; ++q) accS[q] = (f32x4){0.f, 0.f, 0.f, 0.f};
  u32x4 rq[2], rk[2], rkt[2], rvt, rtw, rtu; float rgc = 0.f;
#define SCAN_CHUNK(s) ((s) < 4 ? (NB * 64 + b * 4 + (d ? 3 - (s) : (s))) : (b * 64 + (d ? 67 - (s) : (s) - 4)))
#define SCAN_GLOAD(s) do { const int n_ = SCAN_CHUNK(s), it2_ = n_ * 4 + h; \
    _Pragma("unroll") for (int it = 0; it < 2; ++it) { const int v = tid + 512 * it; \
      rq[it] = *(const u32x4*)(QN + (size_t)(64 * n_ + (v >> 4)) * 512 + h * 128 + (v & 15) * 8); rk[it] = *(const u32x4*)(KN + (size_t)(64 * n_ + (v >> 4)) * 512 + h * 128 + (v & 15) * 8); \
      rkt[it] = *(const u32x4*)(KNT + (size_t)it2_ * 8192 + (v >> 3) * 64 + (v & 7) * 8); } \
    rvt = *(const u32x4*)(VNT + (size_t)it2_ * 8192 + (es * 64 + (tid >> 3)) * 64 + (tid & 7) * 8); \
    rtw = *(const u32x4*)(TT + ((size_t)it2_ * 4 + d * 2 + 0) * 4096 + (tid >> 3) * 64 + (tid & 7) * 8); rtu = *(const u32x4*)(TT + ((size_t)it2_ * 4 + d * 2 + 1) * 4096 + (tid >> 3) * 64 + (tid & 7) * 8); \
    if (tid < 64) rgc = GC[((size_t)it2_ * 2 + d) * 64 + tid]; } while (0)
#define SCAN_LSTORE() do { \
    _Pragma("unroll") for (int it = 0; it < 2; ++it) { const int v = tid + 512 * it; \
      ldsst<u32x4>(L, QS + (v >> 4) * 272 + (v & 15) * 16, rq[it]); ldsst<u32x4>(L, KS + (v >> 4) * 272 + (v & 15) * 16, rk[it]); ldsst<u32x4>(L, KTS + (v >> 3) * 144 + (v & 7) * 16, rkt[it]); } \
    ldsst<u32x4>(L, VTS + (tid >> 3) * 144 + (tid & 7) * 16, rvt); ldsst<u32x4>(L, TW + (tid >> 3) * 144 + (tid & 7) * 16, rtw); ldsst<u32x4>(L, TU + (tid >> 3) * 144 + (tid & 7) * 16, rtu); \
    if (tid < 64) ldsst<float>(L, GCL + tid * 4, rgc); } while (0)
  SCAN_GLOAD(0); SCAN_LSTORE(); __syncthreads();
  for (int s = 0; s < 68; ++s) {
    const int n = SCAN_CHUNK(s);
    if (s + 1 < 68) SCAN_GLOAD(s + 1);
    const float gtot = ldsld<float>(L, GCL + (d ? 0 : 63) * 4);
    f32x4 uacc[2], qacc[2];
    {
      bf16x8 qf[4], kf[2][4], twf[2], tuf[2], vtf[2][2], ktf[4][2], sf[2][4];
#pragma unroll
      for (int kk = 0; kk < 4; ++kk) qf[kk] = ldsld<bf16x8>(L, QS + (16 * ti + fr) * 272 + kk * 64 + fq * 16);
#pragma unroll
      for (int q = 0; q < 2; ++q)
#pragma unroll
        for (int kk = 0; kk < 4; ++kk) { kf[q][kk] = ldsld<bf16x8>(L, KS + (16 * (2 * half + q) + fr) * 272 + kk * 64 + fq * 16); sf[q][kk] = ldsld<bf16x8>(L, STL + (16 * (2 * half + q) + fr) * 272 + kk * 64 + fq * 16); }
      f32x4 at[2], wv[4];
#pragma unroll
      for (int q = 0; q < 2; ++q) { at[q] = (f32x4){0.f, 0.f, 0.f, 0.f}; qacc[q] = at[q]; uacc[q] = at[q]; }
#pragma unroll
      for (int q = 0; q < 4; ++q) wv[q] = (f32x4){0.f, 0.f, 0.f, 0.f};
#pragma unroll
      for (int kk = 0; kk < 4; ++kk)
#pragma unroll
        for (int q = 0; q < 2; ++q) { at[q] = mma(kf[q][kk], qf[kk], at[q]); qacc[q] = mma(sf[q][kk], qf[kk], qacc[q]); }
      __builtin_amdgcn_sched_barrier(0);
#pragma unroll
      for (int kk = 0; kk < 2; ++kk) { twf[kk] = ldsld<bf16x8>(L, TW + (16 * ti + fr) * 144 + kk * 64 + fq * 16); tuf[kk] = ldsld<bf16x8>(L, TU + (16 * ti + fr) * 144 + kk * 64 + fq * 16); }
#pragma unroll
      for (int q = 0; q < 4; ++q)
#pragma unroll
        for (int kk = 0; kk < 2; ++kk) ktf[q][kk] = ldsld<bf16x8>(L, KTS + (16 * (4 * half + q) + fr) * 144 + kk * 64 + fq * 16);
#pragma unroll
      for (int q = 0; q < 2; ++q)
#pragma unroll
        for (int kk = 0; kk < 2; ++kk) vtf[q][kk] = ldsld<bf16x8>(L, VTS + (16 * (2 * half + q) + fr) * 144 + kk * 64 + fq * 16);
#pragma unroll
      for (int kk = 0; kk < 2; ++kk) {
#pragma unroll
        for (int q = 0; q < 4; ++q) wv[q] = mma(ktf[q][kk], twf[kk], wv[q]);
#pragma unroll
        for (int q = 0; q < 2; ++q) uacc[q] = mma(tuf[kk], vtf[q][kk], uacc[q]);
      }
      const int i = 16 * ti + fr; const float gi = ldsld<float>(L, GCL + i * 4);
#pragma unroll
      for (int q = 0; q < 2; ++q) {
        const int j0 = 16 * (2 * half + q) + 4 * fq; f32x4 a = at[q];
#pragma unroll
        for (int e = 0; e < 4; ++e) { const int j = j0 + e; const bool keep = d ? (i <= j) : (i >= j); const float ar = keep ? gi - ldsld<float>(L, GCL + j * 4) : 0.f; a[e] = keep ? a[e] * __expf(ar) : 0.f; }
        ldsst<u32x2>(L, AT + i * 144 + j0 * 2, pack4(a));
      }
#pragma unroll
      for (int q = 0; q < 4; ++q) ldsst<u32x2>(L, WL + (16 * ti + fr) * 272 + (16 * (4 * half + q) + 4 * fq) * 2, pack4(wv[q]));
    }
    __syncthreads();
    {
      bf16x8 wf[4], sf[2][4];
#pragma unroll
      for (int kk = 0; kk < 4; ++kk) { wf[kk] = ldsld<bf16x8>(L, WL + (16 * ti + fr) * 272 + kk * 64 + fq * 16);
#pragma unroll
        for (int q = 0; q < 2; ++q) sf[q][kk] = ldsld<bf16x8>(L, STL + (16 * (2 * half + q) + fr) * 272 + kk * 64 + fq * 16); }
      f32x4 a[2];
#pragma unroll
      for (int q = 0; q < 2; ++q) a[q] = (f32x4){0.f, 0.f, 0.f, 0.f};
#pragma unroll
      for (int kk = 0; kk < 4; ++kk)
#pragma unroll
        for (int q = 0; q < 2; ++q) a[q] = mma(wf[kk], sf[q][kk], a[q]);
      const int i0 = 16 * ti + 4 * fq; float sc4[4];
#pragma unroll
      for (int e = 0; e < 4; ++e) sc4[e] = __expf(gtot - ldsld<float>(L, GCL + (i0 + e) * 4));
#pragma unroll
      for (int q = 0; q < 2; ++q) {
        const int te = 2 * half + q; const f32x4 vn = uacc[q] - a[q]; f32x4 vs;
#pragma unroll
        for (int e = 0; e < 4; ++e) vs[e] = vn[e] * sc4[e];
        ldsst<u32x2>(L, VNT_ + (16 * te + fr) * 144 + i0 * 2, pack4(vn)); ldsst<u32x2>(L, VNS + (16 * te + fr) * 144 + i0 * 2, pack4(vs));
      }
    }
    __syncthreads();
    {
      bf16x8 af[2], vf[2][2], nsf[2], ktf[4][2];
#pragma unroll
      for (int q = 0; q < 4; ++q)
#pragma unroll
        for (int kk = 0; kk < 2; ++kk) ktf[q][kk] = ldsld<bf16x8>(L, KTS + (16 * (4 * half + q) + fr) * 144 + kk * 64 + fq * 16);
#pragma unroll
      for (int kk = 0; kk < 2; ++kk) { af[kk] = ldsld<bf16x8>(L, AT + (16 * ti + fr) * 144 + kk * 64 + fq * 16); nsf[kk] = ldsld<bf16x8>(L, VNS + (16 * ti + fr) * 144 + kk * 64 + fq * 16);
#pragma unroll
        for (int q = 0; q < 2; ++q) vf[q][kk] = ldsld<bf16x8>(L, VNT_ + (16 * (2 * half + q) + fr) * 144 + kk * 64 + fq * 16); }
      const float cd = __expf(gtot);
      f32x4 ov[2];
#pragma unroll
      for (int q = 0; q < 2; ++q) ov[q] = (f32x4){0.f, 0.f, 0.f, 0.f};
#pragma unroll
      for (int q = 0; q < 4; ++q) accS[q] = accS[q] * cd;
#pragma unroll
      for (int kk = 0; kk < 2; ++kk) {
#pragma unroll
        for (int q = 0; q < 2; ++q) ov[q] = mma(vf[q][kk], af[kk], ov[q]);
#pragma unroll
        for (int q = 0; q < 4; ++q) accS[q] = mma(ktf[q][kk], nsf[kk], accS[q]);
      }
      const int i = 16 * ti + fr; const float eg = __expf(ldsld<float>(L, GCL + i * 4));
#pragma unroll
      for (int q = 0; q < 2; ++q) { const f32x4 o4 = qacc[q] * eg + ov[q];
        *(u32x2*)(O + (size_t)(64 * n + i) * 512 + h * 128 + es * 64 + 16 * (2 * half + q) + 4 * fq) = pack4(o4); }
    }
    __syncthreads();
#pragma unroll
    for (int q = 0; q < 4; ++q) ldsst<u32x2>(L, STL + (16 * ti + fr) * 272 + (16 * (4 * half + q) + 4 * fq) * 2, pack4(accS[q]));
    if (s + 1 < 68) SCAN_LSTORE();
    __syncthreads();
  }
#undef SCAN_CHUNK
#undef SCAN_GLOAD
#undef SCAN_LSTORE
}

__device__ void ofprep_phase(const Params& p, int l) {
  const int tid_ = otid(), lane = tid_ & 63, gw = blockIdx.x * 8 + (tid_ >> 6), nw = gridDim.x * 8;
  const bf16_t* O0 = (const bf16_t*)(lws(p.ws) + O_O); const bf16_t* O1 = O0 + (size_t)ROWS * 512; const bf16_t* Z = (const bf16_t*)(lws(p.ws) + O_Z); bf16_t* OF = (bf16_t*)(lws(p.ws) + O_OF);
  const float* og = p.o_gain + (size_t)l * 128 + (lane & 15) * 8;
  for (int r = gw; r < ROWS; r += nw) {
    const u32x4 a = *(const u32x4*)(O0 + (size_t)r * 512 + lane * 8), bq = *(const u32x4*)(O1 + (size_t)r * 512 + lane * 8), zq = *(const u32x4*)(Z + (size_t)r * 512 + lane * 8);
    float o[8]; float ss = 0.f;
#pragma unroll
    for (int e = 0; e < 4; ++e) { o[2 * e] = bflo(a[e]) + bflo(bq[e]); o[2 * e + 1] = bfhi(a[e]) + bfhi(bq[e]); ss += o[2 * e] * o[2 * e] + o[2 * e + 1] * o[2 * e + 1]; }
    ss += __shfl_xor(ss, 1); ss += __shfl_xor(ss, 2); ss += __shfl_xor(ss, 4); ss += __shfl_xor(ss, 8);
    const float rstd = rsqrtf(ss * (1.0f / 128.0f) + 1e-6f);
    float y[8];
#pragma unroll
    for (int e = 0; e < 4; ++e) { y[2 * e] = o[2 * e] * rstd * og[2 * e] * siluf_(bflo(zq[e])); y[2 * e + 1] = o[2 * e + 1] * rstd * og[2 * e + 1] * siluf_(bfhi(zq[e])); }
    u32x4 w; w.x = cvt_pk_bf16(y[0], y[1]); w.y = cvt_pk_bf16(y[2], y[3]); w.z = cvt_pk_bf16(y[4], y[5]); w.w = cvt_pk_bf16(y[6], y[7]);
    *(u32x4*)(OF + (size_t)r * 512 + lane * 8) = w;
  }
}


#define XB_TMO      128
#define XB_XCNT(j)  (256  + 64 * (j))
#define XB_XSUB(j)  (1280 + 64 * (j))
#define XB_XGEN(j)  (2304 + 64 * (j))
#define XB_TOP      3328
#define XB_TOPGEN   3392
#define XCD_BAR_WORDS 3456
#define XB_SPIN_CAP (1u << 18)

__device__ __forceinline__ unsigned xb_ld(unsigned* p)              { return __hip_atomic_load(p, __ATOMIC_RELAXED, __HIP_MEMORY_SCOPE_AGENT); }
__device__ __forceinline__ unsigned xb_add(unsigned* p, unsigned v) { return __hip_atomic_fetch_add(p, v, __ATOMIC_RELAXED, __HIP_MEMORY_SCOPE_AGENT); }
__device__ __forceinline__ unsigned xb_xcc_id() { return (unsigned)__builtin_amdgcn_s_getreg((3 << 11) | 20) & 0xFu; }
#define XB_SPIN(cond, bar) do { unsigned _sp = 0; while (cond) { __builtin_amdgcn_s_sleep(1); \
    if ((++_sp & 255u) == 0u) { if (xb_ld(&(bar)[XB_TMO])) break; if (_sp > XB_SPIN_CAP) { atomicAdd(&(bar)[XB_TMO], 1u); break; } } } } while (0)

struct XcdBarrier {
    unsigned* bar; unsigned x;
    volatile LAS unsigned* st;
};

__device__ __forceinline__ XcdBarrier xcd_barrier_post(unsigned* bar, volatile LAS unsigned* st) {
    XcdBarrier b; b.bar = bar; b.x = xb_xcc_id(); b.st = st;
    if (threadIdx.x == 0) (void)xb_add(&bar[XB_XCNT(b.x)], 1u);
    return b;
}
__device__ __forceinline__ void xcd_barrier_complete(unsigned* bar, unsigned x, unsigned& nloc, unsigned& nx) {
    const unsigned G = gridDim.x * gridDim.y * gridDim.z;
    unsigned sum, cnt, mine, sp = 0u;
    for (;;) {
        sum = 0u; cnt = 0u; mine = 0u;
#pragma unroll
        for (unsigned j = 0; j < 16; ++j) { const unsigned c = xb_ld(&bar[XB_XCNT(j)]); sum += c; cnt += (c > 0u) ? 1u : 0u; mine = (j == x) ? c : mine; }
        if (sum == G) break;
        __builtin_amdgcn_s_sleep(1);
        if ((++sp & 255u) == 0u) { if (xb_ld(&bar[XB_TMO])) break; if (sp > XB_SPIN_CAP) { atomicAdd(&bar[XB_TMO], 1u); break; } }
    }
    nloc = mine > 0u ? mine : 1u; nx = cnt > 0u ? cnt : 1u;
}

__device__ __forceinline__ void xcd_barrier(const XcdBarrier& b) {
    asm volatile("s_waitcnt vmcnt(0)" ::: "memory");
    __syncthreads();
    if (threadIdx.x == 0) {
        unsigned* bar = b.bar;
        __builtin_amdgcn_s_waitcnt(0);
        unsigned nloc = b.st[0], nx = b.st[1];
        if (nloc == 0u) { xcd_barrier_complete(bar, b.x, nloc, nx); b.st[0] = nloc; b.st[1] = nx; }
        const unsigned old = xb_add(&bar[XB_XSUB(b.x)], 1u);
        const unsigned gen = old / nloc;
        if (old + 1u == (gen + 1u) * nloc) {
            __builtin_amdgcn_fence(__ATOMIC_RELEASE, "agent");
            asm volatile("s_waitcnt vmcnt(0)" ::: "memory");
            const unsigned og = xb_add(&bar[XB_TOP], 1u);
            const unsigned tg = og / nx;
            if (og + 1u == (tg + 1u) * nx) xb_add(&bar[XB_TOPGEN], 1u);
            else XB_SPIN(xb_ld(&bar[XB_TOPGEN]) == tg, bar);
            __builtin_amdgcn_fence(__ATOMIC_ACQUIRE, "agent");
            xb_add(&bar[XB_XGEN(b.x)], 1u);
            asm volatile("s_waitcnt vmcnt(0)" ::: "memory");
        } else {
            XB_SPIN(xb_ld(&bar[XB_XGEN(b.x)]) == gen, bar);
            __builtin_amdgcn_fence(__ATOMIC_ACQUIRE, "agent");
            asm volatile("s_waitcnt vmcnt(0)" ::: "memory");
        }
    }
    __syncthreads();
}


__device__ __forceinline__ float rdb(const bf16_t* s_, size_t n, size_t i) { float a = 0.f; for (size_t j = i; j < n; j += (size_t)RLAT * DM) a += __uint_as_float((unsigned)s_[j] << 16); return a; }
__device__ __forceinline__ float rdf(const float* s_, size_t n, size_t i) { float a = 0.f; for (size_t j = i; j < n; j += (size_t)RLAT * DM) a += s_[j]; return a; }
__device__ void dump_phase(const Params& p, int which) {
  const size_t NO = (size_t)RLAT * DM; unsigned char* ws = lws(p.ws);
  for (size_t i = (size_t)blockIdx.x * NTHR + otid(); i < NO; i += (size_t)gridDim.x * NTHR) {
    float a = 0.f;
    if (which == 1) { a = rdb((const bf16_t*)(ws + O_QKV), (size_t)ROWS * 1536, i) + rdb((const bf16_t*)(ws + O_Z), (size_t)ROWS * 512, i) + rdb((const bf16_t*)(ws + O_PI), (size_t)ROWS * 256, i) + rdb((const bf16_t*)(ws + O_FI), (size_t)ROWS * 256, i) + rdf((const float*)(ws + O_AB), (size_t)ROWS * 16, i); }
    if (which == 2) { a = rdb((const bf16_t*)(ws + O_QN), (size_t)ROWS * 512, i) + rdb((const bf16_t*)(ws + O_KN), (size_t)ROWS * 512, i) + rdb((const bf16_t*)(ws + O_KNT), (size_t)ROWS * 512, i) + rdb((const bf16_t*)(ws + O_VNT), (size_t)ROWS * 512, i) + rdb((const bf16_t*)(ws + O_TT), (size_t)ROWS * 1024, i) + rdf((const float*)(ws + O_GC), (size_t)NCH * 4 * 2 * 64, i)
          + rdb((const bf16_t*)(ws + O_FBT), (size_t)NB * 256 * 4096, i) + rdf((const float*)(ws + O_UCS), (size_t)NB * CTX * 512, i); }
    if (which == 3) { a = rdb((const bf16_t*)(ws + O_O), (size_t)ROWS * 1024, i); }
    if (which == 4) { a = rdb((const bf16_t*)(ws + O_OF), (size_t)ROWS * 512, i) + rdb((const bf16_t*)(ws + O_HN), (size_t)ROWS * 1024, i); }
    if (which == 5) { a = rdb((const bf16_t*)(ws + O_MRG), (size_t)ROWS * 1024, i); }
    if ((__float_as_uint(a) & 0xffff0000u) == 0xaaaa0000u) a = 1234.5f;
    if (!(a == a) || fabsf(a) > 1e30f) a = 777.0f;
    a = a * 0.5f + 0.12345678f;
    p.out[i] = a;
  }
}
__global__ void __launch_bounds__(NTHR) fwd_megakernel(Params p) {
  extern __shared__ __attribute__((aligned(16))) unsigned char shm[];
  ldsp L = (ldsp)shm;
  cg::grid_group grid = cg::this_grid();
  volatile LAS unsigned* xst = (volatile LAS unsigned*)(L + LDS_BYTES - 16);
  if (threadIdx.x < 4) xst[threadIdx.x] = 0u;
  __syncthreads();
  XcdBarrier xbar = xcd_barrier_post((unsigned*)(p.ws + O_BAR), xst);
#define GSYNC0() do { asm volatile("s_waitcnt vmcnt(0) lgkmcnt(0)" ::: "memory"); __builtin_amdgcn_fence(__ATOMIC_RELEASE, "agent"); grid.sync(); __builtin_amdgcn_fence(__ATOMIC_ACQUIRE, "agent"); } while (0)
#define GSYNC() xcd_barrier(xbar)
  const int G = gridDim.x, c = blockIdx.x;
#define X ((float*)(lws(p.ws) + O_X))
#define MOD ((const float*)(lws(p.ws) + O_MOD))
#define Hn ((bf16_t*)(lws(p.ws) + O_HN))
#ifndef NO_P0
  phase0(p, L);
#endif
  GSYNC0();
  for (int l = 0; l < DEPTH; ++l) {
    const float* modl = MOD + (size_t)l * 9 * 9216; const float* ng = p.norm_gain + (size_t)l * 3 * 1024; const int notlast = (l != DEPTH - 1) ? 1 : 0, nMx = notlast ? ROWS / 256 : RLAT / 256;
    convert_ffn(p, p.w1gu + (size_t)l * 1024 * 2 * DFF, p.w1d + (size_t)l * DFF * 1024, L);
    convert_mixer(p, l, L);
    norm_phase(X, Hn, ng, modl, 0, 1);
    GSYNC();
#ifndef PROBE_UP
#define PROBE_UP 1
#endif
    for (int rep_ = 0; rep_ < PROBE_UP; ++rep_)
    { pg8::PlainSched S{(const char*)Hn, (const char*)(lws(p.ws) + O_WGU), 2048, 2048, 16, ROWS / 256, 22, G, c}; EpiUp E{(bf16_t*)(lws(p.ws) + O_ACT)}; pg8::gemm_phase(L, S, E); }
    GSYNC();
    { pg8::ResSched S{(const char*)(lws(p.ws) + O_ACT), (const char*)(lws(p.ws) + O_WD), DFF * 2, DFF / 64, G, c, 0}; EpiResT<false> E{(float*)(p.ws + O_X), modl, 2, 0.5f}; pg8::gemm_phase(L, S, E); }
    if (1) { pg8::ResSched S{(const char*)(lws(p.ws) + O_ACT), (const char*)(lws(p.ws) + O_WD), DFF * 2, DFF / 64, G, c, 1}; EpiResT<RES_ATOMIC> E{(float*)(p.ws + O_X), modl, 2, 0.5f}; pg8::gemm_phase(L, S, E); }
    GSYNC();
#ifndef NO_MIXER
    norm_phase(X, Hn, ng + 1024, modl, 3, 4);
    GSYNC();
#ifndef PROBE_IN
#define PROBE_IN 1
#endif
    for (int rep_ = 0; rep_ < PROBE_IN; ++rep_)
    { pg8::PlainSched S{(const char*)Hn, (const char*)(lws(p.ws) + O_WIN), 2048, 2048, 16, ROWS / 256, NINP / 256, G, c};
      EpiIn E{(bf16_t*)(lws(p.ws) + O_QKV), (bf16_t*)(lws(p.ws) + O_Z), (bf16_t*)(lws(p.ws) + O_PI), (bf16_t*)(lws(p.ws) + O_FI), (float*)(lws(p.ws) + O_AB)}; pg8::gemm_phase(L, S, E); }
    GSYNC();
#ifndef PROBE_PREP
#define PROBE_PREP 1
#endif
    for (int rep_ = 0; rep_ < PROBE_PREP; ++rep_) {
    prep_phase(p, l, L);
    }
#ifndef NO_FPREP
    fourier_prep(p, L);
#endif
    GSYNC();
#if defined(DUMP) && DUMP == 2
    dump_phase(p, 2); return;
#endif
#ifndef PROBE_SCAN
#define PROBE_SCAN 1
#endif
#ifndef PROBE_OTHER
#define PROBE_OTHER 1
#endif
    for (int rep_ = 0; rep_ < PROBE_SCAN; ++rep_) {
#ifndef NO_SCAN
    if (c < 128) scan_phase(p, L, c);
#else
    if (c < 128) {}
#endif
    else for (int rep2_ = 0; rep2_ < PROBE_OTHER; ++rep2_) {
      __syncthreads();
      { FourSched S{(const char*)(lws(p.ws) + O_DFT), (const char*)(lws(p.ws) + O_FBT), c - 128}; EpiBf E{(bf16_t*)(lws(p.ws) + O_PPF) + 256, 512}; pg8::gemm_phase(L, S, E); }
      __syncthreads();
      ctx_fourier(p, L, c - 128, G - 128);
      pool_phase(p, L, c - 128, G - 128);
    }
    __syncthreads();
    }
    GSYNC();
#if defined(DUMP) && DUMP == 3
    dump_phase(p, 3); return;
#endif
    ofprep_phase(p, l);
    norm_phase(X, Hn, ng + 1024, modl, 3, 4);
    GSYNC();
#if defined(DUMP) && DUMP == 4
    dump_phase(p, 4); return;
#endif
#ifndef PROBE_MRG
#define PROBE_MRG 1
#endif
    for (int rep_ = 0; rep_ < PROBE_MRG; ++rep_)
    { MergeSched S{(const char*)Hn, (const char*)(lws(p.ws) + O_OF), (const char*)(lws(p.ws) + O_PPF), (const char*)(lws(p.ws) + O_WG), (const char*)(lws(p.ws) + O_WCAT), G, c, nMx};
      EpiMerge E{(unsigned*)(lws(p.ws) + O_SCR) + (size_t)c * 2 * 32768, (bf16_t*)(lws(p.ws) + O_MRG)}; pg8::gemm_phase(L, S, E); }
    GSYNC();
#if defined(DUMP) && DUMP == 5
    dump_phase(p, 5); return;
#endif
    { pg8::ResSched S{(const char*)(lws(p.ws) + O_MRG), (const char*)(lws(p.ws) + O_WOUT), 2048, 16, G, c, 0}; EpiResT<false> E{(float*)(p.ws + O_X), modl, 5, 1.0f}; pg8::gemm_phase(L, S, E); }
    if (notlast) { pg8::ResSched S{(const char*)(lws(p.ws) + O_MRG), (const char*)(lws(p.ws) + O_WOUT), 2048, 16, G, c, 1}; EpiResT<RES_ATOMIC> E{(float*)(p.ws + O_X), modl, 5, 1.0f}; pg8::gemm_phase(L, S, E); }
    GSYNC();
#endif
    convert_ffn(p, p.w2gu + (size_t)l * 1024 * 2 * DFF, p.w2d + (size_t)l * DFF * 1024, L);
    norm_phase(X, Hn, ng + 2048, modl, 6, 7);
    GSYNC();
    { pg8::PlainSched S{(const char*)Hn, (const char*)(lws(p.ws) + O_WGU), 2048, 2048, 16, nMx, 22, G, c}; EpiUp E{(bf16_t*)(lws(p.ws) + O_ACT)}; pg8::gemm_phase(L, S, E); }
    GSYNC();
    { pg8::ResSched S{(const char*)(lws(p.ws) + O_ACT), (const char*)(lws(p.ws) + O_WD), DFF * 2, DFF / 64, G, c, 0}; EpiResT<false> E{(float*)(p.ws + O_X), modl, 8, 0.5f}; pg8::gemm_phase(L, S, E); }
    if (notlast) { pg8::ResSched S{(const char*)(lws(p.ws) + O_ACT), (const char*)(lws(p.ws) + O_WD), DFF * 2, DFF / 64, G, c, 1}; EpiResT<RES_ATOMIC> E{(float*)(p.ws + O_X), modl, 8, 0.5f}; pg8::gemm_phase(L, S, E); }
    GSYNC();
  }
  final_norm(X, p.out, p.final_gain);
}

extern "C" void kernel_launch(void* const* d_in, const int* in_sizes, int n_in, void* d_out, int out_size, void* d_ws, size_t ws_size, hipStream_t stream) {
  (void)in_sizes; (void)n_in; (void)out_size;
  if (ws_size < WS_NEED) { fprintf(stderr, "workspace too small: %zu < %zu\n", ws_size, (size_t)WS_NEED); return; }
  static int grid_blocks = 0;
  if (!grid_blocks) {
    (void)hipFuncSetAttribute((const void*)fwd_megakernel, hipFuncAttributeMaxDynamicSharedMemorySize, LDS_BYTES);
    int dev = 0, cus = 0, per_cu = 0; (void)hipGetDevice(&dev); (void)hipDeviceGetAttribute(&cus, hipDeviceAttributeMultiprocessorCount, dev);
    (void)hipOccupancyMaxActiveBlocksPerMultiprocessor(&per_cu, fwd_megakernel, NTHR, LDS_BYTES);
    grid_blocks = cus * (per_cu > 0 ? 1 : 0);
    if (grid_blocks != 256) fprintf(stderr, "unexpected grid %d (cus %d per_cu %d)\n", grid_blocks, cus, per_cu);
  }
  Params p{};
  const float** f = (const float**)&p;
  for (int i = 0; i < 22; ++i) f[i] = (const float*)d_in[i];
  p.out = (float*)d_out; p.ws = (unsigned char*)d_ws;
  (void)hipMemsetAsync((unsigned char*)d_ws + O_BAR, 0, 16384, stream);
  void* args[] = {&p};
  hipError_t e = hipLaunchCooperativeKernel((void*)fwd_megakernel, dim3(grid_blocks), dim3(NTHR), args, LDS_BYTES, stream);
  if (e != hipSuccess) fprintf(stderr, "cooperative launch failed: %s (grid %d)\n", hipGetErrorString(e), grid_blocks);
}
```

```cpp
#include <hip/hip_runtime.h>
#include <hip/hip_cooperative_groups.h>
#include <cstdio>

namespace cg = cooperative_groups;

#define LAS __attribute__((address_space(3)))
typedef LAS unsigned char* ldsp;
typedef unsigned short bf16_t;
typedef short bf16x8 __attribute__((ext_vector_type(8)));
typedef float f32x4 __attribute__((ext_vector_type(4)));
typedef unsigned u32x4 __attribute__((ext_vector_type(4)));
typedef unsigned u32x2 __attribute__((ext_vector_type(2)));

constexpr int DM = 1024, NB = 8, SEQ = 4096, CTX = 256, DEPTH = 4;
constexpr int RLAT = NB * SEQ, ROWS = RLAT + NB * CTX;
constexpr int DFF = 2816, NMOD = 9, DPROJ = 5648;
constexpr int NCH = ROWS / 64;
constexpr int NINP = 2816;
constexpr int LDS_BYTES = 163840;
constexpr int NTHR = 512;

constexpr size_t al256(size_t x) { return (x + 255) & ~(size_t)255; }
constexpr size_t O_X = 0;
constexpr size_t O_MOD = O_X + (size_t)ROWS * DM * 4;
constexpr size_t O_DFT = al256(O_MOD + (size_t)DEPTH * 9 * 9216 * 4);
constexpr size_t O_WGU = O_DFT + (size_t)4096 * 4096 * 2;
constexpr size_t O_WD = O_WGU + (size_t)5632 * 1024 * 2;
constexpr size_t O_WIN = O_WD + (size_t)1024 * 2816 * 2;
constexpr size_t O_WG = O_WIN + (size_t)NINP * 1024 * 2;
constexpr size_t O_WCAT = O_WG + (size_t)3072 * 1024 * 2;
constexpr size_t O_WOUT = O_WCAT + (size_t)1024 * 1024 * 2;
constexpr size_t O_R = O_WOUT + (size_t)1024 * 1024 * 2;
constexpr size_t SZ_H = (size_t)ROWS * 1024 * 2;
constexpr size_t SZ_Q = (size_t)ROWS * 512 * 2;
constexpr size_t O_HN = O_R;
constexpr size_t O_ACT = O_R + SZ_H;
constexpr size_t O_QN = O_R;
constexpr size_t O_KN = O_R + SZ_Q;
constexpr size_t O_QKV = O_R + SZ_H;
constexpr size_t O_O = O_QKV;
constexpr size_t O_SCR = O_QKV;
constexpr size_t O_Z = O_QKV + (size_t)ROWS * 1536 * 2;
constexpr size_t O_PI = O_Z + SZ_Q;
constexpr size_t O_FI = O_PI + (size_t)ROWS * 256 * 2;
constexpr size_t O_AB = O_FI + (size_t)ROWS * 256 * 2;
constexpr size_t O_KNT = al256(O_AB + (size_t)ROWS * 16 * 4);
constexpr size_t O_VNT = O_KNT + SZ_Q;
constexpr size_t O_MRG = O_KNT;
constexpr size_t O_TT = O_VNT + SZ_Q;
constexpr size_t O_OF = O_TT;
constexpr size_t O_GC = O_TT + SZ_H;
constexpr size_t O_FBT = al256(O_GC + (size_t)NCH * 4 * 2 * 64 * 4);
constexpr size_t O_UCS = O_FBT + (size_t)NB * 256 * 4096 * 2;
constexpr size_t O_PPF = al256(O_UCS + (size_t)NB * CTX * 512 * 4);
constexpr size_t O_BAR = al256(O_PPF + SZ_Q);
constexpr size_t WS_NEED = O_BAR + 16384;
static_assert(O_SCR + (size_t)256 * 2 * 262144 <= O_PI, "merge scratch overlaps");

struct Params {
  const float *x, *c, *ctx, *c_ctx, *w_ada, *b_ada, *norm_gain, *w1gu, *w1d, *w2gu, *w2d, *w_in, *conv_w, *a_log, *dt_bias, *o_gain, *w_a, *w_b,
      *pool_scale, *w_c, *w_out, *final_gain;
  float* out;
  unsigned char* ws;
};

typedef float f32x2_ __attribute__((ext_vector_type(2)));
typedef __bf16 bf16x2_ __attribute__((ext_vector_type(2)));
__device__ __forceinline__ unsigned cvt_pk_bf16(float lo, float hi) { const f32x2_ v = {lo, hi}; const bf16x2_ b = __builtin_convertvector(v, bf16x2_); return __builtin_bit_cast(unsigned, b); }
__device__ __forceinline__ float bflo(unsigned w) { return __uint_as_float(w << 16); }
__device__ __forceinline__ float bfhi(unsigned w) { return __uint_as_float(w & 0xffff0000u); }
__device__ __forceinline__ float sigmoidf_(float x) { return __builtin_amdgcn_rcpf(1.0f + __expf(-x)); }
__device__ __forceinline__ float siluf_(float x) { return x * __builtin_amdgcn_rcpf(1.0f + __expf(-x)); }
template <class T> __device__ __forceinline__ T ldsld(ldsp b, int off) { return *(const LAS T*)(b + off); }
template <class T> __device__ __forceinline__ void ldsst(ldsp b, int off, T v) { *(LAS T*)(b + off) = v; }
__device__ __forceinline__ f32x4 mma(bf16x8 a, bf16x8 b, f32x4 c) { return __builtin_amdgcn_mfma_f32_16x16x32_bf16(a, b, c, 0, 0, 0); }
__device__ __forceinline__ u32x2 pack4(f32x4 v) { u32x2 r; r.x = cvt_pk_bf16(v[0], v[1]); r.y = cvt_pk_bf16(v[2], v[3]); return r; }
__device__ __forceinline__ int otid() { int t = threadIdx.x; asm volatile("" : "+v"(t)); return t; }
extern __shared__ __attribute__((aligned(16))) unsigned char g_shm[];
__device__ __forceinline__ unsigned char* lws(unsigned char*) { ldsp Lb = (ldsp)g_shm; unsigned lo = *(volatile LAS unsigned*)(Lb + LDS_BYTES - 32), hi = *(volatile LAS unsigned*)(Lb + LDS_BYTES - 28);
  lo = __builtin_amdgcn_readfirstlane(lo); hi = __builtin_amdgcn_readfirstlane(hi); return (unsigned char*)(((unsigned long long)hi << 32) | (unsigned long long)lo); }
__device__ __forceinline__ void atomic_add_f32(float* q, float v) { asm volatile("global_atomic_add_f32 %0, %1, off sc1" : : "v"(q), "v"(v) : "memory"); }
__device__ __forceinline__ int modidx(int pm) { return pm < 128 ? (pm >> 4) : 8; }

namespace pg8 {
constexpr int BM = 256, BK = 64, HALF = 128, HTB = HALF * BK * 2, NXCD = 8, WGM = 8;
__device__ __forceinline__ int lds_byte(int r, int c) { const int st = (r >> 4) * 2 + (c >> 5), rr = r & 15, cc = c & 31, ob = rr * 64 + cc * 2; return st * 1024 + (ob ^ (((ob >> 9) & 1) << 5)); }
__device__ __forceinline__ void stage_rc(int b, int& R, int& C) { const int st = b / 1024, sb = b % 1024, swz = sb ^ (((sb >> 9) & 1) << 5); R = (st >> 1) * 16 + swz / 64; C = (st & 1) * 32 + (swz % 64) / 2; }
__device__ __forceinline__ int perm32(int rho) { const int n = rho >> 4, i = rho & 15; return 8 * (i >> 2) + 4 * n + (i & 3); }

struct Unit { const char* A; const char* B; int lda, ldb, nt, pm, pn, seg; };

__device__ __forceinline__ bool tile_of(int nM, int nN, int G, int c, int i, int& pm, int& pn) {
  const int nwg = nM * nN; const long Lq = (long)i * G + c; if (Lq >= nwg) return false;
  int wgid = (int)Lq; { const int q = nwg / NXCD, r = nwg % NXCD, xcd = wgid % NXCD, off = wgid / NXCD; wgid = (xcd < r ? xcd * (q + 1) : r * (q + 1) + (xcd - r) * q) + off; }
  const int nig = WGM * nN, gid = wgid / nig, fm = gid * WGM, gsz = (nM - fm) < WGM ? (nM - fm) : WGM;
  pm = fm + ((wgid % nig) % gsz); pn = (wgid % nig) / gsz; return true;
}
struct PlainSched {
  static constexpr bool VARLDA = false;
  const char* A; const char* B; int lda, ldb, nt, nM, nN, G, c;
  __device__ __forceinline__ bool next(int i, Unit& u) const {
    int pm, pn; if (!tile_of(nM, nN, G, c, i, pm, pn)) return false;
    u.A = A + (size_t)pm * 256 * lda; u.B = B + (size_t)pn * 256 * ldb; u.lda = lda; u.ldb = ldb; u.nt = nt; u.pm = pm; u.pn = pn; u.seg = 0; return true;
  }
};

struct ResSched {
  static constexpr bool VARLDA = false;
  const char* A; const char* B; int ld, nt, G, c, mode;
  __device__ __forceinline__ bool next(int i, Unit& u) const {
    u.lda = ld; u.ldb = ld;
    if (mode == 0) { int pm, pn; if (i >= 2 || !tile_of(128, 4, G, c, i, pm, pn)) return false;
      u.A = A + (size_t)pm * 256 * ld; u.B = B + (size_t)pn * 256 * ld; u.nt = nt; u.pm = pm; u.pn = pn; u.seg = 0; return true; }
#ifdef NO_SPLITK
    if (i > 0 || c >= 32) return false;
    { const int pm = 128 + (c >> 2), pn = c & 3; u.A = A + (size_t)pm * 256 * ld; u.B = B + (size_t)pn * 256 * ld; u.nt = nt; u.pm = pm; u.pn = pn; u.seg = 0; return true; }
#endif
    if (i > 0 || c >= 256) return false;
    const int pm = 128 + (c >> 5), pn = (c >> 3) & 3, kp = c & 7;
    const int base = (nt / 16) * 2, extra = (nt - base * 8) / 2;
    const int k0 = kp * base + 2 * (kp < extra ? kp : extra), np = base + (kp < extra ? 2 : 0);
    u.A = A + (size_t)pm * 256 * ld + (size_t)k0 * 128; u.B = B + (size_t)pn * 256 * ld + (size_t)k0 * 128; u.nt = np; u.pm = pm; u.pn = pn; u.seg = kp; return true;
  }
};
template <class Epi, class Sched>
__device__ __forceinline__ void gemm_phase(ldsp lds, const Sched& S, const Epi& E) {
  const int tid = otid(), wid = __builtin_amdgcn_readfirstlane(tid >> 6), lane = tid & 63, wr = wid >> 2, wc = wid & 3, fr = lane & 15, fq = lane >> 4;
  unsigned rA[2], rB[2], c2[2];
#pragma unroll
  for (int i = 0; i < 2; ++i) { int R, C; stage_rc(tid * 16 + i * 8192, R, C); rA[i] = (unsigned)R; rB[i] = (unsigned)(Epi::PERM ? ((R & ~31) + perm32(R & 31)) : R); c2[i] = (unsigned)C * 2u; }
  const size_t kstep = (size_t)(BK * 2);
  const unsigned ldsw = (unsigned)wid * 1024u;
  const int aoff = lds_byte(wr * 64 + fr, fq * 8), boff = lds_byte(wc * 32 + fr, fq * 8);
#define PG8_SA(b, h) (((b) * 2 + (h)) * HTB)
#define PG8_SB(b, h) ((4 + (b) * 2 + (h)) * HTB)
#define PG8_STAGE(bufoff, gbase, voff) do { _Pragma("unroll") for (int _i = 0; _i < 2; ++_i) \
    __builtin_amdgcn_global_load_lds((const unsigned*)((const char*)(gbase) + (voff)[_i]), (LAS unsigned*)(lds + (bufoff) + ldsw + _i * 8192), 16, 0, 0); } while (0)
#define PG8_LDA(dst, b, h) do { _Pragma("unroll") for (int m = 0; m < 4; ++m) _Pragma("unroll") for (int k = 0; k < 2; ++k) dst[m][k] = *(const LAS bf16x8*)(lds + PG8_SA(b, h) + aoff + m * 2048 + k * 1024); } while (0)
#define PG8_LDB(dst, b, h) do { _Pragma("unroll") for (int n = 0; n < 2; ++n) _Pragma("unroll") for (int k = 0; k < 2; ++k) dst[n][k] = *(const LAS bf16x8*)(lds + PG8_SB(b, h) + boff + n * 2048 + k * 1024); } while (0)
#define PG8_MMA(ai, bj, At, Bt) do { __builtin_amdgcn_s_setprio(1); _Pragma("unroll") for (int m = 0; m < 4; ++m) _Pragma("unroll") for (int n = 0; n < 2; ++n) _Pragma("unroll") for (int k = 0; k < 2; ++k) \
    acc[ai][bj][m][n] = __builtin_amdgcn_mfma_f32_16x16x32_bf16(Bt[n][k], At[m][k], acc[ai][bj][m][n], 0, 0, 0); __builtin_amdgcn_s_setprio(0); } while (0)
#define PG8_WAIT_V(n) asm volatile("s_waitcnt vmcnt(" #n ")" ::: "memory")
#define PG8_WAIT_L(n) asm volatile("s_waitcnt lgkmcnt(" #n ")" ::: "memory")
#define PG8_BAR __builtin_amdgcn_s_barrier()
#define PG8_SCHED __builtin_amdgcn_sched_barrier(0)
  Unit cur, nxt; int ui = 0;
  if (!S.next(0, cur)) return;
  float zz_; asm volatile("v_mov_b32 %0, 0" : "=v"(zz_));
  f32x4 acc[2][2][4][2];
#pragma unroll
  for (int a = 0; a < 2; ++a)
#pragma unroll
    for (int b = 0; b < 2; ++b)
#pragma unroll
      for (int m = 0; m < 4; ++m)
#pragma unroll
        for (int n = 0; n < 2; ++n) acc[a][b][m][n] = (f32x4){zz_, zz_, zz_, zz_};
  bf16x8 At[4][2], B0[2][2], B1[2][2];
  const char* cA = cur.A; const char* cB = cur.B; int ldA = cur.lda; const int ldB = cur.ldb;
  unsigned voffA[2], voffB[2];
#pragma unroll
  for (int i = 0; i < 2; ++i) { voffA[i] = rA[i] * (unsigned)ldA + c2[i]; voffB[i] = rB[i] * (unsigned)ldB + c2[i]; }
  const size_t hB = (size_t)HALF * ldB;
  {
    const size_t hA = (size_t)HALF * ldA;
    PG8_STAGE(PG8_SB(0, 0), cB, voffB); PG8_STAGE(PG8_SA(0, 0), cA, voffA); PG8_STAGE(PG8_SB(0, 1), cB + hB, voffB); PG8_STAGE(PG8_SA(0, 1), cA + hA, voffA);
    if (wr == 1) PG8_BAR;
    PG8_WAIT_V(4); PG8_BAR;
    PG8_STAGE(PG8_SB(1, 0), cB + kstep, voffB); PG8_STAGE(PG8_SA(1, 0), cA + kstep, voffA); PG8_STAGE(PG8_SB(1, 1), cB + hB + kstep, voffB);
    PG8_WAIT_V(6); PG8_BAR;
  }
  for (;;) {
    const bool has_next = S.next(ui + 1, nxt);
    const char* nA = has_next ? nxt.A : cA; const char* nB = has_next ? nxt.B : cB;
    const int nldA = has_next ? nxt.lda : ldA;
    const int nt = cur.nt;
    const size_t hA = (size_t)HALF * ldA;
    for (int t = 0; t < nt; t += 2) {
      const bool last = (t == nt - 2);
      const char* a1 = cA + (size_t)(t + 1) * kstep;
      const char* a2 = last ? nA : cA + (size_t)(t + 2) * kstep; const char* b2 = last ? nB : cB + (size_t)(t + 2) * kstep;
      const size_t h2A = (size_t)HALF * (last ? nldA : ldA);
      const char* a3 = a2 + kstep; const char* b3 = b2 + kstep;
      PG8_LDB(B0, 0, 0); PG8_SCHED; PG8_LDA(At, 0, 0); PG8_STAGE(PG8_SA(1, 1), a1 + hA, voffA);
      if (Sched::VARLDA) { if (last) {
#pragma unroll
        for (int i = 0; i < 2; ++i) voffA[i] = rA[i] * (unsigned)nldA + c2[i]; } }
      PG8_WAIT_L(8); PG8_BAR; PG8_WAIT_L(0); PG8_MMA(0, 0, At, B0); PG8_BAR; PG8_SCHED;
      PG8_LDB(B1, 0, 1); PG8_STAGE(PG8_SB(0, 0), b2, voffB);
      PG8_BAR; PG8_WAIT_L(0); PG8_MMA(0, 1, At, B1); PG8_BAR;
      PG8_LDA(At, 0, 1); PG8_STAGE(PG8_SA(0, 0), a2, voffA);
      PG8_BAR; PG8_WAIT_L(0); PG8_MMA(1, 0, At, B0); PG8_BAR; PG8_SCHED;
      PG8_STAGE(PG8_SB(0, 1), b2 + hB, voffB);
      PG8_WAIT_V(6); PG8_BAR; PG8_MMA(1, 1, At, B1); PG8_BAR;
      PG8_LDB(B0, 1, 0); PG8_SCHED; PG8_LDA(At, 1, 0); PG8_STAGE(PG8_SA(0, 1), a2 + h2A, voffA);
      PG8_WAIT_L(8); PG8_BAR; PG8_WAIT_L(0); PG8_MMA(0, 0, At, B0); PG8_BAR; PG8_SCHED;
      PG8_LDB(B1, 1, 1); PG8_STAGE(PG8_SB(1, 0), b3, voffB);
      PG8_BAR; PG8_WAIT_L(0); PG8_MMA(0, 1, At, B1); PG8_BAR;
      PG8_LDA(At, 1, 1); PG8_STAGE(PG8_SA(1, 0), a3, voffA);
      PG8_BAR; PG8_WAIT_L(0); PG8_MMA(1, 0, At, B0); PG8_BAR; PG8_SCHED;
      PG8_STAGE(PG8_SB(1, 1), b3 + hB, voffB);
      PG8_WAIT_V(6); PG8_BAR; PG8_MMA(1, 1, At, B1); PG8_BAR;
    }
    E(acc, cur, wr, wc, fr, fq);
    if (!has_next) break;
#pragma unroll
    for (int a = 0; a < 2; ++a)
#pragma unroll
      for (int b = 0; b < 2; ++b)
#pragma unroll
        for (int m = 0; m < 4; ++m)
#pragma unroll
          for (int n = 0; n < 2; ++n) acc[a][b][m][n] = (f32x4){zz_, zz_, zz_, zz_};
    cur = nxt; cA = nA; cB = nB; ldA = nldA; ++ui;
  }
  PG8_WAIT_V(0);
  if (wr == 0) PG8_BAR;
  PG8_BAR;
#undef PG8_SA
#undef PG8_SB
#undef PG8_STAGE
#undef PG8_LDA
#undef PG8_LDB
#undef PG8_MMA
#undef PG8_WAIT_V
#undef PG8_WAIT_L
#undef PG8_BAR
#undef PG8_SCHED
}
}
using pg8::Unit;
typedef f32x4 AccT[2][2][4][2];

struct EpiUp {
  static constexpr bool PERM = true;
  bf16_t* act;
  __device__ __forceinline__ void operator()(const AccT& acc, const Unit& u, int wr, int wc, int fr, int fq) const {
    const int row0 = u.pm * 256 + wr * 64 + fr, col0 = u.pn * 128 + wc * 32 + 8 * fq;
#pragma unroll
    for (int ai = 0; ai < 2; ++ai)
#pragma unroll
      for (int m = 0; m < 4; ++m) {
        const f32x4 a0 = acc[ai][0][m][0], a1 = acc[ai][0][m][1], u0 = acc[ai][1][m][0], u1 = acc[ai][1][m][1];
        u32x4 w;
        w.x = cvt_pk_bf16(siluf_(a0[0]) * u0[0], siluf_(a0[1]) * u0[1]); w.y = cvt_pk_bf16(siluf_(a0[2]) * u0[2], siluf_(a0[3]) * u0[3]);
        w.z = cvt_pk_bf16(siluf_(a1[0]) * u1[0], siluf_(a1[1]) * u1[1]); w.w = cvt_pk_bf16(siluf_(a1[2]) * u1[2], siluf_(a1[3]) * u1[3]);
        *(u32x4*)(act + (size_t)(row0 + ai * 128 + m * 16) * DFF + col0) = w;
      }
  }
};
template <bool ATOMIC> struct EpiResT {
  static constexpr bool PERM = false;
  float* X; const float* modl; int gidx; float scale;
  __device__ __forceinline__ void operator()(const AccT& acc, const Unit& u, int wr, int wc, int fr, int fq) const {
    const int row0 = u.pm * 256 + wr * 64 + fr, col0 = u.pn * 256 + wc * 32 + 4 * fq;
    const float* g = modl + (size_t)(modidx(u.pm) * 9 + gidx) * 1024 + col0;
    f32x4 gv[2][2];
#pragma unroll
    for (int bj = 0; bj < 2; ++bj)
#pragma unroll
      for (int n = 0; n < 2; ++n) gv[bj][n] = *(const f32x4*)(g + bj * 128 + n * 16) * scale;
#pragma unroll
    for (int ai = 0; ai < 2; ++ai)
#pragma unroll
      for (int m = 0; m < 4; ++m) {
        float* rowp = X + (size_t)(row0 + ai * 128 + m * 16) * DM + col0;
#pragma unroll
        for (int bj = 0; bj < 2; ++bj)
#pragma unroll
          for (int n = 0; n < 2; ++n) { float* qf = rowp + bj * 128 + n * 16; const f32x4 t = gv[bj][n] * acc[ai][bj][m][n];
            if (ATOMIC) { atomic_add_f32(qf, t[0]); atomic_add_f32(qf + 1, t[1]); atomic_add_f32(qf + 2, t[2]); atomic_add_f32(qf + 3, t[3]); }
            else { f32x4* q = (f32x4*)qf; *q = *q + t; } }
      }
  }
};
struct EpiPart {
  static constexpr bool PERM = false;
  float* part; const float* modl; int gidx; float scale;
  __device__ __forceinline__ void operator()(const AccT& acc, const Unit& u, int wr, int wc, int fr, int fq) const {
    const int row0 = (u.pm - 128) * 256 + wr * 64 + fr, col0 = u.pn * 256 + wc * 32 + 4 * fq;
    const float* g = modl + (size_t)(8 * 9 + gidx) * 1024 + col0;
    float* pb = part + (size_t)u.seg * 2048 * 1024;
    f32x4 gv[2][2];
#pragma unroll
    for (int bj = 0; bj < 2; ++bj)
#pragma unroll
      for (int n = 0; n < 2; ++n) gv[bj][n] = *(const f32x4*)(g + bj * 128 + n * 16) * scale;
#pragma unroll
    for (int ai = 0; ai < 2; ++ai)
#pragma unroll
      for (int m = 0; m < 4; ++m) {
        float* rowp = pb + (size_t)(row0 + ai * 128 + m * 16) * DM + col0;
#pragma unroll
        for (int bj = 0; bj < 2; ++bj)
#pragma unroll
          for (int n = 0; n < 2; ++n) *(f32x4*)(rowp + bj * 128 + n * 16) = gv[bj][n] * acc[ai][bj][m][n];
      }
  }
};
struct EpiIn {
  static constexpr bool PERM = true;
  bf16_t *qkv, *z, *pi, *fi; float* ab;
  __device__ __forceinline__ void operator()(const AccT& acc, const Unit& u, int wr, int wc, int fr, int fq) const {
    const int row0 = u.pm * 256 + wr * 64 + fr;
    if (u.pn == 10) {
      if (wc == 0 && fq < 2) {
#pragma unroll
        for (int ai = 0; ai < 2; ++ai)
#pragma unroll
          for (int m = 0; m < 4; ++m) {
            float* rp = ab + (size_t)(row0 + ai * 128 + m * 16) * 16 + 8 * fq;
            *(f32x4*)(rp) = acc[ai][0][m][0]; *(f32x4*)(rp + 4) = acc[ai][0][m][1];
          }
      }
      return;
    }
    bf16_t* base; int ld, ct;
    if (u.pn < 6) { base = qkv; ld = 1536; ct = u.pn * 256; } else if (u.pn < 8) { base = z; ld = 512; ct = (u.pn - 6) * 256; } else if (u.pn == 8) { base = pi; ld = 256; ct = 0; } else { base = fi; ld = 256; ct = 0; }
    const int col0 = ct + wc * 32 + 8 * fq;
#pragma unroll
    for (int ai = 0; ai < 2; ++ai)
#pragma unroll
      for (int m = 0; m < 4; ++m) {
        bf16_t* rowp = base + (size_t)(row0 + ai * 128 + m * 16) * ld + col0;
#pragma unroll
        for (int bj = 0; bj < 2; ++bj) { const f32x4 v0 = acc[ai][bj][m][0], v1 = acc[ai][bj][m][1]; u32x4 w; w.x = cvt_pk_bf16(v0[0], v0[1]); w.y = cvt_pk_bf16(v0[2], v0[3]); w.z = cvt_pk_bf16(v1[0], v1[1]); w.w = cvt_pk_bf16(v1[2], v1[3]);
          *(u32x4*)(rowp + bj * 128) = w; }
      }
  }
};
struct EpiBf {
  static constexpr bool PERM = true;
  bf16_t* O; int ld;
  __device__ __forceinline__ void operator()(const AccT& acc, const Unit& u, int wr, int wc, int fr, int fq) const {
    const int row0 = u.pm * 256 + wr * 64 + fr, col0 = u.pn * 256 + wc * 32 + 8 * fq;
#pragma unroll
    for (int ai = 0; ai < 2; ++ai)
#pragma unroll
      for (int m = 0; m < 4; ++m) {
        bf16_t* rowp = O + (size_t)(row0 + ai * 128 + m * 16) * ld + col0;
#pragma unroll
        for (int bj = 0; bj < 2; ++bj) { const f32x4 v0 = acc[ai][bj][m][0], v1 = acc[ai][bj][m][1]; u32x4 w; w.x = cvt_pk_bf16(v0[0], v0[1]); w.y = cvt_pk_bf16(v0[2], v0[3]); w.z = cvt_pk_bf16(v1[0], v1[1]); w.w = cvt_pk_bf16(v1[2], v1[3]);
          *(u32x4*)(rowp + bj * 128) = w; }
      }
  }
};
struct EpiMerge {
  static constexpr bool PERM = true;
  unsigned* scr;
  bf16_t* mrg;
  __device__ __forceinline__ void operator()(const AccT& acc, const Unit& u, int wr, int wc, int fr, int fq) const {
    const int tid_ = otid(); u32x4* S1 = (u32x4*)scr + tid_; u32x4* Mx = (u32x4*)scr + 16 * 512 + tid_;
    const int seg = u.seg;
    if ((seg & 1) == 0) {
#pragma unroll
      for (int ai = 0; ai < 2; ++ai)
#pragma unroll
        for (int bj = 0; bj < 2; ++bj)
#pragma unroll
          for (int m = 0; m < 4; ++m) { const f32x4 v0 = acc[ai][bj][m][0], v1 = acc[ai][bj][m][1]; u32x4 w;
            w.x = cvt_pk_bf16(sigmoidf_(v0[0]), sigmoidf_(v0[1])); w.y = cvt_pk_bf16(sigmoidf_(v0[2]), sigmoidf_(v0[3])); w.z = cvt_pk_bf16(sigmoidf_(v1[0]), sigmoidf_(v1[1])); w.w = cvt_pk_bf16(sigmoidf_(v1[2]), sigmoidf_(v1[3]));
            S1[((ai * 2 + bj) * 4 + m) * 512] = w; }
    } else {
      const int row0 = u.pm * 256 + wr * 64 + fr, col0 = u.pn * 256 + wc * 32 + 8 * fq;
#pragma unroll
      for (int ai = 0; ai < 2; ++ai)
#pragma unroll
        for (int m = 0; m < 4; ++m) {
#pragma unroll
          for (int bj = 0; bj < 2; ++bj) {
            const int ix = ((ai * 2 + bj) * 4 + m) * 512; const u32x4 g = S1[ix]; const f32x4 v0 = acc[ai][bj][m][0], v1 = acc[ai][bj][m][1];
            float t[8] = {bflo(g.x) * v0[0], bfhi(g.x) * v0[1], bflo(g.y) * v0[2], bfhi(g.y) * v0[3], bflo(g.z) * v1[0], bfhi(g.z) * v1[1], bflo(g.w) * v1[2], bfhi(g.w) * v1[3]};
            if (seg >= 3) { const u32x4 q = Mx[ix]; t[0] += bflo(q.x); t[1] += bfhi(q.x); t[2] += bflo(q.y); t[3] += bfhi(q.y); t[4] += bflo(q.z); t[5] += bfhi(q.z); t[6] += bflo(q.w); t[7] += bfhi(q.w); }
            u32x4 w; w.x = cvt_pk_bf16(t[0], t[1]); w.y = cvt_pk_bf16(t[2], t[3]); w.z = cvt_pk_bf16(t[4], t[5]); w.w = cvt_pk_bf16(t[6], t[7]);
            if (seg < 5) Mx[ix] = w; else *(u32x4*)(mrg + (size_t)(row0 + ai * 128 + m * 16) * DM + col0 + bj * 128) = w;
          }
        }
    }
  }
};
struct MergeSched {
  static constexpr bool VARLDA = true;
  const char *hn, *of, *ppf, *wg, *wcat; int G, c, nM;
  __device__ __forceinline__ bool next(int i, Unit& u) const {
    const int round = i / 6, seg = i - round * 6; int pm, pn; if (!pg8::tile_of(nM, 4, G, c, round, pm, pn)) return false;
    const int br = seg >> 1;
    u.pm = pm; u.pn = pn; u.seg = seg; u.ldb = 2048;
    if ((seg & 1) == 0) { u.A = hn + (size_t)pm * 256 * 2048; u.lda = 2048; u.B = wg + (size_t)(br * 1024 + pn * 256) * 2048; u.nt = 16; }
    else {
      u.lda = 1024;
      if (br == 0) { u.A = of + (size_t)pm * 256 * 1024; u.B = wcat + (size_t)pn * 256 * 2048; u.nt = 8; }
      else if (br == 1) { u.A = ppf + (size_t)pm * 256 * 1024; u.B = wcat + (size_t)pn * 256 * 2048 + 512 * 2; u.nt = 4; }
      else { u.A = ppf + (size_t)pm * 256 * 1024 + 256 * 2; u.B = wcat + (size_t)pn * 256 * 2048 + 768 * 2; u.nt = 4; }
    }
    return true;
  }
};
struct FourSched {
  static constexpr bool VARLDA = false;
  const char *dft, *fbt; int c;
  __device__ __forceinline__ bool next(int i, Unit& u) const {
    if (i > 0) return false;
    const int b = c >> 4, pm = c & 15;
    u.A = dft + (size_t)pm * 256 * 8192; u.B = fbt + (size_t)b * 256 * 8192; u.lda = 8192; u.ldb = 8192; u.nt = 64; u.pm = b * 16 + pm; u.pn = 0; u.seg = 0; return true;
  }
};

template <class F>
__device__ __forceinline__ void convT(const float* W, int ldw, int K, int nrows, bf16_t* dst, int ldd, int k0d, F srccol, ldsp L, int& cursor) {
  const int tid = otid(), ntk = K >> 6, ntiles = (nrows >> 6) * ntk, G = (int)gridDim.x;
  int t0 = ((int)blockIdx.x - cursor % G + G) % G;
  for (; t0 < ntiles; t0 += 4 * G) {
    float v[4][8];
#pragma unroll
    for (int u = 0; u < 4; ++u) {
      const int t = t0 + u * G;
      if (t < ntiles) {
        const int tr = t / ntk, tk = t - tr * ntk, r0 = tr * 64, kk0 = tk * 64; const int i = tid & 63, sc = srccol(r0 + i);
#pragma unroll
        for (int it = 0; it < 8; ++it) { const int kk = (tid >> 6) + 8 * it; v[u][it] = sc >= 0 ? W[(size_t)(kk0 + kk) * ldw + sc] : 0.f; }
      }
    }
#pragma unroll
    for (int u = 0; u < 4; ++u) { if (t0 + u * G < ntiles) {
#pragma unroll
      for (int it = 0; it < 8; ++it) ldsst<float>(L, u * 16640 + (((tid >> 6) + 8 * it) * 65 + (tid & 63)) * 4, v[u][it]); } }
    __syncthreads();
#pragma unroll
    for (int u = 0; u < 4; ++u) {
      const int t = t0 + u * G;
      if (t < ntiles) {
        const int tr = t / ntk, tk = t - tr * ntk, r0 = tr * 64, kk0 = tk * 64; const int ii = tid >> 3, kv = (tid & 7) * 8; float o[8];
#pragma unroll
        for (int e = 0; e < 8; ++e) o[e] = ldsld<float>(L, u * 16640 + ((kv + e) * 65 + ii) * 4);
        u32x4 w; w.x = cvt_pk_bf16(o[0], o[1]); w.y = cvt_pk_bf16(o[2], o[3]); w.z = cvt_pk_bf16(o[4], o[5]); w.w = cvt_pk_bf16(o[6], o[7]);
        *(u32x4*)(dst + (size_t)(r0 + ii) * ldd + k0d + kk0 + kv) = w;
      }
    }
    __syncthreads();
  }
  cursor += ntiles;
}

__device__ __forceinline__ void convert_ffn(const Params& p, const float* wgu, const float* wd, ldsp L) {
  int cur = 0;
  convT(wgu, 2 * DFF, 1024, 2 * DFF, (bf16_t*)(lws(p.ws) + O_WGU), 1024, 0, [](int r) { const int t = r >> 8, q = r & 255; return q < 128 ? t * 128 + q : DFF + t * 128 + (q - 128); }, L, cur);
  convT(wd, 1024, DFF, 1024, (bf16_t*)(lws(p.ws) + O_WD), DFF, 0, [](int r) { return r; }, L, cur);
}
__device__ __forceinline__ void convert_mixer(const Params& p, int l, ldsp L) {
  int cur = 0;
  const float* win = p.w_in + (size_t)l * 1024 * DPROJ;
  convT(win, DPROJ, 1024, NINP, (bf16_t*)(lws(p.ws) + O_WIN), 1024, 0, [](int r) { return r < 2048 ? r : (r < 2560 ? r + 16 : (r < 2576 ? r - 512 : -1)); }, L, cur);
  convT(win, DPROJ, 1024, 3072, (bf16_t*)(lws(p.ws) + O_WG), 1024, 0, [](int r) { return 2576 + r; }, L, cur);
  convT(p.w_a + (size_t)l * 512 * 1024, 1024, 512, 1024, (bf16_t*)(lws(p.ws) + O_WCAT), 1024, 0, [](int r) { return r; }, L, cur);
  convT(p.w_c + (size_t)l * 256 * 1024, 1024, 256, 1024, (bf16_t*)(lws(p.ws) + O_WCAT), 1024, 768, [](int r) { return r; }, L, cur);
  convT(p.w_out + (size_t)l * 1024 * 1024, 1024, 1024, 1024, (bf16_t*)(lws(p.ws) + O_WOUT), 1024, 0, [](int r) { return r; }, L, cur);
  const float* wb = p.w_b + (size_t)l * 4 * 64 * 256; const float* ps = p.pool_scale + (size_t)l * 1024; bf16_t* wcat = (bf16_t*)(lws(p.ws) + O_WCAT);
  for (int idx = blockIdx.x * NTHR + otid(); idx < 1024 * 256; idx += gridDim.x * NTHR) {
    const int row = idx & 1023, kk = idx >> 10, g = row >> 8;
    const float v = ((kk >> 6) == g) ? wb[((size_t)g * 64 + (kk & 63)) * 256 + (row & 255)] * ps[row] : 0.f;
    wcat[(size_t)row * 1024 + 512 + kk] = (bf16_t)(cvt_pk_bf16(v, 0.f) & 0xffffu);
  }
}

__device__ __forceinline__ void norm_phase(float* X, bf16_t* Hn, const float* gain, const float* modl, int ishift, int iscale, const float* part) {
  const int tid_ = otid(), lane = tid_ & 63, gw = blockIdx.x * 8 + (tid_ >> 6), nw = gridDim.x * 8;
  for (int r = gw; r < ROWS; r += nw) {
    const int j = r < RLAT ? (r >> 12) : 8;
    const float* sh = modl + (size_t)(j * 9 + ishift) * 1024; const float* sc = modl + (size_t)(j * 9 + iscale) * 1024;
    float* xr = X + (size_t)r * DM;
    f32x4 v[4]; float ss = 0.f;
#pragma unroll
    for (int i = 0; i < 2; ++i) { v[2 * i] = *(const f32x4*)(xr + lane * 8 + 512 * i); v[2 * i + 1] = *(const f32x4*)(xr + lane * 8 + 512 * i + 4); }
    if (part != nullptr && r >= RLAT) {
      const float* pr_ = part + (size_t)(r - RLAT) * DM + lane * 8;
#pragma unroll
      for (int kp = 0; kp < 8; ++kp)
#pragma unroll
        for (int i = 0; i < 2; ++i) { v[2 * i] = v[2 * i] + *(const f32x4*)(pr_ + (size_t)kp * 2048 * 1024 + 512 * i); v[2 * i + 1] = v[2 * i + 1] + *(const f32x4*)(pr_ + (size_t)kp * 2048 * 1024 + 512 * i + 4); }
#pragma unroll
      for (int i = 0; i < 2; ++i) { *(f32x4*)(xr + lane * 8 + 512 * i) = v[2 * i]; *(f32x4*)(xr + lane * 8 + 512 * i + 4) = v[2 * i + 1]; }
    }
#pragma unroll
    for (int i = 0; i < 4; ++i) ss += v[i][0] * v[i][0] + v[i][1] * v[i][1] + v[i][2] * v[i][2] + v[i][3] * v[i][3];
#pragma unroll
    for (int o = 32; o >= 1; o >>= 1) ss += __shfl_xor(ss, o);
    const float rstd = rsqrtf(ss * (1.0f / 1024.0f) + 1e-6f);
#pragma unroll
    for (int i = 0; i < 2; ++i) {
      const int c0 = lane * 8 + 512 * i; float o[8];
#pragma unroll
      for (int hh = 0; hh < 2; ++hh) { const f32x4 g = *(const f32x4*)(gain + c0 + 4 * hh), s1 = *(const f32x4*)(sc + c0 + 4 * hh), s0 = *(const f32x4*)(sh + c0 + 4 * hh); const f32x4 y = v[2 * i + hh] * rstd * g * (s1 + 1.0f) + s0;
        o[4 * hh] = y[0]; o[4 * hh + 1] = y[1]; o[4 * hh + 2] = y[2]; o[4 * hh + 3] = y[3]; }
      u32x4 w; w.x = cvt_pk_bf16(o[0], o[1]); w.y = cvt_pk_bf16(o[2], o[3]); w.z = cvt_pk_bf16(o[4], o[5]); w.w = cvt_pk_bf16(o[6], o[7]);
      *(u32x4*)(Hn + (size_t)r * DM + c0) = w;
    }
  }
}
__device__ __forceinline__ void final_norm(const float* X, float* out, const float* gain) {
  const int tid_ = otid(), lane = tid_ & 63, gw = blockIdx.x * 8 + (tid_ >> 6), nw = gridDim.x * 8;
  for (int r = gw; r < RLAT; r += nw) {
    const float* xr = X + (size_t)r * DM; f32x4 v[4]; float ss = 0.f;
#pragma unroll
    for (int i = 0; i < 4; ++i) { v[i] = *(const f32x4*)(xr + lane * 4 + 256 * i); ss += v[i][0] * v[i][0] + v[i][1] * v[i][1] + v[i][2] * v[i][2] + v[i][3] * v[i][3]; }
#pragma unroll
    for (int o = 32; o >= 1; o >>= 1) ss += __shfl_xor(ss, o);
    const float rstd = rsqrtf(ss * (1.0f / 1024.0f) + 1e-6f);
#pragma unroll
    for (int i = 0; i < 4; ++i) { const f32x4 g = *(const f32x4*)(gain + lane * 4 + 256 * i); *(f32x4*)(out + (size_t)r * DM + lane * 4 + 256 * i) = v[i] * rstd * g; }
  }
}

__device__ __forceinline__ void phase0(const Params& p, ldsp L) {
  const int tid = otid(); const size_t gt = (size_t)blockIdx.x * NTHR + tid, gs = (size_t)gridDim.x * NTHR;
  { f32x4* X = (f32x4*)(lws(p.ws) + O_X); const f32x4* xs = (const f32x4*)p.x; const f32x4* cs = (const f32x4*)p.ctx; const size_t n1 = (size_t)RLAT * DM / 4, n2 = (size_t)ROWS * DM / 4;
    for (size_t i = gt; i < n2; i += gs) X[i] = i < n1 ? xs[i] : cs[i - n1]; }
  { bf16_t* D = (bf16_t*)(lws(p.ws) + O_DFT);
    for (size_t v = gt; v < (size_t)4096 * 512; v += gs) { const int k = (int)(v >> 9), j0 = (int)(v & 511) * 8; float o[8];
#pragma unroll
      for (int e = 0; e < 8; ++e) { const int j = j0 + e; const bool cs_ = j <= 2048; const int t = cs_ ? j : j - 2048; const int r = (k * t) & 4095; const float a = (float)r * (1.0f / 2048.0f);
        o[e] = cs_ ? cospif(a) * (1.0f / 64.0f) : -sinpif(a) * (1.0f / 64.0f); }
      u32x4 w; w.x = cvt_pk_bf16(o[0], o[1]); w.y = cvt_pk_bf16(o[2], o[3]); w.z = cvt_pk_bf16(o[4], o[5]); w.w = cvt_pk_bf16(o[6], o[7]);
      *(u32x4*)(D + (size_t)k * 4096 + j0) = w; } }
  for (int idx = tid; idx < 9 * 1024; idx += NTHR) { const int j = idx >> 10, k = idx & 1023; const float v = j < 8 ? p.c[j * 1024 + k] : p.c_ctx[k]; ldsst<float>(L, idx * 4, siluf_(v)); }
  __syncthreads();
  float* MOD = (float*)(lws(p.ws) + O_MOD);
  for (int item = blockIdx.x; item < DEPTH * 144; item += gridDim.x) {
    const int l = item / 144, n0 = (item - l * 144) * 64, ks = tid >> 6, cn = tid & 63;
    float acc[9];
#pragma unroll
    for (int j = 0; j < 9; ++j) acc[j] = 0.f;
    const float* wp = p.w_ada + ((size_t)l * 1024 + ks * 128) * 9216 + n0 + cn;
#pragma unroll 4
    for (int k = 0; k < 128; ++k) { const float w = wp[(size_t)k * 9216];
#pragma unroll
      for (int j = 0; j < 9; ++j) acc[j] += ldsld<float>(L, (j * 1024 + ks * 128 + k) * 4) * w; }
#pragma unroll
    for (int j = 0; j < 9; ++j) ldsst<float>(L, 36864 + ((ks * 9 + j) * 64 + cn) * 4, acc[j]);
    __syncthreads();
    for (int o = tid; o < 576; o += NTHR) { const int j = o >> 6, c = o & 63; float s = p.b_ada[(size_t)l * 9216 + n0 + c];
#pragma unroll
      for (int q = 0; q < 8; ++q) s += ldsld<float>(L, 36864 + ((q * 9 + j) * 64 + c) * 4);
      MOD[((size_t)l * 9 + j) * 9216 + n0 + c] = s; }
    __syncthreads();
  }
}

__device__ __forceinline__ void prep_phase(const Params& p, int l, ldsp L) {
  const int tid = otid(), lane = tid & 63, wid = tid >> 6, fr = lane & 15, fq = lane >> 4;
  constexpr int KSB = 0, KTL = 17408, VTL = 35840, GL = 54272, AL = 71680, GCL = 104448, BTL = 104960, TOL = 105472;
  const bf16_t* QKV = (const bf16_t*)(lws(p.ws) + O_QKV); const float* AB = (const float*)(lws(p.ws) + O_AB);
  bf16_t* QN = (bf16_t*)(lws(p.ws) + O_QN); bf16_t* KN = (bf16_t*)(lws(p.ws) + O_KN); bf16_t* KNT = (bf16_t*)(lws(p.ws) + O_KNT); bf16_t* VNT = (bf16_t*)(lws(p.ws) + O_VNT);
  bf16_t* TT = (bf16_t*)(lws(p.ws) + O_TT); float* GC = (float*)(lws(p.ws) + O_GC);
  const float* cw = p.conv_w + (size_t)l * 3 * 1536;
  for (int item = blockIdx.x; item < NCH * 4; item += gridDim.x) {
    const int n = item >> 2, h = item & 3, R0 = n * 64;
    { const int row = tid >> 3, cs = tid & 7, r = R0 + row, c0 = cs * 16;
      const int t = r < RLAT ? (r & 4095) : ((r - RLAT) & 255), Ls = r < RLAT ? 4096 : 256;
      const bool hp = t > 0, hn = t < Ls - 1;
#pragma unroll
      for (int mtx = 0; mtx < 3; ++mtx) {
        const int cc = mtx * 512 + h * 128 + c0; const bf16_t* bp = QKV + (size_t)r * 1536 + cc;
        u32x4 a0 = {0, 0, 0, 0}, a1 = {0, 0, 0, 0}, c0v = {0, 0, 0, 0}, c1v = {0, 0, 0, 0};
        const u32x4 b0 = *(const u32x4*)(bp), b1 = *(const u32x4*)(bp + 8);
        if (hp) { a0 = *(const u32x4*)(bp - 1536); a1 = *(const u32x4*)(bp - 1536 + 8); }
        if (hn) { c0v = *(const u32x4*)(bp + 1536); c1v = *(const u32x4*)(bp + 1536 + 8); }
        float val[16]; float ss = 0.f;
#pragma unroll
        for (int e = 0; e < 16; ++e) {
          const unsigned wa = e < 8 ? a0[e >> 1] : a1[(e - 8) >> 1], wb = e < 8 ? b0[e >> 1] : b1[(e - 8) >> 1], wc_ = e < 8 ? c0v[e >> 1] : c1v[(e - 8) >> 1];
          const float xa = (e & 1) ? bfhi(wa) : bflo(wa), xb = (e & 1) ? bfhi(wb) : bflo(wb), xc = (e & 1) ? bfhi(wc_) : bflo(wc_);
          const float y = xa * cw[cc + e] + xb * cw[1536 + cc + e] + xc * cw[3072 + cc + e];
          val[e] = siluf_(y); ss += val[e] * val[e];
        }
        if (mtx < 2) { ss += __shfl_xor(ss, 1); ss += __shfl_xor(ss, 2); ss += __shfl_xor(ss, 4); const float sc = rsqrtf(ss + 1e-6f) * (mtx == 0 ? 0.08838834764831845f : 1.0f);
#pragma unroll
          for (int e = 0; e < 16; ++e) val[e] *= sc; }
        u32x4 w0, w1; w0.x = cvt_pk_bf16(val[0], val[1]); w0.y = cvt_pk_bf16(val[2], val[3]); w0.z = cvt_pk_bf16(val[4], val[5]); w0.w = cvt_pk_bf16(val[6], val[7]);
        w1.x = cvt_pk_bf16(val[8], val[9]); w1.y = cvt_pk_bf16(val[10], val[11]); w1.z = cvt_pk_bf16(val[12], val[13]); w1.w = cvt_pk_bf16(val[14], val[15]);
        if (mtx == 0) { bf16_t* o = QN + (size_t)r * 512 + h * 128 + c0; *(u32x4*)o = w0; *(u32x4*)(o + 8) = w1; }
        else if (mtx == 1) { bf16_t* o = KN + (size_t)r * 512 + h * 128 + c0; *(u32x4*)o = w0; *(u32x4*)(o + 8) = w1;
          ldsst<u32x4>(L, KSB + row * 272 + c0 * 2, w0); ldsst<u32x4>(L, KSB + row * 272 + c0 * 2 + 16, w1);
#pragma unroll
          for (int e = 0; e < 16; ++e) { const unsigned wv = e < 8 ? w0[e >> 1] : w1[(e - 8) >> 1]; ldsst<bf16_t>(L, KTL + (c0 + e) * 144 + row * 2, (bf16_t)((e & 1) ? (wv >> 16) : (wv & 0xffffu))); } }
        else {
#pragma unroll
          for (int e = 0; e < 16; ++e) { const unsigned wv = e < 8 ? w0[e >> 1] : w1[(e - 8) >> 1]; ldsst<bf16_t>(L, VTL + (c0 + e) * 144 + row * 2, (bf16_t)((e & 1) ? (wv >> 16) : (wv & 0xffffu))); } }
      }
    }
    if (wid < 2) {
      const int d = wid, r = R0 + lane;
      const float braw = AB[(size_t)r * 16 + d * 4 + h], araw = AB[(size_t)r * 16 + 8 + d * 4 + h];
      const float beta = sigmoidf_(braw);
      const float xs = araw + p.dt_bias[(l * 2 + d) * 4 + h];
      const float sp = fmaxf(xs, 0.f) + log1pf(__expf(-fabsf(xs)));
      const float g = -__expf(p.a_log[(l * 2 + d) * 4 + h]) * sp;
      float pre = g;
#pragma unroll
      for (int o = 1; o < 64; o <<= 1) { const float t2 = __shfl_up(pre, o); if (lane >= o) pre += t2; }
      const float tot = __shfl(pre, 63);
      const float gc = d == 0 ? pre : (tot - pre + g);
      ldsst<float>(L, GCL + (d * 64 + lane) * 4, gc); ldsst<float>(L, BTL + (d * 64 + lane) * 4, beta);
      GC[((size_t)item * 2 + d) * 64 + lane] = gc;
    }
    __syncthreads();
    { const int ti = wid >> 1;
#pragma unroll
      for (int q = 0; q < 2; ++q) { const int tj = 2 * (wid & 1) + q; f32x4 a = {0.f, 0.f, 0.f, 0.f};
#pragma unroll
        for (int kk = 0; kk < 4; ++kk) a = mma(ldsld<bf16x8>(L, KSB + (16 * tj + fr) * 272 + kk * 64 + fq * 16), ldsld<bf16x8>(L, KSB + (16 * ti + fr) * 272 + kk * 64 + fq * 16), a);
        ldsst<f32x4>(L, GL + ((16 * ti + fr) * 68 + 16 * tj + 4 * fq) * 4, a); }
    }
    {
#pragma unroll
      for (int it = 0; it < 2; ++it) { const int v = tid + 512 * it, c = v >> 3, sg = (v & 7) * 8;
        *(u32x4*)(KNT + (size_t)item * 8192 + c * 64 + sg) = ldsld<u32x4>(L, KTL + c * 144 + sg * 2);
        *(u32x4*)(VNT + (size_t)item * 8192 + c * 64 + sg) = ldsld<u32x4>(L, VTL + c * 144 + sg * 2); } }
    __syncthreads();
    { const int d = tid >> 8, a = (tid & 255) >> 2, jq = tid & 3;
      const int pi_ = d ? 63 - a : a; const float bi = ldsld<float>(L, BTL + (d * 64 + pi_) * 4), gi = ldsld<float>(L, GCL + (d * 64 + pi_) * 4);
#pragma unroll
      for (int e = 0; e < 16; ++e) { const int bb = jq * 16 + e, pr = d ? 63 - bb : bb;
        float v = 0.f;
        if (a > bb) v = bi * ldsld<float>(L, GL + (pi_ * 68 + pr) * 4) * __expf(gi - ldsld<float>(L, GCL + (d * 64 + pr) * 4));
        ldsst<float>(L, AL + ((d * 64 + a) * 64 + bb) * 4, v); } }
    __syncthreads();
    if (wid < 2) {
      const int d = wid, c = lane; constexpr int XL = 0;
#pragma unroll 1
      for (int bi = 0; bi < 4; ++bi) {
        float sv[16];
#pragma unroll
        for (int ii = 0; ii < 16; ++ii) sv[ii] = (16 * bi + ii == c) ? 1.f : 0.f;
#pragma unroll 1
        for (int j = 0; j < 16 * bi; j += 4) {
          float xj[4];
#pragma unroll
          for (int e = 0; e < 4; ++e) xj[e] = ldsld<float>(L, XL + ((d * 64 + j + e) * 64 + c) * 4);
#pragma unroll
          for (int ii = 0; ii < 16; ++ii) { const f32x4 av = ldsld<f32x4>(L, AL + ((d * 64 + 16 * bi + ii) * 64 + j) * 4); sv[ii] -= av[0] * xj[0] + av[1] * xj[1] + av[2] * xj[2] + av[3] * xj[3]; }
        }
        float xb[16];
#pragma unroll
        for (int ii = 0; ii < 16; ++ii) {
          float t = sv[ii];
#pragma unroll
          for (int j4 = 0; j4 < (ii + 3) / 4; ++j4) { const f32x4 av = ldsld<f32x4>(L, AL + ((d * 64 + 16 * bi + ii) * 64 + 16 * bi + j4 * 4) * 4);
#pragma unroll
            for (int e = 0; e < 4; ++e) if (j4 * 4 + e < ii) t -= av[e] * xb[j4 * 4 + e]; }
          xb[ii] = t;
          ldsst<float>(L, XL + ((d * 64 + 16 * bi + ii) * 64 + c) * 4, t);
        }
      }
      const int pr = d ? 63 - c : c; const float bc = ldsld<float>(L, BTL + (d * 64 + pr) * 4), fw = bc * __expf(ldsld<float>(L, GCL + (d * 64 + pr) * 4));
#pragma unroll 4
      for (int i = 0; i < 64; ++i) { const int pp = d ? 63 - i : i; const float xi = ldsld<float>(L, XL + ((d * 64 + i) * 64 + c) * 4);
        ldsst<bf16_t>(L, TOL + ((d * 2 + 0) * 64 + pp) * 144 + pr * 2, (bf16_t)(cvt_pk_bf16(xi * fw, 0.f) & 0xffffu));
        ldsst<bf16_t>(L, TOL + ((d * 2 + 1) * 64 + pp) * 144 + pr * 2, (bf16_t)(cvt_pk_bf16(xi * bc, 0.f) & 0xffffu)); }
    }
    __syncthreads();
#pragma unroll
    for (int it = 0; it < 4; ++it) { const int v = tid + 512 * it, mtx = v >> 9, row = (v >> 3) & 63, sg = (v & 7) * 8;
      *(u32x4*)(TT + ((size_t)item * 4 + mtx) * 4096 + row * 64 + sg) = ldsld<u32x4>(L, TOL + (mtx * 64 + row) * 144 + sg * 2); }
    __syncthreads();
  }
}

__device__ __forceinline__ void fourier_prep(const Params& p, ldsp L) {
  const int tid = otid(), lane = tid & 63, wid = tid >> 6, fr = lane & 15, fq = lane >> 4;
  constexpr int UA = 0, UB = 33792, DC = 67584;
  const bf16_t* FI = (const bf16_t*)(lws(p.ws) + O_FI); bf16_t* FBT = (bf16_t*)(lws(p.ws) + O_FBT); float* UCS = (float*)(lws(p.ws) + O_UCS);
  for (int idx = tid; idx < 128 * 64; idx += NTHR) { const int rr = idx >> 6, c = idx & 63, m = rr & 63; const float a = (float)((m * c) & 63) * (1.0f / 32.0f);
    const float v = (rr < 64 ? cospif(a) : sinpif(a)) * 0.125f; ldsst<bf16_t>(L, DC + rr * 144 + c * 2, (bf16_t)(cvt_pk_bf16(v, 0.f) & 0xffffu)); }
  __syncthreads();
  for (int item = blockIdx.x; item < 288; item += gridDim.x) {
    const bool lat = item < 256; const int b = lat ? item >> 5 : 0, jb = item & 31;
#pragma unroll
    for (int it = 0; it < 4; ++it) { const int v = tid + 512 * it, row = v >> 5, sg = (v & 31) * 8;
      int ra, rb;
      if (lat) { const int t = 64 * jb + row; ra = b * 4096 + t; rb = b * 4096 + (t == 0 ? 2048 : 4096 - t); } else { ra = RLAT + (item - 256) * 64 + row; rb = ra; }
      ldsst<u32x4>(L, UA + row * 528 + sg * 2, *(const u32x4*)(FI + (size_t)ra * 256 + sg));
      ldsst<u32x4>(L, UB + row * 528 + sg * 2, *(const u32x4*)(FI + (size_t)rb * 256 + sg)); }
    __syncthreads();
    for (int q = 0; q < 8; ++q) {
      const int combo = wid * 8 + q, g = combo >> 4, ti = (combo >> 2) & 3, tm = combo & 3;
      f32x4 ac = {0.f, 0.f, 0.f, 0.f}, as = ac, bc = ac, bs = ac;
#pragma unroll
      for (int kk = 0; kk < 2; ++kk) {
        const bf16x8 xa = ldsld<bf16x8>(L, UA + (16 * ti + fr) * 528 + (g * 64 + kk * 32 + fq * 8) * 2), xb = ldsld<bf16x8>(L, UB + (16 * ti + fr) * 528 + (g * 64 + kk * 32 + fq * 8) * 2);
        const bf16x8 yc = ldsld<bf16x8>(L, DC + (16 * tm + fr) * 144 + kk * 64 + fq * 16), ys = ldsld<bf16x8>(L, DC + (64 + 16 * tm + fr) * 144 + kk * 64 + fq * 16);
        ac = mma(xa, yc, ac); as = mma(xa, ys, as); bc = mma(xb, yc, bc); bs = mma(xb, ys, bs);
      }
      const int mp = g * 64 + 16 * tm + fr, i0 = 16 * ti + 4 * fq;
      if (lat) {
        f32x4 cv = ac + bc, sv = as - bs;
        if (jb == 0 && i0 == 0) { cv[0] = ac[0]; sv[0] = bc[0]; }
        bf16_t* o = FBT + ((size_t)b * 256 + mp) * 4096 + 64 * jb + i0;
        *(u32x2*)o = pack4(cv); *(u32x2*)(o + 2048) = pack4(sv);
      } else {
#pragma unroll
        for (int e = 0; e < 4; ++e) { float* o = UCS + (size_t)((item - 256) * 64 + i0 + e) * 512; o[mp] = ac[e]; o[256 + mp] = as[e]; }
      }
    }
    __syncthreads();
  }
}

__device__ __forceinline__ void ctx_fourier(const Params& p, ldsp L, int wg, int nwg) {
  const int tid = otid(); const float* UCS = (const float*)(lws(p.ws) + O_UCS); bf16_t* PPF = (bf16_t*)(lws(p.ws) + O_PPF);
  for (int idx = tid; idx < 256; idx += NTHR) { const float a = (float)idx * (1.0f / 128.0f); ldsst<float>(L, idx * 4, cospif(a) * (1.0f / 16.0f)); ldsst<float>(L, 1024 + idx * 4, sinpif(a) * (1.0f / 16.0f)); }
  __syncthreads();
  for (int o = wg * NTHR + tid; o < NB * 64 * 256; o += nwg * NTHR) {
    const int mp = o & 255, kq = (o >> 8) & 63, b = o >> 14; const float* u = UCS + (size_t)b * 256 * 512 + mp; float s4[4] = {0.f, 0.f, 0.f, 0.f};
#pragma unroll 8
    for (int t = 0; t < 256; ++t) { const float uc = u[(size_t)t * 512], us = u[(size_t)t * 512 + 256];
#pragma unroll
      for (int e = 0; e < 4; ++e) { const int r = ((4 * kq + e) * t) & 255; s4[e] += ldsld<float>(L, r * 4) * uc - ldsld<float>(L, 1024 + r * 4) * us; } }
#pragma unroll
    for (int e = 0; e < 4; ++e) PPF[(size_t)(RLAT + b * 256 + 4 * kq + e) * 512 + 256 + mp] = (bf16_t)(cvt_pk_bf16(s4[e], 0.f) & 0xffffu);
  }
  __syncthreads();
}
__device__ __forceinline__ void pool_phase(const Params& p, ldsp L, int wg, int nwg) {
  const int tid_ = otid(), lane = tid_ & 63, wv = tid_ >> 6, gw = wg * 8 + wv, nw = nwg * 8;
  const bf16_t* PI = (const bf16_t*)(lws(p.ws) + O_PI); bf16_t* PPF = (bf16_t*)(lws(p.ws) + O_PPF);
  const int LP = wv * 16640;
  for (int idx = gw; idx < 2048; idx += nw) {
    const int g = 3 - (idx >> 9), b = (idx >> 6) & 7, r = idx & 63;
    const int win = 2 << g, hw = win >> 1, sr = max(r - hw, 0), er = min(r - hw + win, 64);
    const bf16_t* base = PI + (size_t)b * 4096 * 256 + g * 64 + lane;
    ldsst<float>(L, LP + lane * 4, 0.f);
    { const int ci = lane >> 3, ch0 = (lane & 7) * 8;
      const bf16_t* bq = PI + (size_t)b * 4096 * 256 + g * 64 + ch0;
#pragma unroll 2
      for (int cb = 0; cb < 8; ++cb) {
        const int cc = cb * 8 + ci; float ac[8];
#pragma unroll
        for (int e = 0; e < 8; ++e) ac[e] = 0.f;
#pragma unroll 4
        for (int rr = sr; rr < er; ++rr) { const u32x4 v = *(const u32x4*)(bq + (size_t)(rr * 64 + cc) * 256);
#pragma unroll
          for (int e = 0; e < 4; ++e) { ac[2 * e] += bflo(v[e]); ac[2 * e + 1] += bfhi(v[e]); } }
        ldsst<f32x4>(L, LP + ((cc + 1) * 64 + ch0) * 4, (f32x4){ac[0], ac[1], ac[2], ac[3]}); ldsst<f32x4>(L, LP + ((cc + 1) * 64 + ch0 + 4) * 4, (f32x4){ac[4], ac[5], ac[6], ac[7]});
      }
      float run = 0.f;
#pragma unroll 8
      for (int cc = 1; cc <= 64; ++cc) { run += ldsld<float>(L, LP + (cc * 64 + lane) * 4); ldsst<float>(L, LP + (cc * 64 + lane) * 4, run); }
    }
    const float rinv = 1.0f / (float)(er - sr);
#pragma unroll 4
    for (int c = 0; c < 64; ++c) {
      const int sc = max(c - hw, 0), ec = min(c - hw + win, 64);
      const float box = ldsld<float>(L, LP + (ec * 64 + lane) * 4) - ldsld<float>(L, LP + (sc * 64 + lane) * 4);
      const size_t rowi = (size_t)b * 4096 + r * 64 + c;
      const float self = __uint_as_float((unsigned)PI[rowi * 256 + g * 64 + lane] << 16);
      PPF[rowi * 512 + g * 64 + lane] = (bf16_t)(cvt_pk_bf16(box * rinv / (float)(ec - sc) - self, 0.f) & 0xffffu);
    }
  }
  for (int r = RLAT + gw; r < ROWS; r += nw) {
    const int base = r & ~255, t = r - base;
#pragma unroll
    for (int g = 0; g < 4; ++g) {
      const int win = 2 << g, hw = win >> 1, sc = max(t - hw, 0), ec = min(t - hw + win, 256);
      float s_ = 0.f;
      for (int c = sc; c < ec; ++c) s_ += __uint_as_float((unsigned)PI[(size_t)(base + c) * 256 + g * 64 + lane] << 16);
      const float self = __uint_as_float((unsigned)PI[(size_t)r * 256 + g * 64 + lane] << 16);
      PPF[(size_t)r * 512 + g * 64 + lane] = (bf16_t)(cvt_pk_bf16(s_ / (float)(ec - sc) - self, 0.f) & 0xffffu);
    }
  }
}

__device__ __forceinline__ void scan_phase(const Params& p, ldsp L, int item) {
  const int tid = otid(), lane = tid & 63, wid = tid >> 6, fr = lane & 15, fq = lane >> 4;
  const int es = item & 1, d = (item >> 1) & 1, h = (item >> 2) & 3, b = item >> 4;
  const int ti = wid >> 1, half = wid & 1;
  constexpr int QS = 0, KS = 17408, KTS = 34816, VTS = 53248, TW = 62464, TU = 71680, AT = 80896, WL = 90112, VNT_ = 107520, VNS = 116736, STL = 125952, GCL = 143360;
  const bf16_t* QN = (const bf16_t*)(lws(p.ws) + O_QN); const bf16_t* KN = (const bf16_t*)(lws(p.ws) + O_KN); const bf16_t* KNT = (const bf16_t*)(lws(p.ws) + O_KNT); const bf16_t* VNT = (const bf16_t*)(lws(p.ws) + O_VNT);
  const bf16_t* TT = (const bf16_t*)(lws(p.ws) + O_TT); const float* GC = (const float*)(lws(p.ws) + O_GC); bf16_t* O = (bf16_t*)(lws(p.ws) + O_O) + (size_t)d * ROWS * 512;
  { unsigned zz_; asm volatile("v_mov_b32 %0, 0" : "=v"(zz_)); for (int o = tid * 16; o < 17408; o += NTHR * 16) ldsst<u32x4>(L, STL + o, (u32x4){zz_, zz_, zz_, zz_}); }
  f32x4 accS[4];
#pragma unroll
  for (int q = 0; q < 4; ++q) accS[q] = (f32x4){0.f, 0.f, 0.f, 0.f};
  u32x4 rq[2], rk[2], rkt[2], rvt, rtw, rtu; float rgc = 0.f;
#define SCAN_CHUNK(s) ((s) < 4 ? (NB * 64 + b * 4 + (d ? 3 - (s) : (s))) : (b * 64 + (d ? 67 - (s) : (s) - 4)))
#define SCAN_GLOAD(s) do { const int n_ = SCAN_CHUNK(s), it2_ = n_ * 4 + h; \
    _Pragma("unroll") for (int it = 0; it < 2; ++it) { const int v = tid + 512 * it; \
      rq[it] = *(const u32x4*)(QN + (size_t)(64 * n_ + (v >> 4)) * 512 + h * 128 + (v & 15) * 8); rk[it] = *(const u32x4*)(KN + (size_t)(64 * n_ + (v >> 4)) * 512 + h * 128 + (v & 15) * 8); \
      rkt[it] = *(const u32x4*)(KNT + (size_t)it2_ * 8192 + (v >> 3) * 64 + (v & 7) * 8); } \
    rvt = *(const u32x4*)(VNT + (size_t)it2_ * 8192 + (es * 64 + (tid >> 3)) * 64 + (tid & 7) * 8); \
    rtw = *(const u32x4*)(TT + ((size_t)it2_ * 4 + d * 2 + 0) * 4096 + (tid >> 3) * 64 + (tid & 7) * 8); rtu = *(const u32x4*)(TT + ((size_t)it2_ * 4 + d * 2 + 1) * 4096 + (tid >> 3) * 64 + (tid & 7) * 8); \
    if (tid < 64) rgc = GC[((size_t)it2_ * 2 + d) * 64 + tid]; } while (0)
#define SCAN_LSTORE() do { \
    _Pragma("unroll") for (int it = 0; it < 2; ++it) { const int v = tid + 512 * it; \
      ldsst<u32x4>(L, QS + (v >> 4) * 272 + (v & 15) * 16, rq[it]); ldsst<u32x4>(L, KS + (v >> 4) * 272 + (v & 15) * 16, rk[it]); ldsst<u32x4>(L, KTS + (v >> 3) * 144 + (v & 7) * 16, rkt[it]); } \
    ldsst<u32x4>(L, VTS + (tid >> 3) * 144 + (tid & 7) * 16, rvt); ldsst<u32x4>(L, TW + (tid >> 3) * 144 + (tid & 7) * 16, rtw); ldsst<u32x4>(L, TU + (tid >> 3) * 144 + (tid & 7) * 16, rtu); \
    if (tid < 64) ldsst<float>(L, GCL + tid * 4, rgc); } while (0)
  SCAN_GLOAD(0); SCAN_LSTORE(); __syncthreads();
  for (int s = 0; s < 68; ++s) {
    const int n = SCAN_CHUNK(s);
    if (s + 1 < 68) SCAN_GLOAD(s + 1);
    const float gtot = ldsld<float>(L, GCL + (d ? 0 : 63) * 4);
    f32x4 uacc[2], qacc[2];
    {
      bf16x8 qf[4], kf[2][4], twf[2], tuf[2], vtf[2][2], ktf[4][2], sf[2][4];
#pragma unroll
      for (int kk = 0; kk < 4; ++kk) qf[kk] = ldsld<bf16x8>(L, QS + (16 * ti + fr) * 272 + kk * 64 + fq * 16);
#pragma unroll
      for (int q = 0; q < 2; ++q)
#pragma unroll
        for (int kk = 0; kk < 4; ++kk) { kf[q][kk] = ldsld<bf16x8>(L, KS + (16 * (2 * half + q) + fr) * 272 + kk * 64 + fq * 16); sf[q][kk] = ldsld<bf16x8>(L, STL + (16 * (2 * half + q) + fr) * 272 + kk * 64 + fq * 16); }
      f32x4 at[2], wv[4];
#pragma unroll
      for (int q = 0; q < 2; ++q) { at[q] = (f32x4){0.f, 0.f, 0.f, 0.f}; qacc[q] = at[q]; uacc[q] = at[q]; }
#pragma unroll
      for (int q = 0; q < 4; ++q) wv[q] = (f32x4){0.f, 0.f, 0.f, 0.f};
#pragma unroll
      for (int kk = 0; kk < 4; ++kk)
#pragma unroll
        for (int q = 0; q < 2; ++q) { at[q] = mma(kf[q][kk], qf[kk], at[q]); qacc[q] = mma(sf[q][kk], qf[kk], qacc[q]); }
      __builtin_amdgcn_sched_barrier(0);
#pragma unroll
      for (int kk = 0; kk < 2; ++kk) { twf[kk] = ldsld<bf16x8>(L, TW + (16 * ti + fr) * 144 + kk * 64 + fq * 16); tuf[kk] = ldsld<bf16x8>(L, TU + (16 * ti + fr) * 144 + kk * 64 + fq * 16); }
#pragma unroll
      for (int q = 0; q < 4; ++q)
#pragma unroll
        for (int kk = 0; kk < 2; ++kk) ktf[q][kk] = ldsld<bf16x8>(L, KTS + (16 * (4 * half + q) + fr) * 144 + kk * 64 + fq * 16);
#pragma unroll
      for (int q = 0; q < 2; ++q)
#pragma unroll
        for (int kk = 0; kk < 2; ++kk) vtf[q][kk] = ldsld<bf16x8>(L, VTS + (16 * (2 * half + q) + fr) * 144 + kk * 64 + fq * 16);
#pragma unroll
      for (int kk = 0; kk < 2; ++kk) {
#pragma unroll
        for (int q = 0; q < 4; ++q) wv[q] = mma(ktf[q][kk], twf[kk], wv[q]);
#pragma unroll
        for (int q = 0; q < 2; ++q) uacc[q] = mma(tuf[kk], vtf[q][kk], uacc[q]);
      }
      const int i = 16 * ti + fr; const float gi = ldsld<float>(L, GCL + i * 4);
#pragma unroll
      for (int q = 0; q < 2; ++q) {
        const int j0 = 16 * (2 * half + q) + 4 * fq; f32x4 a = at[q];
#pragma unroll
        for (int e = 0; e < 4; ++e) { const int j = j0 + e; const bool keep = d ? (i <= j) : (i >= j); const float ar = keep ? gi - ldsld<float>(L, GCL + j * 4) : 0.f; a[e] = keep ? a[e] * __expf(ar) : 0.f; }
        ldsst<u32x2>(L, AT + i * 144 + j0 * 2, pack4(a));
      }
#pragma unroll
      for (int q = 0; q < 4; ++q) ldsst<u32x2>(L, WL + (16 * ti + fr) * 272 + (16 * (4 * half + q) + 4 * fq) * 2, pack4(wv[q]));
    }
    __syncthreads();
    {
      bf16x8 wf[4], sf[2][4];
#pragma unroll
      for (int kk = 0; kk < 4; ++kk) { wf[kk] = ldsld<bf16x8>(L, WL + (16 * ti + fr) * 272 + kk * 64 + fq * 16);
#pragma unroll
        for (int q = 0; q < 2; ++q) sf[q][kk] = ldsld<bf16x8>(L, STL + (16 * (2 * half + q) + fr) * 272 + kk * 64 + fq * 16); }
      f32x4 a[2];
#pragma unroll
      for (int q = 0; q < 2; ++q) a[q] = (f32x4){0.f, 0.f, 0.f, 0.f};
#pragma unroll
      for (int kk = 0; kk < 4; ++kk)
#pragma unroll
        for (int q = 0; q < 2; ++q) a[q] = mma(wf[kk], sf[q][kk], a[q]);
      const int i0 = 16 * ti + 4 * fq; float sc4[4];
#pragma unroll
      for (int e = 0; e < 4; ++e) sc4[e] = __expf(gtot - ldsld<float>(L, GCL + (i0 + e) * 4));
#pragma unroll
      for (int q = 0; q < 2; ++q) {
        const int te = 2 * half + q; const f32x4 vn = uacc[q] - a[q]; f32x4 vs;
#pragma unroll
        for (int e = 0; e < 4; ++e) vs[e] = vn[e] * sc4[e];
        ldsst<u32x2>(L, VNT_ + (16 * te + fr) * 144 + i0 * 2, pack4(vn)); ldsst<u32x2>(L, VNS + (16 * te + fr) * 144 + i0 * 2, pack4(vs));
      }
    }
    __syncthreads();
    {
      bf16x8 af[2], vf[2][2], nsf[2], ktf[4][2];
#pragma unroll
      for (int q = 0; q < 4; ++q)
#pragma unroll
        for (int kk = 0; kk < 2; ++kk) ktf[q][kk] = ldsld<bf16x8>(L, KTS + (16 * (4 * half + q) + fr) * 144 + kk * 64 + fq * 16);
#pragma unroll
      for (int kk = 0; kk < 2; ++kk) { af[kk] = ldsld<bf16x8>(L, AT + (16 * ti + fr) * 144 + kk * 64 + fq * 16); nsf[kk] = ldsld<bf16x8>(L, VNS + (16 * ti + fr) * 144 + kk * 64 + fq * 16);
#pragma unroll
        for (int q = 0; q < 2; ++q) vf[q][kk] = ldsld<bf16x8>(L, VNT_ + (16 * (2 * half + q) + fr) * 144 + kk * 64 + fq * 16); }
      const float cd = __expf(gtot);
      f32x4 ov[2];
#pragma unroll
      for (int q = 0; q < 2; ++q) ov[q] = (f32x4){0.f, 0.f, 0.f, 0.f};
#pragma unroll
      for (int q = 0; q < 4; ++q) accS[q] = accS[q] * cd;
#pragma unroll
      for (int kk = 0; kk < 2; ++kk) {
#pragma unroll
        for (int q = 0; q < 2; ++q) ov[q] = mma(vf[q][kk], af[kk], ov[q]);
#pragma unroll
        for (int q = 0; q < 4; ++q) accS[q] = mma(ktf[q][kk], nsf[kk], accS[q]);
      }
      const int i = 16 * ti + fr; const float eg = __expf(ldsld<float>(L, GCL + i * 4));
#pragma unroll
      for (int q = 0; q < 2; ++q) { const f32x4 o4 = qacc[q] * eg + ov[q];
        *(u32x2*)(O + (size_t)(64 * n + i) * 512 + h * 128 + es * 64 + 16 * (2 * half + q) + 4 * fq) = pack4(o4); }
    }
    __syncthreads();
#pragma unroll
    for (int q = 0; q < 4; ++q) ldsst<u32x2>(L, STL + (16 * ti + fr) * 272 + (16 * (4 * half + q) + 4 * fq) * 2, pack4(accS[q]));
    if (s + 1 < 68) SCAN_LSTORE();
    __syncthreads();
  }
#undef SCAN_CHUNK
#undef SCAN_GLOAD
#undef SCAN_LSTORE
}

__device__ __forceinline__ void ofprep_phase(const Params& p, int l) {
  const int tid_ = otid(), lane = tid_ & 63, gw = blockIdx.x * 8 + (tid_ >> 6), nw = gridDim.x * 8;
  const bf16_t* O0 = (const bf16_t*)(lws(p.ws) + O_O); const bf16_t* O1 = O0 + (size_t)ROWS * 512; const bf16_t* Z = (const bf16_t*)(lws(p.ws) + O_Z); bf16_t* OF = (bf16_t*)(lws(p.ws) + O_OF);
  const float* og = p.o_gain + (size_t)l * 128 + (lane & 15) * 8;
  for (int r = gw; r < ROWS; r += nw) {
    const u32x4 a = *(const u32x4*)(O0 + (size_t)r * 512 + lane * 8), bq = *(const u32x4*)(O1 + (size_t)r * 512 + lane * 8), zq = *(const u32x4*)(Z + (size_t)r * 512 + lane * 8);
    float o[8]; float ss = 0.f;
#pragma unroll
    for (int e = 0; e < 4; ++e) { o[2 * e] = bflo(a[e]) + bflo(bq[e]); o[2 * e + 1] = bfhi(a[e]) + bfhi(bq[e]); ss += o[2 * e] * o[2 * e] + o[2 * e + 1] * o[2 * e + 1]; }
    ss += __shfl_xor(ss, 1); ss += __shfl_xor(ss, 2); ss += __shfl_xor(ss, 4); ss += __shfl_xor(ss, 8);
    const float rstd = rsqrtf(ss * (1.0f / 128.0f) + 1e-6f);
    float y[8];
#pragma unroll
    for (int e = 0; e < 4; ++e) { y[2 * e] = o[2 * e] * rstd * og[2 * e] * siluf_(bflo(zq[e])); y[2 * e + 1] = o[2 * e + 1] * rstd * og[2 * e + 1] * siluf_(bfhi(zq[e])); }
    u32x4 w; w.x = cvt_pk_bf16(y[0], y[1]); w.y = cvt_pk_bf16(y[2], y[3]); w.z = cvt_pk_bf16(y[4], y[5]); w.w = cvt_pk_bf16(y[6], y[7]);
    *(u32x4*)(OF + (size_t)r * 512 + lane * 8) = w;
  }
}


#define XB_TMO      128
#define XB_XCNT(j)  (256  + 64 * (j))
#define XB_XSUB(j)  (1280 + 64 * (j))
#define XB_XGEN(j)  (2304 + 64 * (j))
#define XB_TOP      3328
#define XB_TOPGEN   3392
#define XCD_BAR_WORDS 3456
#define XB_SPIN_CAP (1u << 18)

__device__ __forceinline__ unsigned xb_ld(unsigned* p)              { return __hip_atomic_load(p, __ATOMIC_RELAXED, __HIP_MEMORY_SCOPE_AGENT); }
__device__ __forceinline__ unsigned xb_add(unsigned* p, unsigned v) { return __hip_atomic_fetch_add(p, v, __ATOMIC_RELAXED, __HIP_MEMORY_SCOPE_AGENT); }
__device__ __forceinline__ unsigned xb_xcc_id() { return (unsigned)__builtin_amdgcn_s_getreg((3 << 11) | 20) & 0xFu; }
#define XB_SPIN(cond, bar) do { unsigned _sp = 0; while (cond) { __builtin_amdgcn_s_sleep(1); \
    if ((++_sp & 255u) == 0u) { if (xb_ld(&(bar)[XB_TMO])) break; if (_sp > XB_SPIN_CAP) { atomicAdd(&(bar)[XB_TMO], 1u); break; } } } } while (0)

struct XcdBarrier {
    unsigned* bar; unsigned x;
    volatile LAS unsigned* st;
};

__device__ __forceinline__ XcdBarrier xcd_barrier_post(unsigned* bar, volatile LAS unsigned* st) {
    XcdBarrier b; b.bar = bar; b.x = xb_xcc_id(); b.st = st;
    if (threadIdx.x == 0) (void)xb_add(&bar[XB_XCNT(b.x)], 1u);
    return b;
}
__device__ __forceinline__ void xcd_barrier_complete(unsigned* bar, unsigned x, unsigned& nloc, unsigned& nx) {
    const unsigned G = gridDim.x * gridDim.y * gridDim.z;
    unsigned sum, cnt, mine, sp = 0u;
    for (;;) {
        sum = 0u; cnt = 0u; mine = 0u;
#pragma unroll
        for (unsigned j = 0; j < 16; ++j) { const unsigned c = xb_ld(&bar[XB_XCNT(j)]); sum += c; cnt += (c > 0u) ? 1u : 0u; mine = (j == x) ? c : mine; }
        if (sum == G) break;
        __builtin_amdgcn_s_sleep(1);
        if ((++sp & 255u) == 0u) { if (xb_ld(&bar[XB_TMO])) break; if (sp > XB_SPIN_CAP) { atomicAdd(&bar[XB_TMO], 1u); break; } }
    }
    nloc = mine > 0u ? mine : 1u; nx = cnt > 0u ? cnt : 1u;
}

__device__ __forceinline__ void xcd_barrier(const XcdBarrier& b) {
    asm volatile("s_waitcnt vmcnt(0)" ::: "memory");
    __syncthreads();
    if (threadIdx.x == 0) {
        unsigned* bar = b.bar;
        __builtin_amdgcn_s_waitcnt(0);
        unsigned nloc = b.st[0], nx = b.st[1];
        if (nloc == 0u) { xcd_barrier_complete(bar, b.x, nloc, nx); b.st[0] = nloc; b.st[1] = nx; }
        const unsigned old = xb_add(&bar[XB_XSUB(b.x)], 1u);
        const unsigned gen = old / nloc;
        if (old + 1u == (gen + 1u) * nloc) {
            __builtin_amdgcn_fence(__ATOMIC_RELEASE, "agent");
            asm volatile("s_waitcnt vmcnt(0)" ::: "memory");
            const unsigned og = xb_add(&bar[XB_TOP], 1u);
            const unsigned tg = og / nx;
            if (og + 1u == (tg + 1u) * nx) xb_add(&bar[XB_TOPGEN], 1u);
            else XB_SPIN(xb_ld(&bar[XB_TOPGEN]) == tg, bar);
            __builtin_amdgcn_fence(__ATOMIC_ACQUIRE, "agent");
            xb_add(&bar[XB_XGEN(b.x)], 1u);
            asm volatile("s_waitcnt vmcnt(0)" ::: "memory");
        } else {
            XB_SPIN(xb_ld(&bar[XB_XGEN(b.x)]) == gen, bar);
            __builtin_amdgcn_fence(__ATOMIC_ACQUIRE, "agent");
            asm volatile("s_waitcnt vmcnt(0)" ::: "memory");
        }
    }
    __syncthreads();
}


__device__ __forceinline__ float rdb(const bf16_t* s_, size_t n, size_t i) { float a = 0.f; for (size_t j = i; j < n; j += (size_t)RLAT * DM) a += __uint_as_float((unsigned)s_[j] << 16); return a; }
__device__ __forceinline__ float rdf(const float* s_, size_t n, size_t i) { float a = 0.f; for (size_t j = i; j < n; j += (size_t)RLAT * DM) a += s_[j]; return a; }
__device__ __forceinline__ void dump_phase(const Params& p, int which) {
  const size_t NO = (size_t)RLAT * DM; unsigned char* ws = lws(p.ws);
  for (size_t i = (size_t)blockIdx.x * NTHR + otid(); i < NO; i += (size_t)gridDim.x * NTHR) {
    float a = 0.f;
    if (which == 1) { a = rdb((const bf16_t*)(ws + O_QKV), (size_t)ROWS * 1536, i) + rdb((const bf16_t*)(ws + O_Z), (size_t)ROWS * 512, i) + rdb((const bf16_t*)(ws + O_PI), (size_t)ROWS * 256, i) + rdb((const bf16_t*)(ws + O_FI), (size_t)ROWS * 256, i) + rdf((const float*)(ws + O_AB), (size_t)ROWS * 16, i); }
    if (which == 2) { a = rdb((const bf16_t*)(ws + O_QN), (size_t)ROWS * 512, i) + rdb((const bf16_t*)(ws + O_KN), (size_t)ROWS * 512, i) + rdb((const bf16_t*)(ws + O_KNT), (size_t)ROWS * 512, i) + rdb((const bf16_t*)(ws + O_VNT), (size_t)ROWS * 512, i) + rdb((const bf16_t*)(ws + O_TT), (size_t)ROWS * 1024, i) + rdf((const float*)(ws + O_GC), (size_t)NCH * 4 * 2 * 64, i)
          + rdb((const bf16_t*)(ws + O_FBT), (size_t)NB * 256 * 4096, i) + rdf((const float*)(ws + O_UCS), (size_t)NB * CTX * 512, i); }
    if (which == 3) { a = rdb((const bf16_t*)(ws + O_O), (size_t)ROWS * 1024, i); }
    if (which == 4) { a = rdb((const bf16_t*)(ws + O_OF), (size_t)ROWS * 512, i) + rdb((const bf16_t*)(ws + O_HN), (size_t)ROWS * 1024, i); }
    if (which == 5) { a = rdb((const bf16_t*)(ws + O_MRG), (size_t)ROWS * 1024, i); }
    if ((__float_as_uint(a) & 0xffff0000u) == 0xaaaa0000u) a = 1234.5f;
    if (!(a == a) || fabsf(a) > 1e30f) a = 777.0f;
    a = a * 0.5f + 0.12345678f;
    p.out[i] = a;
  }
}
__global__ void __launch_bounds__(NTHR) fwd_megakernel(Params p) {
  ldsp L = (ldsp)g_shm;
  cg::grid_group grid = cg::this_grid();
  volatile LAS unsigned* xst = (volatile LAS unsigned*)(L + LDS_BYTES - 16);
  if (threadIdx.x < 4) xst[threadIdx.x] = 0u;
  if (threadIdx.x == 0) { const unsigned long long wa_ = (unsigned long long)p.ws; *(volatile LAS unsigned*)(L + LDS_BYTES - 32) = (unsigned)wa_; *(volatile LAS unsigned*)(L + LDS_BYTES - 28) = (unsigned)(wa_ >> 32); }
  __syncthreads();
  XcdBarrier xbar = xcd_barrier_post((unsigned*)(p.ws + O_BAR), xst);
#define GSYNC0() do { asm volatile("s_waitcnt vmcnt(0) lgkmcnt(0)" ::: "memory"); __builtin_amdgcn_fence(__ATOMIC_RELEASE, "agent"); grid.sync(); __builtin_amdgcn_fence(__ATOMIC_ACQUIRE, "agent"); } while (0)
#define GSYNC() xcd_barrier(xbar)
  const int G = gridDim.x, c = blockIdx.x;
#define X ((float*)(lws(p.ws) + O_X))
#define MOD ((const float*)(lws(p.ws) + O_MOD))
#define Hn ((bf16_t*)(lws(p.ws) + O_HN))
#ifndef NO_P0
  phase0(p, L);
#endif
  GSYNC0();
  for (int l = 0; l < DEPTH; ++l) {
    const float* modl = MOD + (size_t)l * 9 * 9216; const float* ng = p.norm_gain + (size_t)l * 3 * 1024; const int notlast = (l != DEPTH - 1) ? 1 : 0, nMx = notlast ? ROWS / 256 : RLAT / 256;
#ifndef PROBE_CONV
#define PROBE_CONV 1
#endif
    for (int rep_ = 0; rep_ < PROBE_CONV; ++rep_) {
    convert_ffn(p, p.w1gu + (size_t)l * 1024 * 2 * DFF, p.w1d + (size_t)l * DFF * 1024, L);
    convert_mixer(p, l, L);
    }
    norm_phase(X, Hn, ng, modl, 0, 1, l > 0 ? (const float*)(lws(p.ws) + O_TT) : nullptr);
    GSYNC();
#ifndef PROBE_UP
#define PROBE_UP 1
#endif
    for (int rep_ = 0; rep_ < PROBE_UP; ++rep_)
    { pg8::PlainSched S{(const char*)Hn, (const char*)(lws(p.ws) + O_WGU), 2048, 2048, 16, ROWS / 256, 22, G, c}; EpiUp E{(bf16_t*)(lws(p.ws) + O_ACT)}; pg8::gemm_phase(L, S, E); }
    GSYNC();
    { pg8::ResSched S{(const char*)(lws(p.ws) + O_ACT), (const char*)(lws(p.ws) + O_WD), DFF * 2, DFF / 64, G, c, 0}; EpiResT<false> E{(float*)(p.ws + O_X), modl, 2, 0.5f}; pg8::gemm_phase(L, S, E); }
    if (1) { pg8::ResSched S{(const char*)(lws(p.ws) + O_ACT), (const char*)(lws(p.ws) + O_WD), DFF * 2, DFF / 64, G, c, 1}; EpiPart E{(float*)(lws(p.ws) + O_TT), modl, 2, 0.5f}; pg8::gemm_phase(L, S, E); }
    GSYNC();
#ifndef NO_MIXER
    norm_phase(X, Hn, ng + 1024, modl, 3, 4, (const float*)(lws(p.ws) + O_TT));
    GSYNC();
#ifndef PROBE_IN
#define PROBE_IN 1
#endif
    for (int rep_ = 0; rep_ < PROBE_IN; ++rep_)
    { pg8::PlainSched S{(const char*)Hn, (const char*)(lws(p.ws) + O_WIN), 2048, 2048, 16, ROWS / 256, NINP / 256, G, c};
      EpiIn E{(bf16_t*)(lws(p.ws) + O_QKV), (bf16_t*)(lws(p.ws) + O_Z), (bf16_t*)(lws(p.ws) + O_PI), (bf16_t*)(lws(p.ws) + O_FI), (float*)(lws(p.ws) + O_AB)}; pg8::gemm_phase(L, S, E); }
    GSYNC();
#ifndef PROBE_PREP
#define PROBE_PREP 1
#endif
    for (int rep_ = 0; rep_ < PROBE_PREP; ++rep_) {
    prep_phase(p, l, L);
    }
#ifndef NO_FPREP
    fourier_prep(p, L);
#endif
    GSYNC();
#if defined(DUMP) && DUMP == 2
    dump_phase(p, 2); return;
#endif
#ifndef PROBE_SCAN
#define PROBE_SCAN 1
#endif
#ifndef PROBE_OTHER
#define PROBE_OTHER 1
#endif
    for (int rep_ = 0; rep_ < PROBE_SCAN; ++rep_) {
#ifndef NO_SCAN
    if (c < 128) scan_phase(p, L, c);
#else
    if (c < 128) {}
#endif
    else for (int rep2_ = 0; rep2_ < PROBE_OTHER; ++rep2_) {
      __syncthreads();
      { FourSched S{(const char*)(lws(p.ws) + O_DFT), (const char*)(lws(p.ws) + O_FBT), c - 128}; EpiBf E{(bf16_t*)(lws(p.ws) + O_PPF) + 256, 512}; pg8::gemm_phase(L, S, E); }
      __syncthreads();
      ctx_fourier(p, L, c - 128, G - 128);
      pool_phase(p, L, c - 128, G - 128);
    }
    __syncthreads();
    }
    GSYNC();
#if defined(DUMP) && DUMP == 3
    dump_phase(p, 3); return;
#endif
#ifndef PROBE_OFP
#define PROBE_OFP 1
#endif
    for (int rep_ = 0; rep_ < PROBE_OFP; ++rep_) {
    ofprep_phase(p, l);
    norm_phase(X, Hn, ng + 1024, modl, 3, 4, nullptr);
    }
    GSYNC();
#if defined(DUMP) && DUMP == 4
    dump_phase(p, 4); return;
#endif
#ifndef PROBE_MRG
#define PROBE_MRG 1
#endif
    for (int rep_ = 0; rep_ < PROBE_MRG; ++rep_)
    { MergeSched S{(const char*)Hn, (const char*)(lws(p.ws) + O_OF), (const char*)(lws(p.ws) + O_PPF), (const char*)(lws(p.ws) + O_WG), (const char*)(lws(p.ws) + O_WCAT), G, c, nMx};
      EpiMerge E{(unsigned*)(lws(p.ws) + O_SCR) + (size_t)c * 2 * 32768, (bf16_t*)(lws(p.ws) + O_MRG)}; pg8::gemm_phase(L, S, E); }
    GSYNC();
#if defined(DUMP) && DUMP == 5
    dump_phase(p, 5); return;
#endif
    { pg8::ResSched S{(const char*)(lws(p.ws) + O_MRG), (const char*)(lws(p.ws) + O_WOUT), 2048, 16, G, c, 0}; EpiResT<false> E{(float*)(p.ws + O_X), modl, 5, 1.0f}; pg8::gemm_phase(L, S, E); }
    if (notlast) { pg8::ResSched S{(const char*)(lws(p.ws) + O_MRG), (const char*)(lws(p.ws) + O_WOUT), 2048, 16, G, c, 1}; EpiPart E{(float*)(lws(p.ws) + O_TT), modl, 5, 1.0f}; pg8::gemm_phase(L, S, E); }
    GSYNC();
#endif
    convert_ffn(p, p.w2gu + (size_t)l * 1024 * 2 * DFF, p.w2d + (size_t)l * DFF * 1024, L);
    norm_phase(X, Hn, ng + 2048, modl, 6, 7, notlast ? (const float*)(lws(p.ws) + O_TT) : nullptr);
    GSYNC();
    { pg8::PlainSched S{(const char*)Hn, (const char*)(lws(p.ws) + O_WGU), 2048, 2048, 16, nMx, 22, G, c}; EpiUp E{(bf16_t*)(lws(p.ws) + O_ACT)}; pg8::gemm_phase(L, S, E); }
    GSYNC();
    { pg8::ResSched S{(const char*)(lws(p.ws) + O_ACT), (const char*)(lws(p.ws) + O_WD), DFF * 2, DFF / 64, G, c, 0}; EpiResT<false> E{(float*)(p.ws + O_X), modl, 8, 0.5f}; pg8::gemm_phase(L, S, E); }
    if (notlast) { pg8::ResSched S{(const char*)(lws(p.ws) + O_ACT), (const char*)(lws(p.ws) + O_WD), DFF * 2, DFF / 64, G, c, 1}; EpiPart E{(float*)(lws(p.ws) + O_TT), modl, 8, 0.5f}; pg8::gemm_phase(L, S, E); }
    GSYNC();
  }
  final_norm(X, p.out, p.final_gain);
}

extern "C" void kernel_launch(void* const* d_in, const int* in_sizes, int n_in, void* d_out, int out_size, void* d_ws, size_t ws_size, hipStream_t stream) {
  (void)in_sizes; (void)n_in; (void)out_size;
  if (ws_size < WS_NEED) { fprintf(stderr, "workspace too small: %zu < %zu\n", ws_size, (size_t)WS_NEED); return; }
  static int grid_blocks = 0;
  if (!grid_blocks) {
    (void)hipFuncSetAttribute((const void*)fwd_megakernel, hipFuncAttributeMaxDynamicSharedMemorySize, LDS_BYTES);
    int dev = 0, cus = 0, per_cu = 0; (void)hipGetDevice(&dev); (void)hipDeviceGetAttribute(&cus, hipDeviceAttributeMultiprocessorCount, dev);
    (void)hipOccupancyMaxActiveBlocksPerMultiprocessor(&per_cu, fwd_megakernel, NTHR, LDS_BYTES);
    grid_blocks = cus * (per_cu > 0 ? 1 : 0);
    if (grid_blocks != 256) fprintf(stderr, "unexpected grid %d (cus %d per_cu %d)\n", grid_blocks, cus, per_cu);
  }
  Params p{};
  const float** f = (const float**)&p;
  for (int i = 0; i < 22; ++i) f[i] = (const float*)d_in[i];
  p.out = (float*)d_out; p.ws = (unsigned char*)d_ws;
  (void)hipMemsetAsync((unsigned char*)d_ws + O_BAR, 0, 16384, stream);
  void* args[] = {&p};
  hipError_t e = hipLaunchCooperativeKernel((void*)fwd_megakernel, dim3(grid_blocks), dim3(NTHR), args, LDS_BYTES, stream);
  if (e != hipSuccess) fprintf(stderr, "cooperative launch failed: %s (grid %d)\n", hipGetErrorString(e), grid_blocks);
}
```

```cpp
#include <hip/hip_runtime.h>
#include <hip/hip_cooperative_groups.h>
#include <cstdio>

namespace cg = cooperative_groups;

#define LAS __attribute__((address_space(3)))
typedef LAS unsigned char* ldsp;
typedef unsigned short bf16_t;
typedef short bf16x8 __attribute__((ext_vector_type(8)));
typedef float f32x4 __attribute__((ext_vector_type(4)));
typedef unsigned u32x4 __attribute__((ext_vector_type(4)));
typedef unsigned u32x2 __attribute__((ext_vector_type(2)));

constexpr int DM = 1024, NB = 8, SEQ = 4096, CTX = 256, DEPTH = 4;
constexpr int RLAT = NB * SEQ, ROWS = RLAT + NB * CTX;
constexpr int DFF = 2816, NMOD = 9, DPROJ = 5648;
constexpr int NCH = ROWS / 64;
constexpr int NINP = 2816;
constexpr int LDS_BYTES = 163840;
constexpr int NTHR = 512;

constexpr size_t al256(size_t x) { return (x + 255) & ~(size_t)255; }
constexpr size_t O_X = 0;
constexpr size_t O_MOD = O_X + (size_t)ROWS * DM * 4;
constexpr size_t O_DFT = al256(O_MOD + (size_t)DEPTH * 9 * 9216 * 4);
constexpr size_t O_WGU = O_DFT + (size_t)4096 * 4096 * 2;
constexpr size_t O_WD = O_WGU + (size_t)5632 * 1024 * 2;
constexpr size_t O_WIN = O_WD + (size_t)1024 * 2816 * 2;
constexpr size_t O_WG = O_WIN + (size_t)NINP * 1024 * 2;
constexpr size_t O_WCAT = O_WG + (size_t)3072 * 1024 * 2;
constexpr size_t O_WOUT = O_WCAT + (size_t)1024 * 1024 * 2;
constexpr size_t O_R = O_WOUT + (size_t)1024 * 1024 * 2;
constexpr size_t SZ_H = (size_t)ROWS * 1024 * 2;
constexpr size_t SZ_Q = (size_t)ROWS * 512 * 2;
constexpr size_t O_HN = O_R;
constexpr size_t O_ACT = O_R + SZ_H;
constexpr size_t O_QN = O_R;
constexpr size_t O_KN = O_R + SZ_Q;
constexpr size_t O_QKV = O_R + SZ_H;
constexpr size_t O_O = O_QKV;
constexpr size_t O_SCR = O_QKV;
constexpr size_t O_Z = O_QKV + (size_t)ROWS * 1536 * 2;
constexpr size_t O_PI = O_Z + SZ_Q;
constexpr size_t O_FI = O_PI + (size_t)ROWS * 256 * 2;
constexpr size_t O_AB = O_FI + (size_t)ROWS * 256 * 2;
constexpr size_t O_KNT = al256(O_AB + (size_t)ROWS * 16 * 4);
constexpr size_t O_VNT = O_KNT + SZ_Q;
constexpr size_t O_MRG = O_KNT;
constexpr size_t O_TT = O_VNT + SZ_Q;
constexpr size_t O_OF = O_TT;
constexpr size_t O_GC = O_TT + SZ_H;
constexpr size_t O_FBT = al256(O_GC + (size_t)NCH * 4 * 2 * 64 * 4);
constexpr size_t O_UCS = O_FBT + (size_t)NB * 256 * 4096 * 2;
constexpr size_t O_PPF = al256(O_UCS + (size_t)NB * CTX * 512 * 4);
constexpr size_t O_WGU2 = al256(O_PPF + SZ_Q);
constexpr size_t O_WD2 = O_WGU2 + (size_t)5632 * 1024 * 2;
constexpr size_t O_WOUT3 = al256(O_WD2 + (size_t)1024 * 2816 * 2);
constexpr size_t O_BAR = al256(O_WOUT3 + (size_t)1024 * 3072 * 2);
constexpr size_t O_PARTM = O_Z;
constexpr size_t WS_NEED = O_BAR + 16384;
static_assert(O_SCR + (size_t)256 * 2 * 262144 <= O_PI, "merge scratch overlaps");

struct Params {
  const float *x, *c, *ctx, *c_ctx, *w_ada, *b_ada, *norm_gain, *w1gu, *w1d, *w2gu, *w2d, *w_in, *conv_w, *a_log, *dt_bias, *o_gain, *w_a, *w_b,
      *pool_scale, *w_c, *w_out, *final_gain;
  float* out;
  unsigned char* ws;
};

typedef float f32x2_ __attribute__((ext_vector_type(2)));
typedef __bf16 bf16x2_ __attribute__((ext_vector_type(2)));
__device__ __forceinline__ unsigned cvt_pk_bf16(float lo, float hi) { const f32x2_ v = {lo, hi}; const bf16x2_ b = __builtin_convertvector(v, bf16x2_); return __builtin_bit_cast(unsigned, b); }
__device__ __forceinline__ float bflo(unsigned w) { return __uint_as_float(w << 16); }
__device__ __forceinline__ float bfhi(unsigned w) { return __uint_as_float(w & 0xffff0000u); }
__device__ __forceinline__ float sigmoidf_(float x) { return __builtin_amdgcn_rcpf(1.0f + __expf(-x)); }
__device__ __forceinline__ float siluf_(float x) { return x * __builtin_amdgcn_rcpf(1.0f + __expf(-x)); }
template <class T> __device__ __forceinline__ T ldsld(ldsp b, int off) { return *(const LAS T*)(b + off); }
template <class T> __device__ __forceinline__ void ldsst(ldsp b, int off, T v) { *(LAS T*)(b + off) = v; }
__device__ __forceinline__ f32x4 mma(bf16x8 a, bf16x8 b, f32x4 c) { return __builtin_amdgcn_mfma_f32_16x16x32_bf16(a, b, c, 0, 0, 0); }
__device__ __forceinline__ u32x2 pack4(f32x4 v) { u32x2 r; r.x = cvt_pk_bf16(v[0], v[1]); r.y = cvt_pk_bf16(v[2], v[3]); return r; }
__device__ __forceinline__ int otid() { int t = threadIdx.x; asm volatile("" : "+v"(t)); return t; }
extern __shared__ __attribute__((aligned(16))) unsigned char g_shm[];
__device__ __forceinline__ unsigned char* lws(unsigned char*) { ldsp Lb = (ldsp)g_shm; unsigned lo = *(volatile LAS unsigned*)(Lb + LDS_BYTES - 32), hi = *(volatile LAS unsigned*)(Lb + LDS_BYTES - 28);
  lo = __builtin_amdgcn_readfirstlane(lo); hi = __builtin_amdgcn_readfirstlane(hi); return (unsigned char*)(((unsigned long long)hi << 32) | (unsigned long long)lo); }
__device__ __forceinline__ void atomic_add_f32(float* q, float v) { asm volatile("global_atomic_add_f32 %0, %1, off sc1" : : "v"(q), "v"(v) : "memory"); }
__device__ __forceinline__ int modidx(int pm) { return pm < 128 ? (pm >> 4) : 8; }

namespace pg8 {
constexpr int BM = 256, BK = 64, HALF = 128, HTB = HALF * BK * 2, NXCD = 8, WGM = 8;
__device__ __forceinline__ int lds_byte(int r, int c) { const int st = (r >> 4) * 2 + (c >> 5), rr = r & 15, cc = c & 31, ob = rr * 64 + cc * 2; return st * 1024 + (ob ^ (((ob >> 9) & 1) << 5)); }
__device__ __forceinline__ void stage_rc(int b, int& R, int& C) { const int st = b / 1024, sb = b % 1024, swz = sb ^ (((sb >> 9) & 1) << 5); R = (st >> 1) * 16 + swz / 64; C = (st & 1) * 32 + (swz % 64) / 2; }
__device__ __forceinline__ int perm32(int rho) { const int n = rho >> 4, i = rho & 15; return 8 * (i >> 2) + 4 * n + (i & 3); }

struct Unit { const char* A; const char* B; int lda, ldb, nt, pm, pn, seg; };

__device__ __forceinline__ bool tile_of(int nM, int nN, int G, int c, int i, int& pm, int& pn) {
  const int nwg = nM * nN; const long Lq = (long)i * G + c; if (Lq >= nwg) return false;
  int wgid = (int)Lq; { const int q = nwg / NXCD, r = nwg % NXCD, xcd = wgid % NXCD, off = wgid / NXCD; wgid = (xcd < r ? xcd * (q + 1) : r * (q + 1) + (xcd - r) * q) + off; }
  const int nig = WGM * nN, gid = wgid / nig, fm = gid * WGM, gsz = (nM - fm) < WGM ? (nM - fm) : WGM;
  pm = fm + ((wgid % nig) % gsz); pn = (wgid % nig) / gsz; return true;
}
struct PlainSched {
  static constexpr bool VARLDA = false;
  const char* A; const char* B; int lda, ldb, nt, nM, nN, G, c;
  __device__ __forceinline__ bool next(int i, Unit& u) const {
    int pm, pn; if (!tile_of(nM, nN, G, c, i, pm, pn)) return false;
    u.A = A + (size_t)pm * 256 * lda; u.B = B + (size_t)pn * 256 * ldb; u.lda = lda; u.ldb = ldb; u.nt = nt; u.pm = pm; u.pn = pn; u.seg = 0; return true;
  }
};

struct ResSched {
  static constexpr bool VARLDA = false;
  const char* A; const char* B; int ld, nt, G, c, mode;
  __device__ __forceinline__ bool next(int i, Unit& u) const {
    u.lda = ld; u.ldb = ld;
    if (mode == 0) { int pm, pn; if (i >= 2 || !tile_of(128, 4, G, c, i, pm, pn)) return false;
      u.A = A + (size_t)pm * 256 * ld; u.B = B + (size_t)pn * 256 * ld; u.nt = nt; u.pm = pm; u.pn = pn; u.seg = 0; return true; }
#ifdef NO_SPLITK
    if (i > 0 || c >= 32) return false;
    { const int pm = 128 + (c >> 2), pn = c & 3; u.A = A + (size_t)pm * 256 * ld; u.B = B + (size_t)pn * 256 * ld; u.nt = nt; u.pm = pm; u.pn = pn; u.seg = 0; return true; }
#endif
    if (i > 0 || c >= 256) return false;
    const int pm = 128 + (c >> 5), pn = (c >> 3) & 3, kp = c & 7;
    const int base = (nt / 16) * 2, extra = (nt - base * 8) / 2;
    const int k0 = kp * base + 2 * (kp < extra ? kp : extra), np = base + (kp < extra ? 2 : 0);
    u.A = A + (size_t)pm * 256 * ld + (size_t)k0 * 128; u.B = B + (size_t)pn * 256 * ld + (size_t)k0 * 128; u.nt = np; u.pm = pm; u.pn = pn; u.seg = kp; return true;
  }
};
template <class Epi, class Sched>
__device__ __forceinline__ void gemm_phase(ldsp lds, const Sched& S, const Epi& E) {
  const int tid = otid(), wid = __builtin_amdgcn_readfirstlane(tid >> 6), lane = tid & 63, wr = wid >> 2, wc = wid & 3, fr = lane & 15, fq = lane >> 4;
  unsigned rA[2], rB[2], c2[2];
#pragma unroll
  for (int i = 0; i < 2; ++i) { int R, C; stage_rc(tid * 16 + i * 8192, R, C); rA[i] = (unsigned)R; rB[i] = (unsigned)(Epi::PERM ? ((R & ~31) + perm32(R & 31)) : R); c2[i] = (unsigned)C * 2u; }
  const size_t kstep = (size_t)(BK * 2);
  const unsigned ldsw = (unsigned)wid * 1024u;
  const int aoff = lds_byte(wr * 64 + fr, fq * 8), boff = lds_byte(wc * 32 + fr, fq * 8);
#define PG8_SA(b, h) (((b) * 2 + (h)) * HTB)
#define PG8_SB(b, h) ((4 + (b) * 2 + (h)) * HTB)
#define PG8_STAGE(bufoff, gbase, voff) do { _Pragma("unroll") for (int _i = 0; _i < 2; ++_i) \
    __builtin_amdgcn_global_load_lds((const unsigned*)((const char*)(gbase) + (voff)[_i]), (LAS unsigned*)(lds + (bufoff) + ldsw + _i * 8192), 16, 0, 0); } while (0)
#define PG8_LDA(dst, b, h) do { _Pragma("unroll") for (int m = 0; m < 4; ++m) _Pragma("unroll") for (int k = 0; k < 2; ++k) dst[m][k] = *(const LAS bf16x8*)(lds + PG8_SA(b, h) + aoff + m * 2048 + k * 1024); } while (0)
#define PG8_LDB(dst, b, h) do { _Pragma("unroll") for (int n = 0; n < 2; ++n) _Pragma("unroll") for (int k = 0; k < 2; ++k) dst[n][k] = *(const LAS bf16x8*)(lds + PG8_SB(b, h) + boff + n * 2048 + k * 1024); } while (0)
#define PG8_MMA(ai, bj, At, Bt) do { __builtin_amdgcn_s_setprio(1); _Pragma("unroll") for (int m = 0; m < 4; ++m) _Pragma("unroll") for (int n = 0; n < 2; ++n) _Pragma("unroll") for (int k = 0; k < 2; ++k) \
    acc[ai][bj][m][n] = __builtin_amdgcn_mfma_f32_16x16x32_bf16(Bt[n][k], At[m][k], acc[ai][bj][m][n], 0, 0, 0); __builtin_amdgcn_s_setprio(0); } while (0)
#define PG8_WAIT_V(n) asm volatile("s_waitcnt vmcnt(" #n ")" ::: "memory")
#define PG8_WAIT_L(n) asm volatile("s_waitcnt lgkmcnt(" #n ")" ::: "memory")
#define PG8_BAR __builtin_amdgcn_s_barrier()
#define PG8_SCHED __builtin_amdgcn_sched_barrier(0)
  Unit cur, nxt; int ui = 0;
  if (!S.next(0, cur)) return;
  float zz_; asm volatile("v_mov_b32 %0, 0" : "=v"(zz_));
  f32x4 acc[2][2][4][2];
#pragma unroll
  for (int a = 0; a < 2; ++a)
#pragma unroll
    for (int b = 0; b < 2; ++b)
#pragma unroll
      for (int m = 0; m < 4; ++m)
#pragma unroll
        for (int n = 0; n < 2; ++n) acc[a][b][m][n] = (f32x4){zz_, zz_, zz_, zz_};
  bf16x8 At[4][2], B0[2][2], B1[2][2];
  const char* cA = cur.A; const char* cB = cur.B; int ldA = cur.lda; const int ldB = cur.ldb;
  unsigned voffA[2], voffB[2];
#pragma unroll
  for (int i = 0; i < 2; ++i) { voffA[i] = rA[i] * (unsigned)ldA + c2[i]; voffB[i] = rB[i] * (unsigned)ldB + c2[i]; }
  const size_t hB = (size_t)HALF * ldB;
  {
    const size_t hA = (size_t)HALF * ldA;
    PG8_STAGE(PG8_SB(0, 0), cB, voffB); PG8_STAGE(PG8_SA(0, 0), cA, voffA); PG8_STAGE(PG8_SB(0, 1), cB + hB, voffB); PG8_STAGE(PG8_SA(0, 1), cA + hA, voffA);
    if (wr == 1) PG8_BAR;
    PG8_WAIT_V(4); PG8_BAR;
    PG8_STAGE(PG8_SB(1, 0), cB + kstep, voffB); PG8_STAGE(PG8_SA(1, 0), cA + kstep, voffA); PG8_STAGE(PG8_SB(1, 1), cB + hB + kstep, voffB);
    PG8_WAIT_V(6); PG8_BAR;
  }
  for (;;) {
    const bool has_next = S.next(ui + 1, nxt);
    const char* nA = has_next ? nxt.A : cA; const char* nB = has_next ? nxt.B : cB;
    const int nldA = has_next ? nxt.lda : ldA;
    const int nt = cur.nt;
    const size_t hA = (size_t)HALF * ldA;
    for (int t = 0; t < nt; t += 2) {
      const bool last = (t == nt - 2);
      const char* a1 = cA + (size_t)(t + 1) * kstep;
      const char* a2 = last ? nA : cA + (size_t)(t + 2) * kstep; const char* b2 = last ? nB : cB + (size_t)(t + 2) * kstep;
      const size_t h2A = (size_t)HALF * (last ? nldA : ldA);
      const char* a3 = a2 + kstep; const char* b3 = b2 + kstep;
      PG8_LDB(B0, 0, 0); PG8_SCHED; PG8_LDA(At, 0, 0); PG8_STAGE(PG8_SA(1, 1), a1 + hA, voffA);
      if (Sched::VARLDA) { if (last) {
#pragma unroll
        for (int i = 0; i < 2; ++i) voffA[i] = rA[i] * (unsigned)nldA + c2[i]; } }
      PG8_WAIT_L(8); PG8_BAR; PG8_WAIT_L(0); PG8_MMA(0, 0, At, B0); PG8_BAR; PG8_SCHED;
      PG8_LDB(B1, 0, 1); PG8_STAGE(PG8_SB(0, 0), b2, voffB);
      PG8_BAR; PG8_WAIT_L(0); PG8_MMA(0, 1, At, B1); PG8_BAR;
      PG8_LDA(At, 0, 1); PG8_STAGE(PG8_SA(0, 0), a2, voffA);
      PG8_BAR; PG8_WAIT_L(0); PG8_MMA(1, 0, At, B0); PG8_BAR; PG8_SCHED;
      PG8_STAGE(PG8_SB(0, 1), b2 + hB, voffB);
      PG8_WAIT_V(6); PG8_BAR; PG8_MMA(1, 1, At, B1); PG8_BAR;
      PG8_LDB(B0, 1, 0); PG8_SCHED; PG8_LDA(At, 1, 0); PG8_STAGE(PG8_SA(0, 1), a2 + h2A, voffA);
      PG8_WAIT_L(8); PG8_BAR; PG8_WAIT_L(0); PG8_MMA(0, 0, At, B0); PG8_BAR; PG8_SCHED;
      PG8_LDB(B1, 1, 1); PG8_STAGE(PG8_SB(1, 0), b3, voffB);
      PG8_BAR; PG8_WAIT_L(0); PG8_MMA(0, 1, At, B1); PG8_BAR;
      PG8_LDA(At, 1, 1); PG8_STAGE(PG8_SA(1, 0), a3, voffA);
      PG8_BAR; PG8_WAIT_L(0); PG8_MMA(1, 0, At, B0); PG8_BAR; PG8_SCHED;
      PG8_STAGE(PG8_SB(1, 1), b3 + hB, voffB);
      PG8_WAIT_V(6); PG8_BAR; PG8_MMA(1, 1, At, B1); PG8_BAR;
    }
    E(acc, cur, wr, wc, fr, fq);
    if (!has_next) break;
#pragma unroll
    for (int a = 0; a < 2; ++a)
#pragma unroll
      for (int b = 0; b < 2; ++b)
#pragma unroll
        for (int m = 0; m < 4; ++m)
#pragma unroll
          for (int n = 0; n < 2; ++n) acc[a][b][m][n] = (f32x4){zz_, zz_, zz_, zz_};
    cur = nxt; cA = nA; cB = nB; ldA = nldA; ++ui;
  }
  PG8_WAIT_V(0);
  if (wr == 0) PG8_BAR;
  PG8_BAR;
#undef PG8_SA
#undef PG8_SB
#undef PG8_STAGE
#undef PG8_LDA
#undef PG8_LDB
#undef PG8_MMA
#undef PG8_WAIT_V
#undef PG8_WAIT_L
#undef PG8_BAR
#undef PG8_SCHED
}
}
using pg8::Unit;
typedef f32x4 AccT[2][2][4][2];

struct EpiUp {
  static constexpr bool PERM = true;
  bf16_t* act;
  __device__ __forceinline__ void operator()(const AccT& acc, const Unit& u, int wr, int wc, int fr, int fq) const {
    const int row0 = u.pm * 256 + wr * 64 + fr, col0 = u.pn * 128 + wc * 32 + 8 * fq;
#pragma unroll
    for (int ai = 0; ai < 2; ++ai)
#pragma unroll
      for (int m = 0; m < 4; ++m) {
        const f32x4 a0 = acc[ai][0][m][0], a1 = acc[ai][0][m][1], u0 = acc[ai][1][m][0], u1 = acc[ai][1][m][1];
        u32x4 w;
        w.x = cvt_pk_bf16(siluf_(a0[0]) * u0[0], siluf_(a0[1]) * u0[1]); w.y = cvt_pk_bf16(siluf_(a0[2]) * u0[2], siluf_(a0[3]) * u0[3]);
        w.z = cvt_pk_bf16(siluf_(a1[0]) * u1[0], siluf_(a1[1]) * u1[1]); w.w = cvt_pk_bf16(siluf_(a1[2]) * u1[2], siluf_(a1[3]) * u1[3]);
        *(u32x4*)(act + (size_t)(row0 + ai * 128 + m * 16) * DFF + col0) = w;
      }
  }
};
template <bool ATOMIC> struct EpiResT {
  static constexpr bool PERM = false;
  float* X; const float* modl; int gidx; float scale;
  __device__ __forceinline__ void operator()(const AccT& acc, const Unit& u, int wr, int wc, int fr, int fq) const {
    const int row0 = u.pm * 256 + wr * 64 + fr, col0 = u.pn * 256 + wc * 32 + 4 * fq;
    const float* g = modl + (size_t)(modidx(u.pm) * 9 + gidx) * 1024 + col0;
    f32x4 gv[2][2];
#pragma unroll
    for (int bj = 0; bj < 2; ++bj)
#pragma unroll
      for (int n = 0; n < 2; ++n) gv[bj][n] = *(const f32x4*)(g + bj * 128 + n * 16) * scale;
#pragma unroll
    for (int ai = 0; ai < 2; ++ai)
#pragma unroll
      for (int m = 0; m < 4; ++m) {
        float* rowp = X + (size_t)(row0 + ai * 128 + m * 16) * DM + col0;
#pragma unroll
        for (int bj = 0; bj < 2; ++bj)
#pragma unroll
          for (int n = 0; n < 2; ++n) { float* qf = rowp + bj * 128 + n * 16; const f32x4 t = gv[bj][n] * acc[ai][bj][m][n];
            if (ATOMIC) { atomic_add_f32(qf, t[0]); atomic_add_f32(qf + 1, t[1]); atomic_add_f32(qf + 2, t[2]); atomic_add_f32(qf + 3, t[3]); }
            else { f32x4* q = (f32x4*)qf; *q = *q + t; } }
      }
  }
};
struct EpiPart {
  static constexpr bool PERM = false;
  float* part; const float* modl; int gidx; float scale;
  __device__ __forceinline__ void operator()(const AccT& acc, const Unit& u, int wr, int wc, int fr, int fq) const {
    const int row0 = (u.pm - 128) * 256 + wr * 64 + fr, col0 = u.pn * 256 + wc * 32 + 4 * fq;
    const float* g = modl + (size_t)(8 * 9 + gidx) * 1024 + col0;
    float* pb = part + (size_t)u.seg * 2048 * 1024;
    f32x4 gv[2][2];
#pragma unroll
    for (int bj = 0; bj < 2; ++bj)
#pragma unroll
      for (int n = 0; n < 2; ++n) gv[bj][n] = *(const f32x4*)(g + bj * 128 + n * 16) * scale;
#pragma unroll
    for (int ai = 0; ai < 2; ++ai)
#pragma unroll
      for (int m = 0; m < 4; ++m) {
        float* rowp = pb + (size_t)(row0 + ai * 128 + m * 16) * DM + col0;
#pragma unroll
        for (int bj = 0; bj < 2; ++bj)
#pragma unroll
          for (int n = 0; n < 2; ++n) *(f32x4*)(rowp + bj * 128 + n * 16) = gv[bj][n] * acc[ai][bj][m][n];
      }
  }
};
struct EpiIn {
  static constexpr bool PERM = true;
  bf16_t *qkv, *z, *pi, *fi; float* ab;
  __device__ __forceinline__ void operator()(const AccT& acc, const Unit& u, int wr, int wc, int fr, int fq) const {
    const int row0 = u.pm * 256 + wr * 64 + fr;
    if (u.pn == 10) {
      if (wc == 0 && fq < 2) {
#pragma unroll
        for (int ai = 0; ai < 2; ++ai)
#pragma unroll
          for (int m = 0; m < 4; ++m) {
            float* rp = ab + (size_t)(row0 + ai * 128 + m * 16) * 16 + 8 * fq;
            *(f32x4*)(rp) = acc[ai][0][m][0]; *(f32x4*)(rp + 4) = acc[ai][0][m][1];
          }
      }
      return;
    }
    bf16_t* base; int ld, ct;
    if (u.pn < 6) { base = qkv; ld = 1536; ct = u.pn * 256; } else if (u.pn < 8) { base = z; ld = 512; ct = (u.pn - 6) * 256; } else if (u.pn == 8) { base = pi; ld = 256; ct = 0; } else { base = fi; ld = 256; ct = 0; }
    const int col0 = ct + wc * 32 + 8 * fq;
#pragma unroll
    for (int ai = 0; ai < 2; ++ai)
#pragma unroll
      for (int m = 0; m < 4; ++m) {
        bf16_t* rowp = base + (size_t)(row0 + ai * 128 + m * 16) * ld + col0;
#pragma unroll
        for (int bj = 0; bj < 2; ++bj) { const f32x4 v0 = acc[ai][bj][m][0], v1 = acc[ai][bj][m][1]; u32x4 w; w.x = cvt_pk_bf16(v0[0], v0[1]); w.y = cvt_pk_bf16(v0[2], v0[3]); w.z = cvt_pk_bf16(v1[0], v1[1]); w.w = cvt_pk_bf16(v1[2], v1[3]);
          *(u32x4*)(rowp + bj * 128) = w; }
      }
  }
};
struct EpiBf {
  static constexpr bool PERM = true;
  bf16_t* O; int ld;
  __device__ __forceinline__ void operator()(const AccT& acc, const Unit& u, int wr, int wc, int fr, int fq) const {
    const int row0 = u.pm * 256 + wr * 64 + fr, col0 = u.pn * 256 + wc * 32 + 8 * fq;
#pragma unroll
    for (int ai = 0; ai < 2; ++ai)
#pragma unroll
      for (int m = 0; m < 4; ++m) {
        bf16_t* rowp = O + (size_t)(row0 + ai * 128 + m * 16) * ld + col0;
#pragma unroll
        for (int bj = 0; bj < 2; ++bj) { const f32x4 v0 = acc[ai][bj][m][0], v1 = acc[ai][bj][m][1]; u32x4 w; w.x = cvt_pk_bf16(v0[0], v0[1]); w.y = cvt_pk_bf16(v0[2], v0[3]); w.z = cvt_pk_bf16(v1[0], v1[1]); w.w = cvt_pk_bf16(v1[2], v1[3]);
          *(u32x4*)(rowp + bj * 128) = w; }
      }
  }
};
struct EpiMerge {
  static constexpr bool PERM = true;
  unsigned* scr;
  bf16_t* mrg;
  __device__ __forceinline__ void operator()(const AccT& acc, const Unit& u, int wr, int wc, int fr, int fq) const {
    const int tid_ = otid(); u32x4* S1 = (u32x4*)scr + tid_; u32x4* Mx = (u32x4*)scr + 16 * 512 + tid_;
    const int seg = u.seg;
    if ((seg & 1) == 0) {
#pragma unroll
      for (int ai = 0; ai < 2; ++ai)
#pragma unroll
        for (int bj = 0; bj < 2; ++bj)
#pragma unroll
          for (int m = 0; m < 4; ++m) { const f32x4 v0 = acc[ai][bj][m][0], v1 = acc[ai][bj][m][1]; u32x4 w;
            w.x = cvt_pk_bf16(sigmoidf_(v0[0]), sigmoidf_(v0[1])); w.y = cvt_pk_bf16(sigmoidf_(v0[2]), sigmoidf_(v0[3])); w.z = cvt_pk_bf16(sigmoidf_(v1[0]), sigmoidf_(v1[1])); w.w = cvt_pk_bf16(sigmoidf_(v1[2]), sigmoidf_(v1[3]));
            S1[((ai * 2 + bj) * 4 + m) * 512] = w; }
    } else {
      const int row0 = u.pm * 256 + wr * 64 + fr, col0 = u.pn * 256 + wc * 32 + 8 * fq;
#pragma unroll
      for (int ai = 0; ai < 2; ++ai)
#pragma unroll
        for (int m = 0; m < 4; ++m) {
#pragma unroll
          for (int bj = 0; bj < 2; ++bj) {
            const int ix = ((ai * 2 + bj) * 4 + m) * 512; const u32x4 g = S1[ix]; const f32x4 v0 = acc[ai][bj][m][0], v1 = acc[ai][bj][m][1];
            float t[8] = {bflo(g.x) * v0[0], bfhi(g.x) * v0[1], bflo(g.y) * v0[2], bfhi(g.y) * v0[3], bflo(g.z) * v1[0], bfhi(g.z) * v1[1], bflo(g.w) * v1[2], bfhi(g.w) * v1[3]};
            if (seg >= 3) { const u32x4 q = Mx[ix]; t[0] += bflo(q.x); t[1] += bfhi(q.x); t[2] += bflo(q.y); t[3] += bfhi(q.y); t[4] += bflo(q.z); t[5] += bfhi(q.z); t[6] += bflo(q.w); t[7] += bfhi(q.w); }
            u32x4 w; w.x = cvt_pk_bf16(t[0], t[1]); w.y = cvt_pk_bf16(t[2], t[3]); w.z = cvt_pk_bf16(t[4], t[5]); w.w = cvt_pk_bf16(t[6], t[7]);
            if (seg < 5) Mx[ix] = w; else *(u32x4*)(mrg + (size_t)(row0 + ai * 128 + m * 16) * DM + col0 + bj * 128) = w;
          }
        }
    }
  }
};
struct MergeSched {
  static constexpr bool VARLDA = true;
  const char *hn, *of, *ppf, *wg, *wcat; int G, c, nM;
  __device__ __forceinline__ bool next(int i, Unit& u) const {
    const int round = i / 6, seg = i - round * 6; int pm, pn; if (!pg8::tile_of(nM, 4, G, c, round, pm, pn)) return false;
    const int br = seg >> 1;
    u.pm = pm; u.pn = pn; u.seg = seg; u.ldb = 2048;
    if ((seg & 1) == 0) { u.A = hn + (size_t)pm * 256 * 2048; u.lda = 2048; u.B = wg + (size_t)(br * 1024 + pn * 256) * 2048; u.nt = 16; }
    else {
      u.lda = 1024;
      if (br == 0) { u.A = of + (size_t)pm * 256 * 1024; u.B = wcat + (size_t)pn * 256 * 2048; u.nt = 8; }
      else if (br == 1) { u.A = ppf + (size_t)pm * 256 * 1024; u.B = wcat + (size_t)pn * 256 * 2048 + 512 * 2; u.nt = 4; }
      else { u.A = ppf + (size_t)pm * 256 * 1024 + 256 * 2; u.B = wcat + (size_t)pn * 256 * 2048 + 768 * 2; u.nt = 4; }
    }
    return true;
  }
};
struct MergeCtxSched {
  static constexpr bool VARLDA = true;
  const char *hn, *of, *ppf, *wg, *wcat; int c;
  __device__ __forceinline__ bool next(int i, Unit& u) const {
    if (i > 1 || c >= 96) return false;
    const int tile = c / 3, br = c - tile * 3, pm = 128 + (tile >> 2), pn = tile & 3;
    u.pm = pm; u.pn = pn; u.seg = br * 2 + i; u.ldb = 2048;
    if (i == 0) { u.A = hn + (size_t)pm * 256 * 2048; u.lda = 2048; u.B = wg + (size_t)(br * 1024 + pn * 256) * 2048; u.nt = 16; }
    else { u.lda = 1024;
      if (br == 0) { u.A = of + (size_t)pm * 256 * 1024; u.B = wcat + (size_t)pn * 256 * 2048; u.nt = 8; }
      else if (br == 1) { u.A = ppf + (size_t)pm * 256 * 1024; u.B = wcat + (size_t)pn * 256 * 2048 + 512 * 2; u.nt = 4; }
      else { u.A = ppf + (size_t)pm * 256 * 1024 + 256 * 2; u.B = wcat + (size_t)pn * 256 * 2048 + 768 * 2; u.nt = 4; } }
    return true;
  }
};
struct EpiMergeCtx {
  static constexpr bool PERM = true;
  unsigned* scr; bf16_t* partm;
  __device__ __forceinline__ void operator()(const AccT& acc, const Unit& u, int wr, int wc, int fr, int fq) const {
    const int tid_ = otid(); u32x4* S1 = (u32x4*)scr + tid_;
    if ((u.seg & 1) == 0) {
#pragma unroll
      for (int ai = 0; ai < 2; ++ai)
#pragma unroll
        for (int bj = 0; bj < 2; ++bj)
#pragma unroll
          for (int m = 0; m < 4; ++m) { const f32x4 v0 = acc[ai][bj][m][0], v1 = acc[ai][bj][m][1]; u32x4 w;
            w.x = cvt_pk_bf16(sigmoidf_(v0[0]), sigmoidf_(v0[1])); w.y = cvt_pk_bf16(sigmoidf_(v0[2]), sigmoidf_(v0[3])); w.z = cvt_pk_bf16(sigmoidf_(v1[0]), sigmoidf_(v1[1])); w.w = cvt_pk_bf16(sigmoidf_(v1[2]), sigmoidf_(v1[3]));
            S1[((ai * 2 + bj) * 4 + m) * 512] = w; }
    } else {
      const int br = u.seg >> 1, row0 = (u.pm - 128) * 256 + wr * 64 + fr, col0 = br * 1024 + u.pn * 256 + wc * 32 + 8 * fq;
#pragma unroll
      for (int ai = 0; ai < 2; ++ai)
#pragma unroll
        for (int m = 0; m < 4; ++m)
#pragma unroll
          for (int bj = 0; bj < 2; ++bj) {
            const u32x4 g = S1[((ai * 2 + bj) * 4 + m) * 512]; const f32x4 v0 = acc[ai][bj][m][0], v1 = acc[ai][bj][m][1];
            u32x4 w; w.x = cvt_pk_bf16(bflo(g.x) * v0[0], bfhi(g.x) * v0[1]); w.y = cvt_pk_bf16(bflo(g.y) * v0[2], bfhi(g.y) * v0[3]); w.z = cvt_pk_bf16(bflo(g.z) * v1[0], bfhi(g.z) * v1[1]); w.w = cvt_pk_bf16(bflo(g.w) * v1[2], bfhi(g.w) * v1[3]);
            *(u32x4*)(partm + (size_t)(row0 + ai * 128 + m * 16) * 3072 + col0 + bj * 128) = w;
          }
    }
  }
};
struct FourSched {
  static constexpr bool VARLDA = false;
  const char *dft, *fbt; int c;
  __device__ __forceinline__ bool next(int i, Unit& u) const {
    if (i > 0) return false;
    const int b = c >> 4, pm = c & 15;
    u.A = dft + (size_t)pm * 256 * 8192; u.B = fbt + (size_t)b * 256 * 8192; u.lda = 8192; u.ldb = 8192; u.nt = 64; u.pm = b * 16 + pm; u.pn = 0; u.seg = 0; return true;
  }
};

template <class F>
__device__ __forceinline__ void convT(const float* W, int ldw, int K, int nrows, bf16_t* dst, int ldd, int k0d, F srccol, ldsp L, int& cursor, int wg, int G) {
  const int tid = otid(), ntk = K >> 6, ntiles = (nrows >> 6) * ntk;
  int t0 = (wg - cursor % G + G) % G;
  for (; t0 < ntiles; t0 += 4 * G) {
    float v[4][8];
#pragma unroll
    for (int u = 0; u < 4; ++u) {
      const int t = t0 + u * G;
      if (t < ntiles) {
        const int tr = t / ntk, tk = t - tr * ntk, r0 = tr * 64, kk0 = tk * 64; const int i = tid & 63, sc = srccol(r0 + i);
#pragma unroll
        for (int it = 0; it < 8; ++it) { const int kk = (tid >> 6) + 8 * it; v[u][it] = sc >= 0 ? W[(size_t)(kk0 + kk) * ldw + sc] : 0.f; }
      }
    }
#pragma unroll
    for (int u = 0; u < 4; ++u) { if (t0 + u * G < ntiles) {
#pragma unroll
      for (int it = 0; it < 8; ++it) ldsst<float>(L, u * 16640 + (((tid >> 6) + 8 * it) * 65 + (tid & 63)) * 4, v[u][it]); } }
    __syncthreads();
#pragma unroll
    for (int u = 0; u < 4; ++u) {
      const int t = t0 + u * G;
      if (t < ntiles) {
        const int tr = t / ntk, tk = t - tr * ntk, r0 = tr * 64, kk0 = tk * 64; const int ii = tid >> 3, kv = (tid & 7) * 8; float o[8];
#pragma unroll
        for (int e = 0; e < 8; ++e) o[e] = ldsld<float>(L, u * 16640 + ((kv + e) * 65 + ii) * 4);
        u32x4 w; w.x = cvt_pk_bf16(o[0], o[1]); w.y = cvt_pk_bf16(o[2], o[3]); w.z = cvt_pk_bf16(o[4], o[5]); w.w = cvt_pk_bf16(o[6], o[7]);
        *(u32x4*)(dst + (size_t)(r0 + ii) * ldd + k0d + kk0 + kv) = w;
      }
    }
    __syncthreads();
  }
  cursor += ntiles;
}

__device__ __forceinline__ void convert_ffn(const Params& p, const float* wgu, const float* wd, size_t o_gu, size_t o_d, ldsp L, int& cur, int wg, int nwg) {
  convT(wgu, 2 * DFF, 1024, 2 * DFF, (bf16_t*)(lws(p.ws) + o_gu), 1024, 0, [](int r) { const int t = r >> 8, q = r & 255; return q < 128 ? t * 128 + q : DFF + t * 128 + (q - 128); }, L, cur, wg, nwg);
  convT(wd, 1024, DFF, 1024, (bf16_t*)(lws(p.ws) + o_d), DFF, 0, [](int r) { return r; }, L, cur, wg, nwg);
}
__device__ __forceinline__ void convert_win(const Params& p, int l, ldsp L, int& cur, int wg, int nwg) {
  const float* win = p.w_in + (size_t)l * 1024 * DPROJ;
  convT(win, DPROJ, 1024, NINP, (bf16_t*)(lws(p.ws) + O_WIN), 1024, 0, [](int r) { return r < 2048 ? r : (r < 2560 ? r + 16 : (r < 2576 ? r - 512 : -1)); }, L, cur, wg, nwg);
}
__device__ __forceinline__ void convert_mixer(const Params& p, int l, ldsp L, int& cur) {
  const int wg = blockIdx.x, nwg = gridDim.x;
  const float* win = p.w_in + (size_t)l * 1024 * DPROJ;
  convT(win, DPROJ, 1024, 3072, (bf16_t*)(lws(p.ws) + O_WG), 1024, 0, [](int r) { return 2576 + r; }, L, cur, wg, nwg);
  convT(p.w_a + (size_t)l * 512 * 1024, 1024, 512, 1024, (bf16_t*)(lws(p.ws) + O_WCAT), 1024, 0, [](int r) { return r; }, L, cur, wg, nwg);
  convT(p.w_c + (size_t)l * 256 * 1024, 1024, 256, 1024, (bf16_t*)(lws(p.ws) + O_WCAT), 1024, 768, [](int r) { return r; }, L, cur, wg, nwg);
  convT(p.w_out + (size_t)l * 1024 * 1024, 1024, 1024, 1024, (bf16_t*)(lws(p.ws) + O_WOUT), 1024, 0, [](int r) { return r; }, L, cur, wg, nwg);
  for (int rp = 0; rp < 3; ++rp) convT(p.w_out + (size_t)l * 1024 * 1024, 1024, 1024, 1024, (bf16_t*)(lws(p.ws) + O_WOUT3), 3072, rp * 1024, [](int r) { return r; }, L, cur, wg, nwg);
  const float* wb = p.w_b + (size_t)l * 4 * 64 * 256; const float* ps = p.pool_scale + (size_t)l * 1024; bf16_t* wcat = (bf16_t*)(lws(p.ws) + O_WCAT);
  for (int idx = blockIdx.x * NTHR + otid(); idx < 1024 * 256; idx += gridDim.x * NTHR) {
    const int row = idx & 1023, kk = idx >> 10, g = row >> 8;
    const float v = ((kk >> 6) == g) ? wb[((size_t)g * 64 + (kk & 63)) * 256 + (row & 255)] * ps[row] : 0.f;
    wcat[(size_t)row * 1024 + 512 + kk] = (bf16_t)(cvt_pk_bf16(v, 0.f) & 0xffffu);
  }
}

__device__ __forceinline__ void norm_phase(float* X, bf16_t* Hn, const float* gain, const float* modl, int ishift, int iscale, const float* part) {
  const int tid_ = otid(), lane = tid_ & 63, gw = blockIdx.x * 8 + (tid_ >> 6), nw = gridDim.x * 8;
  for (int r = gw; r < ROWS; r += nw) {
    const int j = r < RLAT ? (r >> 12) : 8;
    const float* sh = modl + (size_t)(j * 9 + ishift) * 1024; const float* sc = modl + (size_t)(j * 9 + iscale) * 1024;
    float* xr = X + (size_t)r * DM;
    f32x4 v[4]; float ss = 0.f;
#pragma unroll
    for (int i = 0; i < 2; ++i) { v[2 * i] = *(const f32x4*)(xr + lane * 8 + 512 * i); v[2 * i + 1] = *(const f32x4*)(xr + lane * 8 + 512 * i + 4); }
    if (part != nullptr && r >= RLAT) {
      const float* pr_ = part + (size_t)(r - RLAT) * DM + lane * 8;
#pragma unroll
      for (int kp = 0; kp < 8; ++kp)
#pragma unroll
        for (int i = 0; i < 2; ++i) { v[2 * i] = v[2 * i] + *(const f32x4*)(pr_ + (size_t)kp * 2048 * 1024 + 512 * i); v[2 * i + 1] = v[2 * i + 1] + *(const f32x4*)(pr_ + (size_t)kp * 2048 * 1024 + 512 * i + 4); }
#pragma unroll
      for (int i = 0; i < 2; ++i) { *(f32x4*)(xr + lane * 8 + 512 * i) = v[2 * i]; *(f32x4*)(xr + lane * 8 + 512 * i + 4) = v[2 * i + 1]; }
    }
#pragma unroll
    for (int i = 0; i < 4; ++i) ss += v[i][0] * v[i][0] + v[i][1] * v[i][1] + v[i][2] * v[i][2] + v[i][3] * v[i][3];
#pragma unroll
    for (int o = 32; o >= 1; o >>= 1) ss += __shfl_xor(ss, o);
    const float rstd = rsqrtf(ss * (1.0f / 1024.0f) + 1e-6f);
#pragma unroll
    for (int i = 0; i < 2; ++i) {
      const int c0 = lane * 8 + 512 * i; float o[8];
#pragma unroll
      for (int hh = 0; hh < 2; ++hh) { const f32x4 g = *(const f32x4*)(gain + c0 + 4 * hh), s1 = *(const f32x4*)(sc + c0 + 4 * hh), s0 = *(const f32x4*)(sh + c0 + 4 * hh); const f32x4 y = v[2 * i + hh] * rstd * g * (s1 + 1.0f) + s0;
        o[4 * hh] = y[0]; o[4 * hh + 1] = y[1]; o[4 * hh + 2] = y[2]; o[4 * hh + 3] = y[3]; }
      u32x4 w; w.x = cvt_pk_bf16(o[0], o[1]); w.y = cvt_pk_bf16(o[2], o[3]); w.z = cvt_pk_bf16(o[4], o[5]); w.w = cvt_pk_bf16(o[6], o[7]);
      *(u32x4*)(Hn + (size_t)r * DM + c0) = w;
    }
  }
}
__device__ __forceinline__ void final_norm(const float* X, float* out, const float* gain) {
  const int tid_ = otid(), lane = tid_ & 63, gw = blockIdx.x * 8 + (tid_ >> 6), nw = gridDim.x * 8;
  for (int r = gw; r < RLAT; r += nw) {
    const float* xr = X + (size_t)r * DM; f32x4 v[4]; float ss = 0.f;
#pragma unroll
    for (int i = 0; i < 4; ++i) { v[i] = *(const f32x4*)(xr + lane * 4 + 256 * i); ss += v[i][0] * v[i][0] + v[i][1] * v[i][1] + v[i][2] * v[i][2] + v[i][3] * v[i][3]; }
#pragma unroll
    for (int o = 32; o >= 1; o >>= 1) ss += __shfl_xor(ss, o);
    const float rstd = rsqrtf(ss * (1.0f / 1024.0f) + 1e-6f);
#pragma unroll
    for (int i = 0; i < 4; ++i) { const f32x4 g = *(const f32x4*)(gain + lane * 4 + 256 * i); *(f32x4*)(out + (size_t)r * DM + lane * 4 + 256 * i) = v[i] * rstd * g; }
  }
}

__device__ __forceinline__ void phase0(const Params& p, ldsp L) {
  const int tid = otid(); const size_t gt = (size_t)blockIdx.x * NTHR + tid, gs = (size_t)gridDim.x * NTHR;
  { f32x4* X = (f32x4*)(lws(p.ws) + O_X); const f32x4* xs = (const f32x4*)p.x; const f32x4* cs = (const f32x4*)p.ctx; const size_t n1 = (size_t)RLAT * DM / 4, n2 = (size_t)ROWS * DM / 4;
    for (size_t i = gt; i < n2; i += gs) X[i] = i < n1 ? xs[i] : cs[i - n1]; }
  { bf16_t* D = (bf16_t*)(lws(p.ws) + O_DFT);
    for (size_t v = gt; v < (size_t)4096 * 512; v += gs) { const int k = (int)(v >> 9), j0 = (int)(v & 511) * 8; float o[8];
#pragma unroll
      for (int e = 0; e < 8; ++e) { const int j = j0 + e; const bool cs_ = j <= 2048; const int t = cs_ ? j : j - 2048; const int r = (k * t) & 4095; const float a = (float)r * (1.0f / 2048.0f);
        o[e] = cs_ ? cospif(a) * (1.0f / 64.0f) : -sinpif(a) * (1.0f / 64.0f); }
      u32x4 w; w.x = cvt_pk_bf16(o[0], o[1]); w.y = cvt_pk_bf16(o[2], o[3]); w.z = cvt_pk_bf16(o[4], o[5]); w.w = cvt_pk_bf16(o[6], o[7]);
      *(u32x4*)(D + (size_t)k * 4096 + j0) = w; } }
  for (int idx = tid; idx < 9 * 1024; idx += NTHR) { const int j = idx >> 10, k = idx & 1023; const float v = j < 8 ? p.c[j * 1024 + k] : p.c_ctx[k]; ldsst<float>(L, idx * 4, siluf_(v)); }
  __syncthreads();
  float* MOD = (float*)(lws(p.ws) + O_MOD);
  for (int item = blockIdx.x; item < DEPTH * 144; item += gridDim.x) {
    const int l = item / 144, n0 = (item - l * 144) * 64, ks = tid >> 6, cn = tid & 63;
    float acc[9];
#pragma unroll
    for (int j = 0; j < 9; ++j) acc[j] = 0.f;
    const float* wp = p.w_ada + ((size_t)l * 1024 + ks * 128) * 9216 + n0 + cn;
#pragma unroll 4
    for (int k = 0; k < 128; ++k) { const float w = wp[(size_t)k * 9216];
#pragma unroll
      for (int j = 0; j < 9; ++j) acc[j] += ldsld<float>(L, (j * 1024 + ks * 128 + k) * 4) * w; }
#pragma unroll
    for (int j = 0; j < 9; ++j) ldsst<float>(L, 36864 + ((ks * 9 + j) * 64 + cn) * 4, acc[j]);
    __syncthreads();
    for (int o = tid; o < 576; o += NTHR) { const int j = o >> 6, c = o & 63; float s = p.b_ada[(size_t)l * 9216 + n0 + c];
#pragma unroll
      for (int q = 0; q < 8; ++q) s += ldsld<float>(L, 36864 + ((q * 9 + j) * 64 + c) * 4);
      MOD[((size_t)l * 9 + j) * 9216 + n0 + c] = s; }
    __syncthreads();
  }
}

__device__ __forceinline__ void prep_phase(const Params& p, int l, ldsp L) {
  const int tid = otid(), lane = tid & 63, wid = tid >> 6, fr = lane & 15, fq = lane >> 4;
  constexpr int KSB = 0, KTL = 17408, VTL = 35840, GL = 54272, AL = 71680, GCL = 104448, BTL = 104960, TOL = 105472;
  const bf16_t* QKV = (const bf16_t*)(lws(p.ws) + O_QKV); const float* AB = (const float*)(lws(p.ws) + O_AB);
  bf16_t* QN = (bf16_t*)(lws(p.ws) + O_QN); bf16_t* KN = (bf16_t*)(lws(p.ws) + O_KN); bf16_t* KNT = (bf16_t*)(lws(p.ws) + O_KNT); bf16_t* VNT = (bf16_t*)(lws(p.ws) + O_VNT);
  bf16_t* TT = (bf16_t*)(lws(p.ws) + O_TT); float* GC = (float*)(lws(p.ws) + O_GC);
  const float* cw = p.conv_w + (size_t)l * 3 * 1536;
  for (int item = blockIdx.x; item < NCH * 4; item += gridDim.x) {
    const int n = item >> 2, h = item & 3, R0 = n * 64;
    { const int row = tid >> 3, cs = tid & 7, r = R0 + row, c0 = cs * 16;
      const int t = r < RLAT ? (r & 4095) : ((r - RLAT) & 255), Ls = r < RLAT ? 4096 : 256;
      const bool hp = t > 0, hn = t < Ls - 1;
#pragma unroll
      for (int mtx = 0; mtx < 3; ++mtx) {
        const int cc = mtx * 512 + h * 128 + c0; const bf16_t* bp = QKV + (size_t)r * 1536 + cc;
        u32x4 a0 = {0, 0, 0, 0}, a1 = {0, 0, 0, 0}, c0v = {0, 0, 0, 0}, c1v = {0, 0, 0, 0};
        const u32x4 b0 = *(const u32x4*)(bp), b1 = *(const u32x4*)(bp + 8);
        if (hp) { a0 = *(const u32x4*)(bp - 1536); a1 = *(const u32x4*)(bp - 1536 + 8); }
        if (hn) { c0v = *(const u32x4*)(bp + 1536); c1v = *(const u32x4*)(bp + 1536 + 8); }
        float val[16]; float ss = 0.f;
#pragma unroll
        for (int e = 0; e < 16; ++e) {
          const unsigned wa = e < 8 ? a0[e >> 1] : a1[(e - 8) >> 1], wb = e < 8 ? b0[e >> 1] : b1[(e - 8) >> 1], wc_ = e < 8 ? c0v[e >> 1] : c1v[(e - 8) >> 1];
          const float xa = (e & 1) ? bfhi(wa) : bflo(wa), xb = (e & 1) ? bfhi(wb) : bflo(wb), xc = (e & 1) ? bfhi(wc_) : bflo(wc_);
          const float y = xa * cw[cc + e] + xb * cw[1536 + cc + e] + xc * cw[3072 + cc + e];
          val[e] = siluf_(y); ss += val[e] * val[e];
        }
        if (mtx < 2) { ss += __shfl_xor(ss, 1); ss += __shfl_xor(ss, 2); ss += __shfl_xor(ss, 4); const float sc = rsqrtf(ss + 1e-6f) * (mtx == 0 ? 0.08838834764831845f : 1.0f);
#pragma unroll
          for (int e = 0; e < 16; ++e) val[e] *= sc; }
        u32x4 w0, w1; w0.x = cvt_pk_bf16(val[0], val[1]); w0.y = cvt_pk_bf16(val[2], val[3]); w0.z = cvt_pk_bf16(val[4], val[5]); w0.w = cvt_pk_bf16(val[6], val[7]);
        w1.x = cvt_pk_bf16(val[8], val[9]); w1.y = cvt_pk_bf16(val[10], val[11]); w1.z = cvt_pk_bf16(val[12], val[13]); w1.w = cvt_pk_bf16(val[14], val[15]);
        if (mtx == 0) { bf16_t* o = QN + (size_t)r * 512 + h * 128 + c0; *(u32x4*)o = w0; *(u32x4*)(o + 8) = w1; }
        else if (mtx == 1) { bf16_t* o = KN + (size_t)r * 512 + h * 128 + c0; *(u32x4*)o = w0; *(u32x4*)(o + 8) = w1;
          ldsst<u32x4>(L, KSB + row * 272 + c0 * 2, w0); ldsst<u32x4>(L, KSB + row * 272 + c0 * 2 + 16, w1);
#pragma unroll
          for (int e = 0; e < 16; ++e) { const unsigned wv = e < 8 ? w0[e >> 1] : w1[(e - 8) >> 1]; ldsst<bf16_t>(L, KTL + (c0 + e) * 144 + row * 2, (bf16_t)((e & 1) ? (wv >> 16) : (wv & 0xffffu))); } }
        else {
#pragma unroll
          for (int e = 0; e < 16; ++e) { const unsigned wv = e < 8 ? w0[e >> 1] : w1[(e - 8) >> 1]; ldsst<bf16_t>(L, VTL + (c0 + e) * 144 + row * 2, (bf16_t)((e & 1) ? (wv >> 16) : (wv & 0xffffu))); } }
      }
    }
    if (wid < 2) {
      const int d = wid, r = R0 + lane;
      const float braw = AB[(size_t)r * 16 + d * 4 + h], araw = AB[(size_t)r * 16 + 8 + d * 4 + h];
      const float beta = sigmoidf_(braw);
      const float xs = araw + p.dt_bias[(l * 2 + d) * 4 + h];
      const float sp = fmaxf(xs, 0.f) + log1pf(__expf(-fabsf(xs)));
      const float g = -__expf(p.a_log[(l * 2 + d) * 4 + h]) * sp;
      float pre = g;
#pragma unroll
      for (int o = 1; o < 64; o <<= 1) { const float t2 = __shfl_up(pre, o); if (lane >= o) pre += t2; }
      const float tot = __shfl(pre, 63);
      const float gc = d == 0 ? pre : (tot - pre + g);
      ldsst<float>(L, GCL + (d * 64 + lane) * 4, gc); ldsst<float>(L, BTL + (d * 64 + lane) * 4, beta);
      GC[((size_t)item * 2 + d) * 64 + lane] = gc;
    }
    __syncthreads();
    { const int ti = wid >> 1;
#pragma unroll
      for (int q = 0; q < 2; ++q) { const int tj = 2 * (wid & 1) + q; f32x4 a = {0.f, 0.f, 0.f, 0.f};
#pragma unroll
        for (int kk = 0; kk < 4; ++kk) a = mma(ldsld<bf16x8>(L, KSB + (16 * tj + fr) * 272 + kk * 64 + fq * 16), ldsld<bf16x8>(L, KSB + (16 * ti + fr) * 272 + kk * 64 + fq * 16), a);
        ldsst<f32x4>(L, GL + ((16 * ti + fr) * 68 + 16 * tj + 4 * fq) * 4, a); }
    }
    {
#pragma unroll
      for (int it = 0; it < 2; ++it) { const int v = tid + 512 * it, c = v >> 3, sg = (v & 7) * 8;
        *(u32x4*)(KNT + (size_t)item * 8192 + c * 64 + sg) = ldsld<u32x4>(L, KTL + c * 144 + sg * 2);
        *(u32x4*)(VNT + (size_t)item * 8192 + c * 64 + sg) = ldsld<u32x4>(L, VTL + c * 144 + sg * 2); } }
    __syncthreads();
    { const int d = tid >> 8, a = (tid & 255) >> 2, jq = tid & 3;
      const int pi_ = d ? 63 - a : a; const float bi = ldsld<float>(L, BTL + (d * 64 + pi_) * 4), gi = ldsld<float>(L, GCL + (d * 64 + pi_) * 4);
#pragma unroll
      for (int e = 0; e < 16; ++e) { const int bb = jq * 16 + e, pr = d ? 63 - bb : bb;
        float v = 0.f;
        if (a > bb) v = bi * ldsld<float>(L, GL + (pi_ * 68 + pr) * 4) * __expf(gi - ldsld<float>(L, GCL + (d * 64 + pr) * 4));
        ldsst<float>(L, AL + ((d * 64 + a) * 64 + bb) * 4, v); } }
    __syncthreads();
    { constexpr int XL = 0, ML = GL; int tid5 = tid; asm volatile("" : "+v"(tid5)); const int wid5 = tid5 >> 6, lane5 = tid5 & 63;
#define XLA(d_, r_, c_) (XL + (((d_) * 64 + (r_)) * 64 + (c_)) * 4)
#define ALA(d_, r_, c_) (AL + (((d_) * 64 + (r_)) * 64 + (c_)) * 4)
      if (wid5 < 2) {
        const int d = wid5, bb = lane5 >> 4, cc = lane5 & 15; float xb[16];
#pragma unroll
        for (int ii = 0; ii < 16; ++ii) {
          float t = (ii == cc) ? 1.f : 0.f;
#pragma unroll
          for (int j4 = 0; j4 < (ii + 3) / 4; ++j4) { const f32x4 av = ldsld<f32x4>(L, ALA(d, 16 * bb + ii, 16 * bb + j4 * 4));
#pragma unroll
            for (int e = 0; e < 4; ++e) if (j4 * 4 + e < ii) t -= av[e] * xb[j4 * 4 + e]; }
          xb[ii] = t; ldsst<float>(L, XLA(d, 16 * bb + ii, 16 * bb + cc), t);
        }
      }
      __syncthreads();
#pragma unroll
      for (int lev = 1; lev <= 3; ++lev) {
        const int nblk = 2 * (4 - lev), nel = nblk * 256;
        for (int o = tid5; o < nel; o += NTHR) {
          const int bl = o >> 8, d = bl & 1, i = lev + (bl >> 1), j = i - lev, r = (o >> 4) & 15, c = o & 15; float acc_ = 0.f;
          for (int m = 0; m < lev; ++m) {
#pragma unroll
            for (int k4 = 0; k4 < 4; ++k4) { const f32x4 av = ldsld<f32x4>(L, ALA(d, 16 * i + r, 16 * (j + m) + 4 * k4));
#pragma unroll
              for (int e = 0; e < 4; ++e) acc_ += av[e] * ldsld<float>(L, XLA(d, 16 * (j + m) + 4 * k4 + e, 16 * j + c)); }
          }
          ldsst<float>(L, ML + o * 4, acc_);
        }
        __syncthreads();
        for (int o = tid5; o < nel; o += NTHR) {
          const int bl = o >> 8, d = bl & 1, i = lev + (bl >> 1), j = i - lev, r = (o >> 4) & 15, c = o & 15; float acc_ = 0.f;
#pragma unroll
          for (int k4 = 0; k4 < 4; ++k4) { const f32x4 dv = ldsld<f32x4>(L, XLA(d, 16 * i + r, 16 * i + 4 * k4));
#pragma unroll
            for (int e = 0; e < 4; ++e) acc_ += dv[e] * ldsld<float>(L, ML + ((bl << 8) + ((4 * k4 + e) << 4) + c) * 4); }
          ldsst<float>(L, XLA(d, 16 * i + r, 16 * j + c), -acc_);
        }
        __syncthreads();
      }
      { const int d = tid5 >> 8, i = (tid5 >> 2) & 63, cq = tid5 & 3, pp = d ? 63 - i : i; float tw[16], tu[16];
#pragma unroll
        for (int e = 0; e < 16; ++e) { const int c = cq * 16 + e, pr = d ? 63 - c : c;
          const float x = ((i >> 4) > cq || ((i >> 4) == cq)) ? ldsld<float>(L, XLA(d, i, c)) : 0.f;
          const float bc = ldsld<float>(L, BTL + (d * 64 + pr) * 4), fw = bc * __expf(ldsld<float>(L, GCL + (d * 64 + pr) * 4));
          tw[e] = x * fw; tu[e] = x * bc; }
#pragma unroll
        for (int e = 0; e < 8; ++e) { const float a0 = tw[e], a1 = tw[15 - e], b0 = tu[e], b1 = tu[15 - e]; tw[e] = d ? a1 : a0; tw[15 - e] = d ? a0 : a1; tu[e] = d ? b1 : b0; tu[15 - e] = d ? b0 : b1; }
        const int pr0 = d ? 63 - (cq * 16 + 15) : cq * 16;
        u32x4 w0, w1;
        w0.x = cvt_pk_bf16(tw[0], tw[1]); w0.y = cvt_pk_bf16(tw[2], tw[3]); w0.z = cvt_pk_bf16(tw[4], tw[5]); w0.w = cvt_pk_bf16(tw[6], tw[7]);
        w1.x = cvt_pk_bf16(tw[8], tw[9]); w1.y = cvt_pk_bf16(tw[10], tw[11]); w1.z = cvt_pk_bf16(tw[12], tw[13]); w1.w = cvt_pk_bf16(tw[14], tw[15]);
        ldsst<u32x4>(L, TOL + ((d * 2 + 0) * 64 + pp) * 144 + pr0 * 2, w0); ldsst<u32x4>(L, TOL + ((d * 2 + 0) * 64 + pp) * 144 + pr0 * 2 + 16, w1);
        w0.x = cvt_pk_bf16(tu[0], tu[1]); w0.y = cvt_pk_bf16(tu[2], tu[3]); w0.z = cvt_pk_bf16(tu[4], tu[5]); w0.w = cvt_pk_bf16(tu[6], tu[7]);
        w1.x = cvt_pk_bf16(tu[8], tu[9]); w1.y = cvt_pk_bf16(tu[10], tu[11]); w1.z = cvt_pk_bf16(tu[12], tu[13]); w1.w = cvt_pk_bf16(tu[14], tu[15]);
        ldsst<u32x4>(L, TOL + ((d * 2 + 1) * 64 + pp) * 144 + pr0 * 2, w0); ldsst<u32x4>(L, TOL + ((d * 2 + 1) * 64 + pp) * 144 + pr0 * 2 + 16, w1);
      }
#undef XLA
#undef ALA
    }
    __syncthreads();
#pragma unroll
    for (int it = 0; it < 4; ++it) { const int v = tid + 512 * it, mtx = v >> 9, row = (v >> 3) & 63, sg = (v & 7) * 8;
      *(u32x4*)(TT + ((size_t)item * 4 + mtx) * 4096 + row * 64 + sg) = ldsld<u32x4>(L, TOL + (mtx * 64 + row) * 144 + sg * 2); }
    __syncthreads();
  }
}

__device__ __forceinline__ void fourier_prep(const Params& p, ldsp L) {
  const int tid = otid(), lane = tid & 63, wid = tid >> 6, fr = lane & 15, fq = lane >> 4;
  constexpr int UA = 0, UB = 33792, DC = 67584;
  const bf16_t* FI = (const bf16_t*)(lws(p.ws) + O_FI); bf16_t* FBT = (bf16_t*)(lws(p.ws) + O_FBT); float* UCS = (float*)(lws(p.ws) + O_UCS);
  for (int idx = tid; idx < 128 * 64; idx += NTHR) { const int rr = idx >> 6, c = idx & 63, m = rr & 63; const float a = (float)((m * c) & 63) * (1.0f / 32.0f);
    const float v = (rr < 64 ? cospif(a) : sinpif(a)) * 0.125f; ldsst<bf16_t>(L, DC + rr * 144 + c * 2, (bf16_t)(cvt_pk_bf16(v, 0.f) & 0xffffu)); }
  __syncthreads();
  for (int item = blockIdx.x; item < 288; item += gridDim.x) {
    const bool lat = item < 256; const int b = lat ? item >> 5 : 0, jb = item & 31;
#pragma unroll
    for (int it = 0; it < 4; ++it) { const int v = tid + 512 * it, row = v >> 5, sg = (v & 31) * 8;
      int ra, rb;
      if (lat) { const int t = 64 * jb + row; ra = b * 4096 + t; rb = b * 4096 + (t == 0 ? 2048 : 4096 - t); } else { ra = RLAT + (item - 256) * 64 + row; rb = ra; }
      ldsst<u32x4>(L, UA + row * 528 + sg * 2, *(const u32x4*)(FI + (size_t)ra * 256 + sg));
      ldsst<u32x4>(L, UB + row * 528 + sg * 2, *(const u32x4*)(FI + (size_t)rb * 256 + sg)); }
    __syncthreads();
    for (int q = 0; q < 8; ++q) {
      const int combo = wid * 8 + q, g = combo >> 4, ti = (combo >> 2) & 3, tm = combo & 3;
      f32x4 ac = {0.f, 0.f, 0.f, 0.f}, as = ac, bc = ac, bs = ac;
#pragma unroll
      for (int kk = 0; kk < 2; ++kk) {
        const bf16x8 xa = ldsld<bf16x8>(L, UA + (16 * ti + fr) * 528 + (g * 64 + kk * 32 + fq * 8) * 2), xb = ldsld<bf16x8>(L, UB + (16 * ti + fr) * 528 + (g * 64 + kk * 32 + fq * 8) * 2);
        const bf16x8 yc = ldsld<bf16x8>(L, DC + (16 * tm + fr) * 144 + kk * 64 + fq * 16), ys = ldsld<bf16x8>(L, DC + (64 + 16 * tm + fr) * 144 + kk * 64 + fq * 16);
        ac = mma(xa, yc, ac); as = mma(xa, ys, as); bc = mma(xb, yc, bc); bs = mma(xb, ys, bs);
      }
      const int mp = g * 64 + 16 * tm + fr, i0 = 16 * ti + 4 * fq;
      if (lat) {
        f32x4 cv = ac + bc, sv = as - bs;
        if (jb == 0 && i0 == 0) { cv[0] = ac[0]; sv[0] = bc[0]; }
        bf16_t* o = FBT + ((size_t)b * 256 + mp) * 4096 + 64 * jb + i0;
        *(u32x2*)o = pack4(cv); *(u32x2*)(o + 2048) = pack4(sv);
      } else {
#pragma unroll
        for (int e = 0; e < 4; ++e) { float* o = UCS + (size_t)((item - 256) * 64 + i0 + e) * 512; o[mp] = ac[e]; o[256 + mp] = as[e]; }
      }
    }
    __syncthreads();
  }
}

__device__ __forceinline__ void ctx_fourier(const Params& p, ldsp L, int wg, int nwg) {
  const int tid = otid(); const float* UCS = (const float*)(lws(p.ws) + O_UCS); bf16_t* PPF = (bf16_t*)(lws(p.ws) + O_PPF);
  for (int idx = tid; idx < 256; idx += NTHR) { const float a = (float)idx * (1.0f / 128.0f); ldsst<float>(L, idx * 4, cospif(a) * (1.0f / 16.0f)); ldsst<float>(L, 1024 + idx * 4, sinpif(a) * (1.0f / 16.0f)); }
  __syncthreads();
  for (int o = wg * NTHR + tid; o < NB * 64 * 256; o += nwg * NTHR) {
    const int mp = o & 255, kq = (o >> 8) & 63, b = o >> 14; const float* u = UCS + (size_t)b * 256 * 512 + mp; float s4[4] = {0.f, 0.f, 0.f, 0.f};
#pragma unroll 16
    for (int t = 0; t < 256; ++t) { const float uc = u[(size_t)t * 512], us = u[(size_t)t * 512 + 256];
#pragma unroll
      for (int e = 0; e < 4; ++e) { const int r = ((4 * kq + e) * t) & 255; s4[e] += ldsld<float>(L, r * 4) * uc - ldsld<float>(L, 1024 + r * 4) * us; } }
#pragma unroll
    for (int e = 0; e < 4; ++e) PPF[(size_t)(RLAT + b * 256 + 4 * kq + e) * 512 + 256 + mp] = (bf16_t)(cvt_pk_bf16(s4[e], 0.f) & 0xffffu);
  }
  __syncthreads();
}
__device__ __forceinline__ void pool_phase(const Params& p, ldsp L, int wg, int nwg) {
  const int tid_ = otid(), lane = tid_ & 63, wv = tid_ >> 6, gw = wg * 8 + wv, nw = nwg * 8;
  const bf16_t* PI = (const bf16_t*)(lws(p.ws) + O_PI); bf16_t* PPF = (bf16_t*)(lws(p.ws) + O_PPF);
  const int LP = wv * 16640;
  for (int idx = gw; idx < 2048; idx += nw) {
    const int g = 3 - (idx >> 9), b = (idx >> 6) & 7, r = idx & 63;
    const int win = 2 << g, hw = win >> 1, sr = max(r - hw, 0), er = min(r - hw + win, 64);
    const bf16_t* base = PI + (size_t)b * 4096 * 256 + g * 64 + lane;
    ldsst<float>(L, LP + lane * 4, 0.f);
    { const int ci = lane >> 3, ch0 = (lane & 7) * 8;
      const bf16_t* bq = PI + (size_t)b * 4096 * 256 + g * 64 + ch0;
#pragma unroll 1
      for (int cb = 0; cb < 8; ++cb) {
        const int cc = cb * 8 + ci; float ac[8];
#pragma unroll
        for (int e = 0; e < 8; ++e) ac[e] = 0.f;
        u32x4 vv[16];
#pragma unroll
        for (int q = 0; q < 16; ++q) { const int rr = sr + q; vv[q] = (u32x4){0u, 0u, 0u, 0u}; if (q < win && rr < er) vv[q] = *(const u32x4*)(bq + (size_t)(rr * 64 + cc) * 256); }
#pragma unroll
        for (int q = 0; q < 16; ++q) {
#pragma unroll
          for (int e = 0; e < 4; ++e) { ac[2 * e] += bflo(vv[q][e]); ac[2 * e + 1] += bfhi(vv[q][e]); } }
        ldsst<f32x4>(L, LP + ((cc + 1) * 64 + ch0) * 4, (f32x4){ac[0], ac[1], ac[2], ac[3]}); ldsst<f32x4>(L, LP + ((cc + 1) * 64 + ch0 + 4) * 4, (f32x4){ac[4], ac[5], ac[6], ac[7]});
      }
      float run = 0.f;
#pragma unroll 8
      for (int cc = 1; cc <= 64; ++cc) { run += ldsld<float>(L, LP + (cc * 64 + lane) * 4); ldsst<float>(L, LP + (cc * 64 + lane) * 4, run); }
    }
    const float rinv = 1.0f / (float)(er - sr);
#pragma unroll 16
    for (int c = 0; c < 64; ++c) {
      const int sc = max(c - hw, 0), ec = min(c - hw + win, 64);
      const float box = ldsld<float>(L, LP + (ec * 64 + lane) * 4) - ldsld<float>(L, LP + (sc * 64 + lane) * 4);
      const size_t rowi = (size_t)b * 4096 + r * 64 + c;
      const float self = __uint_as_float((unsigned)PI[rowi * 256 + g * 64 + lane] << 16);
      PPF[rowi * 512 + g * 64 + lane] = (bf16_t)(cvt_pk_bf16(box * rinv / (float)(ec - sc) - self, 0.f) & 0xffffu);
    }
  }
  for (int r = RLAT + gw; r < ROWS; r += nw) {
    const int base = r & ~255, t = r - base;
#pragma unroll
    for (int g = 0; g < 4; ++g) {
      const int win = 2 << g, hw = win >> 1, sc = max(t - hw, 0), ec = min(t - hw + win, 256);
      float s_ = 0.f;
#pragma unroll
      for (int q = 0; q < (2 << g); ++q) { const int c = sc + q; if (c < ec) s_ += __uint_as_float((unsigned)PI[(size_t)(base + c) * 256 + g * 64 + lane] << 16); }
      const float self = __uint_as_float((unsigned)PI[(size_t)r * 256 + g * 64 + lane] << 16);
      PPF[(size_t)r * 512 + g * 64 + lane] = (bf16_t)(cvt_pk_bf16(s_ / (float)(ec - sc) - self, 0.f) & 0xffffu);
    }
  }
}

__device__ __forceinline__ void scan_phase(const Params& p, ldsp L, int item) {
  const int tid = otid(), lane = tid & 63, wid = tid >> 6, fr = lane & 15, fq = lane >> 4;
  const int es = item & 1, d = (item >> 1) & 1, h = (item >> 2) & 3, b = item >> 4;
  const int ti = wid >> 1, half = wid & 1;
  constexpr int QS = 0, KS = 17408, KTS = 34816, VTS = 53248, TW = 62464, TU = 71680, AT = 80896, WL = 90112, VNT_ = 107520, VNS = 116736, STL = 125952, GCL = 143360;
  const bf16_t* QN = (const bf16_t*)(lws(p.ws) + O_QN); const bf16_t* KN = (const bf16_t*)(lws(p.ws) + O_KN); const bf16_t* KNT = (const bf16_t*)(lws(p.ws) + O_KNT); const bf16_t* VNT = (const bf16_t*)(lws(p.ws) + O_VNT);
  const bf16_t* TT = (const bf16_t*)(lws(p.ws) + O_TT); const float* GC = (const float*)(lws(p.ws) + O_GC); bf16_t* O = (bf16_t*)(lws(p.ws) + O_O) + (size_t)d * ROWS * 512;
  { unsigned zz_; asm volatile("v_mov_b32 %0, 0" : "=v"(zz_)); for (int o = tid * 16; o < 17408; o += NTHR * 16) ldsst<u32x4>(L, STL + o, (u32x4){zz_, zz_, zz_, zz_}); }
  f32x4 accS[4];
#pragma unroll
  for (int q = 0; q < 4; ++q) accS[q] = (f32x4){0.f, 0.f, 0.f, 0.f};
  u32x4 rq[2], rk[2], rkt[2], rvt, rtw, rtu; float rgc = 0.f;
#define SCAN_CHUNK(s) ((s) < 4 ? (NB * 64 + b * 4 + (d ? 3 - (s) : (s))) : (b * 64 + (d ? 67 - (s) : (s) - 4)))
#define SCAN_GLOAD(s) do { const int n_ = SCAN_CHUNK(s), it2_ = n_ * 4 + h; \
    _Pragma("unroll") for (int it = 0; it < 2; ++it) { const int v = tid + 512 * it; \
      rq[it] = *(const u32x4*)(QN + (size_t)(64 * n_ + (v >> 4)) * 512 + h * 128 + (v & 15) * 8); rk[it] = *(const u32x4*)(KN + (size_t)(64 * n_ + (v >> 4)) * 512 + h * 128 + (v & 15) * 8); \
      rkt[it] = *(const u32x4*)(KNT + (size_t)it2_ * 8192 + (v >> 3) * 64 + (v & 7) * 8); } \
    rvt = *(const u32x4*)(VNT + (size_t)it2_ * 8192 + (es * 64 + (tid >> 3)) * 64 + (tid & 7) * 8); \
    rtw = *(const u32x4*)(TT + ((size_t)it2_ * 4 + d * 2 + 0) * 4096 + (tid >> 3) * 64 + (tid & 7) * 8); rtu = *(const u32x4*)(TT + ((size_t)it2_ * 4 + d * 2 + 1) * 4096 + (tid >> 3) * 64 + (tid & 7) * 8); \
    if (tid < 64) rgc = GC[((size_t)it2_ * 2 + d) * 64 + tid]; } while (0)
#define SCAN_LSTORE() do { \
    _Pragma("unroll") for (int it = 0; it < 2; ++it) { const int v = tid + 512 * it; \
      ldsst<u32x4>(L, QS + (v >> 4) * 272 + (v & 15) * 16, rq[it]); ldsst<u32x4>(L, KS + (v >> 4) * 272 + (v & 15) * 16, rk[it]); ldsst<u32x4>(L, KTS + (v >> 3) * 144 + (v & 7) * 16, rkt[it]); } \
    ldsst<u32x4>(L, VTS + (tid >> 3) * 144 + (tid & 7) * 16, rvt); ldsst<u32x4>(L, TW + (tid >> 3) * 144 + (tid & 7) * 16, rtw); ldsst<u32x4>(L, TU + (tid >> 3) * 144 + (tid & 7) * 16, rtu); \
    if (tid < 64) ldsst<float>(L, GCL + tid * 4, rgc); } while (0)
  SCAN_GLOAD(0); SCAN_LSTORE(); __syncthreads();
  for (int s = 0; s < 68; ++s) {
    const int n = SCAN_CHUNK(s);
    if (s + 1 < 68) SCAN_GLOAD(s + 1);
    const float gtot = ldsld<float>(L, GCL + (d ? 0 : 63) * 4);
    f32x4 uacc[2], qacc[2];
    {
      bf16x8 qf[4], kf[2][4], twf[2], tuf[2], vtf[2][2], ktf[4][2], sf[2][4];
#pragma unroll
      for (int kk = 0; kk < 4; ++kk) qf[kk] = ldsld<bf16x8>(L, QS + (16 * ti + fr) * 272 + kk * 64 + fq * 16);
#pragma unroll
      for (int q = 0; q < 2; ++q)
#pragma unroll
        for (int kk = 0; kk < 4; ++kk) { kf[q][kk] = ldsld<bf16x8>(L, KS + (16 * (2 * half + q) + fr) * 272 + kk * 64 + fq * 16); sf[q][kk] = ldsld<bf16x8>(L, STL + (16 * (2 * half + q) + fr) * 272 + kk * 64 + fq * 16); }
      f32x4 at[2], wv[4];
#pragma unroll
      for (int q = 0; q < 2; ++q) { at[q] = (f32x4){0.f, 0.f, 0.f, 0.f}; qacc[q] = at[q]; uacc[q] = at[q]; }
#pragma unroll
      for (int q = 0; q < 4; ++q) wv[q] = (f32x4){0.f, 0.f, 0.f, 0.f};
#pragma unroll
      for (int kk = 0; kk < 4; ++kk)
#pragma unroll
        for (int q = 0; q < 2; ++q) { at[q] = mma(kf[q][kk], qf[kk], at[q]); qacc[q] = mma(sf[q][kk], qf[kk], qacc[q]); }
      __builtin_amdgcn_sched_barrier(0);
#pragma unroll
      for (int kk = 0; kk < 2; ++kk) { twf[kk] = ldsld<bf16x8>(L, TW + (16 * ti + fr) * 144 + kk * 64 + fq * 16); tuf[kk] = ldsld<bf16x8>(L, TU + (16 * ti + fr) * 144 + kk * 64 + fq * 16); }
#pragma unroll
      for (int q = 0; q < 4; ++q)
#pragma unroll
        for (int kk = 0; kk < 2; ++kk) ktf[q][kk] = ldsld<bf16x8>(L, KTS + (16 * (4 * half + q) + fr) * 144 + kk * 64 + fq * 16);
#pragma unroll
      for (int q = 0; q < 2; ++q)
#pragma unroll
        for (int kk = 0; kk < 2; ++kk) vtf[q][kk] = ldsld<bf16x8>(L, VTS + (16 * (2 * half + q) + fr) * 144 + kk * 64 + fq * 16);
#pragma unroll
      for (int kk = 0; kk < 2; ++kk) {
#pragma unroll
        for (int q = 0; q < 4; ++q) wv[q] = mma(ktf[q][kk], twf[kk], wv[q]);
#pragma unroll
        for (int q = 0; q < 2; ++q) uacc[q] = mma(tuf[kk], vtf[q][kk], uacc[q]);
      }
      const int i = 16 * ti + fr; const float gi = ldsld<float>(L, GCL + i * 4);
#pragma unroll
      for (int q = 0; q < 2; ++q) {
        const int j0 = 16 * (2 * half + q) + 4 * fq; f32x4 a = at[q];
#pragma unroll
        for (int e = 0; e < 4; ++e) { const int j = j0 + e; const bool keep = d ? (i <= j) : (i >= j); const float ar = keep ? gi - ldsld<float>(L, GCL + j * 4) : 0.f; a[e] = keep ? a[e] * __expf(ar) : 0.f; }
        ldsst<u32x2>(L, AT + i * 144 + j0 * 2, pack4(a));
      }
#pragma unroll
      for (int q = 0; q < 4; ++q) ldsst<u32x2>(L, WL + (16 * ti + fr) * 272 + (16 * (4 * half + q) + 4 * fq) * 2, pack4(wv[q]));
    }
    __syncthreads();
    {
      bf16x8 wf[4], sf[2][4];
#pragma unroll
      for (int kk = 0; kk < 4; ++kk) { wf[kk] = ldsld<bf16x8>(L, WL + (16 * ti + fr) * 272 + kk * 64 + fq * 16);
#pragma unroll
        for (int q = 0; q < 2; ++q) sf[q][kk] = ldsld<bf16x8>(L, STL + (16 * (2 * half + q) + fr) * 272 + kk * 64 + fq * 16); }
      f32x4 a[2];
#pragma unroll
      for (int q = 0; q < 2; ++q) a[q] = (f32x4){0.f, 0.f, 0.f, 0.f};
#pragma unroll
      for (int kk = 0; kk < 4; ++kk)
#pragma unroll
        for (int q = 0; q < 2; ++q) a[q] = mma(wf[kk], sf[q][kk], a[q]);
      const int i0 = 16 * ti + 4 * fq; float sc4[4];
#pragma unroll
      for (int e = 0; e < 4; ++e) sc4[e] = __expf(gtot - ldsld<float>(L, GCL + (i0 + e) * 4));
#pragma unroll
      for (int q = 0; q < 2; ++q) {
        const int te = 2 * half + q; const f32x4 vn = uacc[q] - a[q]; f32x4 vs;
#pragma unroll
        for (int e = 0; e < 4; ++e) vs[e] = vn[e] * sc4[e];
        ldsst<u32x2>(L, VNT_ + (16 * te + fr) * 144 + i0 * 2, pack4(vn)); ldsst<u32x2>(L, VNS + (16 * te + fr) * 144 + i0 * 2, pack4(vs));
      }
    }
    __syncthreads();
    {
      bf16x8 af[2], vf[2][2], nsf[2], ktf[4][2];
#pragma unroll
      for (int q = 0; q < 4; ++q)
#pragma unroll
        for (int kk = 0; kk < 2; ++kk) ktf[q][kk] = ldsld<bf16x8>(L, KTS + (16 * (4 * half + q) + fr) * 144 + kk * 64 + fq * 16);
#pragma unroll
      for (int kk = 0; kk < 2; ++kk) { af[kk] = ldsld<bf16x8>(L, AT + (16 * ti + fr) * 144 + kk * 64 + fq * 16); nsf[kk] = ldsld<bf16x8>(L, VNS + (16 * ti + fr) * 144 + kk * 64 + fq * 16);
#pragma unroll
        for (int q = 0; q < 2; ++q) vf[q][kk] = ldsld<bf16x8>(L, VNT_ + (16 * (2 * half + q) + fr) * 144 + kk * 64 + fq * 16); }
      const float cd = __expf(gtot);
      f32x4 ov[2];
#pragma unroll
      for (int q = 0; q < 2; ++q) ov[q] = (f32x4){0.f, 0.f, 0.f, 0.f};
#pragma unroll
      for (int q = 0; q < 4; ++q) accS[q] = accS[q] * cd;
#pragma unroll
      for (int kk = 0; kk < 2; ++kk) {
#pragma unroll
        for (int q = 0; q < 2; ++q) ov[q] = mma(vf[q][kk], af[kk], ov[q]);
#pragma unroll
        for (int q = 0; q < 4; ++q) accS[q] = mma(ktf[q][kk], nsf[kk], accS[q]);
      }
      const int i = 16 * ti + fr; const float eg = __expf(ldsld<float>(L, GCL + i * 4));
#pragma unroll
      for (int q = 0; q < 2; ++q) { const f32x4 o4 = qacc[q] * eg + ov[q];
        *(u32x2*)(O + (size_t)(64 * n + i) * 512 + h * 128 + es * 64 + 16 * (2 * half + q) + 4 * fq) = pack4(o4); }
    }
    __syncthreads();
#pragma unroll
    for (int q = 0; q < 4; ++q) ldsst<u32x2>(L, STL + (16 * ti + fr) * 272 + (16 * (4 * half + q) + 4 * fq) * 2, pack4(accS[q]));
    if (s + 1 < 68) SCAN_LSTORE();
    __syncthreads();
  }
#undef SCAN_CHUNK
#undef SCAN_GLOAD
#undef SCAN_LSTORE
}

__device__ __forceinline__ void ofprep_phase(const Params& p, int l) {
  const int tid_ = otid(), lane = tid_ & 63, gw = blockIdx.x * 8 + (tid_ >> 6), nw = gridDim.x * 8;
  const bf16_t* O0 = (const bf16_t*)(lws(p.ws) + O_O); const bf16_t* O1 = O0 + (size_t)ROWS * 512; const bf16_t* Z = (const bf16_t*)(lws(p.ws) + O_Z); bf16_t* OF = (bf16_t*)(lws(p.ws) + O_OF);
  const float* og = p.o_gain + (size_t)l * 128 + (lane & 15) * 8;
  for (int r = gw; r < ROWS; r += nw) {
    const u32x4 a = *(const u32x4*)(O0 + (size_t)r * 512 + lane * 8), bq = *(const u32x4*)(O1 + (size_t)r * 512 + lane * 8), zq = *(const u32x4*)(Z + (size_t)r * 512 + lane * 8);
    float o[8]; float ss = 0.f;
#pragma unroll
    for (int e = 0; e < 4; ++e) { o[2 * e] = bflo(a[e]) + bflo(bq[e]); o[2 * e + 1] = bfhi(a[e]) + bfhi(bq[e]); ss += o[2 * e] * o[2 * e] + o[2 * e + 1] * o[2 * e + 1]; }
    ss += __shfl_xor(ss, 1); ss += __shfl_xor(ss, 2); ss += __shfl_xor(ss, 4); ss += __shfl_xor(ss, 8);
    const float rstd = rsqrtf(ss * (1.0f / 128.0f) + 1e-6f);
    float y[8];
#pragma unroll
    for (int e = 0; e < 4; ++e) { y[2 * e] = o[2 * e] * rstd * og[2 * e] * siluf_(bflo(zq[e])); y[2 * e + 1] = o[2 * e + 1] * rstd * og[2 * e + 1] * siluf_(bfhi(zq[e])); }
    u32x4 w; w.x = cvt_pk_bf16(y[0], y[1]); w.y = cvt_pk_bf16(y[2], y[3]); w.z = cvt_pk_bf16(y[4], y[5]); w.w = cvt_pk_bf16(y[6], y[7]);
    *(u32x4*)(OF + (size_t)r * 512 + lane * 8) = w;
  }
}


#define XB_TMO      128
#define XB_XCNT(j)  (256  + 64 * (j))
#define XB_XSUB(j)  (1280 + 64 * (j))
#define XB_XGEN(j)  (2304 + 64 * (j))
#define XB_TOP      3328
#define XB_TOPGEN   3392
#define XCD_BAR_WORDS 3456
#define XB_SPIN_CAP (1u << 18)

__device__ __forceinline__ unsigned xb_ld(unsigned* p)              { return __hip_atomic_load(p, __ATOMIC_RELAXED, __HIP_MEMORY_SCOPE_AGENT); }
__device__ __forceinline__ unsigned xb_add(unsigned* p, unsigned v) { return __hip_atomic_fetch_add(p, v, __ATOMIC_RELAXED, __HIP_MEMORY_SCOPE_AGENT); }
__device__ __forceinline__ unsigned xb_xcc_id() { return (unsigned)__builtin_amdgcn_s_getreg((3 << 11) | 20) & 0xFu; }
#define XB_SPIN(cond, bar) do { unsigned _sp = 0; while (cond) { __builtin_amdgcn_s_sleep(1); \
    if ((++_sp & 255u) == 0u) { if (xb_ld(&(bar)[XB_TMO])) break; if (_sp > XB_SPIN_CAP) { atomicAdd(&(bar)[XB_TMO], 1u); break; } } } } while (0)

struct XcdBarrier {
    unsigned* bar; unsigned x;
    volatile LAS unsigned* st;
};

__device__ __forceinline__ XcdBarrier xcd_barrier_post(unsigned* bar, volatile LAS unsigned* st) {
    XcdBarrier b; b.bar = bar; b.x = xb_xcc_id(); b.st = st;
    if (threadIdx.x == 0) (void)xb_add(&bar[XB_XCNT(b.x)], 1u);
    return b;
}
__device__ __forceinline__ void xcd_barrier_complete(unsigned* bar, unsigned x, unsigned& nloc, unsigned& nx) {
    const unsigned G = gridDim.x * gridDim.y * gridDim.z;
    unsigned sum, cnt, mine, sp = 0u;
    for (;;) {
        sum = 0u; cnt = 0u; mine = 0u;
#pragma unroll
        for (unsigned j = 0; j < 16; ++j) { const unsigned c = xb_ld(&bar[XB_XCNT(j)]); sum += c; cnt += (c > 0u) ? 1u : 0u; mine = (j == x) ? c : mine; }
        if (sum == G) break;
        __builtin_amdgcn_s_sleep(1);
        if ((++sp & 255u) == 0u) { if (xb_ld(&bar[XB_TMO])) break; if (sp > XB_SPIN_CAP) { atomicAdd(&bar[XB_TMO], 1u); break; } }
    }
    nloc = mine > 0u ? mine : 1u; nx = cnt > 0u ? cnt : 1u;
}

__device__ __forceinline__ void xcd_barrier(const XcdBarrier& b) {
    asm volatile("s_waitcnt vmcnt(0)" ::: "memory");
    __syncthreads();
    if (threadIdx.x == 0) {
        unsigned* bar = b.bar;
        __builtin_amdgcn_s_waitcnt(0);
        unsigned nloc = b.st[0], nx = b.st[1];
        if (nloc == 0u) { xcd_barrier_complete(bar, b.x, nloc, nx); b.st[0] = nloc; b.st[1] = nx; }
        const unsigned old = xb_add(&bar[XB_XSUB(b.x)], 1u);
        const unsigned gen = old / nloc;
        if (old + 1u == (gen + 1u) * nloc) {
            __builtin_amdgcn_fence(__ATOMIC_RELEASE, "agent");
            asm volatile("s_waitcnt vmcnt(0)" ::: "memory");
            const unsigned og = xb_add(&bar[XB_TOP], 1u);
            const unsigned tg = og / nx;
            if (og + 1u == (tg + 1u) * nx) xb_add(&bar[XB_TOPGEN], 1u);
            else XB_SPIN(xb_ld(&bar[XB_TOPGEN]) == tg, bar);
            __builtin_amdgcn_fence(__ATOMIC_ACQUIRE, "agent");
            xb_add(&bar[XB_XGEN(b.x)], 1u);
            asm volatile("s_waitcnt vmcnt(0)" ::: "memory");
        } else {
            XB_SPIN(xb_ld(&bar[XB_XGEN(b.x)]) == gen, bar);
            __builtin_amdgcn_fence(__ATOMIC_ACQUIRE, "agent");
            asm volatile("s_waitcnt vmcnt(0)" ::: "memory");
        }
    }
    __syncthreads();
}


__device__ __forceinline__ float rdb(const bf16_t* s_, size_t n, size_t i) { float a = 0.f; for (size_t j = i; j < n; j += (size_t)RLAT * DM) a += __uint_as_float((unsigned)s_[j] << 16); return a; }
__device__ __forceinline__ float rdf(const float* s_, size_t n, size_t i) { float a = 0.f; for (size_t j = i; j < n; j += (size_t)RLAT * DM) a += s_[j]; return a; }
__device__ __forceinline__ void dump_phase(const Params& p, int which) {
  const size_t NO = (size_t)RLAT * DM; unsigned char* ws = lws(p.ws);
  for (size_t i = (size_t)blockIdx.x * NTHR + otid(); i < NO; i += (size_t)gridDim.x * NTHR) {
    float a = 0.f;
    if (which == 1) { a = rdb((const bf16_t*)(ws + O_QKV), (size_t)ROWS * 1536, i) + rdb((const bf16_t*)(ws + O_Z), (size_t)ROWS * 512, i) + rdb((const bf16_t*)(ws + O_PI), (size_t)ROWS * 256, i) + rdb((const bf16_t*)(ws + O_FI), (size_t)ROWS * 256, i) + rdf((const float*)(ws + O_AB), (size_t)ROWS * 16, i); }
    if (which == 2) { a = rdb((const bf16_t*)(ws + O_QN), (size_t)ROWS * 512, i) + rdb((const bf16_t*)(ws + O_KN), (size_t)ROWS * 512, i) + rdb((const bf16_t*)(ws + O_KNT), (size_t)ROWS * 512, i) + rdb((const bf16_t*)(ws + O_VNT), (size_t)ROWS * 512, i) + rdb((const bf16_t*)(ws + O_TT), (size_t)ROWS * 1024, i) + rdf((const float*)(ws + O_GC), (size_t)NCH * 4 * 2 * 64, i)
          + rdb((const bf16_t*)(ws + O_FBT), (size_t)NB * 256 * 4096, i) + rdf((const float*)(ws + O_UCS), (size_t)NB * CTX * 512, i); }
    if (which == 3) { a = rdb((const bf16_t*)(ws + O_O), (size_t)ROWS * 1024, i); }
    if (which == 4) { a = rdb((const bf16_t*)(ws + O_OF), (size_t)ROWS * 512, i) + rdb((const bf16_t*)(ws + O_HN), (size_t)ROWS * 1024, i); }
    if (which == 5) { a = rdb((const bf16_t*)(ws + O_MRG), (size_t)ROWS * 1024, i); }
    if ((__float_as_uint(a) & 0xffff0000u) == 0xaaaa0000u) a = 1234.5f;
    if (!(a == a) || fabsf(a) > 1e30f) a = 777.0f;
    a = a * 0.5f + 0.12345678f;
    p.out[i] = a;
  }
}
__global__ void __launch_bounds__(NTHR) fwd_megakernel(Params p) {
  ldsp L = (ldsp)g_shm;
  cg::grid_group grid = cg::this_grid();
  volatile LAS unsigned* xst = (volatile LAS unsigned*)(L + LDS_BYTES - 16);
  if (threadIdx.x < 4) xst[threadIdx.x] = 0u;
  if (threadIdx.x == 0) { const unsigned long long wa_ = (unsigned long long)p.ws; *(volatile LAS unsigned*)(L + LDS_BYTES - 32) = (unsigned)wa_; *(volatile LAS unsigned*)(L + LDS_BYTES - 28) = (unsigned)(wa_ >> 32); }
  __syncthreads();
  XcdBarrier xbar = xcd_barrier_post((unsigned*)(p.ws + O_BAR), xst);
#define GSYNC0() do { asm volatile("s_waitcnt vmcnt(0) lgkmcnt(0)" ::: "memory"); __builtin_amdgcn_fence(__ATOMIC_RELEASE, "agent"); grid.sync(); __builtin_amdgcn_fence(__ATOMIC_ACQUIRE, "agent"); } while (0)
#define GSYNC() xcd_barrier(xbar)
  const int G = gridDim.x, c = blockIdx.x;
#define X ((float*)(lws(p.ws) + O_X))
#define MOD ((const float*)(lws(p.ws) + O_MOD))
#define Hn ((bf16_t*)(lws(p.ws) + O_HN))
#ifndef NO_P0
  phase0(p, L);
#endif
  GSYNC0();
  for (int l = 0; l < DEPTH; ++l) {
    const float* modl = MOD + (size_t)l * 9 * 9216; const float* ng = p.norm_gain + (size_t)l * 3 * 1024; const int notlast = (l != DEPTH - 1) ? 1 : 0, nMx = notlast ? ROWS / 256 : RLAT / 256;
#ifndef PROBE_CONV
#define PROBE_CONV 1
#endif
    { int cur_ = 0;
      if (l == 0) { convert_ffn(p, p.w1gu, p.w1d, O_WGU, O_WD, L, cur_, c, G); convert_win(p, 0, L, cur_, c, G); }
      convert_mixer(p, l, L, cur_); }
    norm_phase(X, Hn, ng, modl, 0, 1, l > 0 ? (const float*)(lws(p.ws) + O_TT) : nullptr);
    GSYNC();
#ifndef PROBE_UP
#define PROBE_UP 1
#endif
    for (int rep_ = 0; rep_ < PROBE_UP; ++rep_)
    { pg8::PlainSched S{(const char*)Hn, (const char*)(lws(p.ws) + O_WGU), 2048, 2048, 16, ROWS / 256, 22, G, c}; EpiUp E{(bf16_t*)(lws(p.ws) + O_ACT)}; pg8::gemm_phase(L, S, E); }
    GSYNC();
    { pg8::ResSched S{(const char*)(lws(p.ws) + O_ACT), (const char*)(lws(p.ws) + O_WD), DFF * 2, DFF / 64, G, c, 0}; EpiResT<false> E{(float*)(p.ws + O_X), modl, 2, 0.5f}; pg8::gemm_phase(L, S, E); }
    if (1) { pg8::ResSched S{(const char*)(lws(p.ws) + O_ACT), (const char*)(lws(p.ws) + O_WD), DFF * 2, DFF / 64, G, c, 1}; EpiPart E{(float*)(lws(p.ws) + O_TT), modl, 2, 0.5f}; pg8::gemm_phase(L, S, E); }
    GSYNC();
#ifndef NO_MIXER
    norm_phase(X, Hn, ng + 1024, modl, 3, 4, (const float*)(lws(p.ws) + O_TT));
    GSYNC();
#ifndef PROBE_IN
#define PROBE_IN 1
#endif
    for (int rep_ = 0; rep_ < PROBE_IN; ++rep_)
    { pg8::PlainSched S{(const char*)Hn, (const char*)(lws(p.ws) + O_WIN), 2048, 2048, 16, ROWS / 256, NINP / 256, G, c};
      EpiIn E{(bf16_t*)(lws(p.ws) + O_QKV), (bf16_t*)(lws(p.ws) + O_Z), (bf16_t*)(lws(p.ws) + O_PI), (bf16_t*)(lws(p.ws) + O_FI), (float*)(lws(p.ws) + O_AB)}; pg8::gemm_phase(L, S, E); }
    GSYNC();
#ifndef PROBE_PREP
#define PROBE_PREP 1
#endif
    for (int rep_ = 0; rep_ < PROBE_PREP; ++rep_) {
    prep_phase(p, l, L);
    }
#ifndef NO_FPREP
    fourier_prep(p, L);
#endif
    GSYNC();
#if defined(DUMP) && DUMP == 2
    dump_phase(p, 2); return;
#endif
#ifndef PROBE_SCAN
#define PROBE_SCAN 1
#endif
#ifndef PROBE_OTHER
#define PROBE_OTHER 1
#endif
    for (int rep_ = 0; rep_ < PROBE_SCAN; ++rep_) {
#ifndef NO_SCAN
    if (c < 128) scan_phase(p, L, c);
#else
    if (c < 128) {}
#endif
    else for (int rep2_ = 0; rep2_ < PROBE_OTHER; ++rep2_) {
      __syncthreads();
      { FourSched S{(const char*)(lws(p.ws) + O_DFT), (const char*)(lws(p.ws) + O_FBT), c - 128}; EpiBf E{(bf16_t*)(lws(p.ws) + O_PPF) + 256, 512}; pg8::gemm_phase(L, S, E); }
      __syncthreads();
      ctx_fourier(p, L, c - 128, G - 128);
      pool_phase(p, L, c - 128, G - 128);
    }
    __syncthreads();
    }
    GSYNC();
#if defined(DUMP) && DUMP == 3
    dump_phase(p, 3); return;
#endif
#ifndef PROBE_OFP
#define PROBE_OFP 1
#endif
    for (int rep_ = 0; rep_ < PROBE_OFP; ++rep_) {
    ofprep_phase(p, l);
    norm_phase(X, Hn, ng + 1024, modl, 3, 4, nullptr);
    }
    GSYNC();
#if defined(DUMP) && DUMP == 4
    dump_phase(p, 4); return;
#endif
#ifndef PROBE_MRG
#define PROBE_MRG 1
#endif
    for (int rep_ = 0; rep_ < PROBE_MRG; ++rep_)
    { MergeSched S{(const char*)Hn, (const char*)(lws(p.ws) + O_OF), (const char*)(lws(p.ws) + O_PPF), (const char*)(lws(p.ws) + O_WG), (const char*)(lws(p.ws) + O_WCAT), G, c, RLAT / 256};
      EpiMerge E{(unsigned*)(lws(p.ws) + O_SCR) + (size_t)c * 2 * 32768, (bf16_t*)(lws(p.ws) + O_MRG)}; pg8::gemm_phase(L, S, E); }
    if (notlast) { MergeCtxSched S{(const char*)Hn, (const char*)(lws(p.ws) + O_OF), (const char*)(lws(p.ws) + O_PPF), (const char*)(lws(p.ws) + O_WG), (const char*)(lws(p.ws) + O_WCAT), c};
      EpiMergeCtx E{(unsigned*)(lws(p.ws) + O_SCR) + (size_t)c * 2 * 32768, (bf16_t*)(lws(p.ws) + O_PARTM)}; pg8::gemm_phase(L, S, E); }
    if (notlast && c >= 96) {
      int cur_ = 0; convert_ffn(p, p.w2gu + (size_t)l * 1024 * 2 * DFF, p.w2d + (size_t)l * DFF * 1024, O_WGU2, O_WD2, L, cur_, c - 96, G - 96);
      convert_ffn(p, p.w1gu + (size_t)(l + 1) * 1024 * 2 * DFF, p.w1d + (size_t)(l + 1) * DFF * 1024, O_WGU, O_WD, L, cur_, c - 96, G - 96);
      convert_win(p, l + 1, L, cur_, c - 96, G - 96); }
    GSYNC();
#if defined(DUMP) && DUMP == 5
    dump_phase(p, 5); return;
#endif
    { pg8::ResSched S{(const char*)(lws(p.ws) + O_MRG), (const char*)(lws(p.ws) + O_WOUT), 2048, 16, G, c, 0}; EpiResT<false> E{(float*)(p.ws + O_X), modl, 5, 1.0f}; pg8::gemm_phase(L, S, E); }
    if (notlast) { pg8::ResSched S{(const char*)(lws(p.ws) + O_PARTM) - (size_t)128 * 256 * 6144, (const char*)(lws(p.ws) + O_WOUT3), 6144, 48, G, c, 1}; EpiPart E{(float*)(lws(p.ws) + O_TT), modl, 5, 1.0f}; pg8::gemm_phase(L, S, E); }
    GSYNC();
#endif
    if (!notlast) { int cur_ = 0; convert_ffn(p, p.w2gu + (size_t)l * 1024 * 2 * DFF, p.w2d + (size_t)l * DFF * 1024, O_WGU2, O_WD2, L, cur_, c, G); }
    norm_phase(X, Hn, ng + 2048, modl, 6, 7, notlast ? (const float*)(lws(p.ws) + O_TT) : nullptr);
    GSYNC();
    { pg8::PlainSched S{(const char*)Hn, (const char*)(lws(p.ws) + O_WGU2), 2048, 2048, 16, nMx, 22, G, c}; EpiUp E{(bf16_t*)(lws(p.ws) + O_ACT)}; pg8::gemm_phase(L, S, E); }
    GSYNC();
    { pg8::ResSched S{(const char*)(lws(p.ws) + O_ACT), (const char*)(lws(p.ws) + O_WD2), DFF * 2, DFF / 64, G, c, 0}; EpiResT<false> E{(float*)(p.ws + O_X), modl, 8, 0.5f}; pg8::gemm_phase(L, S, E); }
    if (notlast) { pg8::ResSched S{(const char*)(lws(p.ws) + O_ACT), (const char*)(lws(p.ws) + O_WD2), DFF * 2, DFF / 64, G, c, 1}; EpiPart E{(float*)(lws(p.ws) + O_TT), modl, 8, 0.5f}; pg8::gemm_phase(L, S, E); }
    GSYNC();
  }
  final_norm(X, p.out, p.final_gain);
}

extern "C" void kernel_launch(void* const* d_in, const int* in_sizes, int n_in, void* d_out, int out_size, void* d_ws, size_t ws_size, hipStream_t stream) {
  (void)in_sizes; (void)n_in; (void)out_size;
  if (ws_size < WS_NEED) { fprintf(stderr, "workspace too small: %zu < %zu\n", ws_size, (size_t)WS_NEED); return; }
  static int grid_blocks = 0;
  if (!grid_blocks) {
    (void)hipFuncSetAttribute((const void*)fwd_megakernel, hipFuncAttributeMaxDynamicSharedMemorySize, LDS_BYTES);
    int dev = 0, cus = 0, per_cu = 0; (void)hipGetDevice(&dev); (void)hipDeviceGetAttribute(&cus, hipDeviceAttributeMultiprocessorCount, dev);
    (void)hipOccupancyMaxActiveBlocksPerMultiprocessor(&per_cu, fwd_megakernel, NTHR, LDS_BYTES);
    grid_blocks = cus * (per_cu > 0 ? 1 : 0);
    if (grid_blocks != 256) fprintf(stderr, "unexpected grid %d (cus %d per_cu %d)\n", grid_blocks, cus, per_cu);
  }
  Params p{};
  const float** f = (const float**)&p;
  for (int i = 0; i < 22; ++i) f[i] = (const float*)d_in[i];
  p.out = (float*)d_out; p.ws = (unsigned char*)d_ws;
  (void)hipMemsetAsync((unsigned char*)d_ws + O_BAR, 0, 16384, stream);
  void* args[] = {&p};
  hipError_t e = hipLaunchCooperativeKernel((void*)fwd_megakernel, dim3(grid_blocks), dim3(NTHR), args, LDS_BYTES, stream);
  if (e != hipSuccess) fprintf(stderr, "cooperative launch failed: %s (grid %d)\n", hipGetErrorString(e), grid_blocks);
}
```

```cpp
#include <hip/hip_runtime.h>
#include <hip/hip_cooperative_groups.h>
#include <cstdio>

namespace cg = cooperative_groups;

#define LAS __attribute__((address_space(3)))
typedef LAS unsigned char* ldsp;
typedef unsigned short bf16_t;
typedef short bf16x8 __attribute__((ext_vector_type(8)));
typedef float f32x4 __attribute__((ext_vector_type(4)));
typedef unsigned u32x4 __attribute__((ext_vector_type(4)));
typedef unsigned u32x2 __attribute__((ext_vector_type(2)));

constexpr int DM = 1024, NB = 8, SEQ = 4096, CTX = 256, DEPTH = 4;
constexpr int RLAT = NB * SEQ, ROWS = RLAT + NB * CTX;
constexpr int DFF = 2816, NMOD = 9, DPROJ = 5648;
constexpr int NCH = ROWS / 64;
constexpr int NINP = 2816;
constexpr int LDS_BYTES = 163840;
constexpr int NTHR = 512;

constexpr size_t al256(size_t x) { return (x + 255) & ~(size_t)255; }
constexpr size_t O_X = 0;
constexpr size_t O_MOD = O_X + (size_t)ROWS * DM * 4;
constexpr size_t O_DFT = al256(O_MOD + (size_t)DEPTH * 9 * 9216 * 4);
constexpr size_t O_WGU = O_DFT + (size_t)4096 * 4096 * 2;
constexpr size_t O_WD = O_WGU + (size_t)5632 * 1024 * 2;
constexpr size_t O_WIN = O_WD + (size_t)1024 * 2816 * 2;
constexpr size_t O_WG = O_WIN + (size_t)NINP * 1024 * 2;
constexpr size_t O_WCAT = O_WG + (size_t)3072 * 1024 * 2;
constexpr size_t O_WOUT = O_WCAT + (size_t)1024 * 1024 * 2;
constexpr size_t O_R = O_WOUT + (size_t)1024 * 1024 * 2;
constexpr size_t SZ_H = (size_t)ROWS * 1024 * 2;
constexpr size_t SZ_Q = (size_t)ROWS * 512 * 2;
constexpr size_t O_HN = O_R;
constexpr size_t O_ACT = O_R + SZ_H;
constexpr size_t O_QN = O_R;
constexpr size_t O_KN = O_R + SZ_Q;
constexpr size_t O_QKV = O_R + SZ_H;
constexpr size_t O_O = O_QKV;
constexpr size_t O_SCR = O_QKV;
constexpr size_t O_Z = O_QKV + (size_t)ROWS * 1536 * 2;
constexpr size_t O_PI = O_Z + SZ_Q;
constexpr size_t O_FI = O_PI + (size_t)ROWS * 256 * 2;
constexpr size_t O_AB = O_FI + (size_t)ROWS * 256 * 2;
constexpr size_t O_KNT = al256(O_AB + (size_t)ROWS * 16 * 4);
constexpr size_t O_VNT = O_KNT + SZ_Q;
constexpr size_t O_MRG = O_KNT;
constexpr size_t O_TT = O_VNT + SZ_Q;
constexpr size_t O_OF = O_TT;
constexpr size_t O_GC = O_TT + SZ_H;
constexpr size_t O_FBT = al256(O_GC + (size_t)NCH * 4 * 2 * 64 * 4);
constexpr size_t O_UCS = O_FBT + (size_t)NB * 256 * 4096 * 2;
constexpr size_t O_PPF = al256(O_UCS + (size_t)NB * CTX * 512 * 4);
constexpr size_t O_WGU2 = al256(O_PPF + SZ_Q);
constexpr size_t O_WD2 = O_WGU2 + (size_t)5632 * 1024 * 2;
constexpr size_t O_WOUT3 = al256(O_WD2 + (size_t)1024 * 2816 * 2);
constexpr size_t O_BAR = al256(O_WOUT3 + (size_t)1024 * 3072 * 2);
constexpr size_t O_PARTM = O_Z;
constexpr size_t WS_NEED = O_BAR + 16384;
static_assert(O_SCR + (size_t)256 * 2 * 262144 <= O_PI, "merge scratch overlaps");

struct Params {
  const float *x, *c, *ctx, *c_ctx, *w_ada, *b_ada, *norm_gain, *w1gu, *w1d, *w2gu, *w2d, *w_in, *conv_w, *a_log, *dt_bias, *o_gain, *w_a, *w_b,
      *pool_scale, *w_c, *w_out, *final_gain;
  float* out;
  unsigned char* ws;
};

typedef float f32x2_ __attribute__((ext_vector_type(2)));
typedef __bf16 bf16x2_ __attribute__((ext_vector_type(2)));
__device__ __forceinline__ unsigned cvt_pk_bf16(float lo, float hi) { const f32x2_ v = {lo, hi}; const bf16x2_ b = __builtin_convertvector(v, bf16x2_); return __builtin_bit_cast(unsigned, b); }
__device__ __forceinline__ float bflo(unsigned w) { return __uint_as_float(w << 16); }
__device__ __forceinline__ float bfhi(unsigned w) { return __uint_as_float(w & 0xffff0000u); }
__device__ __forceinline__ float sigmoidf_(float x) { return __builtin_amdgcn_rcpf(1.0f + __expf(-x)); }
__device__ __forceinline__ float siluf_(float x) { return x * __builtin_amdgcn_rcpf(1.0f + __expf(-x)); }
template <class T> __device__ __forceinline__ T ldsld(ldsp b, int off) { return *(const LAS T*)(b + off); }
template <class T> __device__ __forceinline__ void ldsst(ldsp b, int off, T v) { *(LAS T*)(b + off) = v; }
__device__ __forceinline__ f32x4 mma(bf16x8 a, bf16x8 b, f32x4 c) { return __builtin_amdgcn_mfma_f32_16x16x32_bf16(a, b, c, 0, 0, 0); }
__device__ __forceinline__ u32x2 pack4(f32x4 v) { u32x2 r; r.x = cvt_pk_bf16(v[0], v[1]); r.y = cvt_pk_bf16(v[2], v[3]); return r; }
__device__ __forceinline__ int otid() { int t = threadIdx.x; asm volatile("" : "+v"(t)); return t; }
extern __shared__ __attribute__((aligned(16))) unsigned char g_shm[];
__device__ __forceinline__ unsigned char* lws(unsigned char*) { ldsp Lb = (ldsp)g_shm; unsigned lo = *(volatile LAS unsigned*)(Lb + LDS_BYTES - 32), hi = *(volatile LAS unsigned*)(Lb + LDS_BYTES - 28);
  lo = __builtin_amdgcn_readfirstlane(lo); hi = __builtin_amdgcn_readfirstlane(hi); return (unsigned char*)(((unsigned long long)hi << 32) | (unsigned long long)lo); }
__device__ __forceinline__ void atomic_add_f32(float* q, float v) { asm volatile("global_atomic_add_f32 %0, %1, off sc1" : : "v"(q), "v"(v) : "memory"); }
__device__ __forceinline__ int modidx(int pm) { return pm < 128 ? (pm >> 4) : 8; }

namespace pg8 {
constexpr int BM = 256, BK = 64, HALF = 128, HTB = HALF * BK * 2, NXCD = 8, WGM = 8;
__device__ __forceinline__ int lds_byte(int r, int c) { const int st = (r >> 4) * 2 + (c >> 5), rr = r & 15, cc = c & 31, ob = rr * 64 + cc * 2; return st * 1024 + (ob ^ (((ob >> 9) & 1) << 5)); }
__device__ __forceinline__ void stage_rc(int b, int& R, int& C) { const int st = b / 1024, sb = b % 1024, swz = sb ^ (((sb >> 9) & 1) << 5); R = (st >> 1) * 16 + swz / 64; C = (st & 1) * 32 + (swz % 64) / 2; }
__device__ __forceinline__ int perm32(int rho) { const int n = rho >> 4, i = rho & 15; return 8 * (i >> 2) + 4 * n + (i & 3); }

struct Unit { const char* A; const char* B; int lda, ldb, nt, pm, pn, seg; };

__device__ __forceinline__ bool tile_of(int nM, int nN, int G, int c, int i, int& pm, int& pn) {
  const int nwg = nM * nN; const long Lq = (long)i * G + c; if (Lq >= nwg) return false;
  int wgid = (int)Lq; { const int q = nwg / NXCD, r = nwg % NXCD, xcd = wgid % NXCD, off = wgid / NXCD; wgid = (xcd < r ? xcd * (q + 1) : r * (q + 1) + (xcd - r) * q) + off; }
  const int nig = WGM * nN, gid = wgid / nig, fm = gid * WGM, gsz = (nM - fm) < WGM ? (nM - fm) : WGM;
  pm = fm + ((wgid % nig) % gsz); pn = (wgid % nig) / gsz; return true;
}
struct PlainSched {
  static constexpr bool VARLDA = false;
  const char* A; const char* B; int lda, ldb, nt, nM, nN, G, c;
  __device__ __forceinline__ bool next(int i, Unit& u) const {
    int pm, pn; if (!tile_of(nM, nN, G, c, i, pm, pn)) return false;
    u.A = A + (size_t)pm * 256 * lda; u.B = B + (size_t)pn * 256 * ldb; u.lda = lda; u.ldb = ldb; u.nt = nt; u.pm = pm; u.pn = pn; u.seg = 0; return true;
  }
};

struct ResSched {
  static constexpr bool VARLDA = false;
  const char* A; const char* B; int ld, nt, G, c, mode;
  __device__ __forceinline__ bool next(int i, Unit& u) const {
    u.lda = ld; u.ldb = ld;
    if (mode == 0) { int pm, pn; if (i >= 2 || !tile_of(128, 4, G, c, i, pm, pn)) return false;
      u.A = A + (size_t)pm * 256 * ld; u.B = B + (size_t)pn * 256 * ld; u.nt = nt; u.pm = pm; u.pn = pn; u.seg = 0; return true; }
#ifdef NO_SPLITK
    if (i > 0 || c >= 32) return false;
    { const int pm = 128 + (c >> 2), pn = c & 3; u.A = A + (size_t)pm * 256 * ld; u.B = B + (size_t)pn * 256 * ld; u.nt = nt; u.pm = pm; u.pn = pn; u.seg = 0; return true; }
#endif
    if (i > 0 || c >= 256) return false;
    const int pm = 128 + (c >> 5), pn = (c >> 3) & 3, kp = c & 7;
    const int base = (nt / 16) * 2, extra = (nt - base * 8) / 2;
    const int k0 = kp * base + 2 * (kp < extra ? kp : extra), np = base + (kp < extra ? 2 : 0);
    u.A = A + (size_t)pm * 256 * ld + (size_t)k0 * 128; u.B = B + (size_t)pn * 256 * ld + (size_t)k0 * 128; u.nt = np; u.pm = pm; u.pn = pn; u.seg = kp; return true;
  }
};
template <class Epi, class Sched>
__device__ __forceinline__ void gemm_phase(ldsp lds, const Sched& S, const Epi& E) {
  const int tid = otid(), wid = __builtin_amdgcn_readfirstlane(tid >> 6), lane = tid & 63, wr = wid >> 2, wc = wid & 3, fr = lane & 15, fq = lane >> 4;
  unsigned rA[2], rB[2], c2[2];
#pragma unroll
  for (int i = 0; i < 2; ++i) { int R, C; stage_rc(tid * 16 + i * 8192, R, C); rA[i] = (unsigned)R; rB[i] = (unsigned)(Epi::PERM ? ((R & ~31) + perm32(R & 31)) : R); c2[i] = (unsigned)C * 2u; }
  const size_t kstep = (size_t)(BK * 2);
  const unsigned ldsw = (unsigned)wid * 1024u;
  const int aoff = lds_byte(wr * 64 + fr, fq * 8), boff = lds_byte(wc * 32 + fr, fq * 8);
#define PG8_SA(b, h) (((b) * 2 + (h)) * HTB)
#define PG8_SB(b, h) ((4 + (b) * 2 + (h)) * HTB)
#define PG8_STAGE(bufoff, gbase, voff) do { _Pragma("unroll") for (int _i = 0; _i < 2; ++_i) \
    __builtin_amdgcn_global_load_lds((const unsigned*)((const char*)(gbase) + (voff)[_i]), (LAS unsigned*)(lds + (bufoff) + ldsw + _i * 8192), 16, 0, 0); } while (0)
#define PG8_LDA(dst, b, h) do { _Pragma("unroll") for (int m = 0; m < 4; ++m) _Pragma("unroll") for (int k = 0; k < 2; ++k) dst[m][k] = *(const LAS bf16x8*)(lds + PG8_SA(b, h) + aoff + m * 2048 + k * 1024); } while (0)
#define PG8_LDB(dst, b, h) do { _Pragma("unroll") for (int n = 0; n < 2; ++n) _Pragma("unroll") for (int k = 0; k < 2; ++k) dst[n][k] = *(const LAS bf16x8*)(lds + PG8_SB(b, h) + boff + n * 2048 + k * 1024); } while (0)
#define PG8_MMA(ai, bj, At, Bt) do { __builtin_amdgcn_s_setprio(1); _Pragma("unroll") for (int m = 0; m < 4; ++m) _Pragma("unroll") for (int n = 0; n < 2; ++n) _Pragma("unroll") for (int k = 0; k < 2; ++k) \
    acc[ai][bj][m][n] = __builtin_amdgcn_mfma_f32_16x16x32_bf16(Bt[n][k], At[m][k], acc[ai][bj][m][n], 0, 0, 0); __builtin_amdgcn_s_setprio(0); } while (0)
#define PG8_WAIT_V(n) asm volatile("s_waitcnt vmcnt(" #n ")" ::: "memory")
#define PG8_WAIT_L(n) asm volatile("s_waitcnt lgkmcnt(" #n ")" ::: "memory")
#define PG8_BAR __builtin_amdgcn_s_barrier()
#define PG8_SCHED __builtin_amdgcn_sched_barrier(0)
  Unit cur, nxt; int ui = 0;
  if (!S.next(0, cur)) return;
  float zz_; asm volatile("v_mov_b32 %0, 0" : "=v"(zz_));
  f32x4 acc[2][2][4][2];
#pragma unroll
  for (int a = 0; a < 2; ++a)
#pragma unroll
    for (int b = 0; b < 2; ++b)
#pragma unroll
      for (int m = 0; m < 4; ++m)
#pragma unroll
        for (int n = 0; n < 2; ++n) acc[a][b][m][n] = (f32x4){zz_, zz_, zz_, zz_};
  bf16x8 At[4][2], B0[2][2], B1[2][2];
  const char* cA = cur.A; const char* cB = cur.B; int ldA = cur.lda; const int ldB = cur.ldb;
  unsigned voffA[2], voffB[2];
#pragma unroll
  for (int i = 0; i < 2; ++i) { voffA[i] = rA[i] * (unsigned)ldA + c2[i]; voffB[i] = rB[i] * (unsigned)ldB + c2[i]; }
  const size_t hB = (size_t)HALF * ldB;
  {
    const size_t hA = (size_t)HALF * ldA;
    PG8_STAGE(PG8_SB(0, 0), cB, voffB); PG8_STAGE(PG8_SA(0, 0), cA, voffA); PG8_STAGE(PG8_SB(0, 1), cB + hB, voffB); PG8_STAGE(PG8_SA(0, 1), cA + hA, voffA);
    if (wr == 1) PG8_BAR;
    PG8_WAIT_V(4); PG8_BAR;
    PG8_STAGE(PG8_SB(1, 0), cB + kstep, voffB); PG8_STAGE(PG8_SA(1, 0), cA + kstep, voffA); PG8_STAGE(PG8_SB(1, 1), cB + hB + kstep, voffB);
    PG8_WAIT_V(6); PG8_BAR;
  }
  for (;;) {
    const bool has_next = S.next(ui + 1, nxt);
    const char* nA = has_next ? nxt.A : cA; const char* nB = has_next ? nxt.B : cB;
    const int nldA = has_next ? nxt.lda : ldA;
    const int nt = cur.nt;
    const size_t hA = (size_t)HALF * ldA;
    for (int t = 0; t < nt; t += 2) {
      const bool last = (t == nt - 2);
      const char* a1 = cA + (size_t)(t + 1) * kstep;
      const char* a2 = last ? nA : cA + (size_t)(t + 2) * kstep; const char* b2 = last ? nB : cB + (size_t)(t + 2) * kstep;
      const size_t h2A = (size_t)HALF * (last ? nldA : ldA);
      const char* a3 = a2 + kstep; const char* b3 = b2 + kstep;
      PG8_LDB(B0, 0, 0); PG8_SCHED; PG8_LDA(At, 0, 0); PG8_STAGE(PG8_SA(1, 1), a1 + hA, voffA);
      if (Sched::VARLDA) { if (last) {
#pragma unroll
        for (int i = 0; i < 2; ++i) voffA[i] = rA[i] * (unsigned)nldA + c2[i]; } }
      PG8_WAIT_L(8); PG8_BAR; PG8_WAIT_L(0); PG8_MMA(0, 0, At, B0); PG8_BAR; PG8_SCHED;
      PG8_LDB(B1, 0, 1); PG8_STAGE(PG8_SB(0, 0), b2, voffB);
      PG8_BAR; PG8_WAIT_L(0); PG8_MMA(0, 1, At, B1); PG8_BAR;
      PG8_LDA(At, 0, 1); PG8_STAGE(PG8_SA(0, 0), a2, voffA);
      PG8_BAR; PG8_WAIT_L(0); PG8_MMA(1, 0, At, B0); PG8_BAR; PG8_SCHED;
      PG8_STAGE(PG8_SB(0, 1), b2 + hB, voffB);
      PG8_WAIT_V(6); PG8_BAR; PG8_MMA(1, 1, At, B1); PG8_BAR;
      PG8_LDB(B0, 1, 0); PG8_SCHED; PG8_LDA(At, 1, 0); PG8_STAGE(PG8_SA(0, 1), a2 + h2A, voffA);
      PG8_WAIT_L(8); PG8_BAR; PG8_WAIT_L(0); PG8_MMA(0, 0, At, B0); PG8_BAR; PG8_SCHED;
      PG8_LDB(B1, 1, 1); PG8_STAGE(PG8_SB(1, 0), b3, voffB);
      PG8_BAR; PG8_WAIT_L(0); PG8_MMA(0, 1, At, B1); PG8_BAR;
      PG8_LDA(At, 1, 1); PG8_STAGE(PG8_SA(1, 0), a3, voffA);
      PG8_BAR; PG8_WAIT_L(0); PG8_MMA(1, 0, At, B0); PG8_BAR; PG8_SCHED;
      PG8_STAGE(PG8_SB(1, 1), b3 + hB, voffB);
      PG8_WAIT_V(6); PG8_BAR; PG8_MMA(1, 1, At, B1); PG8_BAR;
    }
    E(acc, cur, wr, wc, fr, fq);
    if (!has_next) break;
#pragma unroll
    for (int a = 0; a < 2; ++a)
#pragma unroll
      for (int b = 0; b < 2; ++b)
#pragma unroll
        for (int m = 0; m < 4; ++m)
#pragma unroll
          for (int n = 0; n < 2; ++n) acc[a][b][m][n] = (f32x4){zz_, zz_, zz_, zz_};
    cur = nxt; cA = nA; cB = nB; ldA = nldA; ++ui;
  }
  PG8_WAIT_V(0);
  if (wr == 0) PG8_BAR;
  PG8_BAR;
#undef PG8_SA
#undef PG8_SB
#undef PG8_STAGE
#undef PG8_LDA
#undef PG8_LDB
#undef PG8_MMA
#undef PG8_WAIT_V
#undef PG8_WAIT_L
#undef PG8_BAR
#undef PG8_SCHED
}
}
using pg8::Unit;
typedef f32x4 AccT[2][2][4][2];

struct EpiUp {
  static constexpr bool PERM = true;
  bf16_t* act;
  __device__ __forceinline__ void operator()(const AccT& acc, const Unit& u, int wr, int wc, int fr, int fq) const {
    const int row0 = u.pm * 256 + wr * 64 + fr, col0 = u.pn * 128 + wc * 32 + 8 * fq;
#pragma unroll
    for (int ai = 0; ai < 2; ++ai)
#pragma unroll
      for (int m = 0; m < 4; ++m) {
        const f32x4 a0 = acc[ai][0][m][0], a1 = acc[ai][0][m][1], u0 = acc[ai][1][m][0], u1 = acc[ai][1][m][1];
        u32x4 w;
        w.x = cvt_pk_bf16(siluf_(a0[0]) * u0[0], siluf_(a0[1]) * u0[1]); w.y = cvt_pk_bf16(siluf_(a0[2]) * u0[2], siluf_(a0[3]) * u0[3]);
        w.z = cvt_pk_bf16(siluf_(a1[0]) * u1[0], siluf_(a1[1]) * u1[1]); w.w = cvt_pk_bf16(siluf_(a1[2]) * u1[2], siluf_(a1[3]) * u1[3]);
        *(u32x4*)(act + (size_t)(row0 + ai * 128 + m * 16) * DFF + col0) = w;
      }
  }
};
template <bool ATOMIC> struct EpiResT {
  static constexpr bool PERM = false;
  float* X; const float* modl; int gidx; float scale;
  __device__ __forceinline__ void operator()(const AccT& acc, const Unit& u, int wr, int wc, int fr, int fq) const {
    const int row0 = u.pm * 256 + wr * 64 + fr, col0 = u.pn * 256 + wc * 32 + 4 * fq;
    const float* g = modl + (size_t)(modidx(u.pm) * 9 + gidx) * 1024 + col0;
    f32x4 gv[2][2];
#pragma unroll
    for (int bj = 0; bj < 2; ++bj)
#pragma unroll
      for (int n = 0; n < 2; ++n) gv[bj][n] = *(const f32x4*)(g + bj * 128 + n * 16) * scale;
#pragma unroll
    for (int ai = 0; ai < 2; ++ai)
#pragma unroll
      for (int mh = 0; mh < 2; ++mh) {
        f32x4 xv[2][2][2];
#pragma unroll
        for (int m2 = 0; m2 < 2; ++m2)
#pragma unroll
          for (int bj = 0; bj < 2; ++bj)
#pragma unroll
            for (int n = 0; n < 2; ++n) xv[m2][bj][n] = *(const f32x4*)(X + (size_t)(row0 + ai * 128 + (mh * 2 + m2) * 16) * DM + col0 + bj * 128 + n * 16);
        asm volatile("" ::: "memory");
#pragma unroll
        for (int m2 = 0; m2 < 2; ++m2)
#pragma unroll
          for (int bj = 0; bj < 2; ++bj)
#pragma unroll
            for (int n = 0; n < 2; ++n) *(f32x4*)(X + (size_t)(row0 + ai * 128 + (mh * 2 + m2) * 16) * DM + col0 + bj * 128 + n * 16) = xv[m2][bj][n] + gv[bj][n] * acc[ai][bj][mh * 2 + m2][n];
        asm volatile("" ::: "memory");
      }
  }
};
struct EpiPart {
  static constexpr bool PERM = false;
  float* part; const float* modl; int gidx; float scale;
  __device__ __forceinline__ void operator()(const AccT& acc, const Unit& u, int wr, int wc, int fr, int fq) const {
    const int row0 = (u.pm - 128) * 256 + wr * 64 + fr, col0 = u.pn * 256 + wc * 32 + 4 * fq;
    const float* g = modl + (size_t)(8 * 9 + gidx) * 1024 + col0;
    float* pb = part + (size_t)u.seg * 2048 * 1024;
    f32x4 gv[2][2];
#pragma unroll
    for (int bj = 0; bj < 2; ++bj)
#pragma unroll
      for (int n = 0; n < 2; ++n) gv[bj][n] = *(const f32x4*)(g + bj * 128 + n * 16) * scale;
#pragma unroll
    for (int ai = 0; ai < 2; ++ai)
#pragma unroll
      for (int m = 0; m < 4; ++m) {
        float* rowp = pb + (size_t)(row0 + ai * 128 + m * 16) * DM + col0;
#pragma unroll
        for (int bj = 0; bj < 2; ++bj)
#pragma unroll
          for (int n = 0; n < 2; ++n) *(f32x4*)(rowp + bj * 128 + n * 16) = gv[bj][n] * acc[ai][bj][m][n];
      }
  }
};
struct EpiIn {
  static constexpr bool PERM = true;
  bf16_t *qkv, *z, *pi, *fi; float* ab;
  __device__ __forceinline__ void operator()(const AccT& acc, const Unit& u, int wr, int wc, int fr, int fq) const {
    const int row0 = u.pm * 256 + wr * 64 + fr;
    if (u.pn == 10) {
      if (wc == 0 && fq < 2) {
#pragma unroll
        for (int ai = 0; ai < 2; ++ai)
#pragma unroll
          for (int m = 0; m < 4; ++m) {
            float* rp = ab + (size_t)(row0 + ai * 128 + m * 16) * 16 + 8 * fq;
            *(f32x4*)(rp) = acc[ai][0][m][0]; *(f32x4*)(rp + 4) = acc[ai][0][m][1];
          }
      }
      return;
    }
    bf16_t* base; int ld, ct;
    if (u.pn < 6) { base = qkv; ld = 1536; ct = u.pn * 256; } else if (u.pn < 8) { base = z; ld = 512; ct = (u.pn - 6) * 256; } else if (u.pn == 8) { base = pi; ld = 256; ct = 0; } else { base = fi; ld = 256; ct = 0; }
    const int col0 = ct + wc * 32 + 8 * fq;
#pragma unroll
    for (int ai = 0; ai < 2; ++ai)
#pragma unroll
      for (int m = 0; m < 4; ++m) {
        bf16_t* rowp = base + (size_t)(row0 + ai * 128 + m * 16) * ld + col0;
#pragma unroll
        for (int bj = 0; bj < 2; ++bj) { const f32x4 v0 = acc[ai][bj][m][0], v1 = acc[ai][bj][m][1]; u32x4 w; w.x = cvt_pk_bf16(v0[0], v0[1]); w.y = cvt_pk_bf16(v0[2], v0[3]); w.z = cvt_pk_bf16(v1[0], v1[1]); w.w = cvt_pk_bf16(v1[2], v1[3]);
          *(u32x4*)(rowp + bj * 128) = w; }
      }
  }
};
struct EpiBf {
  static constexpr bool PERM = true;
  bf16_t* O; int ld;
  __device__ __forceinline__ void operator()(const AccT& acc, const Unit& u, int wr, int wc, int fr, int fq) const {
    const int row0 = u.pm * 256 + wr * 64 + fr, col0 = u.pn * 256 + wc * 32 + 8 * fq;
#pragma unroll
    for (int ai = 0; ai < 2; ++ai)
#pragma unroll
      for (int m = 0; m < 4; ++m) {
        bf16_t* rowp = O + (size_t)(row0 + ai * 128 + m * 16) * ld + col0;
#pragma unroll
        for (int bj = 0; bj < 2; ++bj) { const f32x4 v0 = acc[ai][bj][m][0], v1 = acc[ai][bj][m][1]; u32x4 w; w.x = cvt_pk_bf16(v0[0], v0[1]); w.y = cvt_pk_bf16(v0[2], v0[3]); w.z = cvt_pk_bf16(v1[0], v1[1]); w.w = cvt_pk_bf16(v1[2], v1[3]);
          *(u32x4*)(rowp + bj * 128) = w; }
      }
  }
};
struct EpiMerge {
  static constexpr bool PERM = true;
  unsigned* scr;
  bf16_t* mrg;
  __device__ __forceinline__ void operator()(const AccT& acc, const Unit& u, int wr, int wc, int fr, int fq) const {
    const int tid_ = otid(); u32x4* S1 = (u32x4*)scr + tid_; u32x4* Mx = (u32x4*)scr + 16 * 512 + tid_;
    const int seg = u.seg;
    if ((seg & 1) == 0) {
#pragma unroll
      for (int ai = 0; ai < 2; ++ai)
#pragma unroll
        for (int bj = 0; bj < 2; ++bj)
#pragma unroll
          for (int m = 0; m < 4; ++m) { const f32x4 v0 = acc[ai][bj][m][0], v1 = acc[ai][bj][m][1]; u32x4 w;
            w.x = cvt_pk_bf16(sigmoidf_(v0[0]), sigmoidf_(v0[1])); w.y = cvt_pk_bf16(sigmoidf_(v0[2]), sigmoidf_(v0[3])); w.z = cvt_pk_bf16(sigmoidf_(v1[0]), sigmoidf_(v1[1])); w.w = cvt_pk_bf16(sigmoidf_(v1[2]), sigmoidf_(v1[3]));
            S1[((ai * 2 + bj) * 4 + m) * 512] = w; }
    } else {
      const int row0 = u.pm * 256 + wr * 64 + fr, col0 = u.pn * 256 + wc * 32 + 8 * fq;
#pragma unroll
      for (int ai = 0; ai < 2; ++ai)
#pragma unroll
        for (int bj = 0; bj < 2; ++bj) {
          u32x4 gq[4], mq[4];
#pragma unroll
          for (int m = 0; m < 4; ++m) { const int ix = ((ai * 2 + bj) * 4 + m) * 512; gq[m] = S1[ix]; mq[m] = (seg >= 3) ? Mx[ix] : (u32x4){0u, 0u, 0u, 0u}; }
          asm volatile("" ::: "memory");
#pragma unroll
          for (int m = 0; m < 4; ++m) {
            const int ix = ((ai * 2 + bj) * 4 + m) * 512; const u32x4 g = gq[m], q = mq[m]; const f32x4 v0 = acc[ai][bj][m][0], v1 = acc[ai][bj][m][1];
            float t[8] = {bflo(g.x) * v0[0], bfhi(g.x) * v0[1], bflo(g.y) * v0[2], bfhi(g.y) * v0[3], bflo(g.z) * v1[0], bfhi(g.z) * v1[1], bflo(g.w) * v1[2], bfhi(g.w) * v1[3]};
            t[0] += bflo(q.x); t[1] += bfhi(q.x); t[2] += bflo(q.y); t[3] += bfhi(q.y); t[4] += bflo(q.z); t[5] += bfhi(q.z); t[6] += bflo(q.w); t[7] += bfhi(q.w);
            u32x4 w; w.x = cvt_pk_bf16(t[0], t[1]); w.y = cvt_pk_bf16(t[2], t[3]); w.z = cvt_pk_bf16(t[4], t[5]); w.w = cvt_pk_bf16(t[6], t[7]);
            if (seg < 5) Mx[ix] = w; else *(u32x4*)(mrg + (size_t)(row0 + ai * 128 + m * 16) * DM + col0 + bj * 128) = w;
          }
          asm volatile("" ::: "memory");
        }
    }
  }
};
struct MergeSched {
  static constexpr bool VARLDA = true;
  const char *hn, *of, *ppf, *wg, *wcat; int G, c, nM;
  __device__ __forceinline__ bool next(int i, Unit& u) const {
    const int round = i / 6, seg = i - round * 6; int pm, pn; if (!pg8::tile_of(nM, 4, G, c, round, pm, pn)) return false;
    const int br = seg >> 1;
    u.pm = pm; u.pn = pn; u.seg = seg; u.ldb = 2048;
    if ((seg & 1) == 0) { u.A = hn + (size_t)pm * 256 * 2048; u.lda = 2048; u.B = wg + (size_t)(br * 1024 + pn * 256) * 2048; u.nt = 16; }
    else {
      u.lda = 1024;
      if (br == 0) { u.A = of + (size_t)pm * 256 * 1024; u.B = wcat + (size_t)pn * 256 * 2048; u.nt = 8; }
      else if (br == 1) { u.A = ppf + (size_t)pm * 256 * 1024; u.B = wcat + (size_t)pn * 256 * 2048 + 512 * 2; u.nt = 4; }
      else { u.A = ppf + (size_t)pm * 256 * 1024 + 256 * 2; u.B = wcat + (size_t)pn * 256 * 2048 + 768 * 2; u.nt = 4; }
    }
    return true;
  }
};
struct MergeCtxSched {
  static constexpr bool VARLDA = true;
  const char *hn, *of, *ppf, *wg, *wcat; int c;
  __device__ __forceinline__ bool next(int i, Unit& u) const {
    if (i > 1 || c >= 96) return false;
    const int tile = c / 3, br = c - tile * 3, pm = 128 + (tile >> 2), pn = tile & 3;
    u.pm = pm; u.pn = pn; u.seg = br * 2 + i; u.ldb = 2048;
    if (i == 0) { u.A = hn + (size_t)pm * 256 * 2048; u.lda = 2048; u.B = wg + (size_t)(br * 1024 + pn * 256) * 2048; u.nt = 16; }
    else { u.lda = 1024;
      if (br == 0) { u.A = of + (size_t)pm * 256 * 1024; u.B = wcat + (size_t)pn * 256 * 2048; u.nt = 8; }
      else if (br == 1) { u.A = ppf + (size_t)pm * 256 * 1024; u.B = wcat + (size_t)pn * 256 * 2048 + 512 * 2; u.nt = 4; }
      else { u.A = ppf + (size_t)pm * 256 * 1024 + 256 * 2; u.B = wcat + (size_t)pn * 256 * 2048 + 768 * 2; u.nt = 4; } }
    return true;
  }
};
struct EpiMergeCtx {
  static constexpr bool PERM = true;
  unsigned* scr; bf16_t* partm;
  __device__ __forceinline__ void operator()(const AccT& acc, const Unit& u, int wr, int wc, int fr, int fq) const {
    const int tid_ = otid(); u32x4* S1 = (u32x4*)scr + tid_;
    if ((u.seg & 1) == 0) {
#pragma unroll
      for (int ai = 0; ai < 2; ++ai)
#pragma unroll
        for (int bj = 0; bj < 2; ++bj)
#pragma unroll
          for (int m = 0; m < 4; ++m) { const f32x4 v0 = acc[ai][bj][m][0], v1 = acc[ai][bj][m][1]; u32x4 w;
            w.x = cvt_pk_bf16(sigmoidf_(v0[0]), sigmoidf_(v0[1])); w.y = cvt_pk_bf16(sigmoidf_(v0[2]), sigmoidf_(v0[3])); w.z = cvt_pk_bf16(sigmoidf_(v1[0]), sigmoidf_(v1[1])); w.w = cvt_pk_bf16(sigmoidf_(v1[2]), sigmoidf_(v1[3]));
            S1[((ai * 2 + bj) * 4 + m) * 512] = w; }
    } else {
      const int br = u.seg >> 1, row0 = (u.pm - 128) * 256 + wr * 64 + fr, col0 = br * 1024 + u.pn * 256 + wc * 32 + 8 * fq;
#pragma unroll
      for (int ai = 0; ai < 2; ++ai) {
        u32x4 gq[2][4];
#pragma unroll
        for (int bj = 0; bj < 2; ++bj)
#pragma unroll
          for (int m = 0; m < 4; ++m) gq[bj][m] = S1[((ai * 2 + bj) * 4 + m) * 512];
        asm volatile("" ::: "memory");
#pragma unroll
        for (int m = 0; m < 4; ++m)
#pragma unroll
          for (int bj = 0; bj < 2; ++bj) {
            const u32x4 g = gq[bj][m]; const f32x4 v0 = acc[ai][bj][m][0], v1 = acc[ai][bj][m][1];
            u32x4 w; w.x = cvt_pk_bf16(bflo(g.x) * v0[0], bfhi(g.x) * v0[1]); w.y = cvt_pk_bf16(bflo(g.y) * v0[2], bfhi(g.y) * v0[3]); w.z = cvt_pk_bf16(bflo(g.z) * v1[0], bfhi(g.z) * v1[1]); w.w = cvt_pk_bf16(bflo(g.w) * v1[2], bfhi(g.w) * v1[3]);
            *(u32x4*)(partm + (size_t)(row0 + ai * 128 + m * 16) * 3072 + col0 + bj * 128) = w;
          }
      }
    }
  }
};
struct FourSched {
  static constexpr bool VARLDA = false;
  const char *dft, *fbt; int c;
  __device__ __forceinline__ bool next(int i, Unit& u) const {
    if (i > 0) return false;
    const int b = c >> 4, pm = c & 15;
    u.A = dft + (size_t)pm * 256 * 8192; u.B = fbt + (size_t)b * 256 * 8192; u.lda = 8192; u.ldb = 8192; u.nt = 64; u.pm = b * 16 + pm; u.pn = 0; u.seg = 0; return true;
  }
};

template <class F>
__device__ __forceinline__ void convT(const float* W, int ldw, int K, int nrows, bf16_t* dst, int ldd, int k0d, F srccol, ldsp L, int& cursor, int wg, int G) {
  const int tid = otid(), ntk = K >> 6, ntiles = (nrows >> 6) * ntk;
  int t0 = (wg - cursor % G + G) % G;
  for (; t0 < ntiles; t0 += 4 * G) {
    float v[4][8];
#pragma unroll
    for (int u = 0; u < 4; ++u) {
      const int t = t0 + u * G;
      if (t < ntiles) {
        const int tr = t / ntk, tk = t - tr * ntk, r0 = tr * 64, kk0 = tk * 64; const int i = tid & 63, sc = srccol(r0 + i);
#pragma unroll
        for (int it = 0; it < 8; ++it) { const int kk = (tid >> 6) + 8 * it; v[u][it] = sc >= 0 ? W[(size_t)(kk0 + kk) * ldw + sc] : 0.f; }
      }
    }
#pragma unroll
    for (int u = 0; u < 4; ++u) { if (t0 + u * G < ntiles) {
#pragma unroll
      for (int it = 0; it < 8; ++it) ldsst<float>(L, u * 16640 + (((tid >> 6) + 8 * it) * 65 + (tid & 63)) * 4, v[u][it]); } }
    __syncthreads();
#pragma unroll
    for (int u = 0; u < 4; ++u) {
      const int t = t0 + u * G;
      if (t < ntiles) {
        const int tr = t / ntk, tk = t - tr * ntk, r0 = tr * 64, kk0 = tk * 64; const int ii = tid >> 3, kv = (tid & 7) * 8; float o[8];
#pragma unroll
        for (int e = 0; e < 8; ++e) o[e] = ldsld<float>(L, u * 16640 + ((kv + e) * 65 + ii) * 4);
        u32x4 w; w.x = cvt_pk_bf16(o[0], o[1]); w.y = cvt_pk_bf16(o[2], o[3]); w.z = cvt_pk_bf16(o[4], o[5]); w.w = cvt_pk_bf16(o[6], o[7]);
        *(u32x4*)(dst + (size_t)(r0 + ii) * ldd + k0d + kk0 + kv) = w;
      }
    }
    __syncthreads();
  }
  cursor += ntiles;
}

__device__ __forceinline__ void convert_ffn(const Params& p, const float* wgu, const float* wd, size_t o_gu, size_t o_d, ldsp L, int& cur, int wg, int nwg) {
  convT(wgu, 2 * DFF, 1024, 2 * DFF, (bf16_t*)(lws(p.ws) + o_gu), 1024, 0, [](int r) { const int t = r >> 8, q = r & 255; return q < 128 ? t * 128 + q : DFF + t * 128 + (q - 128); }, L, cur, wg, nwg);
  convT(wd, 1024, DFF, 1024, (bf16_t*)(lws(p.ws) + o_d), DFF, 0, [](int r) { return r; }, L, cur, wg, nwg);
}
__device__ __forceinline__ void convert_win(const Params& p, int l, ldsp L, int& cur, int wg, int nwg) {
  const float* win = p.w_in + (size_t)l * 1024 * DPROJ;
  convT(win, DPROJ, 1024, NINP, (bf16_t*)(lws(p.ws) + O_WIN), 1024, 0, [](int r) { return r < 2048 ? r : (r < 2560 ? r + 16 : (r < 2576 ? r - 512 : -1)); }, L, cur, wg, nwg);
}
__device__ __forceinline__ void convert_mixer(const Params& p, int l, ldsp L, int& cur) {
  const int wg = blockIdx.x, nwg = gridDim.x;
  const float* win = p.w_in + (size_t)l * 1024 * DPROJ;
  convT(win, DPROJ, 1024, 3072, (bf16_t*)(lws(p.ws) + O_WG), 1024, 0, [](int r) { return 2576 + r; }, L, cur, wg, nwg);
  convT(p.w_a + (size_t)l * 512 * 1024, 1024, 512, 1024, (bf16_t*)(lws(p.ws) + O_WCAT), 1024, 0, [](int r) { return r; }, L, cur, wg, nwg);
  convT(p.w_c + (size_t)l * 256 * 1024, 1024, 256, 1024, (bf16_t*)(lws(p.ws) + O_WCAT), 1024, 768, [](int r) { return r; }, L, cur, wg, nwg);
  convT(p.w_out + (size_t)l * 1024 * 1024, 1024, 1024, 1024, (bf16_t*)(lws(p.ws) + O_WOUT), 1024, 0, [](int r) { return r; }, L, cur, wg, nwg);
  for (int rp = 0; rp < 3; ++rp) convT(p.w_out + (size_t)l * 1024 * 1024, 1024, 1024, 1024, (bf16_t*)(lws(p.ws) + O_WOUT3), 3072, rp * 1024, [](int r) { return r; }, L, cur, wg, nwg);
  const float* wb = p.w_b + (size_t)l * 4 * 64 * 256; const float* ps = p.pool_scale + (size_t)l * 1024; bf16_t* wcat = (bf16_t*)(lws(p.ws) + O_WCAT);
  for (int idx = blockIdx.x * NTHR + otid(); idx < 1024 * 256; idx += gridDim.x * NTHR) {
    const int row = idx & 1023, kk = idx >> 10, g = row >> 8;
    const float v = ((kk >> 6) == g) ? wb[((size_t)g * 64 + (kk & 63)) * 256 + (row & 255)] * ps[row] : 0.f;
    wcat[(size_t)row * 1024 + 512 + kk] = (bf16_t)(cvt_pk_bf16(v, 0.f) & 0xffffu);
  }
}

__device__ __forceinline__ void norm_phase(float* X, bf16_t* Hn, const float* gain, const float* modl, int ishift, int iscale, const float* part) {
  const int tid_ = otid(), lane = tid_ & 63, gw = blockIdx.x * 8 + (tid_ >> 6), nw = gridDim.x * 8;
  for (int r0 = gw; r0 < ROWS; r0 += 2 * nw) {
    f32x4 v[2][4]; float ss[2];
#pragma unroll
    for (int q = 0; q < 2; ++q) { const int r = r0 + q * nw; const int rr = r < ROWS ? r : r0; const float* xr = X + (size_t)rr * DM;
#pragma unroll
      for (int i = 0; i < 2; ++i) { v[q][2 * i] = *(const f32x4*)(xr + lane * 8 + 512 * i); v[q][2 * i + 1] = *(const f32x4*)(xr + lane * 8 + 512 * i + 4); } }
#pragma unroll
    for (int q = 0; q < 2; ++q) {
      const int r = r0 + q * nw;
      if (part != nullptr && r >= RLAT && r < ROWS) {
        float* xr = X + (size_t)r * DM; const float* pr_ = part + (size_t)(r - RLAT) * DM + lane * 8;
#pragma unroll
        for (int kp = 0; kp < 8; ++kp)
#pragma unroll
          for (int i = 0; i < 2; ++i) { v[q][2 * i] = v[q][2 * i] + *(const f32x4*)(pr_ + (size_t)kp * 2048 * 1024 + 512 * i); v[q][2 * i + 1] = v[q][2 * i + 1] + *(const f32x4*)(pr_ + (size_t)kp * 2048 * 1024 + 512 * i + 4); }
#pragma unroll
        for (int i = 0; i < 2; ++i) { *(f32x4*)(xr + lane * 8 + 512 * i) = v[q][2 * i]; *(f32x4*)(xr + lane * 8 + 512 * i + 4) = v[q][2 * i + 1]; }
      }
      float s_ = 0.f;
#pragma unroll
      for (int i = 0; i < 4; ++i) s_ += v[q][i][0] * v[q][i][0] + v[q][i][1] * v[q][i][1] + v[q][i][2] * v[q][i][2] + v[q][i][3] * v[q][i][3];
      ss[q] = s_;
    }
#pragma unroll
    for (int o = 32; o >= 1; o >>= 1) { ss[0] += __shfl_xor(ss[0], o); ss[1] += __shfl_xor(ss[1], o); }
#pragma unroll
    for (int q = 0; q < 2; ++q) {
      const int r = r0 + q * nw; if (r >= ROWS) continue;
      const int j = r < RLAT ? (r >> 12) : 8;
      const float* sh = modl + (size_t)(j * 9 + ishift) * 1024; const float* sc = modl + (size_t)(j * 9 + iscale) * 1024;
      const float rstd = rsqrtf(ss[q] * (1.0f / 1024.0f) + 1e-6f);
#pragma unroll
      for (int i = 0; i < 2; ++i) {
        const int c0 = lane * 8 + 512 * i; float o[8];
#pragma unroll
        for (int hh = 0; hh < 2; ++hh) { const f32x4 g = *(const f32x4*)(gain + c0 + 4 * hh), s1 = *(const f32x4*)(sc + c0 + 4 * hh), s0 = *(const f32x4*)(sh + c0 + 4 * hh); const f32x4 y = v[q][2 * i + hh] * rstd * g * (s1 + 1.0f) + s0;
          o[4 * hh] = y[0]; o[4 * hh + 1] = y[1]; o[4 * hh + 2] = y[2]; o[4 * hh + 3] = y[3]; }
        u32x4 w; w.x = cvt_pk_bf16(o[0], o[1]); w.y = cvt_pk_bf16(o[2], o[3]); w.z = cvt_pk_bf16(o[4], o[5]); w.w = cvt_pk_bf16(o[6], o[7]);
        *(u32x4*)(Hn + (size_t)r * DM + c0) = w;
      }
    }
  }
}
__device__ __forceinline__ void final_norm(const float* X, float* out, const float* gain) {
  const int tid_ = otid(), lane = tid_ & 63, gw = blockIdx.x * 8 + (tid_ >> 6), nw = gridDim.x * 8;
  for (int r = gw; r < RLAT; r += nw) {
    const float* xr = X + (size_t)r * DM; f32x4 v[4]; float ss = 0.f;
#pragma unroll
    for (int i = 0; i < 4; ++i) { v[i] = *(const f32x4*)(xr + lane * 4 + 256 * i); ss += v[i][0] * v[i][0] + v[i][1] * v[i][1] + v[i][2] * v[i][2] + v[i][3] * v[i][3]; }
#pragma unroll
    for (int o = 32; o >= 1; o >>= 1) ss += __shfl_xor(ss, o);
    const float rstd = rsqrtf(ss * (1.0f / 1024.0f) + 1e-6f);
#pragma unroll
    for (int i = 0; i < 4; ++i) { const f32x4 g = *(const f32x4*)(gain + lane * 4 + 256 * i); *(f32x4*)(out + (size_t)r * DM + lane * 4 + 256 * i) = v[i] * rstd * g; }
  }
}

__device__ __forceinline__ void phase0(const Params& p, ldsp L) {
  const int tid = otid(); const size_t gt = (size_t)blockIdx.x * NTHR + tid, gs = (size_t)gridDim.x * NTHR;
  { f32x4* X = (f32x4*)(lws(p.ws) + O_X); const f32x4* xs = (const f32x4*)p.x; const f32x4* cs = (const f32x4*)p.ctx; const size_t n1 = (size_t)RLAT * DM / 4, n2 = (size_t)ROWS * DM / 4;
    for (size_t i = gt; i < n2; i += gs) X[i] = i < n1 ? xs[i] : cs[i - n1]; }
  { bf16_t* D = (bf16_t*)(lws(p.ws) + O_DFT);
    for (size_t v = gt; v < (size_t)4096 * 512; v += gs) { const int k = (int)(v >> 9), j0 = (int)(v & 511) * 8; float o[8];
#pragma unroll
      for (int e = 0; e < 8; ++e) { const int j = j0 + e; const bool cs_ = j <= 2048; const int t = cs_ ? j : j - 2048; const int r = (k * t) & 4095; const float a = (float)r * (1.0f / 2048.0f);
        o[e] = cs_ ? cospif(a) * (1.0f / 64.0f) : -sinpif(a) * (1.0f / 64.0f); }
      u32x4 w; w.x = cvt_pk_bf16(o[0], o[1]); w.y = cvt_pk_bf16(o[2], o[3]); w.z = cvt_pk_bf16(o[4], o[5]); w.w = cvt_pk_bf16(o[6], o[7]);
      *(u32x4*)(D + (size_t)k * 4096 + j0) = w; } }
  for (int idx = tid; idx < 9 * 1024; idx += NTHR) { const int j = idx >> 10, k = idx & 1023; const float v = j < 8 ? p.c[j * 1024 + k] : p.c_ctx[k]; ldsst<float>(L, idx * 4, siluf_(v)); }
  __syncthreads();
  float* MOD = (float*)(lws(p.ws) + O_MOD);
  for (int item = blockIdx.x; item < DEPTH * 144; item += gridDim.x) {
    const int l = item / 144, n0 = (item - l * 144) * 64, ks = tid >> 6, cn = tid & 63;
    float acc[9];
#pragma unroll
    for (int j = 0; j < 9; ++j) acc[j] = 0.f;
    const float* wp = p.w_ada + ((size_t)l * 1024 + ks * 128) * 9216 + n0 + cn;
#pragma unroll 4
    for (int k = 0; k < 128; ++k) { const float w = wp[(size_t)k * 9216];
#pragma unroll
      for (int j = 0; j < 9; ++j) acc[j] += ldsld<float>(L, (j * 1024 + ks * 128 + k) * 4) * w; }
#pragma unroll
    for (int j = 0; j < 9; ++j) ldsst<float>(L, 36864 + ((ks * 9 + j) * 64 + cn) * 4, acc[j]);
    __syncthreads();
    for (int o = tid; o < 576; o += NTHR) { const int j = o >> 6, c = o & 63; float s = p.b_ada[(size_t)l * 9216 + n0 + c];
#pragma unroll
      for (int q = 0; q < 8; ++q) s += ldsld<float>(L, 36864 + ((q * 9 + j) * 64 + c) * 4);
      MOD[((size_t)l * 9 + j) * 9216 + n0 + c] = s; }
    __syncthreads();
  }
}

__device__ __forceinline__ void prep_phase(const Params& p, int l, ldsp L) {
  const int tid = otid(), lane = tid & 63, wid = tid >> 6, fr = lane & 15, fq = lane >> 4;
  constexpr int KSB = 0, KTL = 17408, VTL = 35840, GL = 54272, AL = 71680, GCL = 104448, BTL = 104960, TOL = 105472;
  const bf16_t* QKV = (const bf16_t*)(lws(p.ws) + O_QKV); const float* AB = (const float*)(lws(p.ws) + O_AB);
  bf16_t* QN = (bf16_t*)(lws(p.ws) + O_QN); bf16_t* KN = (bf16_t*)(lws(p.ws) + O_KN); bf16_t* KNT = (bf16_t*)(lws(p.ws) + O_KNT); bf16_t* VNT = (bf16_t*)(lws(p.ws) + O_VNT);
  bf16_t* TT = (bf16_t*)(lws(p.ws) + O_TT); float* GC = (float*)(lws(p.ws) + O_GC);
  const float* cw = p.conv_w + (size_t)l * 3 * 1536;
  for (int item = blockIdx.x; item < NCH * 4; item += gridDim.x) {
    const int n = item >> 2, h = item & 3, R0 = n * 64;
    { const int row = tid >> 3, cs = tid & 7, r = R0 + row, c0 = cs * 16;
      const int t = r < RLAT ? (r & 4095) : ((r - RLAT) & 255), Ls = r < RLAT ? 4096 : 256;
      const bool hp = t > 0, hn = t < Ls - 1;
#pragma unroll
      for (int mtx = 0; mtx < 3; ++mtx) {
        const int cc = mtx * 512 + h * 128 + c0; const bf16_t* bp = QKV + (size_t)r * 1536 + cc;
        u32x4 a0 = {0, 0, 0, 0}, a1 = {0, 0, 0, 0}, c0v = {0, 0, 0, 0}, c1v = {0, 0, 0, 0};
        const u32x4 b0 = *(const u32x4*)(bp), b1 = *(const u32x4*)(bp + 8);
        if (hp) { a0 = *(const u32x4*)(bp - 1536); a1 = *(const u32x4*)(bp - 1536 + 8); }
        if (hn) { c0v = *(const u32x4*)(bp + 1536); c1v = *(const u32x4*)(bp + 1536 + 8); }
        float val[16]; float ss = 0.f;
#pragma unroll
        for (int e = 0; e < 16; ++e) {
          const unsigned wa = e < 8 ? a0[e >> 1] : a1[(e - 8) >> 1], wb = e < 8 ? b0[e >> 1] : b1[(e - 8) >> 1], wc_ = e < 8 ? c0v[e >> 1] : c1v[(e - 8) >> 1];
          const float xa = (e & 1) ? bfhi(wa) : bflo(wa), xb = (e & 1) ? bfhi(wb) : bflo(wb), xc = (e & 1) ? bfhi(wc_) : bflo(wc_);
          const float y = xa * cw[cc + e] + xb * cw[1536 + cc + e] + xc * cw[3072 + cc + e];
          val[e] = siluf_(y); ss += val[e] * val[e];
        }
        if (mtx < 2) { ss += __shfl_xor(ss, 1); ss += __shfl_xor(ss, 2); ss += __shfl_xor(ss, 4); const float sc = rsqrtf(ss + 1e-6f) * (mtx == 0 ? 0.08838834764831845f : 1.0f);
#pragma unroll
          for (int e = 0; e < 16; ++e) val[e] *= sc; }
        u32x4 w0, w1; w0.x = cvt_pk_bf16(val[0], val[1]); w0.y = cvt_pk_bf16(val[2], val[3]); w0.z = cvt_pk_bf16(val[4], val[5]); w0.w = cvt_pk_bf16(val[6], val[7]);
        w1.x = cvt_pk_bf16(val[8], val[9]); w1.y = cvt_pk_bf16(val[10], val[11]); w1.z = cvt_pk_bf16(val[12], val[13]); w1.w = cvt_pk_bf16(val[14], val[15]);
        if (mtx == 0) { bf16_t* o = QN + (size_t)r * 512 + h * 128 + c0; *(u32x4*)o = w0; *(u32x4*)(o + 8) = w1; }
        else if (mtx == 1) { bf16_t* o = KN + (size_t)r * 512 + h * 128 + c0; *(u32x4*)o = w0; *(u32x4*)(o + 8) = w1;
          ldsst<u32x4>(L, KSB + row * 272 + c0 * 2, w0); ldsst<u32x4>(L, KSB + row * 272 + c0 * 2 + 16, w1);
#pragma unroll
          for (int e = 0; e < 16; ++e) { const unsigned wv = e < 8 ? w0[e >> 1] : w1[(e - 8) >> 1]; ldsst<bf16_t>(L, KTL + (c0 + e) * 144 + row * 2, (bf16_t)((e & 1) ? (wv >> 16) : (wv & 0xffffu))); } }
        else {
#pragma unroll
          for (int e = 0; e < 16; ++e) { const unsigned wv = e < 8 ? w0[e >> 1] : w1[(e - 8) >> 1]; ldsst<bf16_t>(L, VTL + (c0 + e) * 144 + row * 2, (bf16_t)((e & 1) ? (wv >> 16) : (wv & 0xffffu))); } }
      }
    }
    if (wid < 2) {
      const int d = wid, r = R0 + lane;
      const float braw = AB[(size_t)r * 16 + d * 4 + h], araw = AB[(size_t)r * 16 + 8 + d * 4 + h];
      const float beta = sigmoidf_(braw);
      const float xs = araw + p.dt_bias[(l * 2 + d) * 4 + h];
      const float sp = fmaxf(xs, 0.f) + log1pf(__expf(-fabsf(xs)));
      const float g = -__expf(p.a_log[(l * 2 + d) * 4 + h]) * sp;
      float pre = g;
#pragma unroll
      for (int o = 1; o < 64; o <<= 1) { const float t2 = __shfl_up(pre, o); if (lane >= o) pre += t2; }
      const float tot = __shfl(pre, 63);
      const float gc = d == 0 ? pre : (tot - pre + g);
      ldsst<float>(L, GCL + (d * 64 + lane) * 4, gc); ldsst<float>(L, BTL + (d * 64 + lane) * 4, beta);
      GC[((size_t)item * 2 + d) * 64 + lane] = gc;
    }
    __syncthreads();
    { const int ti = wid >> 1;
#pragma unroll
      for (int q = 0; q < 2; ++q) { const int tj = 2 * (wid & 1) + q; f32x4 a = {0.f, 0.f, 0.f, 0.f};
#pragma unroll
        for (int kk = 0; kk < 4; ++kk) a = mma(ldsld<bf16x8>(L, KSB + (16 * tj + fr) * 272 + kk * 64 + fq * 16), ldsld<bf16x8>(L, KSB + (16 * ti + fr) * 272 + kk * 64 + fq * 16), a);
        ldsst<f32x4>(L, GL + ((16 * ti + fr) * 68 + 16 * tj + 4 * fq) * 4, a); }
    }
    {
#pragma unroll
      for (int it = 0; it < 2; ++it) { const int v = tid + 512 * it, c = v >> 3, sg = (v & 7) * 8;
        *(u32x4*)(KNT + (size_t)item * 8192 + c * 64 + sg) = ldsld<u32x4>(L, KTL + c * 144 + sg * 2);
        *(u32x4*)(VNT + (size_t)item * 8192 + c * 64 + sg) = ldsld<u32x4>(L, VTL + c * 144 + sg * 2); } }
    __syncthreads();
    { const int d = tid >> 8, a = (tid & 255) >> 2, jq = tid & 3;
      const int pi_ = d ? 63 - a : a; const float bi = ldsld<float>(L, BTL + (d * 64 + pi_) * 4), gi = ldsld<float>(L, GCL + (d * 64 + pi_) * 4);
#pragma unroll
      for (int e = 0; e < 16; ++e) { const int bb = jq * 16 + e, pr = d ? 63 - bb : bb;
        float v = 0.f;
        if (a > bb) v = bi * ldsld<float>(L, GL + (pi_ * 68 + pr) * 4) * __expf(gi - ldsld<float>(L, GCL + (d * 64 + pr) * 4));
        ldsst<float>(L, AL + ((d * 64 + a) * 64 + bb) * 4, v); } }
    __syncthreads();
    { constexpr int XL = 0, ML = GL; int tid5 = tid; asm volatile("" : "+v"(tid5)); const int wid5 = tid5 >> 6, lane5 = tid5 & 63;
#define XLA(d_, r_, c_) (XL + (((d_) * 64 + (r_)) * 64 + (c_)) * 4)
#define ALA(d_, r_, c_) (AL + (((d_) * 64 + (r_)) * 64 + (c_)) * 4)
      if (wid5 < 2) {
        const int d = wid5, bb = lane5 >> 4, cc = lane5 & 15; float xb[16];
#pragma unroll
        for (int ii = 0; ii < 16; ++ii) {
          float t = (ii == cc) ? 1.f : 0.f;
#pragma unroll
          for (int j4 = 0; j4 < (ii + 3) / 4; ++j4) { const f32x4 av = ldsld<f32x4>(L, ALA(d, 16 * bb + ii, 16 * bb + j4 * 4));
#pragma unroll
            for (int e = 0; e < 4; ++e) if (j4 * 4 + e < ii) t -= av[e] * xb[j4 * 4 + e]; }
          xb[ii] = t; ldsst<float>(L, XLA(d, 16 * bb + ii, 16 * bb + cc), t);
        }
      }
      __syncthreads();
#pragma unroll
      for (int lev = 1; lev <= 3; ++lev) {
        const int nblk = 2 * (4 - lev), nel = nblk * 256;
        for (int o = tid5; o < nel; o += NTHR) {
          const int bl = o >> 8, d = bl & 1, i = lev + (bl >> 1), j = i - lev, r = (o >> 4) & 15, c = o & 15; float acc_ = 0.f;
          for (int m = 0; m < lev; ++m) {
#pragma unroll
            for (int k4 = 0; k4 < 4; ++k4) { const f32x4 av = ldsld<f32x4>(L, ALA(d, 16 * i + r, 16 * (j + m) + 4 * k4));
#pragma unroll
              for (int e = 0; e < 4; ++e) acc_ += av[e] * ldsld<float>(L, XLA(d, 16 * (j + m) + 4 * k4 + e, 16 * j + c)); }
          }
          ldsst<float>(L, ML + o * 4, acc_);
        }
        __syncthreads();
        for (int o = tid5; o < nel; o += NTHR) {
          const int bl = o >> 8, d = bl & 1, i = lev + (bl >> 1), j = i - lev, r = (o >> 4) & 15, c = o & 15; float acc_ = 0.f;
#pragma unroll
          for (int k4 = 0; k4 < 4; ++k4) { const f32x4 dv = ldsld<f32x4>(L, XLA(d, 16 * i + r, 16 * i + 4 * k4));
#pragma unroll
            for (int e = 0; e < 4; ++e) acc_ += dv[e] * ldsld<float>(L, ML + ((bl << 8) + ((4 * k4 + e) << 4) + c) * 4); }
          ldsst<float>(L, XLA(d, 16 * i + r, 16 * j + c), -acc_);
        }
        __syncthreads();
      }
      { const int d = tid5 >> 8, i = (tid5 >> 2) & 63, cq = tid5 & 3, pp = d ? 63 - i : i; float tw[16], tu[16];
#pragma unroll
        for (int e = 0; e < 16; ++e) { const int c = cq * 16 + e, pr = d ? 63 - c : c;
          const float x = ((i >> 4) > cq || ((i >> 4) == cq)) ? ldsld<float>(L, XLA(d, i, c)) : 0.f;
          const float bc = ldsld<float>(L, BTL + (d * 64 + pr) * 4), fw = bc * __expf(ldsld<float>(L, GCL + (d * 64 + pr) * 4));
          tw[e] = x * fw; tu[e] = x * bc; }
#pragma unroll
        for (int e = 0; e < 8; ++e) { const float a0 = tw[e], a1 = tw[15 - e], b0 = tu[e], b1 = tu[15 - e]; tw[e] = d ? a1 : a0; tw[15 - e] = d ? a0 : a1; tu[e] = d ? b1 : b0; tu[15 - e] = d ? b0 : b1; }
        const int pr0 = d ? 63 - (cq * 16 + 15) : cq * 16;
        u32x4 w0, w1;
        w0.x = cvt_pk_bf16(tw[0], tw[1]); w0.y = cvt_pk_bf16(tw[2], tw[3]); w0.z = cvt_pk_bf16(tw[4], tw[5]); w0.w = cvt_pk_bf16(tw[6], tw[7]);
        w1.x = cvt_pk_bf16(tw[8], tw[9]); w1.y = cvt_pk_bf16(tw[10], tw[11]); w1.z = cvt_pk_bf16(tw[12], tw[13]); w1.w = cvt_pk_bf16(tw[14], tw[15]);
        ldsst<u32x4>(L, TOL + ((d * 2 + 0) * 64 + pp) * 144 + pr0 * 2, w0); ldsst<u32x4>(L, TOL + ((d * 2 + 0) * 64 + pp) * 144 + pr0 * 2 + 16, w1);
        w0.x = cvt_pk_bf16(tu[0], tu[1]); w0.y = cvt_pk_bf16(tu[2], tu[3]); w0.z = cvt_pk_bf16(tu[4], tu[5]); w0.w = cvt_pk_bf16(tu[6], tu[7]);
        w1.x = cvt_pk_bf16(tu[8], tu[9]); w1.y = cvt_pk_bf16(tu[10], tu[11]); w1.z = cvt_pk_bf16(tu[12], tu[13]); w1.w = cvt_pk_bf16(tu[14], tu[15]);
        ldsst<u32x4>(L, TOL + ((d * 2 + 1) * 64 + pp) * 144 + pr0 * 2, w0); ldsst<u32x4>(L, TOL + ((d * 2 + 1) * 64 + pp) * 144 + pr0 * 2 + 16, w1);
      }
#undef XLA
#undef ALA
    }
    __syncthreads();
#pragma unroll
    for (int it = 0; it < 4; ++it) { const int v = tid + 512 * it, mtx = v >> 9, row = (v >> 3) & 63, sg = (v & 7) * 8;
      *(u32x4*)(TT + ((size_t)item * 4 + mtx) * 4096 + row * 64 + sg) = ldsld<u32x4>(L, TOL + (mtx * 64 + row) * 144 + sg * 2); }
    __syncthreads();
  }
}

__device__ __forceinline__ void fourier_prep(const Params& p, ldsp L) {
  const int tid = otid(), lane = tid & 63, wid = tid >> 6, fr = lane & 15, fq = lane >> 4;
  constexpr int UA = 0, UB = 33792, DC = 67584;
  const bf16_t* FI = (const bf16_t*)(lws(p.ws) + O_FI); bf16_t* FBT = (bf16_t*)(lws(p.ws) + O_FBT); float* UCS = (float*)(lws(p.ws) + O_UCS);
  for (int idx = tid; idx < 128 * 64; idx += NTHR) { const int rr = idx >> 6, c = idx & 63, m = rr & 63; const float a = (float)((m * c) & 63) * (1.0f / 32.0f);
    const float v = (rr < 64 ? cospif(a) : sinpif(a)) * 0.125f; ldsst<bf16_t>(L, DC + rr * 144 + c * 2, (bf16_t)(cvt_pk_bf16(v, 0.f) & 0xffffu)); }
  __syncthreads();
  for (int item = (int)gridDim.x - 1 - (int)blockIdx.x; item < 288; item += gridDim.x) {
    const bool lat = item < 256; const int b = lat ? item >> 5 : 0, jb = item & 31;
#pragma unroll
    for (int it = 0; it < 4; ++it) { const int v = tid + 512 * it, row = v >> 5, sg = (v & 31) * 8;
      int ra, rb;
      if (lat) { const int t = 64 * jb + row; ra = b * 4096 + t; rb = b * 4096 + (t == 0 ? 2048 : 4096 - t); } else { ra = RLAT + (item - 256) * 64 + row; rb = ra; }
      ldsst<u32x4>(L, UA + row * 528 + sg * 2, *(const u32x4*)(FI + (size_t)ra * 256 + sg));
      ldsst<u32x4>(L, UB + row * 528 + sg * 2, *(const u32x4*)(FI + (size_t)rb * 256 + sg)); }
    __syncthreads();
    for (int q = 0; q < 8; ++q) {
      const int combo = wid * 8 + q, g = combo >> 4, ti = (combo >> 2) & 3, tm = combo & 3;
      f32x4 ac = {0.f, 0.f, 0.f, 0.f}, as = ac, bc = ac, bs = ac;
#pragma unroll
      for (int kk = 0; kk < 2; ++kk) {
        const bf16x8 xa = ldsld<bf16x8>(L, UA + (16 * ti + fr) * 528 + (g * 64 + kk * 32 + fq * 8) * 2), xb = ldsld<bf16x8>(L, UB + (16 * ti + fr) * 528 + (g * 64 + kk * 32 + fq * 8) * 2);
        const bf16x8 yc = ldsld<bf16x8>(L, DC + (16 * tm + fr) * 144 + kk * 64 + fq * 16), ys = ldsld<bf16x8>(L, DC + (64 + 16 * tm + fr) * 144 + kk * 64 + fq * 16);
        ac = mma(xa, yc, ac); as = mma(xa, ys, as); bc = mma(xb, yc, bc); bs = mma(xb, ys, bs);
      }
      const int mp = g * 64 + 16 * tm + fr, i0 = 16 * ti + 4 * fq;
      if (lat) {
        f32x4 cv = ac + bc, sv = as - bs;
        if (jb == 0 && i0 == 0) { cv[0] = ac[0]; sv[0] = bc[0]; }
        bf16_t* o = FBT + ((size_t)b * 256 + mp) * 4096 + 64 * jb + i0;
        *(u32x2*)o = pack4(cv); *(u32x2*)(o + 2048) = pack4(sv);
      } else {
#pragma unroll
        for (int e = 0; e < 4; ++e) { float* o = UCS + (size_t)((item - 256) * 64 + i0 + e) * 512; o[mp] = ac[e]; o[256 + mp] = as[e]; }
      }
    }
    __syncthreads();
  }
}

__device__ __forceinline__ void ctx_fourier(const Params& p, ldsp L, int wg, int nwg) {
  const int tid = otid(); const float* UCS = (const float*)(lws(p.ws) + O_UCS); bf16_t* PPF = (bf16_t*)(lws(p.ws) + O_PPF);
  for (int idx = tid; idx < 256; idx += NTHR) { const float a = (float)idx * (1.0f / 128.0f); ldsst<float>(L, idx * 4, cospif(a) * (1.0f / 16.0f)); ldsst<float>(L, 1024 + idx * 4, sinpif(a) * (1.0f / 16.0f)); }
  __syncthreads();
  for (int o = wg * NTHR + tid; o < NB * 64 * 256; o += nwg * NTHR) {
    const int mp = o & 255, kq = (o >> 8) & 63, b = o >> 14; const float* u = UCS + (size_t)b * 256 * 512 + mp; float s4[4] = {0.f, 0.f, 0.f, 0.f};
#pragma unroll 16
    for (int t = 0; t < 256; ++t) { const float uc = u[(size_t)t * 512], us = u[(size_t)t * 512 + 256];
#pragma unroll
      for (int e = 0; e < 4; ++e) { const int r = ((4 * kq + e) * t) & 255; s4[e] += ldsld<float>(L, r * 4) * uc - ldsld<float>(L, 1024 + r * 4) * us; } }
#pragma unroll
    for (int e = 0; e < 4; ++e) PPF[(size_t)(RLAT + b * 256 + 4 * kq + e) * 512 + 256 + mp] = (bf16_t)(cvt_pk_bf16(s4[e], 0.f) & 0xffffu);
  }
  __syncthreads();
}
__device__ __forceinline__ void pool_phase(const Params& p, ldsp L, int wg, int nwg) {
  const int tid_ = otid(), lane = tid_ & 63, wv = tid_ >> 6, gw = wg * 8 + wv, nw = nwg * 8;
  const bf16_t* PI = (const bf16_t*)(lws(p.ws) + O_PI); bf16_t* PPF = (bf16_t*)(lws(p.ws) + O_PPF);
  const int LP = wv * 16640;
  for (int idx = gw; idx < 2048; idx += nw) {
    const int g = 3 - (idx >> 9), b = (idx >> 6) & 7, r = idx & 63;
    const int win = 2 << g, hw = win >> 1, sr = max(r - hw, 0), er = min(r - hw + win, 64);
    const bf16_t* base = PI + (size_t)b * 4096 * 256 + g * 64 + lane;
    ldsst<float>(L, LP + lane * 4, 0.f);
    { const int ci = lane >> 3, ch0 = (lane & 7) * 8;
      const bf16_t* bq = PI + (size_t)b * 4096 * 256 + g * 64 + ch0;
#pragma unroll 1
      for (int cb = 0; cb < 8; ++cb) {
        const int cc = cb * 8 + ci; float ac[8];
#pragma unroll
        for (int e = 0; e < 8; ++e) ac[e] = 0.f;
        u32x4 vv[16];
#pragma unroll
        for (int q = 0; q < 16; ++q) { const int rr = sr + q; vv[q] = (u32x4){0u, 0u, 0u, 0u}; if (q < win && rr < er) vv[q] = *(const u32x4*)(bq + (size_t)(rr * 64 + cc) * 256); }
#pragma unroll
        for (int q = 0; q < 16; ++q) {
#pragma unroll
          for (int e = 0; e < 4; ++e) { ac[2 * e] += bflo(vv[q][e]); ac[2 * e + 1] += bfhi(vv[q][e]); } }
        ldsst<f32x4>(L, LP + ((cc + 1) * 64 + ch0) * 4, (f32x4){ac[0], ac[1], ac[2], ac[3]}); ldsst<f32x4>(L, LP + ((cc + 1) * 64 + ch0 + 4) * 4, (f32x4){ac[4], ac[5], ac[6], ac[7]});
      }
      float run = 0.f;
#pragma unroll 8
      for (int cc = 1; cc <= 64; ++cc) { run += ldsld<float>(L, LP + (cc * 64 + lane) * 4); ldsst<float>(L, LP + (cc * 64 + lane) * 4, run); }
    }
    const float rinv = 1.0f / (float)(er - sr);
#pragma unroll 16
    for (int c = 0; c < 64; ++c) {
      const int sc = max(c - hw, 0), ec = min(c - hw + win, 64);
      const float box = ldsld<float>(L, LP + (ec * 64 + lane) * 4) - ldsld<float>(L, LP + (sc * 64 + lane) * 4);
      const size_t rowi = (size_t)b * 4096 + r * 64 + c;
      const float self = __uint_as_float((unsigned)PI[rowi * 256 + g * 64 + lane] << 16);
      PPF[rowi * 512 + g * 64 + lane] = (bf16_t)(cvt_pk_bf16(box * rinv / (float)(ec - sc) - self, 0.f) & 0xffffu);
    }
  }
  for (int r = RLAT + gw; r < ROWS; r += nw) {
    const int base = r & ~255, t = r - base;
#pragma unroll
    for (int g = 0; g < 4; ++g) {
      const int win = 2 << g, hw = win >> 1, sc = max(t - hw, 0), ec = min(t - hw + win, 256);
      float s_ = 0.f;
#pragma unroll
      for (int q = 0; q < (2 << g); ++q) { const int c = sc + q; if (c < ec) s_ += __uint_as_float((unsigned)PI[(size_t)(base + c) * 256 + g * 64 + lane] << 16); }
      const float self = __uint_as_float((unsigned)PI[(size_t)r * 256 + g * 64 + lane] << 16);
      PPF[(size_t)r * 512 + g * 64 + lane] = (bf16_t)(cvt_pk_bf16(s_ / (float)(ec - sc) - self, 0.f) & 0xffffu);
    }
  }
}

__device__ __forceinline__ void scan_phase(const Params& p, ldsp L, int item) {
  const int tid = otid(), lane = tid & 63, wid = tid >> 6, fr = lane & 15, fq = lane >> 4;
  const int es = item & 1, d = (item >> 1) & 1, h = (item >> 2) & 3, b = item >> 4;
  const int ti = wid >> 1, half = wid & 1;
  constexpr int QS = 0, KS = 17408, KTS = 34816, VTS = 53248, TW = 62464, TU = 71680, AT = 80896, WL = 90112, VNT_ = 107520, VNS = 116736, STL = 125952, GCL = 143360;
  const bf16_t* QN = (const bf16_t*)(lws(p.ws) + O_QN); const bf16_t* KN = (const bf16_t*)(lws(p.ws) + O_KN); const bf16_t* KNT = (const bf16_t*)(lws(p.ws) + O_KNT); const bf16_t* VNT = (const bf16_t*)(lws(p.ws) + O_VNT);
  const bf16_t* TT = (const bf16_t*)(lws(p.ws) + O_TT); const float* GC = (const float*)(lws(p.ws) + O_GC); bf16_t* O = (bf16_t*)(lws(p.ws) + O_O) + (size_t)d * ROWS * 512;
  { unsigned zz_; asm volatile("v_mov_b32 %0, 0" : "=v"(zz_)); for (int o = tid * 16; o < 17408; o += NTHR * 16) ldsst<u32x4>(L, STL + o, (u32x4){zz_, zz_, zz_, zz_}); }
  f32x4 accS[4];
#pragma unroll
  for (int q = 0; q < 4; ++q) accS[q] = (f32x4){0.f, 0.f, 0.f, 0.f};
  u32x4 rq[2], rk[2], rkt[2], rvt, rtw, rtu; float rgc = 0.f;
#define SCAN_CHUNK(s) ((s) < 4 ? (NB * 64 + b * 4 + (d ? 3 - (s) : (s))) : (b * 64 + (d ? 67 - (s) : (s) - 4)))
#define SCAN_GLOAD(s) do { const int n_ = SCAN_CHUNK(s), it2_ = n_ * 4 + h; \
    _Pragma("unroll") for (int it = 0; it < 2; ++it) { const int v = tid + 512 * it; \
      rq[it] = *(const u32x4*)(QN + (size_t)(64 * n_ + (v >> 4)) * 512 + h * 128 + (v & 15) * 8); rk[it] = *(const u32x4*)(KN + (size_t)(64 * n_ + (v >> 4)) * 512 + h * 128 + (v & 15) * 8); \
      rkt[it] = *(const u32x4*)(KNT + (size_t)it2_ * 8192 + (v >> 3) * 64 + (v & 7) * 8); } \
    rvt = *(const u32x4*)(VNT + (size_t)it2_ * 8192 + (es * 64 + (tid >> 3)) * 64 + (tid & 7) * 8); \
    rtw = *(const u32x4*)(TT + ((size_t)it2_ * 4 + d * 2 + 0) * 4096 + (tid >> 3) * 64 + (tid & 7) * 8); rtu = *(const u32x4*)(TT + ((size_t)it2_ * 4 + d * 2 + 1) * 4096 + (tid >> 3) * 64 + (tid & 7) * 8); \
    if (tid < 64) rgc = GC[((size_t)it2_ * 2 + d) * 64 + tid]; } while (0)
#define SCAN_LSTORE() do { \
    _Pragma("unroll") for (int it = 0; it < 2; ++it) { const int v = tid + 512 * it; \
      ldsst<u32x4>(L, QS + (v >> 4) * 272 + (v & 15) * 16, rq[it]); ldsst<u32x4>(L, KS + (v >> 4) * 272 + (v & 15) * 16, rk[it]); ldsst<u32x4>(L, KTS + (v >> 3) * 144 + (v & 7) * 16, rkt[it]); } \
    ldsst<u32x4>(L, VTS + (tid >> 3) * 144 + (tid & 7) * 16, rvt); ldsst<u32x4>(L, TW + (tid >> 3) * 144 + (tid & 7) * 16, rtw); ldsst<u32x4>(L, TU + (tid >> 3) * 144 + (tid & 7) * 16, rtu); \
    if (tid < 64) ldsst<float>(L, GCL + tid * 4, rgc); } while (0)
  SCAN_GLOAD(0); SCAN_LSTORE(); __syncthreads();
  for (int s = 0; s < 68; ++s) {
    const int n = SCAN_CHUNK(s);
    if (s + 1 < 68) SCAN_GLOAD(s + 1);
    const float gtot = ldsld<float>(L, GCL + (d ? 0 : 63) * 4);
    f32x4 uacc[2], qacc[2];
    {
      bf16x8 qf[4], kf[2][4], twf[2], tuf[2], vtf[2][2], ktf[4][2], sf[2][4];
#pragma unroll
      for (int kk = 0; kk < 4; ++kk) qf[kk] = ldsld<bf16x8>(L, QS + (16 * ti + fr) * 272 + kk * 64 + fq * 16);
#pragma unroll
      for (int q = 0; q < 2; ++q)
#pragma unroll
        for (int kk = 0; kk < 4; ++kk) { kf[q][kk] = ldsld<bf16x8>(L, KS + (16 * (2 * half + q) + fr) * 272 + kk * 64 + fq * 16); sf[q][kk] = ldsld<bf16x8>(L, STL + (16 * (2 * half + q) + fr) * 272 + kk * 64 + fq * 16); }
      f32x4 at[2], wv[4];
#pragma unroll
      for (int q = 0; q < 2; ++q) { at[q] = (f32x4){0.f, 0.f, 0.f, 0.f}; qacc[q] = at[q]; uacc[q] = at[q]; }
#pragma unroll
      for (int q = 0; q < 4; ++q) wv[q] = (f32x4){0.f, 0.f, 0.f, 0.f};
#pragma unroll
      for (int kk = 0; kk < 4; ++kk)
#pragma unroll
        for (int q = 0; q < 2; ++q) { at[q] = mma(kf[q][kk], qf[kk], at[q]); qacc[q] = mma(sf[q][kk], qf[kk], qacc[q]); }
      __builtin_amdgcn_sched_barrier(0);
#pragma unroll
      for (int kk = 0; kk < 2; ++kk) { twf[kk] = ldsld<bf16x8>(L, TW + (16 * ti + fr) * 144 + kk * 64 + fq * 16); tuf[kk] = ldsld<bf16x8>(L, TU + (16 * ti + fr) * 144 + kk * 64 + fq * 16); }
#pragma unroll
      for (int q = 0; q < 4; ++q)
#pragma unroll
        for (int kk = 0; kk < 2; ++kk) ktf[q][kk] = ldsld<bf16x8>(L, KTS + (16 * (4 * half + q) + fr) * 144 + kk * 64 + fq * 16);
#pragma unroll
      for (int q = 0; q < 2; ++q)
#pragma unroll
        for (int kk = 0; kk < 2; ++kk) vtf[q][kk] = ldsld<bf16x8>(L, VTS + (16 * (2 * half + q) + fr) * 144 + kk * 64 + fq * 16);
#pragma unroll
      for (int kk = 0; kk < 2; ++kk) {
#pragma unroll
        for (int q = 0; q < 4; ++q) wv[q] = mma(ktf[q][kk], twf[kk], wv[q]);
#pragma unroll
        for (int q = 0; q < 2; ++q) uacc[q] = mma(tuf[kk], vtf[q][kk], uacc[q]);
      }
      const int i = 16 * ti + fr; const float gi = ldsld<float>(L, GCL + i * 4);
#pragma unroll
      for (int q = 0; q < 2; ++q) {
        const int j0 = 16 * (2 * half + q) + 4 * fq; f32x4 a = at[q];
#pragma unroll
        for (int e = 0; e < 4; ++e) { const int j = j0 + e; const bool keep = d ? (i <= j) : (i >= j); const float ar = keep ? gi - ldsld<float>(L, GCL + j * 4) : 0.f; a[e] = keep ? a[e] * __expf(ar) : 0.f; }
        ldsst<u32x2>(L, AT + i * 144 + j0 * 2, pack4(a));
      }
#pragma unroll
      for (int q = 0; q < 4; ++q) ldsst<u32x2>(L, WL + (16 * ti + fr) * 272 + (16 * (4 * half + q) + 4 * fq) * 2, pack4(wv[q]));
    }
    __syncthreads();
    {
      bf16x8 wf[4], sf[2][4];
#pragma unroll
      for (int kk = 0; kk < 4; ++kk) { wf[kk] = ldsld<bf16x8>(L, WL + (16 * ti + fr) * 272 + kk * 64 + fq * 16);
#pragma unroll
        for (int q = 0; q < 2; ++q) sf[q][kk] = ldsld<bf16x8>(L, STL + (16 * (2 * half + q) + fr) * 272 + kk * 64 + fq * 16); }
      f32x4 a[2];
#pragma unroll
      for (int q = 0; q < 2; ++q) a[q] = (f32x4){0.f, 0.f, 0.f, 0.f};
#pragma unroll
      for (int kk = 0; kk < 4; ++kk)
#pragma unroll
        for (int q = 0; q < 2; ++q) a[q] = mma(wf[kk], sf[q][kk], a[q]);
      const int i0 = 16 * ti + 4 * fq; float sc4[4];
#pragma unroll
      for (int e = 0; e < 4; ++e) sc4[e] = __expf(gtot - ldsld<float>(L, GCL + (i0 + e) * 4));
#pragma unroll
      for (int q = 0; q < 2; ++q) {
        const int te = 2 * half + q; const f32x4 vn = uacc[q] - a[q]; f32x4 vs;
#pragma unroll
        for (int e = 0; e < 4; ++e) vs[e] = vn[e] * sc4[e];
        ldsst<u32x2>(L, VNT_ + (16 * te + fr) * 144 + i0 * 2, pack4(vn)); ldsst<u32x2>(L, VNS + (16 * te + fr) * 144 + i0 * 2, pack4(vs));
      }
    }
    __syncthreads();
    {
      bf16x8 af[2], vf[2][2], nsf[2], ktf[4][2];
#pragma unroll
      for (int q = 0; q < 4; ++q)
#pragma unroll
        for (int kk = 0; kk < 2; ++kk) ktf[q][kk] = ldsld<bf16x8>(L, KTS + (16 * (4 * half + q) + fr) * 144 + kk * 64 + fq * 16);
#pragma unroll
      for (int kk = 0; kk < 2; ++kk) { af[kk] = ldsld<bf16x8>(L, AT + (16 * ti + fr) * 144 + kk * 64 + fq * 16); nsf[kk] = ldsld<bf16x8>(L, VNS + (16 * ti + fr) * 144 + kk * 64 + fq * 16);
#pragma unroll
        for (int q = 0; q < 2; ++q) vf[q][kk] = ldsld<bf16x8>(L, VNT_ + (16 * (2 * half + q) + fr) * 144 + kk * 64 + fq * 16); }
      const float cd = __expf(gtot);
      f32x4 ov[2];
#pragma unroll
      for (int q = 0; q < 2; ++q) ov[q] = (f32x4){0.f, 0.f, 0.f, 0.f};
#pragma unroll
      for (int q = 0; q < 4; ++q) accS[q] = accS[q] * cd;
#pragma unroll
      for (int kk = 0; kk < 2; ++kk) {
#pragma unroll
        for (int q = 0; q < 2; ++q) ov[q] = mma(vf[q][kk], af[kk], ov[q]);
#pragma unroll
        for (int q = 0; q < 4; ++q) accS[q] = mma(ktf[q][kk], nsf[kk], accS[q]);
      }
      const int i = 16 * ti + fr; const float eg = __expf(ldsld<float>(L, GCL + i * 4));
#pragma unroll
      for (int q = 0; q < 2; ++q) { const f32x4 o4 = qacc[q] * eg + ov[q];
        *(u32x2*)(O + (size_t)(64 * n + i) * 512 + h * 128 + es * 64 + 16 * (2 * half + q) + 4 * fq) = pack4(o4); }
    }
    __syncthreads();
#pragma unroll
    for (int q = 0; q < 4; ++q) ldsst<u32x2>(L, STL + (16 * ti + fr) * 272 + (16 * (4 * half + q) + 4 * fq) * 2, pack4(accS[q]));
    if (s + 1 < 68) SCAN_LSTORE();
    __syncthreads();
  }
#undef SCAN_CHUNK
#undef SCAN_GLOAD
#undef SCAN_LSTORE
}

__device__ __forceinline__ void ofprep_phase(const Params& p, int l) {
  const int tid_ = otid(), lane = tid_ & 63, gw = blockIdx.x * 8 + (tid_ >> 6), nw = gridDim.x * 8;
  const bf16_t* O0 = (const bf16_t*)(lws(p.ws) + O_O); const bf16_t* O1 = O0 + (size_t)ROWS * 512; const bf16_t* Z = (const bf16_t*)(lws(p.ws) + O_Z); bf16_t* OF = (bf16_t*)(lws(p.ws) + O_OF);
  const float* og = p.o_gain + (size_t)l * 128 + (lane & 15) * 8;
  for (int r0 = gw; r0 < ROWS; r0 += 2 * nw) {
    u32x4 av[2], bv[2], zv[2];
#pragma unroll
    for (int q = 0; q < 2; ++q) { const int r = (r0 + q * nw) < ROWS ? (r0 + q * nw) : r0;
      av[q] = *(const u32x4*)(O0 + (size_t)r * 512 + lane * 8); bv[q] = *(const u32x4*)(O1 + (size_t)r * 512 + lane * 8); zv[q] = *(const u32x4*)(Z + (size_t)r * 512 + lane * 8); }
#pragma unroll
    for (int q = 0; q < 2; ++q) {
      const int r = r0 + q * nw; if (r >= ROWS) continue;
      const u32x4 a = av[q], bq = bv[q], zq = zv[q];
      float o[8]; float ss = 0.f;
#pragma unroll
      for (int e = 0; e < 4; ++e) { o[2 * e] = bflo(a[e]) + bflo(bq[e]); o[2 * e + 1] = bfhi(a[e]) + bfhi(bq[e]); ss += o[2 * e] * o[2 * e] + o[2 * e + 1] * o[2 * e + 1]; }
      ss += __shfl_xor(ss, 1); ss += __shfl_xor(ss, 2); ss += __shfl_xor(ss, 4); ss += __shfl_xor(ss, 8);
      const float rstd = rsqrtf(ss * (1.0f / 128.0f) + 1e-6f);
      float y[8];
#pragma unroll
      for (int e = 0; e < 4; ++e) { y[2 * e] = o[2 * e] * rstd * og[2 * e] * siluf_(bflo(zq[e])); y[2 * e + 1] = o[2 * e + 1] * rstd * og[2 * e + 1] * siluf_(bfhi(zq[e])); }
      u32x4 w; w.x = cvt_pk_bf16(y[0], y[1]); w.y = cvt_pk_bf16(y[2], y[3]); w.z = cvt_pk_bf16(y[4], y[5]); w.w = cvt_pk_bf16(y[6], y[7]);
      *(u32x4*)(OF + (size_t)r * 512 + lane * 8) = w;
    }
  }
}

#define XB_TMO      128
#define XB_XCNT(j)  (256  + 64 * (j))
#define XB_XSUB(j)  (1280 + 64 * (j))
#define XB_XGEN(j)  (2304 + 64 * (j))
#define XB_TOP      3328
#define XB_TOPGEN   3392
#define XCD_BAR_WORDS 3456
#define XB_SPIN_CAP (1u << 18)

__device__ __forceinline__ unsigned xb_ld(unsigned* p)              { return __hip_atomic_load(p, __ATOMIC_RELAXED, __HIP_MEMORY_SCOPE_AGENT); }
__device__ __forceinline__ unsigned xb_add(unsigned* p, unsigned v) { return __hip_atomic_fetch_add(p, v, __ATOMIC_RELAXED, __HIP_MEMORY_SCOPE_AGENT); }
__device__ __forceinline__ unsigned xb_xcc_id() { return (unsigned)__builtin_amdgcn_s_getreg((3 << 11) | 20) & 0xFu; }
#define XB_SPIN(cond, bar) do { unsigned _sp = 0; while (cond) { __builtin_amdgcn_s_sleep(1); \
    if ((++_sp & 255u) == 0u) { if (xb_ld(&(bar)[XB_TMO])) break; if (_sp > XB_SPIN_CAP) { atomicAdd(&(bar)[XB_TMO], 1u); break; } } } } while (0)

struct XcdBarrier {
    unsigned* bar; unsigned x;
    volatile LAS unsigned* st;
};

__device__ __forceinline__ XcdBarrier xcd_barrier_post(unsigned* bar, volatile LAS unsigned* st) {
    XcdBarrier b; b.bar = bar; b.x = xb_xcc_id(); b.st = st;
    if (threadIdx.x == 0) (void)xb_add(&bar[XB_XCNT(b.x)], 1u);
    return b;
}
__device__ __forceinline__ void xcd_barrier_complete(unsigned* bar, unsigned x, unsigned& nloc, unsigned& nx) {
    const unsigned G = gridDim.x * gridDim.y * gridDim.z;
    unsigned sum, cnt, mine, sp = 0u;
    for (;;) {
        sum = 0u; cnt = 0u; mine = 0u;
#pragma unroll
        for (unsigned j = 0; j < 16; ++j) { const unsigned c = xb_ld(&bar[XB_XCNT(j)]); sum += c; cnt += (c > 0u) ? 1u : 0u; mine = (j == x) ? c : mine; }
        if (sum == G) break;
        __builtin_amdgcn_s_sleep(1);
        if ((++sp & 255u) == 0u) { if (xb_ld(&bar[XB_TMO])) break; if (sp > XB_SPIN_CAP) { atomicAdd(&bar[XB_TMO], 1u); break; } }
    }
    nloc = mine > 0u ? mine : 1u; nx = cnt > 0u ? cnt : 1u;
}

__device__ __forceinline__ void xcd_barrier(const XcdBarrier& b) {
    asm volatile("s_waitcnt vmcnt(0)" ::: "memory");
    __syncthreads();
    if (threadIdx.x == 0) {
        unsigned* bar = b.bar;
        __builtin_amdgcn_s_waitcnt(0);
        unsigned nloc = b.st[0], nx = b.st[1];
        if (nloc == 0u) { xcd_barrier_complete(bar, b.x, nloc, nx); b.st[0] = nloc; b.st[1] = nx; }
        const unsigned old = xb_add(&bar[XB_XSUB(b.x)], 1u);
        const unsigned gen = old / nloc;
        if (old + 1u == (gen + 1u) * nloc) {
            __builtin_amdgcn_fence(__ATOMIC_RELEASE, "agent");
            asm volatile("s_waitcnt vmcnt(0)" ::: "memory");
            const unsigned og = xb_add(&bar[XB_TOP], 1u);
            const unsigned tg = og / nx;
            if (og + 1u == (tg + 1u) * nx) xb_add(&bar[XB_TOPGEN], 1u);
            else XB_SPIN(xb_ld(&bar[XB_TOPGEN]) == tg, bar);
            __builtin_amdgcn_fence(__ATOMIC_ACQUIRE, "agent");
            xb_add(&bar[XB_XGEN(b.x)], 1u);
            asm volatile("s_waitcnt vmcnt(0)" ::: "memory");
        } else {
            XB_SPIN(xb_ld(&bar[XB_XGEN(b.x)]) == gen, bar);
            __builtin_amdgcn_fence(__ATOMIC_ACQUIRE, "agent");
            asm volatile("s_waitcnt vmcnt(0)" ::: "memory");
        }
    }
    __syncthreads();
}


__device__ __forceinline__ float rdb(const bf16_t* s_, size_t n, size_t i) { float a = 0.f; for (size_t j = i; j < n; j += (size_t)RLAT * DM) a += __uint_as_float((unsigned)s_[j] << 16); return a; }
__device__ __forceinline__ float rdf(const float* s_, size_t n, size_t i) { float a = 0.f; for (size_t j = i; j < n; j += (size_t)RLAT * DM) a += s_[j]; return a; }
__device__ __forceinline__ void dump_phase(const Params& p, int which) {
  const size_t NO = (size_t)RLAT * DM; unsigned char* ws = lws(p.ws);
  for (size_t i = (size_t)blockIdx.x * NTHR + otid(); i < NO; i += (size_t)gridDim.x * NTHR) {
    float a = 0.f;
    if (which == 1) { a = rdb((const bf16_t*)(ws + O_QKV), (size_t)ROWS * 1536, i) + rdb((const bf16_t*)(ws + O_Z), (size_t)ROWS * 512, i) + rdb((const bf16_t*)(ws + O_PI), (size_t)ROWS * 256, i) + rdb((const bf16_t*)(ws + O_FI), (size_t)ROWS * 256, i) + rdf((const float*)(ws + O_AB), (size_t)ROWS * 16, i); }
    if (which == 2) { a = rdb((const bf16_t*)(ws + O_QN), (size_t)ROWS * 512, i) + rdb((const bf16_t*)(ws + O_KN), (size_t)ROWS * 512, i) + rdb((const bf16_t*)(ws + O_KNT), (size_t)ROWS * 512, i) + rdb((const bf16_t*)(ws + O_VNT), (size_t)ROWS * 512, i) + rdb((const bf16_t*)(ws + O_TT), (size_t)ROWS * 1024, i) + rdf((const float*)(ws + O_GC), (size_t)NCH * 4 * 2 * 64, i)
          + rdb((const bf16_t*)(ws + O_FBT), (size_t)NB * 256 * 4096, i) + rdf((const float*)(ws + O_UCS), (size_t)NB * CTX * 512, i); }
    if (which == 3) { a = rdb((const bf16_t*)(ws + O_O), (size_t)ROWS * 1024, i); }
    if (which == 4) { a = rdb((const bf16_t*)(ws + O_OF), (size_t)ROWS * 512, i) + rdb((const bf16_t*)(ws + O_HN), (size_t)ROWS * 1024, i); }
    if (which == 5) { a = rdb((const bf16_t*)(ws + O_MRG), (size_t)ROWS * 1024, i); }
    if ((__float_as_uint(a) & 0xffff0000u) == 0xaaaa0000u) a = 1234.5f;
    if (!(a == a) || fabsf(a) > 1e30f) a = 777.0f;
    a = a * 0.5f + 0.12345678f;
    p.out[i] = a;
  }
}
__global__ void __launch_bounds__(NTHR) fwd_megakernel(Params p) {
  ldsp L = (ldsp)g_shm;
  cg::grid_group grid = cg::this_grid();
  volatile LAS unsigned* xst = (volatile LAS unsigned*)(L + LDS_BYTES - 16);
  if (threadIdx.x < 4) xst[threadIdx.x] = 0u;
  if (threadIdx.x == 0) { const unsigned long long wa_ = (unsigned long long)p.ws; *(volatile LAS unsigned*)(L + LDS_BYTES - 32) = (unsigned)wa_; *(volatile LAS unsigned*)(L + LDS_BYTES - 28) = (unsigned)(wa_ >> 32); }
  __syncthreads();
  XcdBarrier xbar = xcd_barrier_post((unsigned*)(p.ws + O_BAR), xst);
#define GSYNC0() do { asm volatile("s_waitcnt vmcnt(0) lgkmcnt(0)" ::: "memory"); __builtin_amdgcn_fence(__ATOMIC_RELEASE, "agent"); grid.sync(); __builtin_amdgcn_fence(__ATOMIC_ACQUIRE, "agent"); } while (0)
#define GSYNC() xcd_barrier(xbar)
  const int G = gridDim.x, c = blockIdx.x;
#define X ((float*)(lws(p.ws) + O_X))
#define MOD ((const float*)(lws(p.ws) + O_MOD))
#define Hn ((bf16_t*)(lws(p.ws) + O_HN))
#ifndef NO_P0
  phase0(p, L);
#endif
  GSYNC0();
  for (int l = 0; l < DEPTH; ++l) {
    const float* modl = MOD + (size_t)l * 9 * 9216; const float* ng = p.norm_gain + (size_t)l * 3 * 1024; const int notlast = (l != DEPTH - 1) ? 1 : 0, nMx = notlast ? ROWS / 256 : RLAT / 256;
#ifndef PROBE_CONV
#define PROBE_CONV 1
#endif
    { int cur_ = 0;
      if (l == 0) { convert_ffn(p, p.w1gu, p.w1d, O_WGU, O_WD, L, cur_, c, G); convert_win(p, 0, L, cur_, c, G); }
      convert_mixer(p, l, L, cur_); }
    norm_phase(X, Hn, ng, modl, 0, 1, l > 0 ? (const float*)(lws(p.ws) + O_TT) : nullptr);
    GSYNC();
#ifndef PROBE_UP
#define PROBE_UP 1
#endif
    for (int rep_ = 0; rep_ < PROBE_UP; ++rep_)
    { pg8::PlainSched S{(const char*)Hn, (const char*)(lws(p.ws) + O_WGU), 2048, 2048, 16, ROWS / 256, 22, G, c}; EpiUp E{(bf16_t*)(lws(p.ws) + O_ACT)}; pg8::gemm_phase(L, S, E); }
    GSYNC();
    { pg8::ResSched S{(const char*)(lws(p.ws) + O_ACT), (const char*)(lws(p.ws) + O_WD), DFF * 2, DFF / 64, G, c, 0}; EpiResT<false> E{(float*)(p.ws + O_X), modl, 2, 0.5f}; pg8::gemm_phase(L, S, E); }
    if (1) { pg8::ResSched S{(const char*)(lws(p.ws) + O_ACT), (const char*)(lws(p.ws) + O_WD), DFF * 2, DFF / 64, G, c, 1}; EpiPart E{(float*)(lws(p.ws) + O_TT), modl, 2, 0.5f}; pg8::gemm_phase(L, S, E); }
    GSYNC();
#ifndef NO_MIXER
    norm_phase(X, Hn, ng + 1024, modl, 3, 4, (const float*)(lws(p.ws) + O_TT));
    GSYNC();
#ifndef PROBE_IN
#define PROBE_IN 1
#endif
    for (int rep_ = 0; rep_ < PROBE_IN; ++rep_)
    { pg8::PlainSched S{(const char*)Hn, (const char*)(lws(p.ws) + O_WIN), 2048, 2048, 16, ROWS / 256, NINP / 256, G, c};
      EpiIn E{(bf16_t*)(lws(p.ws) + O_QKV), (bf16_t*)(lws(p.ws) + O_Z), (bf16_t*)(lws(p.ws) + O_PI), (bf16_t*)(lws(p.ws) + O_FI), (float*)(lws(p.ws) + O_AB)}; pg8::gemm_phase(L, S, E); }
    GSYNC();
#ifndef PROBE_PREP
#define PROBE_PREP 1
#endif
    for (int rep_ = 0; rep_ < PROBE_PREP; ++rep_) {
    prep_phase(p, l, L);
    }
#ifndef NO_FPREP
    fourier_prep(p, L);
#endif
    GSYNC();
#if defined(DUMP) && DUMP == 2
    dump_phase(p, 2); return;
#endif
#ifndef PROBE_SCAN
#define PROBE_SCAN 1
#endif
#ifndef PROBE_OTHER
#define PROBE_OTHER 1
#endif
    for (int rep_ = 0; rep_ < PROBE_SCAN; ++rep_) {
#ifndef NO_SCAN
    if (c < 128) scan_phase(p, L, c);
#else
    if (c < 128) {}
#endif
    else for (int rep2_ = 0; rep2_ < PROBE_OTHER; ++rep2_) {
      __syncthreads();
      { FourSched S{(const char*)(lws(p.ws) + O_DFT), (const char*)(lws(p.ws) + O_FBT), c - 128}; EpiBf E{(bf16_t*)(lws(p.ws) + O_PPF) + 256, 512}; pg8::gemm_phase(L, S, E); }
      __syncthreads();
      ctx_fourier(p, L, c - 128, G - 128);
      pool_phase(p, L, c - 128, G - 128);
    }
    __syncthreads();
    }
    GSYNC();
#if defined(DUMP) && DUMP == 3
    dump_phase(p, 3); return;
#endif
#ifndef PROBE_OFP
#define PROBE_OFP 1
#endif
    for (int rep_ = 0; rep_ < PROBE_OFP; ++rep_) {
    ofprep_phase(p, l);
    norm_phase(X, Hn, ng + 1024, modl, 3, 4, nullptr);
    }
    GSYNC();
#if defined(DUMP) && DUMP == 4
    dump_phase(p, 4); return;
#endif
#ifndef PROBE_MRG
#define PROBE_MRG 1
#endif
    for (int rep_ = 0; rep_ < PROBE_MRG; ++rep_)
    { MergeSched S{(const char*)Hn, (const char*)(lws(p.ws) + O_OF), (const char*)(lws(p.ws) + O_PPF), (const char*)(lws(p.ws) + O_WG), (const char*)(lws(p.ws) + O_WCAT), G, c, RLAT / 256};
      EpiMerge E{(unsigned*)(lws(p.ws) + O_SCR) + (size_t)c * 2 * 32768, (bf16_t*)(lws(p.ws) + O_MRG)}; pg8::gemm_phase(L, S, E); }
    if (notlast) { MergeCtxSched S{(const char*)Hn, (const char*)(lws(p.ws) + O_OF), (const char*)(lws(p.ws) + O_PPF), (const char*)(lws(p.ws) + O_WG), (const char*)(lws(p.ws) + O_WCAT), c};
      EpiMergeCtx E{(unsigned*)(lws(p.ws) + O_SCR) + (size_t)c * 2 * 32768, (bf16_t*)(lws(p.ws) + O_PARTM)}; pg8::gemm_phase(L, S, E); }
    if (notlast && c >= 96) {
      int cur_ = 0; convert_ffn(p, p.w2gu + (size_t)l * 1024 * 2 * DFF, p.w2d + (size_t)l * DFF * 1024, O_WGU2, O_WD2, L, cur_, c - 96, G - 96);
      convert_ffn(p, p.w1gu + (size_t)(l + 1) * 1024 * 2 * DFF, p.w1d + (size_t)(l + 1) * DFF * 1024, O_WGU, O_WD, L, cur_, c - 96, G - 96);
      convert_win(p, l + 1, L, cur_, c - 96, G - 96); }
    GSYNC();
#if defined(DUMP) && DUMP == 5
    dump_phase(p, 5); return;
#endif
    { pg8::ResSched S{(const char*)(lws(p.ws) + O_MRG), (const char*)(lws(p.ws) + O_WOUT), 2048, 16, G, c, 0}; EpiResT<false> E{(float*)(p.ws + O_X), modl, 5, 1.0f}; pg8::gemm_phase(L, S, E); }
    if (notlast) { pg8::ResSched S{(const char*)(lws(p.ws) + O_PARTM) - (size_t)128 * 256 * 6144, (const char*)(lws(p.ws) + O_WOUT3), 6144, 48, G, c, 1}; EpiPart E{(float*)(lws(p.ws) + O_TT), modl, 5, 1.0f}; pg8::gemm_phase(L, S, E); }
    GSYNC();
#endif
    if (!notlast) { int cur_ = 0; convert_ffn(p, p.w2gu + (size_t)l * 1024 * 2 * DFF, p.w2d + (size_t)l * DFF * 1024, O_WGU2, O_WD2, L, cur_, c, G); }
    norm_phase(X, Hn, ng + 2048, modl, 6, 7, notlast ? (const float*)(lws(p.ws) + O_TT) : nullptr);
    GSYNC();
    { pg8::PlainSched S{(const char*)Hn, (const char*)(lws(p.ws) + O_WGU2), 2048, 2048, 16, nMx, 22, G, c}; EpiUp E{(bf16_t*)(lws(p.ws) + O_ACT)}; pg8::gemm_phase(L, S, E); }
    GSYNC();
    { pg8::ResSched S{(const char*)(lws(p.ws) + O_ACT), (const char*)(lws(p.ws) + O_WD2), DFF * 2, DFF / 64, G, c, 0}; EpiResT<false> E{(float*)(p.ws + O_X), modl, 8, 0.5f}; pg8::gemm_phase(L, S, E); }
    if (notlast) { pg8::ResSched S{(const char*)(lws(p.ws) + O_ACT), (const char*)(lws(p.ws) + O_WD2), DFF * 2, DFF / 64, G, c, 1}; EpiPart E{(float*)(lws(p.ws) + O_TT), modl, 8, 0.5f}; pg8::gemm_phase(L, S, E); }
    GSYNC();
  }
  final_norm(X, p.out, p.final_gain);
}

extern "C" void kernel_launch(void* const* d_in, const int* in_sizes, int n_in, void* d_out, int out_size, void* d_ws, size_t ws_size, hipStream_t stream) {
  (void)in_sizes; (void)n_in; (void)out_size;
  if (ws_size < WS_NEED) { fprintf(stderr, "workspace too small: %zu < %zu\n", ws_size, (size_t)WS_NEED); return; }
  static int grid_blocks = 0;
  if (!grid_blocks) {
    (void)hipFuncSetAttribute((const void*)fwd_megakernel, hipFuncAttributeMaxDynamicSharedMemorySize, LDS_BYTES);
    int dev = 0, cus = 0, per_cu = 0; (void)hipGetDevice(&dev); (void)hipDeviceGetAttribute(&cus, hipDeviceAttributeMultiprocessorCount, dev);
    (void)hipOccupancyMaxActiveBlocksPerMultiprocessor(&per_cu, fwd_megakernel, NTHR, LDS_BYTES);
    grid_blocks = cus * (per_cu > 0 ? 1 : 0);
    if (grid_blocks != 256) fprintf(stderr, "unexpected grid %d (cus %d per_cu %d)\n", grid_blocks, cus, per_cu);
  }
  Params p{};
  const float** f = (const float**)&p;
  for (int i = 0; i < 22; ++i) f[i] = (const float*)d_in[i];
  p.out = (float*)d_out; p.ws = (unsigned char*)d_ws;
  (void)hipMemsetAsync((unsigned char*)d_ws + O_BAR, 0, 16384, stream);
  void* args[] = {&p};
  hipError_t e = hipLaunchCooperativeKernel((void*)fwd_megakernel, dim3(grid_blocks), dim3(NTHR), args, LDS_BYTES, stream);
  if (e != hipSuccess) fprintf(stderr, "cooperative launch failed: %s (grid %d)\n", hipGetErrorString(e), grid_blocks);
}
```

```cpp
#include <hip/hip_runtime.h>
#include <hip/hip_cooperative_groups.h>
#include <cstdio>

namespace cg = cooperative_groups;

#define LAS __attribute__((address_space(3)))
typedef LAS unsigned char* ldsp;
typedef unsigned short bf16_t;
typedef short bf16x8 __attribute__((ext_vector_type(8)));
typedef float f32x4 __attribute__((ext_vector_type(4)));
typedef unsigned u32x4 __attribute__((ext_vector_type(4)));
typedef unsigned u32x2 __attribute__((ext_vector_type(2)));

constexpr int DM = 1024, NB = 8, SEQ = 4096, CTX = 256, DEPTH = 4;
constexpr int RLAT = NB * SEQ, ROWS = RLAT + NB * CTX;
constexpr int DFF = 2816, NMOD = 9, DPROJ = 5648;
constexpr int NCH = ROWS / 64;
constexpr int NINP = 2816;
constexpr int LDS_BYTES = 163840;
constexpr int NTHR = 512;

constexpr size_t al256(size_t x) { return (x + 255) & ~(size_t)255; }
constexpr size_t O_X = 0;
constexpr size_t O_MOD = O_X + (size_t)ROWS * DM * 4;
constexpr size_t O_DFT = al256(O_MOD + (size_t)DEPTH * 9 * 9216 * 4);
constexpr size_t O_WGU = O_DFT + (size_t)4096 * 4096 * 2;
constexpr size_t O_WD = O_WGU + (size_t)5632 * 1024 * 2;
constexpr size_t O_WIN = O_WD + (size_t)1024 * 2816 * 2;
constexpr size_t O_WG = O_WIN + (size_t)NINP * 1024 * 2;
constexpr size_t O_WCAT = O_WG + (size_t)3072 * 1024 * 2;
constexpr size_t O_WOUT = O_WCAT + (size_t)1024 * 1024 * 2;
constexpr size_t O_R = O_WOUT + (size_t)1024 * 1024 * 2;
constexpr size_t SZ_H = (size_t)ROWS * 1024 * 2;
constexpr size_t SZ_Q = (size_t)ROWS * 512 * 2;
constexpr size_t O_HN = O_R;
constexpr size_t O_ACT = O_R + SZ_H;
constexpr size_t O_QN = O_R;
constexpr size_t O_KN = O_R + SZ_Q;
constexpr size_t O_QKV = O_R + SZ_H;
constexpr size_t O_O = O_QKV;
constexpr size_t O_SCR = O_QKV;
constexpr size_t O_Z = O_QKV + (size_t)ROWS * 1536 * 2;
constexpr size_t O_PI = O_Z + SZ_Q;
constexpr size_t O_FI = O_PI + (size_t)ROWS * 256 * 2;
constexpr size_t O_AB = O_FI + (size_t)ROWS * 256 * 2;
constexpr size_t O_KNT = al256(O_AB + (size_t)ROWS * 16 * 4);
constexpr size_t O_VNT = O_KNT + SZ_Q;
constexpr size_t O_MRG = O_KNT;
constexpr size_t O_TT = O_VNT + SZ_Q;
constexpr size_t O_OF = O_TT;
constexpr size_t O_GC = O_TT + SZ_H;
constexpr size_t O_FBT = al256(O_GC + (size_t)NCH * 4 * 2 * 64 * 4);
constexpr size_t O_UCS = O_FBT + (size_t)NB * 256 * 4096 * 2;
constexpr size_t O_PPF = al256(O_UCS + (size_t)NB * CTX * 512 * 4);
constexpr size_t O_WGU2 = al256(O_PPF + SZ_Q);
constexpr size_t O_WD2 = O_WGU2 + (size_t)5632 * 1024 * 2;
constexpr size_t O_WOUT3 = al256(O_WD2 + (size_t)1024 * 2816 * 2);
constexpr size_t O_BAR = al256(O_WOUT3 + (size_t)1024 * 3072 * 2);
constexpr size_t O_PARTM = O_Z;
constexpr size_t WS_NEED = O_BAR + 16384;
static_assert(O_SCR + (size_t)256 * 2 * 262144 <= O_PI, "merge scratch overlaps");

struct Params {
  const float *x, *c, *ctx, *c_ctx, *w_ada, *b_ada, *norm_gain, *w1gu, *w1d, *w2gu, *w2d, *w_in, *conv_w, *a_log, *dt_bias, *o_gain, *w_a, *w_b,
      *pool_scale, *w_c, *w_out, *final_gain;
  float* out;
  unsigned char* ws;
};

typedef float f32x2_ __attribute__((ext_vector_type(2)));
typedef __bf16 bf16x2_ __attribute__((ext_vector_type(2)));
__device__ __forceinline__ unsigned cvt_pk_bf16(float lo, float hi) { const f32x2_ v = {lo, hi}; const bf16x2_ b = __builtin_convertvector(v, bf16x2_); return __builtin_bit_cast(unsigned, b); }
__device__ __forceinline__ float bflo(unsigned w) { return __uint_as_float(w << 16); }
__device__ __forceinline__ float bfhi(unsigned w) { return __uint_as_float(w & 0xffff0000u); }
__device__ __forceinline__ float sigmoidf_(float x) { return __builtin_amdgcn_rcpf(1.0f + __expf(-x)); }
__device__ __forceinline__ float siluf_(float x) { return x * __builtin_amdgcn_rcpf(1.0f + __expf(-x)); }
template <class T> __device__ __forceinline__ T ldsld(ldsp b, int off) { return *(const LAS T*)(b + off); }
template <class T> __device__ __forceinline__ void ldsst(ldsp b, int off, T v) { *(LAS T*)(b + off) = v; }
__device__ __forceinline__ f32x4 mma(bf16x8 a, bf16x8 b, f32x4 c) { return __builtin_amdgcn_mfma_f32_16x16x32_bf16(a, b, c, 0, 0, 0); }
__device__ __forceinline__ u32x2 pack4(f32x4 v) { u32x2 r; r.x = cvt_pk_bf16(v[0], v[1]); r.y = cvt_pk_bf16(v[2], v[3]); return r; }
__device__ __forceinline__ int otid() { int t = threadIdx.x; asm volatile("" : "+v"(t)); return t; }
extern __shared__ __attribute__((aligned(16))) unsigned char g_shm[];
__device__ __forceinline__ unsigned char* lws(unsigned char*) { ldsp Lb = (ldsp)g_shm; unsigned lo = *(volatile LAS unsigned*)(Lb + LDS_BYTES - 32), hi = *(volatile LAS unsigned*)(Lb + LDS_BYTES - 28);
  lo = __builtin_amdgcn_readfirstlane(lo); hi = __builtin_amdgcn_readfirstlane(hi); return (unsigned char*)(((unsigned long long)hi << 32) | (unsigned long long)lo); }
__device__ __forceinline__ void atomic_add_f32(float* q, float v) { asm volatile("global_atomic_add_f32 %0, %1, off sc1" : : "v"(q), "v"(v) : "memory"); }
__device__ __forceinline__ int modidx(int pm) { return pm < 128 ? (pm >> 4) : 8; }

namespace pg8 {
constexpr int BM = 256, BK = 64, HALF = 128, HTB = HALF * BK * 2, NXCD = 8, WGM = 8;
__device__ __forceinline__ int lds_byte(int r, int c) { const int st = (r >> 4) * 2 + (c >> 5), rr = r & 15, cc = c & 31, ob = rr * 64 + cc * 2; return st * 1024 + (ob ^ (((ob >> 9) & 1) << 5)); }
__device__ __forceinline__ void stage_rc(int b, int& R, int& C) { const int st = b / 1024, sb = b % 1024, swz = sb ^ (((sb >> 9) & 1) << 5); R = (st >> 1) * 16 + swz / 64; C = (st & 1) * 32 + (swz % 64) / 2; }
__device__ __forceinline__ int perm32(int rho) { const int n = rho >> 4, i = rho & 15; return 8 * (i >> 2) + 4 * n + (i & 3); }

struct Unit { const char* A; const char* B; int lda, ldb, nt, pm, pn, seg; };

__device__ __forceinline__ bool tile_of(int nM, int nN, int G, int c, int i, int& pm, int& pn) {
  const int nwg = nM * nN; const long Lq = (long)i * G + c; if (Lq >= nwg) return false;
  int wgid = (int)Lq; { const int q = nwg / NXCD, r = nwg % NXCD, xcd = wgid % NXCD, off = wgid / NXCD; wgid = (xcd < r ? xcd * (q + 1) : r * (q + 1) + (xcd - r) * q) + off; }
  const int nig = WGM * nN, gid = wgid / nig, fm = gid * WGM, gsz = (nM - fm) < WGM ? (nM - fm) : WGM;
  pm = fm + ((wgid % nig) % gsz); pn = (wgid % nig) / gsz; return true;
}
struct PlainSched {
  static constexpr bool VARLDA = false;
  const char* A; const char* B; int lda, ldb, nt, nM, nN, G, c;
  __device__ __forceinline__ bool next(int i, Unit& u) const {
    int pm, pn; if (!tile_of(nM, nN, G, c, i, pm, pn)) return false;
    u.A = A + (size_t)pm * 256 * lda; u.B = B + (size_t)pn * 256 * ldb; u.lda = lda; u.ldb = ldb; u.nt = nt; u.pm = pm; u.pn = pn; u.seg = 0; return true;
  }
};

struct ResSched {
  static constexpr bool VARLDA = false;
  const char* A; const char* B; int ld, nt, G, c, mode;
  __device__ __forceinline__ bool next(int i, Unit& u) const {
    u.lda = ld; u.ldb = ld;
    if (mode == 0) { int pm, pn; if (i >= 2 || !tile_of(128, 4, G, c, i, pm, pn)) return false;
      u.A = A + (size_t)pm * 256 * ld; u.B = B + (size_t)pn * 256 * ld; u.nt = nt; u.pm = pm; u.pn = pn; u.seg = 0; return true; }
#ifdef NO_SPLITK
    if (i > 0 || c >= 32) return false;
    { const int pm = 128 + (c >> 2), pn = c & 3; u.A = A + (size_t)pm * 256 * ld; u.B = B + (size_t)pn * 256 * ld; u.nt = nt; u.pm = pm; u.pn = pn; u.seg = 0; return true; }
#endif
    if (i > 0 || c >= 256) return false;
    const int pm = 128 + (c >> 5), pn = (c >> 3) & 3, kp = c & 7;
    const int base = (nt / 16) * 2, extra = (nt - base * 8) / 2;
    const int k0 = kp * base + 2 * (kp < extra ? kp : extra), np = base + (kp < extra ? 2 : 0);
    u.A = A + (size_t)pm * 256 * ld + (size_t)k0 * 128; u.B = B + (size_t)pn * 256 * ld + (size_t)k0 * 128; u.nt = np; u.pm = pm; u.pn = pn; u.seg = kp; return true;
  }
};
template <class Epi, class Sched>
__device__ __forceinline__ void gemm_phase(ldsp lds, const Sched& S, const Epi& E) {
  const int tid = otid(), wid = __builtin_amdgcn_readfirstlane(tid >> 6), lane = tid & 63, wr = wid >> 2, wc = wid & 3, fr = lane & 15, fq = lane >> 4;
  unsigned rA[2], rB[2], c2[2];
#pragma unroll
  for (int i = 0; i < 2; ++i) { int R, C; stage_rc(tid * 16 + i * 8192, R, C); rA[i] = (unsigned)R; rB[i] = (unsigned)(Epi::PERM ? ((R & ~31) + perm32(R & 31)) : R); c2[i] = (unsigned)C * 2u; }
  const size_t kstep = (size_t)(BK * 2);
  const unsigned ldsw = (unsigned)wid * 1024u;
  const int aoff = lds_byte(wr * 64 + fr, fq * 8), boff = lds_byte(wc * 32 + fr, fq * 8);
#define PG8_SA(b, h) (((b) * 2 + (h)) * HTB)
#define PG8_SB(b, h) ((4 + (b) * 2 + (h)) * HTB)
#define PG8_STAGE(bufoff, gbase, voff) do { _Pragma("unroll") for (int _i = 0; _i < 2; ++_i) \
    __builtin_amdgcn_global_load_lds((const unsigned*)((const char*)(gbase) + (voff)[_i]), (LAS unsigned*)(lds + (bufoff) + ldsw + _i * 8192), 16, 0, 0); } while (0)
#define PG8_LDA(dst, b, h) do { _Pragma("unroll") for (int m = 0; m < 4; ++m) _Pragma("unroll") for (int k = 0; k < 2; ++k) dst[m][k] = *(const LAS bf16x8*)(lds + PG8_SA(b, h) + aoff + m * 2048 + k * 1024); } while (0)
#define PG8_LDB(dst, b, h) do { _Pragma("unroll") for (int n = 0; n < 2; ++n) _Pragma("unroll") for (int k = 0; k < 2; ++k) dst[n][k] = *(const LAS bf16x8*)(lds + PG8_SB(b, h) + boff + n * 2048 + k * 1024); } while (0)
#define PG8_MMA(ai, bj, At, Bt) do { __builtin_amdgcn_s_setprio(1); _Pragma("unroll") for (int m = 0; m < 4; ++m) _Pragma("unroll") for (int n = 0; n < 2; ++n) _Pragma("unroll") for (int k = 0; k < 2; ++k) \
    acc[ai][bj][m][n] = __builtin_amdgcn_mfma_f32_16x16x32_bf16(Bt[n][k], At[m][k], acc[ai][bj][m][n], 0, 0, 0); __builtin_amdgcn_s_setprio(0); } while (0)
#define PG8_WAIT_V(n) asm volatile("s_waitcnt vmcnt(" #n ")" ::: "memory")
#define PG8_WAIT_L(n) asm volatile("s_waitcnt lgkmcnt(" #n ")" ::: "memory")
#define PG8_BAR __builtin_amdgcn_s_barrier()
#define PG8_SCHED __builtin_amdgcn_sched_barrier(0)
  Unit cur, nxt; int ui = 0;
  if (!S.next(0, cur)) return;
  float zz_; asm volatile("v_mov_b32 %0, 0" : "=v"(zz_));
  f32x4 acc[2][2][4][2];
#pragma unroll
  for (int a = 0; a < 2; ++a)
#pragma unroll
    for (int b = 0; b < 2; ++b)
#pragma unroll
      for (int m = 0; m < 4; ++m)
#pragma unroll
        for (int n = 0; n < 2; ++n) acc[a][b][m][n] = (f32x4){zz_, zz_, zz_, zz_};
  bf16x8 At[4][2], B0[2][2], B1[2][2];
  const char* cA = cur.A; const char* cB = cur.B; int ldA = cur.lda; const int ldB = cur.ldb;
  unsigned voffA[2], voffB[2];
#pragma unroll
  for (int i = 0; i < 2; ++i) { voffA[i] = rA[i] * (unsigned)ldA + c2[i]; voffB[i] = rB[i] * (unsigned)ldB + c2[i]; }
  const size_t hB = (size_t)HALF * ldB;
  {
    const size_t hA = (size_t)HALF * ldA;
    PG8_STAGE(PG8_SB(0, 0), cB, voffB); PG8_STAGE(PG8_SA(0, 0), cA, voffA); PG8_STAGE(PG8_SB(0, 1), cB + hB, voffB); PG8_STAGE(PG8_SA(0, 1), cA + hA, voffA);
    if (wr == 1) PG8_BAR;
    PG8_WAIT_V(4); PG8_BAR;
    PG8_STAGE(PG8_SB(1, 0), cB + kstep, voffB); PG8_STAGE(PG8_SA(1, 0), cA + kstep, voffA); PG8_STAGE(PG8_SB(1, 1), cB + hB + kstep, voffB);
    PG8_WAIT_V(6); PG8_BAR;
  }
  for (;;) {
    const bool has_next = S.next(ui + 1, nxt);
    const char* nA = has_next ? nxt.A : cA; const char* nB = has_next ? nxt.B : cB;
    const int nldA = has_next ? nxt.lda : ldA;
    const int nt = cur.nt;
    const size_t hA = (size_t)HALF * ldA;
    for (int t = 0; t < nt; t += 2) {
      const bool last = (t == nt - 2);
      const char* a1 = cA + (size_t)(t + 1) * kstep;
      const char* a2 = last ? nA : cA + (size_t)(t + 2) * kstep; const char* b2 = last ? nB : cB + (size_t)(t + 2) * kstep;
      const size_t h2A = (size_t)HALF * (last ? nldA : ldA);
      const char* a3 = a2 + kstep; const char* b3 = b2 + kstep;
      PG8_LDB(B0, 0, 0); PG8_SCHED; PG8_LDA(At, 0, 0); PG8_STAGE(PG8_SA(1, 1), a1 + hA, voffA);
      if (Sched::VARLDA) { if (last) {
#pragma unroll
        for (int i = 0; i < 2; ++i) voffA[i] = rA[i] * (unsigned)nldA + c2[i]; } }
      PG8_WAIT_L(8); PG8_BAR; PG8_WAIT_L(0); PG8_MMA(0, 0, At, B0); PG8_BAR; PG8_SCHED;
      PG8_LDB(B1, 0, 1); PG8_STAGE(PG8_SB(0, 0), b2, voffB);
      PG8_BAR; PG8_WAIT_L(0); PG8_MMA(0, 1, At, B1); PG8_BAR;
      PG8_LDA(At, 0, 1); PG8_STAGE(PG8_SA(0, 0), a2, voffA);
      PG8_BAR; PG8_WAIT_L(0); PG8_MMA(1, 0, At, B0); PG8_BAR; PG8_SCHED;
      PG8_STAGE(PG8_SB(0, 1), b2 + hB, voffB);
      PG8_WAIT_V(6); PG8_BAR; PG8_MMA(1, 1, At, B1); PG8_BAR;
      PG8_LDB(B0, 1, 0); PG8_SCHED; PG8_LDA(At, 1, 0); PG8_STAGE(PG8_SA(0, 1), a2 + h2A, voffA);
      PG8_WAIT_L(8); PG8_BAR; PG8_WAIT_L(0); PG8_MMA(0, 0, At, B0); PG8_BAR; PG8_SCHED;
      PG8_LDB(B1, 1, 1); PG8_STAGE(PG8_SB(1, 0), b3, voffB);
      PG8_BAR; PG8_WAIT_L(0); PG8_MMA(0, 1, At, B1); PG8_BAR;
      PG8_LDA(At, 1, 1); PG8_STAGE(PG8_SA(1, 0), a3, voffA);
      PG8_BAR; PG8_WAIT_L(0); PG8_MMA(1, 0, At, B0); PG8_BAR; PG8_SCHED;
      PG8_STAGE(PG8_SB(1, 1), b3 + hB, voffB);
      PG8_WAIT_V(6); PG8_BAR; PG8_MMA(1, 1, At, B1); PG8_BAR;
    }
    E(acc, cur, wr, wc, fr, fq);
    if (!has_next) break;
#pragma unroll
    for (int a = 0; a < 2; ++a)
#pragma unroll
      for (int b = 0; b < 2; ++b)
#pragma unroll
        for (int m = 0; m < 4; ++m)
#pragma unroll
          for (int n = 0; n < 2; ++n) acc[a][b][m][n] = (f32x4){zz_, zz_, zz_, zz_};
    cur = nxt; cA = nA; cB = nB; ldA = nldA; ++ui;
  }
  PG8_WAIT_V(0);
  if (wr == 0) PG8_BAR;
  PG8_BAR;
#undef PG8_SA
#undef PG8_SB
#undef PG8_STAGE
#undef PG8_LDA
#undef PG8_LDB
#undef PG8_MMA
#undef PG8_WAIT_V
#undef PG8_WAIT_L
#undef PG8_BAR
#undef PG8_SCHED
}
}
using pg8::Unit;
typedef f32x4 AccT[2][2][4][2];

struct EpiUp {
  static constexpr bool PERM = true;
  bf16_t* act;
  __device__ __forceinline__ void operator()(const AccT& acc, const Unit& u, int wr, int wc, int fr, int fq) const {
    const int row0 = u.pm * 256 + wr * 64 + fr, col0 = u.pn * 128 + wc * 32 + 8 * fq;
#pragma unroll
    for (int ai = 0; ai < 2; ++ai)
#pragma unroll
      for (int m = 0; m < 4; ++m) {
        const f32x4 a0 = acc[ai][0][m][0], a1 = acc[ai][0][m][1], u0 = acc[ai][1][m][0], u1 = acc[ai][1][m][1];
        u32x4 w;
        w.x = cvt_pk_bf16(siluf_(a0[0]) * u0[0], siluf_(a0[1]) * u0[1]); w.y = cvt_pk_bf16(siluf_(a0[2]) * u0[2], siluf_(a0[3]) * u0[3]);
        w.z = cvt_pk_bf16(siluf_(a1[0]) * u1[0], siluf_(a1[1]) * u1[1]); w.w = cvt_pk_bf16(siluf_(a1[2]) * u1[2], siluf_(a1[3]) * u1[3]);
        *(u32x4*)(act + (size_t)(row0 + ai * 128 + m * 16) * DFF + col0) = w;
      }
  }
};
template <bool ATOMIC> struct EpiResT {
  static constexpr bool PERM = false;
  float* X; const float* modl; int gidx; float scale;
  __device__ __forceinline__ void operator()(const AccT& acc, const Unit& u, int wr, int wc, int fr, int fq) const {
    const int row0 = u.pm * 256 + wr * 64 + fr, col0 = u.pn * 256 + wc * 32 + 4 * fq;
    const float* g = modl + (size_t)(modidx(u.pm) * 9 + gidx) * 1024 + col0;
    f32x4 gv[2][2];
#pragma unroll
    for (int bj = 0; bj < 2; ++bj)
#pragma unroll
      for (int n = 0; n < 2; ++n) gv[bj][n] = *(const f32x4*)(g + bj * 128 + n * 16) * scale;
#pragma unroll
    for (int ai = 0; ai < 2; ++ai)
#pragma unroll
      for (int mh = 0; mh < 2; ++mh) {
        f32x4 xv[2][2][2];
#pragma unroll
        for (int m2 = 0; m2 < 2; ++m2)
#pragma unroll
          for (int bj = 0; bj < 2; ++bj)
#pragma unroll
            for (int n = 0; n < 2; ++n) xv[m2][bj][n] = *(const f32x4*)(X + (size_t)(row0 + ai * 128 + (mh * 2 + m2) * 16) * DM + col0 + bj * 128 + n * 16);
        asm volatile("" ::: "memory");
#pragma unroll
        for (int m2 = 0; m2 < 2; ++m2)
#pragma unroll
          for (int bj = 0; bj < 2; ++bj)
#pragma unroll
            for (int n = 0; n < 2; ++n) *(f32x4*)(X + (size_t)(row0 + ai * 128 + (mh * 2 + m2) * 16) * DM + col0 + bj * 128 + n * 16) = xv[m2][bj][n] + gv[bj][n] * acc[ai][bj][mh * 2 + m2][n];
        asm volatile("" ::: "memory");
      }
  }
};
struct EpiPart {
  static constexpr bool PERM = false;
  float* part; const float* modl; int gidx; float scale;
  __device__ __forceinline__ void operator()(const AccT& acc, const Unit& u, int wr, int wc, int fr, int fq) const {
    const int row0 = (u.pm - 128) * 256 + wr * 64 + fr, col0 = u.pn * 256 + wc * 32 + 4 * fq;
    const float* g = modl + (size_t)(8 * 9 + gidx) * 1024 + col0;
    float* pb = part + (size_t)u.seg * 2048 * 1024;
    f32x4 gv[2][2];
#pragma unroll
    for (int bj = 0; bj < 2; ++bj)
#pragma unroll
      for (int n = 0; n < 2; ++n) gv[bj][n] = *(const f32x4*)(g + bj * 128 + n * 16) * scale;
#pragma unroll
    for (int ai = 0; ai < 2; ++ai)
#pragma unroll
      for (int m = 0; m < 4; ++m) {
        float* rowp = pb + (size_t)(row0 + ai * 128 + m * 16) * DM + col0;
#pragma unroll
        for (int bj = 0; bj < 2; ++bj)
#pragma unroll
          for (int n = 0; n < 2; ++n) *(f32x4*)(rowp + bj * 128 + n * 16) = gv[bj][n] * acc[ai][bj][m][n];
      }
  }
};
struct EpiIn {
  static constexpr bool PERM = true;
  bf16_t *qkv, *z, *pi, *fi; float* ab;
  __device__ __forceinline__ void operator()(const AccT& acc, const Unit& u, int wr, int wc, int fr, int fq) const {
    const int row0 = u.pm * 256 + wr * 64 + fr;
    if (u.pn == 10) {
      if (wc == 0 && fq < 2) {
#pragma unroll
        for (int ai = 0; ai < 2; ++ai)
#pragma unroll
          for (int m = 0; m < 4; ++m) {
            float* rp = ab + (size_t)(row0 + ai * 128 + m * 16) * 16 + 8 * fq;
            *(f32x4*)(rp) = acc[ai][0][m][0]; *(f32x4*)(rp + 4) = acc[ai][0][m][1];
          }
      }
      return;
    }
    bf16_t* base; int ld, ct;
    if (u.pn < 6) { base = qkv; ld = 1536; ct = u.pn * 256; } else if (u.pn < 8) { base = z; ld = 512; ct = (u.pn - 6) * 256; } else if (u.pn == 8) { base = pi; ld = 256; ct = 0; } else { base = fi; ld = 256; ct = 0; }
    const int col0 = ct + wc * 32 + 8 * fq;
#pragma unroll
    for (int ai = 0; ai < 2; ++ai)
#pragma unroll
      for (int m = 0; m < 4; ++m) {
        bf16_t* rowp = base + (size_t)(row0 + ai * 128 + m * 16) * ld + col0;
#pragma unroll
        for (int bj = 0; bj < 2; ++bj) { const f32x4 v0 = acc[ai][bj][m][0], v1 = acc[ai][bj][m][1]; u32x4 w; w.x = cvt_pk_bf16(v0[0], v0[1]); w.y = cvt_pk_bf16(v0[2], v0[3]); w.z = cvt_pk_bf16(v1[0], v1[1]); w.w = cvt_pk_bf16(v1[2], v1[3]);
          *(u32x4*)(rowp + bj * 128) = w; }
      }
  }
};
struct EpiBf {
  static constexpr bool PERM = true;
  bf16_t* O; int ld;
  __device__ __forceinline__ void operator()(const AccT& acc, const Unit& u, int wr, int wc, int fr, int fq) const {
    const int row0 = u.pm * 256 + wr * 64 + fr, col0 = u.pn * 256 + wc * 32 + 8 * fq;
#pragma unroll
    for (int ai = 0; ai < 2; ++ai)
#pragma unroll
      for (int m = 0; m < 4; ++m) {
        bf16_t* rowp = O + (size_t)(row0 + ai * 128 + m * 16) * ld + col0;
#pragma unroll
        for (int bj = 0; bj < 2; ++bj) { const f32x4 v0 = acc[ai][bj][m][0], v1 = acc[ai][bj][m][1]; u32x4 w; w.x = cvt_pk_bf16(v0[0], v0[1]); w.y = cvt_pk_bf16(v0[2], v0[3]); w.z = cvt_pk_bf16(v1[0], v1[1]); w.w = cvt_pk_bf16(v1[2], v1[3]);
          *(u32x4*)(rowp + bj * 128) = w; }
      }
  }
};
struct EpiMerge {
  static constexpr bool PERM = true;
  unsigned* scr;
  bf16_t* mrg;
  __device__ __forceinline__ void operator()(const AccT& acc, const Unit& u, int wr, int wc, int fr, int fq) const {
    const int tid_ = otid(); u32x4* S1 = (u32x4*)scr + tid_; u32x4* Mx = (u32x4*)scr + 16 * 512 + tid_;
    const int seg = u.seg;
    if ((seg & 1) == 0) {
#pragma unroll
      for (int ai = 0; ai < 2; ++ai)
#pragma unroll
        for (int bj = 0; bj < 2; ++bj)
#pragma unroll
          for (int m = 0; m < 4; ++m) { const f32x4 v0 = acc[ai][bj][m][0], v1 = acc[ai][bj][m][1]; u32x4 w;
            w.x = cvt_pk_bf16(sigmoidf_(v0[0]), sigmoidf_(v0[1])); w.y = cvt_pk_bf16(sigmoidf_(v0[2]), sigmoidf_(v0[3])); w.z = cvt_pk_bf16(sigmoidf_(v1[0]), sigmoidf_(v1[1])); w.w = cvt_pk_bf16(sigmoidf_(v1[2]), sigmoidf_(v1[3]));
            S1[((ai * 2 + bj) * 4 + m) * 512] = w; }
    } else {
      const int row0 = u.pm * 256 + wr * 64 + fr, col0 = u.pn * 256 + wc * 32 + 8 * fq;
#pragma unroll
      for (int ai = 0; ai < 2; ++ai)
#pragma unroll
        for (int bj = 0; bj < 2; ++bj) {
          u32x4 gq[4], mq[4];
#pragma unroll
          for (int m = 0; m < 4; ++m) { const int ix = ((ai * 2 + bj) * 4 + m) * 512; gq[m] = S1[ix]; mq[m] = (seg >= 3) ? Mx[ix] : (u32x4){0u, 0u, 0u, 0u}; }
          asm volatile("" ::: "memory");
#pragma unroll
          for (int m = 0; m < 4; ++m) {
            const int ix = ((ai * 2 + bj) * 4 + m) * 512; const u32x4 g = gq[m], q = mq[m]; const f32x4 v0 = acc[ai][bj][m][0], v1 = acc[ai][bj][m][1];
            float t[8] = {bflo(g.x) * v0[0], bfhi(g.x) * v0[1], bflo(g.y) * v0[2], bfhi(g.y) * v0[3], bflo(g.z) * v1[0], bfhi(g.z) * v1[1], bflo(g.w) * v1[2], bfhi(g.w) * v1[3]};
            t[0] += bflo(q.x); t[1] += bfhi(q.x); t[2] += bflo(q.y); t[3] += bfhi(q.y); t[4] += bflo(q.z); t[5] += bfhi(q.z); t[6] += bflo(q.w); t[7] += bfhi(q.w);
            u32x4 w; w.x = cvt_pk_bf16(t[0], t[1]); w.y = cvt_pk_bf16(t[2], t[3]); w.z = cvt_pk_bf16(t[4], t[5]); w.w = cvt_pk_bf16(t[6], t[7]);
            if (seg < 5) Mx[ix] = w; else *(u32x4*)(mrg + (size_t)(row0 + ai * 128 + m * 16) * DM + col0 + bj * 128) = w;
          }
          asm volatile("" ::: "memory");
        }
    }
  }
};
struct MergeSched {
  static constexpr bool VARLDA = true;
  const char *hn, *of, *ppf, *wg, *wcat; int G, c, nM;
  __device__ __forceinline__ bool next(int i, Unit& u) const {
    const int round = i / 6, seg = i - round * 6; int pm, pn; if (!pg8::tile_of(nM, 4, G, c, round, pm, pn)) return false;
    const int br = seg >> 1;
    u.pm = pm; u.pn = pn; u.seg = seg; u.ldb = 2048;
    if ((seg & 1) == 0) { u.A = hn + (size_t)pm * 256 * 2048; u.lda = 2048; u.B = wg + (size_t)(br * 1024 + pn * 256) * 2048; u.nt = 16; }
    else {
      u.lda = 1024;
      if (br == 0) { u.A = of + (size_t)pm * 256 * 1024; u.B = wcat + (size_t)pn * 256 * 2048; u.nt = 8; }
      else if (br == 1) { u.A = ppf + (size_t)pm * 256 * 1024; u.B = wcat + (size_t)pn * 256 * 2048 + 512 * 2; u.nt = 4; }
      else { u.A = ppf + (size_t)pm * 256 * 1024 + 256 * 2; u.B = wcat + (size_t)pn * 256 * 2048 + 768 * 2; u.nt = 4; }
    }
    return true;
  }
};
struct MergeCtxSched {
  static constexpr bool VARLDA = true;
  const char *hn, *of, *ppf, *wg, *wcat; int c;
  __device__ __forceinline__ bool next(int i, Unit& u) const {
    if (i > 1 || c >= 96) return false;
    const int tile = c / 3, br = c - tile * 3, pm = 128 + (tile >> 2), pn = tile & 3;
    u.pm = pm; u.pn = pn; u.seg = br * 2 + i; u.ldb = 2048;
    if (i == 0) { u.A = hn + (size_t)pm * 256 * 2048; u.lda = 2048; u.B = wg + (size_t)(br * 1024 + pn * 256) * 2048; u.nt = 16; }
    else { u.lda = 1024;
      if (br == 0) { u.A = of + (size_t)pm * 256 * 1024; u.B = wcat + (size_t)pn * 256 * 2048; u.nt = 8; }
      else if (br == 1) { u.A = ppf + (size_t)pm * 256 * 1024; u.B = wcat + (size_t)pn * 256 * 2048 + 512 * 2; u.nt = 4; }
      else { u.A = ppf + (size_t)pm * 256 * 1024 + 256 * 2; u.B = wcat + (size_t)pn * 256 * 2048 + 768 * 2; u.nt = 4; } }
    return true;
  }
};
struct EpiMergeCtx {
  static constexpr bool PERM = true;
  unsigned* scr; bf16_t* partm;
  __device__ __forceinline__ void operator()(const AccT& acc, const Unit& u, int wr, int wc, int fr, int fq) const {
    const int tid_ = otid(); u32x4* S1 = (u32x4*)scr + tid_;
    if ((u.seg & 1) == 0) {
#pragma unroll
      for (int ai = 0; ai < 2; ++ai)
#pragma unroll
        for (int bj = 0; bj < 2; ++bj)
#pragma unroll
          for (int m = 0; m < 4; ++m) { const f32x4 v0 = acc[ai][bj][m][0], v1 = acc[ai][bj][m][1]; u32x4 w;
            w.x = cvt_pk_bf16(sigmoidf_(v0[0]), sigmoidf_(v0[1])); w.y = cvt_pk_bf16(sigmoidf_(v0[2]), sigmoidf_(v0[3])); w.z = cvt_pk_bf16(sigmoidf_(v1[0]), sigmoidf_(v1[1])); w.w = cvt_pk_bf16(sigmoidf_(v1[2]), sigmoidf_(v1[3]));
            S1[((ai * 2 + bj) * 4 + m) * 512] = w; }
    } else {
      const int br = u.seg >> 1, row0 = (u.pm - 128) * 256 + wr * 64 + fr, col0 = br * 1024 + u.pn * 256 + wc * 32 + 8 * fq;
#pragma unroll
      for (int ai = 0; ai < 2; ++ai) {
        u32x4 gq[2][4];
#pragma unroll
        for (int bj = 0; bj < 2; ++bj)
#pragma unroll
          for (int m = 0; m < 4; ++m) gq[bj][m] = S1[((ai * 2 + bj) * 4 + m) * 512];
        asm volatile("" ::: "memory");
#pragma unroll
        for (int m = 0; m < 4; ++m)
#pragma unroll
          for (int bj = 0; bj < 2; ++bj) {
            const u32x4 g = gq[bj][m]; const f32x4 v0 = acc[ai][bj][m][0], v1 = acc[ai][bj][m][1];
            u32x4 w; w.x = cvt_pk_bf16(bflo(g.x) * v0[0], bfhi(g.x) * v0[1]); w.y = cvt_pk_bf16(bflo(g.y) * v0[2], bfhi(g.y) * v0[3]); w.z = cvt_pk_bf16(bflo(g.z) * v1[0], bfhi(g.z) * v1[1]); w.w = cvt_pk_bf16(bflo(g.w) * v1[2], bfhi(g.w) * v1[3]);
            *(u32x4*)(partm + (size_t)(row0 + ai * 128 + m * 16) * 3072 + col0 + bj * 128) = w;
          }
      }
    }
  }
};
struct FourSched {
  static constexpr bool VARLDA = false;
  const char *dft, *fbt; int c;
  __device__ __forceinline__ bool next(int i, Unit& u) const {
    if (i > 0) return false;
    const int b = c >> 4, pm = c & 15;
    u.A = dft + (size_t)pm * 256 * 8192; u.B = fbt + (size_t)b * 256 * 8192; u.lda = 8192; u.ldb = 8192; u.nt = 64; u.pm = b * 16 + pm; u.pn = 0; u.seg = 0; return true;
  }
};

template <class F>
__device__ __forceinline__ void convT(const float* W, int ldw, int K, int nrows, bf16_t* dst, int ldd, int k0d, F srccol, ldsp L, int& cursor, int wg, int G) {
  const int tid = otid(), ntk = K >> 6, ntiles = (nrows >> 6) * ntk;
  int t0 = (wg - cursor % G + G) % G;
  for (; t0 < ntiles; t0 += 4 * G) {
    float v[4][8];
#pragma unroll
    for (int u = 0; u < 4; ++u) {
      const int t = t0 + u * G;
      if (t < ntiles) {
        const int tr = t / ntk, tk = t - tr * ntk, r0 = tr * 64, kk0 = tk * 64; const int i = tid & 63, sc = srccol(r0 + i);
#pragma unroll
        for (int it = 0; it < 8; ++it) { const int kk = (tid >> 6) + 8 * it; v[u][it] = sc >= 0 ? W[(size_t)(kk0 + kk) * ldw + sc] : 0.f; }
      }
    }
#pragma unroll
    for (int u = 0; u < 4; ++u) { if (t0 + u * G < ntiles) {
#pragma unroll
      for (int it = 0; it < 8; ++it) ldsst<float>(L, u * 16640 + (((tid >> 6) + 8 * it) * 65 + (tid & 63)) * 4, v[u][it]); } }
    __syncthreads();
#pragma unroll
    for (int u = 0; u < 4; ++u) {
      const int t = t0 + u * G;
      if (t < ntiles) {
        const int tr = t / ntk, tk = t - tr * ntk, r0 = tr * 64, kk0 = tk * 64; const int ii = tid >> 3, kv = (tid & 7) * 8; float o[8];
#pragma unroll
        for (int e = 0; e < 8; ++e) o[e] = ldsld<float>(L, u * 16640 + ((kv + e) * 65 + ii) * 4);
        u32x4 w; w.x = cvt_pk_bf16(o[0], o[1]); w.y = cvt_pk_bf16(o[2], o[3]); w.z = cvt_pk_bf16(o[4], o[5]); w.w = cvt_pk_bf16(o[6], o[7]);
        *(u32x4*)(dst + (size_t)(r0 + ii) * ldd + k0d + kk0 + kv) = w;
      }
    }
    __syncthreads();
  }
  cursor += ntiles;
}

__device__ __forceinline__ void convert_ffn(const Params& p, const float* wgu, const float* wd, size_t o_gu, size_t o_d, ldsp L, int& cur, int wg, int nwg) {
  convT(wgu, 2 * DFF, 1024, 2 * DFF, (bf16_t*)(lws(p.ws) + o_gu), 1024, 0, [](int r) { const int t = r >> 8, q = r & 255; return q < 128 ? t * 128 + q : DFF + t * 128 + (q - 128); }, L, cur, wg, nwg);
  convT(wd, 1024, DFF, 1024, (bf16_t*)(lws(p.ws) + o_d), DFF, 0, [](int r) { return r; }, L, cur, wg, nwg);
}
__device__ __forceinline__ void convert_win(const Params& p, int l, ldsp L, int& cur, int wg, int nwg) {
  const float* win = p.w_in + (size_t)l * 1024 * DPROJ;
  convT(win, DPROJ, 1024, NINP, (bf16_t*)(lws(p.ws) + O_WIN), 1024, 0, [](int r) { return r < 2048 ? r : (r < 2560 ? r + 16 : (r < 2576 ? r - 512 : -1)); }, L, cur, wg, nwg);
}
__device__ __forceinline__ void convert_mixer(const Params& p, int l, ldsp L, int& cur) {
  const int wg = blockIdx.x, nwg = gridDim.x;
  const float* win = p.w_in + (size_t)l * 1024 * DPROJ;
  convT(win, DPROJ, 1024, 3072, (bf16_t*)(lws(p.ws) + O_WG), 1024, 0, [](int r) { return 2576 + r; }, L, cur, wg, nwg);
  convT(p.w_a + (size_t)l * 512 * 1024, 1024, 512, 1024, (bf16_t*)(lws(p.ws) + O_WCAT), 1024, 0, [](int r) { return r; }, L, cur, wg, nwg);
  convT(p.w_c + (size_t)l * 256 * 1024, 1024, 256, 1024, (bf16_t*)(lws(p.ws) + O_WCAT), 1024, 768, [](int r) { return r; }, L, cur, wg, nwg);
  convT(p.w_out + (size_t)l * 1024 * 1024, 1024, 1024, 1024, (bf16_t*)(lws(p.ws) + O_WOUT), 1024, 0, [](int r) { return r; }, L, cur, wg, nwg);
  for (int rp = 0; rp < 3; ++rp) convT(p.w_out + (size_t)l * 1024 * 1024, 1024, 1024, 1024, (bf16_t*)(lws(p.ws) + O_WOUT3), 3072, rp * 1024, [](int r) { return r; }, L, cur, wg, nwg);
  const float* wb = p.w_b + (size_t)l * 4 * 64 * 256; const float* ps = p.pool_scale + (size_t)l * 1024; bf16_t* wcat = (bf16_t*)(lws(p.ws) + O_WCAT);
  for (int idx = blockIdx.x * NTHR + otid(); idx < 1024 * 256; idx += gridDim.x * NTHR) {
    const int row = idx & 1023, kk = idx >> 10, g = row >> 8;
    const float v = ((kk >> 6) == g) ? wb[((size_t)g * 64 + (kk & 63)) * 256 + (row & 255)] * ps[row] : 0.f;
    wcat[(size_t)row * 1024 + 512 + kk] = (bf16_t)(cvt_pk_bf16(v, 0.f) & 0xffffu);
  }
}

__device__ __forceinline__ void norm_phase(float* X, bf16_t* Hn, const float* gain, const float* modl, int ishift, int iscale, const float* part) {
  const int tid_ = otid(), lane = tid_ & 63, gw = blockIdx.x * 8 + (tid_ >> 6), nw = gridDim.x * 8;
  for (int r0 = gw; r0 < ROWS; r0 += 2 * nw) {
    f32x4 v[2][4]; float ss[2];
#pragma unroll
    for (int q = 0; q < 2; ++q) { const int r = r0 + q * nw; const int rr = r < ROWS ? r : r0; const float* xr = X + (size_t)rr * DM;
#pragma unroll
      for (int i = 0; i < 2; ++i) { v[q][2 * i] = *(const f32x4*)(xr + lane * 8 + 512 * i); v[q][2 * i + 1] = *(const f32x4*)(xr + lane * 8 + 512 * i + 4); } }
#pragma unroll
    for (int q = 0; q < 2; ++q) {
      const int r = r0 + q * nw;
      if (part != nullptr && r >= RLAT && r < ROWS) {
        float* xr = X + (size_t)r * DM; const float* pr_ = part + (size_t)(r - RLAT) * DM + lane * 8;
#pragma unroll
        for (int kp = 0; kp < 8; ++kp)
#pragma unroll
          for (int i = 0; i < 2; ++i) { v[q][2 * i] = v[q][2 * i] + *(const f32x4*)(pr_ + (size_t)kp * 2048 * 1024 + 512 * i); v[q][2 * i + 1] = v[q][2 * i + 1] + *(const f32x4*)(pr_ + (size_t)kp * 2048 * 1024 + 512 * i + 4); }
#pragma unroll
        for (int i = 0; i < 2; ++i) { *(f32x4*)(xr + lane * 8 + 512 * i) = v[q][2 * i]; *(f32x4*)(xr + lane * 8 + 512 * i + 4) = v[q][2 * i + 1]; }
      }
      float s_ = 0.f;
#pragma unroll
      for (int i = 0; i < 4; ++i) s_ += v[q][i][0] * v[q][i][0] + v[q][i][1] * v[q][i][1] + v[q][i][2] * v[q][i][2] + v[q][i][3] * v[q][i][3];
      ss[q] = s_;
    }
#pragma unroll
    for (int o = 32; o >= 1; o >>= 1) { ss[0] += __shfl_xor(ss[0], o); ss[1] += __shfl_xor(ss[1], o); }
#pragma unroll
    for (int q = 0; q < 2; ++q) {
      const int r = r0 + q * nw; if (r >= ROWS) continue;
      const int j = r < RLAT ? (r >> 12) : 8;
      const float* sh = modl + (size_t)(j * 9 + ishift) * 1024; const float* sc = modl + (size_t)(j * 9 + iscale) * 1024;
      const float rstd = rsqrtf(ss[q] * (1.0f / 1024.0f) + 1e-6f);
#pragma unroll
      for (int i = 0; i < 2; ++i) {
        const int c0 = lane * 8 + 512 * i; float o[8];
#pragma unroll
        for (int hh = 0; hh < 2; ++hh) { const f32x4 g = *(const f32x4*)(gain + c0 + 4 * hh), s1 = *(const f32x4*)(sc + c0 + 4 * hh), s0 = *(const f32x4*)(sh + c0 + 4 * hh); const f32x4 y = v[q][2 * i + hh] * rstd * g * (s1 + 1.0f) + s0;
          o[4 * hh] = y[0]; o[4 * hh + 1] = y[1]; o[4 * hh + 2] = y[2]; o[4 * hh + 3] = y[3]; }
        u32x4 w; w.x = cvt_pk_bf16(o[0], o[1]); w.y = cvt_pk_bf16(o[2], o[3]); w.z = cvt_pk_bf16(o[4], o[5]); w.w = cvt_pk_bf16(o[6], o[7]);
        *(u32x4*)(Hn + (size_t)r * DM + c0) = w;
      }
    }
  }
}
__device__ __forceinline__ void final_norm(const float* X, float* out, const float* gain) {
  const int tid_ = otid(), lane = tid_ & 63, gw = blockIdx.x * 8 + (tid_ >> 6), nw = gridDim.x * 8;
  for (int r = gw; r < RLAT; r += nw) {
    const float* xr = X + (size_t)r * DM; f32x4 v[4]; float ss = 0.f;
#pragma unroll
    for (int i = 0; i < 4; ++i) { v[i] = *(const f32x4*)(xr + lane * 4 + 256 * i); ss += v[i][0] * v[i][0] + v[i][1] * v[i][1] + v[i][2] * v[i][2] + v[i][3] * v[i][3]; }
#pragma unroll
    for (int o = 32; o >= 1; o >>= 1) ss += __shfl_xor(ss, o);
    const float rstd = rsqrtf(ss * (1.0f / 1024.0f) + 1e-6f);
#pragma unroll
    for (int i = 0; i < 4; ++i) { const f32x4 g = *(const f32x4*)(gain + lane * 4 + 256 * i); *(f32x4*)(out + (size_t)r * DM + lane * 4 + 256 * i) = v[i] * rstd * g; }
  }
}

__device__ __forceinline__ void phase0(const Params& p, ldsp L) {
  const int tid = otid(); const size_t gt = (size_t)blockIdx.x * NTHR + tid, gs = (size_t)gridDim.x * NTHR;
  { f32x4* X = (f32x4*)(lws(p.ws) + O_X); const f32x4* xs = (const f32x4*)p.x; const f32x4* cs = (const f32x4*)p.ctx; const size_t n1 = (size_t)RLAT * DM / 4, n2 = (size_t)ROWS * DM / 4;
    for (size_t i = gt; i < n2; i += gs) X[i] = i < n1 ? xs[i] : cs[i - n1]; }
  { bf16_t* D = (bf16_t*)(lws(p.ws) + O_DFT);
    for (size_t v = gt; v < (size_t)4096 * 512; v += gs) { const int k = (int)(v >> 9), j0 = (int)(v & 511) * 8; float o[8];
#pragma unroll
      for (int e = 0; e < 8; ++e) { const int j = j0 + e; const bool cs_ = j <= 2048; const int t = cs_ ? j : j - 2048; const int r = (k * t) & 4095; const float a = (float)r * (1.0f / 2048.0f);
        o[e] = cs_ ? cospif(a) * (1.0f / 64.0f) : -sinpif(a) * (1.0f / 64.0f); }
      u32x4 w; w.x = cvt_pk_bf16(o[0], o[1]); w.y = cvt_pk_bf16(o[2], o[3]); w.z = cvt_pk_bf16(o[4], o[5]); w.w = cvt_pk_bf16(o[6], o[7]);
      *(u32x4*)(D + (size_t)k * 4096 + j0) = w; } }
  for (int idx = tid; idx < 9 * 1024; idx += NTHR) { const int j = idx >> 10, k = idx & 1023; const float v = j < 8 ? p.c[j * 1024 + k] : p.c_ctx[k]; ldsst<float>(L, idx * 4, siluf_(v)); }
  __syncthreads();
  float* MOD = (float*)(lws(p.ws) + O_MOD);
  for (int item = blockIdx.x; item < DEPTH * 144; item += gridDim.x) {
    const int l = item / 144, n0 = (item - l * 144) * 64, ks = tid >> 6, cn = tid & 63;
    float acc[9];
#pragma unroll
    for (int j = 0; j < 9; ++j) acc[j] = 0.f;
    const float* wp = p.w_ada + ((size_t)l * 1024 + ks * 128) * 9216 + n0 + cn;
#pragma unroll 4
    for (int k = 0; k < 128; ++k) { const float w = wp[(size_t)k * 9216];
#pragma unroll
      for (int j = 0; j < 9; ++j) acc[j] += ldsld<float>(L, (j * 1024 + ks * 128 + k) * 4) * w; }
#pragma unroll
    for (int j = 0; j < 9; ++j) ldsst<float>(L, 36864 + ((ks * 9 + j) * 64 + cn) * 4, acc[j]);
    __syncthreads();
    for (int o = tid; o < 576; o += NTHR) { const int j = o >> 6, c = o & 63; float s = p.b_ada[(size_t)l * 9216 + n0 + c];
#pragma unroll
      for (int q = 0; q < 8; ++q) s += ldsld<float>(L, 36864 + ((q * 9 + j) * 64 + c) * 4);
      MOD[((size_t)l * 9 + j) * 9216 + n0 + c] = s; }
    __syncthreads();
  }
}

__device__ __forceinline__ void prep_phase(const Params& p, int l, ldsp L) {
  const int tid = otid(), lane = tid & 63, wid = tid >> 6, fr = lane & 15, fq = lane >> 4;
  constexpr int KSB = 0, KTL = 17408, VTL = 35840, GL = 54272, AL = 71680, GCL = 104448, BTL = 104960, TOL = 105472;
  const bf16_t* QKV = (const bf16_t*)(lws(p.ws) + O_QKV); const float* AB = (const float*)(lws(p.ws) + O_AB);
  bf16_t* QN = (bf16_t*)(lws(p.ws) + O_QN); bf16_t* KN = (bf16_t*)(lws(p.ws) + O_KN); bf16_t* KNT = (bf16_t*)(lws(p.ws) + O_KNT); bf16_t* VNT = (bf16_t*)(lws(p.ws) + O_VNT);
  bf16_t* TT = (bf16_t*)(lws(p.ws) + O_TT); float* GC = (float*)(lws(p.ws) + O_GC);
  const float* cw = p.conv_w + (size_t)l * 3 * 1536;
  for (int item = blockIdx.x; item < NCH * 4; item += gridDim.x) {
    const int n = item >> 2, h = item & 3, R0 = n * 64;
    { const int row = tid >> 3, cs = tid & 7, r = R0 + row, c0 = cs * 16;
      const int t = r < RLAT ? (r & 4095) : ((r - RLAT) & 255), Ls = r < RLAT ? 4096 : 256;
      const bool hp = t > 0, hn = t < Ls - 1;
#pragma unroll
      for (int mtx = 0; mtx < 3; ++mtx) {
        const int cc = mtx * 512 + h * 128 + c0; const bf16_t* bp = QKV + (size_t)r * 1536 + cc;
        u32x4 a0 = {0, 0, 0, 0}, a1 = {0, 0, 0, 0}, c0v = {0, 0, 0, 0}, c1v = {0, 0, 0, 0};
        const u32x4 b0 = *(const u32x4*)(bp), b1 = *(const u32x4*)(bp + 8);
        if (hp) { a0 = *(const u32x4*)(bp - 1536); a1 = *(const u32x4*)(bp - 1536 + 8); }
        if (hn) { c0v = *(const u32x4*)(bp + 1536); c1v = *(const u32x4*)(bp + 1536 + 8); }
        float val[16]; float ss = 0.f;
#pragma unroll
        for (int e = 0; e < 16; ++e) {
          const unsigned wa = e < 8 ? a0[e >> 1] : a1[(e - 8) >> 1], wb = e < 8 ? b0[e >> 1] : b1[(e - 8) >> 1], wc_ = e < 8 ? c0v[e >> 1] : c1v[(e - 8) >> 1];
          const float xa = (e & 1) ? bfhi(wa) : bflo(wa), xb = (e & 1) ? bfhi(wb) : bflo(wb), xc = (e & 1) ? bfhi(wc_) : bflo(wc_);
          const float y = xa * cw[cc + e] + xb * cw[1536 + cc + e] + xc * cw[3072 + cc + e];
          val[e] = siluf_(y); ss += val[e] * val[e];
        }
        if (mtx < 2) { ss += __shfl_xor(ss, 1); ss += __shfl_xor(ss, 2); ss += __shfl_xor(ss, 4); const float sc = rsqrtf(ss + 1e-6f) * (mtx == 0 ? 0.08838834764831845f : 1.0f);
#pragma unroll
          for (int e = 0; e < 16; ++e) val[e] *= sc; }
        u32x4 w0, w1; w0.x = cvt_pk_bf16(val[0], val[1]); w0.y = cvt_pk_bf16(val[2], val[3]); w0.z = cvt_pk_bf16(val[4], val[5]); w0.w = cvt_pk_bf16(val[6], val[7]);
        w1.x = cvt_pk_bf16(val[8], val[9]); w1.y = cvt_pk_bf16(val[10], val[11]); w1.z = cvt_pk_bf16(val[12], val[13]); w1.w = cvt_pk_bf16(val[14], val[15]);
        if (mtx == 0) { bf16_t* o = QN + (size_t)r * 512 + h * 128 + c0; *(u32x4*)o = w0; *(u32x4*)(o + 8) = w1; }
        else if (mtx == 1) { bf16_t* o = KN + (size_t)r * 512 + h * 128 + c0; *(u32x4*)o = w0; *(u32x4*)(o + 8) = w1;
          ldsst<u32x4>(L, KSB + row * 272 + c0 * 2, w0); ldsst<u32x4>(L, KSB + row * 272 + c0 * 2 + 16, w1);
#pragma unroll
          for (int e = 0; e < 16; ++e) { const unsigned wv = e < 8 ? w0[e >> 1] : w1[(e - 8) >> 1]; ldsst<bf16_t>(L, KTL + (c0 + e) * 144 + row * 2, (bf16_t)((e & 1) ? (wv >> 16) : (wv & 0xffffu))); } }
        else {
#pragma unroll
          for (int e = 0; e < 16; ++e) { const unsigned wv = e < 8 ? w0[e >> 1] : w1[(e - 8) >> 1]; ldsst<bf16_t>(L, VTL + (c0 + e) * 144 + row * 2, (bf16_t)((e & 1) ? (wv >> 16) : (wv & 0xffffu))); } }
      }
    }
    if (wid < 2) {
      const int d = wid, r = R0 + lane;
      const float braw = AB[(size_t)r * 16 + d * 4 + h], araw = AB[(size_t)r * 16 + 8 + d * 4 + h];
      const float beta = sigmoidf_(braw);
      const float xs = araw + p.dt_bias[(l * 2 + d) * 4 + h];
      const float sp = fmaxf(xs, 0.f) + log1pf(__expf(-fabsf(xs)));
      const float g = -__expf(p.a_log[(l * 2 + d) * 4 + h]) * sp;
      float pre = g;
#pragma unroll
      for (int o = 1; o < 64; o <<= 1) { const float t2 = __shfl_up(pre, o); if (lane >= o) pre += t2; }
      const float tot = __shfl(pre, 63);
      const float gc = d == 0 ? pre : (tot - pre + g);
      ldsst<float>(L, GCL + (d * 64 + lane) * 4, gc); ldsst<float>(L, BTL + (d * 64 + lane) * 4, beta);
      GC[((size_t)item * 2 + d) * 64 + lane] = gc;
    }
    __syncthreads();
    { const int ti = wid >> 1;
#pragma unroll
      for (int q = 0; q < 2; ++q) { const int tj = 2 * (wid & 1) + q; f32x4 a = {0.f, 0.f, 0.f, 0.f};
#pragma unroll
        for (int kk = 0; kk < 4; ++kk) a = mma(ldsld<bf16x8>(L, KSB + (16 * tj + fr) * 272 + kk * 64 + fq * 16), ldsld<bf16x8>(L, KSB + (16 * ti + fr) * 272 + kk * 64 + fq * 16), a);
        ldsst<f32x4>(L, GL + ((16 * ti + fr) * 68 + 16 * tj + 4 * fq) * 4, a); }
    }
    {
#pragma unroll
      for (int it = 0; it < 2; ++it) { const int v = tid + 512 * it, c = v >> 3, sg = (v & 7) * 8;
        *(u32x4*)(KNT + (size_t)item * 8192 + c * 64 + sg) = ldsld<u32x4>(L, KTL + c * 144 + sg * 2);
        *(u32x4*)(VNT + (size_t)item * 8192 + c * 64 + sg) = ldsld<u32x4>(L, VTL + c * 144 + sg * 2); } }
    __syncthreads();
    { const int d = tid >> 8, a = (tid & 255) >> 2, jq = tid & 3;
      const int pi_ = d ? 63 - a : a; const float bi = ldsld<float>(L, BTL + (d * 64 + pi_) * 4), gi = ldsld<float>(L, GCL + (d * 64 + pi_) * 4);
#pragma unroll
      for (int e = 0; e < 16; ++e) { const int bb = jq * 16 + e, pr = d ? 63 - bb : bb;
        float v = 0.f;
        if (a > bb) v = bi * ldsld<float>(L, GL + (pi_ * 68 + pr) * 4) * __expf(gi - ldsld<float>(L, GCL + (d * 64 + pr) * 4));
        ldsst<float>(L, AL + ((d * 64 + a) * 64 + bb) * 4, v); } }
    __syncthreads();
    { constexpr int XL = 0, ML = GL; int tid5 = tid; asm volatile("" : "+v"(tid5)); const int wid5 = tid5 >> 6, lane5 = tid5 & 63;
#define XLA(d_, r_, c_) (XL + (((d_) * 64 + (r_)) * 64 + (c_)) * 4)
#define ALA(d_, r_, c_) (AL + (((d_) * 64 + (r_)) * 64 + (c_)) * 4)
      if (wid5 < 2) {
        const int d = wid5, bb = lane5 >> 4, cc = lane5 & 15; float xb[16];
#pragma unroll
        for (int ii = 0; ii < 16; ++ii) {
          float t = (ii == cc) ? 1.f : 0.f;
#pragma unroll
          for (int j4 = 0; j4 < (ii + 3) / 4; ++j4) { const f32x4 av = ldsld<f32x4>(L, ALA(d, 16 * bb + ii, 16 * bb + j4 * 4));
#pragma unroll
            for (int e = 0; e < 4; ++e) if (j4 * 4 + e < ii) t -= av[e] * xb[j4 * 4 + e]; }
          xb[ii] = t; ldsst<float>(L, XLA(d, 16 * bb + ii, 16 * bb + cc), t);
        }
      }
      __syncthreads();
#pragma unroll
      for (int lev = 1; lev <= 3; ++lev) {
        const int nblk = 2 * (4 - lev), nel = nblk * 256;
        for (int o = tid5; o < nel; o += NTHR) {
          const int bl = o >> 8, d = bl & 1, i = lev + (bl >> 1), j = i - lev, r = (o >> 4) & 15, c = o & 15; float acc_ = 0.f;
          for (int m = 0; m < lev; ++m) {
#pragma unroll
            for (int k4 = 0; k4 < 4; ++k4) { const f32x4 av = ldsld<f32x4>(L, ALA(d, 16 * i + r, 16 * (j + m) + 4 * k4));
#pragma unroll
              for (int e = 0; e < 4; ++e) acc_ += av[e] * ldsld<float>(L, XLA(d, 16 * (j + m) + 4 * k4 + e, 16 * j + c)); }
          }
          ldsst<float>(L, ML + o * 4, acc_);
        }
        __syncthreads();
        for (int o = tid5; o < nel; o += NTHR) {
          const int bl = o >> 8, d = bl & 1, i = lev + (bl >> 1), j = i - lev, r = (o >> 4) & 15, c = o & 15; float acc_ = 0.f;
#pragma unroll
          for (int k4 = 0; k4 < 4; ++k4) { const f32x4 dv = ldsld<f32x4>(L, XLA(d, 16 * i + r, 16 * i + 4 * k4));
#pragma unroll
            for (int e = 0; e < 4; ++e) acc_ += dv[e] * ldsld<float>(L, ML + ((bl << 8) + ((4 * k4 + e) << 4) + c) * 4); }
          ldsst<float>(L, XLA(d, 16 * i + r, 16 * j + c), -acc_);
        }
        __syncthreads();
      }
      { const int d = tid5 >> 8, i = (tid5 >> 2) & 63, cq = tid5 & 3, pp = d ? 63 - i : i; float tw[16], tu[16];
#pragma unroll
        for (int e = 0; e < 16; ++e) { const int c = cq * 16 + e, pr = d ? 63 - c : c;
          const float x = ((i >> 4) > cq || ((i >> 4) == cq)) ? ldsld<float>(L, XLA(d, i, c)) : 0.f;
          const float bc = ldsld<float>(L, BTL + (d * 64 + pr) * 4), fw = bc * __expf(ldsld<float>(L, GCL + (d * 64 + pr) * 4));
          tw[e] = x * fw; tu[e] = x * bc; }
#pragma unroll
        for (int e = 0; e < 8; ++e) { const float a0 = tw[e], a1 = tw[15 - e], b0 = tu[e], b1 = tu[15 - e]; tw[e] = d ? a1 : a0; tw[15 - e] = d ? a0 : a1; tu[e] = d ? b1 : b0; tu[15 - e] = d ? b0 : b1; }
        const int pr0 = d ? 63 - (cq * 16 + 15) : cq * 16;
        u32x4 w0, w1;
        w0.x = cvt_pk_bf16(tw[0], tw[1]); w0.y = cvt_pk_bf16(tw[2], tw[3]); w0.z = cvt_pk_bf16(tw[4], tw[5]); w0.w = cvt_pk_bf16(tw[6], tw[7]);
        w1.x = cvt_pk_bf16(tw[8], tw[9]); w1.y = cvt_pk_bf16(tw[10], tw[11]); w1.z = cvt_pk_bf16(tw[12], tw[13]); w1.w = cvt_pk_bf16(tw[14], tw[15]);
        ldsst<u32x4>(L, TOL + ((d * 2 + 0) * 64 + pp) * 144 + pr0 * 2, w0); ldsst<u32x4>(L, TOL + ((d * 2 + 0) * 64 + pp) * 144 + pr0 * 2 + 16, w1);
        w0.x = cvt_pk_bf16(tu[0], tu[1]); w0.y = cvt_pk_bf16(tu[2], tu[3]); w0.z = cvt_pk_bf16(tu[4], tu[5]); w0.w = cvt_pk_bf16(tu[6], tu[7]);
        w1.x = cvt_pk_bf16(tu[8], tu[9]); w1.y = cvt_pk_bf16(tu[10], tu[11]); w1.z = cvt_pk_bf16(tu[12], tu[13]); w1.w = cvt_pk_bf16(tu[14], tu[15]);
        ldsst<u32x4>(L, TOL + ((d * 2 + 1) * 64 + pp) * 144 + pr0 * 2, w0); ldsst<u32x4>(L, TOL + ((d * 2 + 1) * 64 + pp) * 144 + pr0 * 2 + 16, w1);
      }
#undef XLA
#undef ALA
    }
    __syncthreads();
#pragma unroll
    for (int it = 0; it < 4; ++it) { const int v = tid + 512 * it, mtx = v >> 9, row = (v >> 3) & 63, sg = (v & 7) * 8;
      *(u32x4*)(TT + ((size_t)item * 4 + mtx) * 4096 + row * 64 + sg) = ldsld<u32x4>(L, TOL + (mtx * 64 + row) * 144 + sg * 2); }
    __syncthreads();
  }
}

__device__ __forceinline__ void fourier_prep(const Params& p, ldsp L) {
  const int tid = otid(), lane = tid & 63, wid = tid >> 6, fr = lane & 15, fq = lane >> 4;
  constexpr int UA = 0, UB = 33792, DC = 67584;
  const bf16_t* FI = (const bf16_t*)(lws(p.ws) + O_FI); bf16_t* FBT = (bf16_t*)(lws(p.ws) + O_FBT); float* UCS = (float*)(lws(p.ws) + O_UCS);
  for (int idx = tid; idx < 128 * 64; idx += NTHR) { const int rr = idx >> 6, c = idx & 63, m = rr & 63; const float a = (float)((m * c) & 63) * (1.0f / 32.0f);
    const float v = (rr < 64 ? cospif(a) : sinpif(a)) * 0.125f; ldsst<bf16_t>(L, DC + rr * 144 + c * 2, (bf16_t)(cvt_pk_bf16(v, 0.f) & 0xffffu)); }
  __syncthreads();
  for (int item = (int)gridDim.x - 1 - (int)blockIdx.x; item < 288; item += gridDim.x) {
    const bool lat = item < 256; const int b = lat ? item >> 5 : 0, jb = item & 31;
#pragma unroll
    for (int it = 0; it < 4; ++it) { const int v = tid + 512 * it, row = v >> 5, sg = (v & 31) * 8;
      int ra, rb;
      if (lat) { const int t = 64 * jb + row; ra = b * 4096 + t; rb = b * 4096 + (t == 0 ? 2048 : 4096 - t); } else { ra = RLAT + (item - 256) * 64 + row; rb = ra; }
      ldsst<u32x4>(L, UA + row * 528 + sg * 2, *(const u32x4*)(FI + (size_t)ra * 256 + sg));
      ldsst<u32x4>(L, UB + row * 528 + sg * 2, *(const u32x4*)(FI + (size_t)rb * 256 + sg)); }
    __syncthreads();
    for (int q = 0; q < 8; ++q) {
      const int combo = wid * 8 + q, g = combo >> 4, ti = (combo >> 2) & 3, tm = combo & 3;
      f32x4 ac = {0.f, 0.f, 0.f, 0.f}, as = ac, bc = ac, bs = ac;
#pragma unroll
      for (int kk = 0; kk < 2; ++kk) {
        const bf16x8 xa = ldsld<bf16x8>(L, UA + (16 * ti + fr) * 528 + (g * 64 + kk * 32 + fq * 8) * 2), xb = ldsld<bf16x8>(L, UB + (16 * ti + fr) * 528 + (g * 64 + kk * 32 + fq * 8) * 2);
        const bf16x8 yc = ldsld<bf16x8>(L, DC + (16 * tm + fr) * 144 + kk * 64 + fq * 16), ys = ldsld<bf16x8>(L, DC + (64 + 16 * tm + fr) * 144 + kk * 64 + fq * 16);
        ac = mma(xa, yc, ac); as = mma(xa, ys, as); bc = mma(xb, yc, bc); bs = mma(xb, ys, bs);
      }
      const int mp = g * 64 + 16 * tm + fr, i0 = 16 * ti + 4 * fq;
      if (lat) {
        f32x4 cv = ac + bc, sv = as - bs;
        if (jb == 0 && i0 == 0) { cv[0] = ac[0]; sv[0] = bc[0]; }
        bf16_t* o = FBT + ((size_t)b * 256 + mp) * 4096 + 64 * jb + i0;
        *(u32x2*)o = pack4(cv); *(u32x2*)(o + 2048) = pack4(sv);
      } else {
#pragma unroll
        for (int e = 0; e < 4; ++e) { float* o = UCS + (size_t)((item - 256) * 64 + i0 + e) * 512; o[mp] = ac[e]; o[256 + mp] = as[e]; }
      }
    }
    __syncthreads();
  }
}

__device__ __forceinline__ void ctx_fourier(const Params& p, ldsp L, int wg, int nwg) {
  const int tid = otid(); const float* UCS = (const float*)(lws(p.ws) + O_UCS); bf16_t* PPF = (bf16_t*)(lws(p.ws) + O_PPF);
  for (int idx = tid; idx < 256; idx += NTHR) { const float a = (float)idx * (1.0f / 128.0f); ldsst<float>(L, idx * 4, cospif(a) * (1.0f / 16.0f)); ldsst<float>(L, 1024 + idx * 4, sinpif(a) * (1.0f / 16.0f)); }
  __syncthreads();
  for (int o = wg * NTHR + tid; o < NB * 32 * 256; o += nwg * NTHR) {
    const int mp = o & 255, kq = (o >> 8) & 31, b = o >> 13; const float* u = UCS + (size_t)b * 256 * 512 + mp; float s8[8];
#pragma unroll
    for (int e = 0; e < 8; ++e) s8[e] = 0.f;
#pragma unroll 16
    for (int t = 0; t < 256; ++t) { const float uc = u[(size_t)t * 512], us = u[(size_t)t * 512 + 256];
#pragma unroll
      for (int e = 0; e < 8; ++e) { const int r = ((8 * kq + e) * t) & 255; s8[e] += ldsld<float>(L, r * 4) * uc - ldsld<float>(L, 1024 + r * 4) * us; } }
#pragma unroll
    for (int e = 0; e < 8; ++e) PPF[(size_t)(RLAT + b * 256 + 8 * kq + e) * 512 + 256 + mp] = (bf16_t)(cvt_pk_bf16(s8[e], 0.f) & 0xffffu);
  }
  __syncthreads();
}
__device__ __forceinline__ void pool_phase(const Params& p, ldsp L, int wg, int nwg) {
  const int tid_ = otid(), lane = tid_ & 63, wv = tid_ >> 6, gw = wg * 8 + wv, nw = nwg * 8;
  const bf16_t* PI = (const bf16_t*)(lws(p.ws) + O_PI); bf16_t* PPF = (bf16_t*)(lws(p.ws) + O_PPF);
  const int LP = wv * 16640;
  for (int idx = gw; idx < 2048; idx += nw) {
    const int g = 3 - (idx >> 9), b = (idx >> 6) & 7, r = idx & 63;
    const int win = 2 << g, hw = win >> 1, sr = max(r - hw, 0), er = min(r - hw + win, 64);
    const bf16_t* base = PI + (size_t)b * 4096 * 256 + g * 64 + lane;
    ldsst<float>(L, LP + lane * 4, 0.f);
    { const int ci = lane >> 3, ch0 = (lane & 7) * 8;
      const bf16_t* bq = PI + (size_t)b * 4096 * 256 + g * 64 + ch0;
      const int ncb = 16 >> (g + 1);
#pragma unroll 1
      for (int cb0 = 0; cb0 < 8; cb0 += ncb) {
        u32x4 vv[16];
#pragma unroll
        for (int q = 0; q < 16; ++q) { const int cbq = q >> (g + 1), rr = sr + (q & (win - 1)), cc = (cb0 + cbq) * 8 + ci; vv[q] = (u32x4){0u, 0u, 0u, 0u}; if (rr < er) vv[q] = *(const u32x4*)(bq + (size_t)(rr * 64 + cc) * 256); }
        float ac[8];
        for (int cbq = 0; cbq < ncb; ++cbq) {
#pragma unroll
          for (int e = 0; e < 8; ++e) ac[e] = 0.f;
#pragma unroll
          for (int q = 0; q < 16; ++q) { const bool mine = (q >> (g + 1)) == cbq;
#pragma unroll
            for (int e = 0; e < 4; ++e) { ac[2 * e] += mine ? bflo(vv[q][e]) : 0.f; ac[2 * e + 1] += mine ? bfhi(vv[q][e]) : 0.f; } }
          const int cc = (cb0 + cbq) * 8 + ci;
          ldsst<f32x4>(L, LP + ((cc + 1) * 64 + ch0) * 4, (f32x4){ac[0], ac[1], ac[2], ac[3]}); ldsst<f32x4>(L, LP + ((cc + 1) * 64 + ch0 + 4) * 4, (f32x4){ac[4], ac[5], ac[6], ac[7]});
        }
      }
      float run = 0.f;
#pragma unroll 8
      for (int cc = 1; cc <= 64; ++cc) { run += ldsld<float>(L, LP + (cc * 64 + lane) * 4); ldsst<float>(L, LP + (cc * 64 + lane) * 4, run); }
    }
    const float rinv = 1.0f / (float)(er - sr);
#pragma unroll 16
    for (int c = 0; c < 64; ++c) {
      const int sc = max(c - hw, 0), ec = min(c - hw + win, 64);
      const float box = ldsld<float>(L, LP + (ec * 64 + lane) * 4) - ldsld<float>(L, LP + (sc * 64 + lane) * 4);
      const size_t rowi = (size_t)b * 4096 + r * 64 + c;
      const float self = __uint_as_float((unsigned)PI[rowi * 256 + g * 64 + lane] << 16);
      PPF[rowi * 512 + g * 64 + lane] = (bf16_t)(cvt_pk_bf16(box * rinv / (float)(ec - sc) - self, 0.f) & 0xffffu);
    }
  }
  for (int r = RLAT + gw; r < ROWS; r += nw) {
    const int base = r & ~255, t = r - base;
#pragma unroll
    for (int g = 0; g < 4; ++g) {
      const int win = 2 << g, hw = win >> 1, sc = max(t - hw, 0), ec = min(t - hw + win, 256);
      float s_ = 0.f;
#pragma unroll
      for (int q = 0; q < (2 << g); ++q) { const int c = sc + q; if (c < ec) s_ += __uint_as_float((unsigned)PI[(size_t)(base + c) * 256 + g * 64 + lane] << 16); }
      const float self = __uint_as_float((unsigned)PI[(size_t)r * 256 + g * 64 + lane] << 16);
      PPF[(size_t)r * 512 + g * 64 + lane] = (bf16_t)(cvt_pk_bf16(s_ / (float)(ec - sc) - self, 0.f) & 0xffffu);
    }
  }
}

__device__ __forceinline__ void scan_phase(const Params& p, ldsp L, int item) {
  const int tid = otid(), lane = tid & 63, wid = tid >> 6, fr = lane & 15, fq = lane >> 4;
  const int es = item & 1, d = (item >> 1) & 1, h = (item >> 2) & 3, b = item >> 4;
  const int ti = wid >> 1, half = wid & 1;
  constexpr int QS = 0, KS = 17408, KTS = 34816, VTS = 53248, TW = 62464, TU = 71680, AT = 80896, WL = 90112, VNT_ = 107520, VNS = 116736, STL = 125952, GCL = 143360;
  const bf16_t* QN = (const bf16_t*)(lws(p.ws) + O_QN); const bf16_t* KN = (const bf16_t*)(lws(p.ws) + O_KN); const bf16_t* KNT = (const bf16_t*)(lws(p.ws) + O_KNT); const bf16_t* VNT = (const bf16_t*)(lws(p.ws) + O_VNT);
  const bf16_t* TT = (const bf16_t*)(lws(p.ws) + O_TT); const float* GC = (const float*)(lws(p.ws) + O_GC); bf16_t* O = (bf16_t*)(lws(p.ws) + O_O) + (size_t)d * ROWS * 512;
  { unsigned zz_; asm volatile("v_mov_b32 %0, 0" : "=v"(zz_)); for (int o = tid * 16; o < 17408; o += NTHR * 16) ldsst<u32x4>(L, STL + o, (u32x4){zz_, zz_, zz_, zz_}); }
  f32x4 accS[4];
#pragma unroll
  for (int q = 0; q < 4; ++q) accS[q] = (f32x4){0.f, 0.f, 0.f, 0.f};
  u32x4 rq[2], rk[2], rkt[2], rvt, rtw, rtu; float rgc = 0.f;
#define SCAN_CHUNK(s) ((s) < 4 ? (NB * 64 + b * 4 + (d ? 3 - (s) : (s))) : (b * 64 + (d ? 67 - (s) : (s) - 4)))
#define SCAN_GLOAD(s) do { const int n_ = SCAN_CHUNK(s), it2_ = n_ * 4 + h; \
    _Pragma("unroll") for (int it = 0; it < 2; ++it) { const int v = tid + 512 * it; \
      rq[it] = *(const u32x4*)(QN + (size_t)(64 * n_ + (v >> 4)) * 512 + h * 128 + (v & 15) * 8); rk[it] = *(const u32x4*)(KN + (size_t)(64 * n_ + (v >> 4)) * 512 + h * 128 + (v & 15) * 8); \
      rkt[it] = *(const u32x4*)(KNT + (size_t)it2_ * 8192 + (v >> 3) * 64 + (v & 7) * 8); } \
    rvt = *(const u32x4*)(VNT + (size_t)it2_ * 8192 + (es * 64 + (tid >> 3)) * 64 + (tid & 7) * 8); \
    rtw = *(const u32x4*)(TT + ((size_t)it2_ * 4 + d * 2 + 0) * 4096 + (tid >> 3) * 64 + (tid & 7) * 8); rtu = *(const u32x4*)(TT + ((size_t)it2_ * 4 + d * 2 + 1) * 4096 + (tid >> 3) * 64 + (tid & 7) * 8); \
    if (tid < 64) rgc = GC[((size_t)it2_ * 2 + d) * 64 + tid]; } while (0)
#define SCAN_LSTORE() do { \
    _Pragma("unroll") for (int it = 0; it < 2; ++it) { const int v = tid + 512 * it; \
      ldsst<u32x4>(L, QS + (v >> 4) * 272 + (v & 15) * 16, rq[it]); ldsst<u32x4>(L, KS + (v >> 4) * 272 + (v & 15) * 16, rk[it]); ldsst<u32x4>(L, KTS + (v >> 3) * 144 + (v & 7) * 16, rkt[it]); } \
    ldsst<u32x4>(L, VTS + (tid >> 3) * 144 + (tid & 7) * 16, rvt); ldsst<u32x4>(L, TW + (tid >> 3) * 144 + (tid & 7) * 16, rtw); ldsst<u32x4>(L, TU + (tid >> 3) * 144 + (tid & 7) * 16, rtu); \
    if (tid < 64) ldsst<float>(L, GCL + tid * 4, rgc); } while (0)
  SCAN_GLOAD(0); SCAN_LSTORE(); __syncthreads();
  for (int s = 0; s < 68; ++s) {
    const int n = SCAN_CHUNK(s);
    if (s + 1 < 68) SCAN_GLOAD(s + 1);
    const float gtot = ldsld<float>(L, GCL + (d ? 0 : 63) * 4);
    f32x4 uacc[2], qacc[2];
    {
      bf16x8 qf[4], kf[2][4], twf[2], tuf[2], vtf[2][2], ktf[4][2], sf[2][4];
#pragma unroll
      for (int kk = 0; kk < 4; ++kk) qf[kk] = ldsld<bf16x8>(L, QS + (16 * ti + fr) * 272 + kk * 64 + fq * 16);
#pragma unroll
      for (int q = 0; q < 2; ++q)
#pragma unroll
        for (int kk = 0; kk < 4; ++kk) { kf[q][kk] = ldsld<bf16x8>(L, KS + (16 * (2 * half + q) + fr) * 272 + kk * 64 + fq * 16); sf[q][kk] = ldsld<bf16x8>(L, STL + (16 * (2 * half + q) + fr) * 272 + kk * 64 + fq * 16); }
      f32x4 at[2], wv[4];
#pragma unroll
      for (int q = 0; q < 2; ++q) { at[q] = (f32x4){0.f, 0.f, 0.f, 0.f}; qacc[q] = at[q]; uacc[q] = at[q]; }
#pragma unroll
      for (int q = 0; q < 4; ++q) wv[q] = (f32x4){0.f, 0.f, 0.f, 0.f};
#pragma unroll
      for (int kk = 0; kk < 4; ++kk)
#pragma unroll
        for (int q = 0; q < 2; ++q) { at[q] = mma(kf[q][kk], qf[kk], at[q]); qacc[q] = mma(sf[q][kk], qf[kk], qacc[q]); }
      __builtin_amdgcn_sched_barrier(0);
#pragma unroll
      for (int kk = 0; kk < 2; ++kk) { twf[kk] = ldsld<bf16x8>(L, TW + (16 * ti + fr) * 144 + kk * 64 + fq * 16); tuf[kk] = ldsld<bf16x8>(L, TU + (16 * ti + fr) * 144 + kk * 64 + fq * 16); }
#pragma unroll
      for (int q = 0; q < 4; ++q)
#pragma unroll
        for (int kk = 0; kk < 2; ++kk) ktf[q][kk] = ldsld<bf16x8>(L, KTS + (16 * (4 * half + q) + fr) * 144 + kk * 64 + fq * 16);
#pragma unroll
      for (int q = 0; q < 2; ++q)
#pragma unroll
        for (int kk = 0; kk < 2; ++kk) vtf[q][kk] = ldsld<bf16x8>(L, VTS + (16 * (2 * half + q) + fr) * 144 + kk * 64 + fq * 16);
#pragma unroll
      for (int kk = 0; kk < 2; ++kk) {
#pragma unroll
        for (int q = 0; q < 4; ++q) wv[q] = mma(ktf[q][kk], twf[kk], wv[q]);
#pragma unroll
        for (int q = 0; q < 2; ++q) uacc[q] = mma(tuf[kk], vtf[q][kk], uacc[q]);
      }
      const int i = 16 * ti + fr; const float gi = ldsld<float>(L, GCL + i * 4);
#pragma unroll
      for (int q = 0; q < 2; ++q) {
        const int j0 = 16 * (2 * half + q) + 4 * fq; f32x4 a = at[q];
#pragma unroll
        for (int e = 0; e < 4; ++e) { const int j = j0 + e; const bool keep = d ? (i <= j) : (i >= j); const float ar = keep ? gi - ldsld<float>(L, GCL + j * 4) : 0.f; a[e] = keep ? a[e] * __expf(ar) : 0.f; }
        ldsst<u32x2>(L, AT + i * 144 + j0 * 2, pack4(a));
      }
#pragma unroll
      for (int q = 0; q < 4; ++q) ldsst<u32x2>(L, WL + (16 * ti + fr) * 272 + (16 * (4 * half + q) + 4 * fq) * 2, pack4(wv[q]));
    }
    __syncthreads();
    {
      bf16x8 wf[4], sf[2][4];
#pragma unroll
      for (int kk = 0; kk < 4; ++kk) { wf[kk] = ldsld<bf16x8>(L, WL + (16 * ti + fr) * 272 + kk * 64 + fq * 16);
#pragma unroll
        for (int q = 0; q < 2; ++q) sf[q][kk] = ldsld<bf16x8>(L, STL + (16 * (2 * half + q) + fr) * 272 + kk * 64 + fq * 16); }
      f32x4 a[2];
#pragma unroll
      for (int q = 0; q < 2; ++q) a[q] = (f32x4){0.f, 0.f, 0.f, 0.f};
#pragma unroll
      for (int kk = 0; kk < 4; ++kk)
#pragma unroll
        for (int q = 0; q < 2; ++q) a[q] = mma(wf[kk], sf[q][kk], a[q]);
      const int i0 = 16 * ti + 4 * fq; float sc4[4];
#pragma unroll
      for (int e = 0; e < 4; ++e) sc4[e] = __expf(gtot - ldsld<float>(L, GCL + (i0 + e) * 4));
#pragma unroll
      for (int q = 0; q < 2; ++q) {
        const int te = 2 * half + q; const f32x4 vn = uacc[q] - a[q]; f32x4 vs;
#pragma unroll
        for (int e = 0; e < 4; ++e) vs[e] = vn[e] * sc4[e];
        ldsst<u32x2>(L, VNT_ + (16 * te + fr) * 144 + i0 * 2, pack4(vn)); ldsst<u32x2>(L, VNS + (16 * te + fr) * 144 + i0 * 2, pack4(vs));
      }
    }
    __syncthreads();
    {
      bf16x8 af[2], vf[2][2], nsf[2], ktf[4][2];
#pragma unroll
      for (int q = 0; q < 4; ++q)
#pragma unroll
        for (int kk = 0; kk < 2; ++kk) ktf[q][kk] = ldsld<bf16x8>(L, KTS + (16 * (4 * half + q) + fr) * 144 + kk * 64 + fq * 16);
#pragma unroll
      for (int kk = 0; kk < 2; ++kk) { af[kk] = ldsld<bf16x8>(L, AT + (16 * ti + fr) * 144 + kk * 64 + fq * 16); nsf[kk] = ldsld<bf16x8>(L, VNS + (16 * ti + fr) * 144 + kk * 64 + fq * 16);
#pragma unroll
        for (int q = 0; q < 2; ++q) vf[q][kk] = ldsld<bf16x8>(L, VNT_ + (16 * (2 * half + q) + fr) * 144 + kk * 64 + fq * 16); }
      const float cd = __expf(gtot);
      f32x4 ov[2];
#pragma unroll
      for (int q = 0; q < 2; ++q) ov[q] = (f32x4){0.f, 0.f, 0.f, 0.f};
#pragma unroll
      for (int q = 0; q < 4; ++q) accS[q] = accS[q] * cd;
#pragma unroll
      for (int kk = 0; kk < 2; ++kk) {
#pragma unroll
        for (int q = 0; q < 2; ++q) ov[q] = mma(vf[q][kk], af[kk], ov[q]);
#pragma unroll
        for (int q = 0; q < 4; ++q) accS[q] = mma(ktf[q][kk], nsf[kk], accS[q]);
      }
      const int i = 16 * ti + fr; const float eg = __expf(ldsld<float>(L, GCL + i * 4));
#pragma unroll
      for (int q = 0; q < 2; ++q) { const f32x4 o4 = qacc[q] * eg + ov[q];
        *(u32x2*)(O + (size_t)(64 * n + i) * 512 + h * 128 + es * 64 + 16 * (2 * half + q) + 4 * fq) = pack4(o4); }
    }
    __syncthreads();
#pragma unroll
    for (int q = 0; q < 4; ++q) ldsst<u32x2>(L, STL + (16 * ti + fr) * 272 + (16 * (4 * half + q) + 4 * fq) * 2, pack4(accS[q]));
    if (s + 1 < 68) SCAN_LSTORE();
    __syncthreads();
  }
#undef SCAN_CHUNK
#undef SCAN_GLOAD
#undef SCAN_LSTORE
}

__device__ __forceinline__ void ofprep_phase(const Params& p, int l) {
  const int tid_ = otid(), lane = tid_ & 63, gw = blockIdx.x * 8 + (tid_ >> 6), nw = gridDim.x * 8;
  const bf16_t* O0 = (const bf16_t*)(lws(p.ws) + O_O); const bf16_t* O1 = O0 + (size_t)ROWS * 512; const bf16_t* Z = (const bf16_t*)(lws(p.ws) + O_Z); bf16_t* OF = (bf16_t*)(lws(p.ws) + O_OF);
  const float* og = p.o_gain + (size_t)l * 128 + (lane & 15) * 8;
  for (int r0 = gw; r0 < ROWS; r0 += 2 * nw) {
    u32x4 av[2], bv[2], zv[2];
#pragma unroll
    for (int q = 0; q < 2; ++q) { const int r = (r0 + q * nw) < ROWS ? (r0 + q * nw) : r0;
      av[q] = *(const u32x4*)(O0 + (size_t)r * 512 + lane * 8); bv[q] = *(const u32x4*)(O1 + (size_t)r * 512 + lane * 8); zv[q] = *(const u32x4*)(Z + (size_t)r * 512 + lane * 8); }
#pragma unroll
    for (int q = 0; q < 2; ++q) {
      const int r = r0 + q * nw; if (r >= ROWS) continue;
      const u32x4 a = av[q], bq = bv[q], zq = zv[q];
      float o[8]; float ss = 0.f;
#pragma unroll
      for (int e = 0; e < 4; ++e) { o[2 * e] = bflo(a[e]) + bflo(bq[e]); o[2 * e + 1] = bfhi(a[e]) + bfhi(bq[e]); ss += o[2 * e] * o[2 * e] + o[2 * e + 1] * o[2 * e + 1]; }
      ss += __shfl_xor(ss, 1); ss += __shfl_xor(ss, 2); ss += __shfl_xor(ss, 4); ss += __shfl_xor(ss, 8);
      const float rstd = rsqrtf(ss * (1.0f / 128.0f) + 1e-6f);
      float y[8];
#pragma unroll
      for (int e = 0; e < 4; ++e) { y[2 * e] = o[2 * e] * rstd * og[2 * e] * siluf_(bflo(zq[e])); y[2 * e + 1] = o[2 * e + 1] * rstd * og[2 * e + 1] * siluf_(bfhi(zq[e])); }
      u32x4 w; w.x = cvt_pk_bf16(y[0], y[1]); w.y = cvt_pk_bf16(y[2], y[3]); w.z = cvt_pk_bf16(y[4], y[5]); w.w = cvt_pk_bf16(y[6], y[7]);
      *(u32x4*)(OF + (size_t)r * 512 + lane * 8) = w;
    }
  }
}

#define XB_TMO      128
#define XB_XCNT(j)  (256  + 64 * (j))
#define XB_XSUB(j)  (1280 + 64 * (j))
#define XB_XGEN(j)  (2304 + 64 * (j))
#define XB_TOP      3328
#define XB_TOPGEN   3392
#define XCD_BAR_WORDS 3456
#define XB_SPIN_CAP (1u << 18)

__device__ __forceinline__ unsigned xb_ld(unsigned* p)              { return __hip_atomic_load(p, __ATOMIC_RELAXED, __HIP_MEMORY_SCOPE_AGENT); }
__device__ __forceinline__ unsigned xb_add(unsigned* p, unsigned v) { return __hip_atomic_fetch_add(p, v, __ATOMIC_RELAXED, __HIP_MEMORY_SCOPE_AGENT); }
__device__ __forceinline__ unsigned xb_xcc_id() { return (unsigned)__builtin_amdgcn_s_getreg((3 << 11) | 20) & 0xFu; }
#define XB_SPIN(cond, bar) do { unsigned _sp = 0; while (cond) { __builtin_amdgcn_s_sleep(1); \
    if ((++_sp & 255u) == 0u) { if (xb_ld(&(bar)[XB_TMO])) break; if (_sp > XB_SPIN_CAP) { atomicAdd(&(bar)[XB_TMO], 1u); break; } } } } while (0)

struct XcdBarrier {
    unsigned* bar; unsigned x;
    volatile LAS unsigned* st;
};

__device__ __forceinline__ XcdBarrier xcd_barrier_post(unsigned* bar, volatile LAS unsigned* st) {
    XcdBarrier b; b.bar = bar; b.x = xb_xcc_id(); b.st = st;
    if (threadIdx.x == 0) (void)xb_add(&bar[XB_XCNT(b.x)], 1u);
    return b;
}
__device__ __forceinline__ void xcd_barrier_complete(unsigned* bar, unsigned x, unsigned& nloc, unsigned& nx) {
    const unsigned G = gridDim.x * gridDim.y * gridDim.z;
    unsigned sum, cnt, mine, sp = 0u;
    for (;;) {
        sum = 0u; cnt = 0u; mine = 0u;
#pragma unroll
        for (unsigned j = 0; j < 16; ++j) { const unsigned c = xb_ld(&bar[XB_XCNT(j)]); sum += c; cnt += (c > 0u) ? 1u : 0u; mine = (j == x) ? c : mine; }
        if (sum == G) break;
        __builtin_amdgcn_s_sleep(1);
        if ((++sp & 255u) == 0u) { if (xb_ld(&bar[XB_TMO])) break; if (sp > XB_SPIN_CAP) { atomicAdd(&bar[XB_TMO], 1u); break; } }
    }
    nloc = mine > 0u ? mine : 1u; nx = cnt > 0u ? cnt : 1u;
}

__device__ __forceinline__ void xcd_barrier(const XcdBarrier& b) {
    asm volatile("s_waitcnt vmcnt(0)" ::: "memory");
    __syncthreads();
    if (threadIdx.x == 0) {
        unsigned* bar = b.bar;
        __builtin_amdgcn_s_waitcnt(0);
        unsigned nloc = b.st[0], nx = b.st[1];
        if (nloc == 0u) { xcd_barrier_complete(bar, b.x, nloc, nx); b.st[0] = nloc; b.st[1] = nx; }
        const unsigned old = xb_add(&bar[XB_XSUB(b.x)], 1u);
        const unsigned gen = old / nloc;
        if (old + 1u == (gen + 1u) * nloc) {
            __builtin_amdgcn_fence(__ATOMIC_RELEASE, "agent");
            asm volatile("s_waitcnt vmcnt(0)" ::: "memory");
            const unsigned og = xb_add(&bar[XB_TOP], 1u);
            const unsigned tg = og / nx;
            if (og + 1u == (tg + 1u) * nx) xb_add(&bar[XB_TOPGEN], 1u);
            else XB_SPIN(xb_ld(&bar[XB_TOPGEN]) == tg, bar);
            __builtin_amdgcn_fence(__ATOMIC_ACQUIRE, "agent");
            xb_add(&bar[XB_XGEN(b.x)], 1u);
            asm volatile("s_waitcnt vmcnt(0)" ::: "memory");
        } else {
            XB_SPIN(xb_ld(&bar[XB_XGEN(b.x)]) == gen, bar);
            __builtin_amdgcn_fence(__ATOMIC_ACQUIRE, "agent");
            asm volatile("s_waitcnt vmcnt(0)" ::: "memory");
        }
    }
    __syncthreads();
}


__device__ __forceinline__ float rdb(const bf16_t* s_, size_t n, size_t i) { float a = 0.f; for (size_t j = i; j < n; j += (size_t)RLAT * DM) a += __uint_as_float((unsigned)s_[j] << 16); return a; }
__device__ __forceinline__ float rdf(const float* s_, size_t n, size_t i) { float a = 0.f; for (size_t j = i; j < n; j += (size_t)RLAT * DM) a += s_[j]; return a; }
__device__ __forceinline__ void dump_phase(const Params& p, int which) {
  const size_t NO = (size_t)RLAT * DM; unsigned char* ws = lws(p.ws);
  for (size_t i = (size_t)blockIdx.x * NTHR + otid(); i < NO; i += (size_t)gridDim.x * NTHR) {
    float a = 0.f;
    if (which == 1) { a = rdb((const bf16_t*)(ws + O_QKV), (size_t)ROWS * 1536, i) + rdb((const bf16_t*)(ws + O_Z), (size_t)ROWS * 512, i) + rdb((const bf16_t*)(ws + O_PI), (size_t)ROWS * 256, i) + rdb((const bf16_t*)(ws + O_FI), (size_t)ROWS * 256, i) + rdf((const float*)(ws + O_AB), (size_t)ROWS * 16, i); }
    if (which == 2) { a = rdb((const bf16_t*)(ws + O_QN), (size_t)ROWS * 512, i) + rdb((const bf16_t*)(ws + O_KN), (size_t)ROWS * 512, i) + rdb((const bf16_t*)(ws + O_KNT), (size_t)ROWS * 512, i) + rdb((const bf16_t*)(ws + O_VNT), (size_t)ROWS * 512, i) + rdb((const bf16_t*)(ws + O_TT), (size_t)ROWS * 1024, i) + rdf((const float*)(ws + O_GC), (size_t)NCH * 4 * 2 * 64, i)
          + rdb((const bf16_t*)(ws + O_FBT), (size_t)NB * 256 * 4096, i) + rdf((const float*)(ws + O_UCS), (size_t)NB * CTX * 512, i); }
    if (which == 3) { a = rdb((const bf16_t*)(ws + O_O), (size_t)ROWS * 1024, i); }
    if (which == 4) { a = rdb((const bf16_t*)(ws + O_OF), (size_t)ROWS * 512, i) + rdb((const bf16_t*)(ws + O_HN), (size_t)ROWS * 1024, i); }
    if (which == 5) { a = rdb((const bf16_t*)(ws + O_MRG), (size_t)ROWS * 1024, i); }
    if ((__float_as_uint(a) & 0xffff0000u) == 0xaaaa0000u) a = 1234.5f;
    if (!(a == a) || fabsf(a) > 1e30f) a = 777.0f;
    a = a * 0.5f + 0.12345678f;
    p.out[i] = a;
  }
}
__global__ void __launch_bounds__(NTHR) fwd_megakernel(Params p) {
  ldsp L = (ldsp)g_shm;
  cg::grid_group grid = cg::this_grid();
  volatile LAS unsigned* xst = (volatile LAS unsigned*)(L + LDS_BYTES - 16);
  if (threadIdx.x < 4) xst[threadIdx.x] = 0u;
  if (threadIdx.x == 0) { const unsigned long long wa_ = (unsigned long long)p.ws; *(volatile LAS unsigned*)(L + LDS_BYTES - 32) = (unsigned)wa_; *(volatile LAS unsigned*)(L + LDS_BYTES - 28) = (unsigned)(wa_ >> 32); }
  __syncthreads();
  XcdBarrier xbar = xcd_barrier_post((unsigned*)(p.ws + O_BAR), xst);
#define GSYNC0() do { asm volatile("s_waitcnt vmcnt(0) lgkmcnt(0)" ::: "memory"); __builtin_amdgcn_fence(__ATOMIC_RELEASE, "agent"); grid.sync(); __builtin_amdgcn_fence(__ATOMIC_ACQUIRE, "agent"); } while (0)
#define GSYNC() xcd_barrier(xbar)
  const int G = gridDim.x, c = blockIdx.x;
#define X ((float*)(lws(p.ws) + O_X))
#define MOD ((const float*)(lws(p.ws) + O_MOD))
#define Hn ((bf16_t*)(lws(p.ws) + O_HN))
#ifndef NO_P0
  phase0(p, L);
#endif
  GSYNC0();
  for (int l = 0; l < DEPTH; ++l) {
    const float* modl = MOD + (size_t)l * 9 * 9216; const float* ng = p.norm_gain + (size_t)l * 3 * 1024; const int notlast = (l != DEPTH - 1) ? 1 : 0, nMx = notlast ? ROWS / 256 : RLAT / 256;
#ifndef PROBE_CONV
#define PROBE_CONV 1
#endif
    { int cur_ = 0;
      if (l == 0) { convert_ffn(p, p.w1gu, p.w1d, O_WGU, O_WD, L, cur_, c, G); convert_win(p, 0, L, cur_, c, G); }
      convert_mixer(p, l, L, cur_); }
    norm_phase(X, Hn, ng, modl, 0, 1, l > 0 ? (const float*)(lws(p.ws) + O_TT) : nullptr);
    GSYNC();
#ifndef PROBE_UP
#define PROBE_UP 1
#endif
    for (int rep_ = 0; rep_ < PROBE_UP; ++rep_)
    { pg8::PlainSched S{(const char*)Hn, (const char*)(lws(p.ws) + O_WGU), 2048, 2048, 16, ROWS / 256, 22, G, c}; EpiUp E{(bf16_t*)(lws(p.ws) + O_ACT)}; pg8::gemm_phase(L, S, E); }
    GSYNC();
    { pg8::ResSched S{(const char*)(lws(p.ws) + O_ACT), (const char*)(lws(p.ws) + O_WD), DFF * 2, DFF / 64, G, c, 0}; EpiResT<false> E{(float*)(p.ws + O_X), modl, 2, 0.5f}; pg8::gemm_phase(L, S, E); }
    if (1) { pg8::ResSched S{(const char*)(lws(p.ws) + O_ACT), (const char*)(lws(p.ws) + O_WD), DFF * 2, DFF / 64, G, c, 1}; EpiPart E{(float*)(lws(p.ws) + O_TT), modl, 2, 0.5f}; pg8::gemm_phase(L, S, E); }
    GSYNC();
#ifndef NO_MIXER
    norm_phase(X, Hn, ng + 1024, modl, 3, 4, (const float*)(lws(p.ws) + O_TT));
    GSYNC();
#ifndef PROBE_IN
#define PROBE_IN 1
#endif
    for (int rep_ = 0; rep_ < PROBE_IN; ++rep_)
    { pg8::PlainSched S{(const char*)Hn, (const char*)(lws(p.ws) + O_WIN), 2048, 2048, 16, ROWS / 256, NINP / 256, G, c};
      EpiIn E{(bf16_t*)(lws(p.ws) + O_QKV), (bf16_t*)(lws(p.ws) + O_Z), (bf16_t*)(lws(p.ws) + O_PI), (bf16_t*)(lws(p.ws) + O_FI), (float*)(lws(p.ws) + O_AB)}; pg8::gemm_phase(L, S, E); }
    GSYNC();
#ifndef PROBE_PREP
#define PROBE_PREP 1
#endif
    for (int rep_ = 0; rep_ < PROBE_PREP; ++rep_) {
    prep_phase(p, l, L);
    }
#ifndef NO_FPREP
    fourier_prep(p, L);
#endif
    GSYNC();
#if defined(DUMP) && DUMP == 2
    dump_phase(p, 2); return;
#endif
#ifndef PROBE_SCAN
#define PROBE_SCAN 1
#endif
#ifndef PROBE_OTHER
#define PROBE_OTHER 1
#endif
    for (int rep_ = 0; rep_ < PROBE_SCAN; ++rep_) {
#ifndef NO_SCAN
    if (c < 128) scan_phase(p, L, c);
#else
    if (c < 128) {}
#endif
    else for (int rep2_ = 0; rep2_ < PROBE_OTHER; ++rep2_) {
      __syncthreads();
      { FourSched S{(const char*)(lws(p.ws) + O_DFT), (const char*)(lws(p.ws) + O_FBT), c - 128}; EpiBf E{(bf16_t*)(lws(p.ws) + O_PPF) + 256, 512}; pg8::gemm_phase(L, S, E); }
      __syncthreads();
      ctx_fourier(p, L, c - 128, G - 128);
      pool_phase(p, L, c - 128, G - 128);
    }
    __syncthreads();
    }
    GSYNC();
#if defined(DUMP) && DUMP == 3
    dump_phase(p, 3); return;
#endif
#ifndef PROBE_OFP
#define PROBE_OFP 1
#endif
    for (int rep_ = 0; rep_ < PROBE_OFP; ++rep_) {
    ofprep_phase(p, l);
    norm_phase(X, Hn, ng + 1024, modl, 3, 4, nullptr);
    }
    GSYNC();
#if defined(DUMP) && DUMP == 4
    dump_phase(p, 4); return;
#endif
#ifndef PROBE_MRG
#define PROBE_MRG 1
#endif
    for (int rep_ = 0; rep_ < PROBE_MRG; ++rep_)
    { MergeSched S{(const char*)Hn, (const char*)(lws(p.ws) + O_OF), (const char*)(lws(p.ws) + O_PPF), (const char*)(lws(p.ws) + O_WG), (const char*)(lws(p.ws) + O_WCAT), G, c, RLAT / 256};
      EpiMerge E{(unsigned*)(lws(p.ws) + O_SCR) + (size_t)c * 2 * 32768, (bf16_t*)(lws(p.ws) + O_MRG)}; pg8::gemm_phase(L, S, E); }
    if (notlast) { MergeCtxSched S{(const char*)Hn, (const char*)(lws(p.ws) + O_OF), (const char*)(lws(p.ws) + O_PPF), (const char*)(lws(p.ws) + O_WG), (const char*)(lws(p.ws) + O_WCAT), c};
      EpiMergeCtx E{(unsigned*)(lws(p.ws) + O_SCR) + (size_t)c * 2 * 32768, (bf16_t*)(lws(p.ws) + O_PARTM)}; pg8::gemm_phase(L, S, E); }
    if (notlast && c >= 96) {
      int cur_ = 0; convert_ffn(p, p.w2gu + (size_t)l * 1024 * 2 * DFF, p.w2d + (size_t)l * DFF * 1024, O_WGU2, O_WD2, L, cur_, c - 96, G - 96);
      convert_ffn(p, p.w1gu + (size_t)(l + 1) * 1024 * 2 * DFF, p.w1d + (size_t)(l + 1) * DFF * 1024, O_WGU, O_WD, L, cur_, c - 96, G - 96);
      convert_win(p, l + 1, L, cur_, c - 96, G - 96); }
    GSYNC();
#if defined(DUMP) && DUMP == 5
    dump_phase(p, 5); return;
#endif
    { pg8::ResSched S{(const char*)(lws(p.ws) + O_MRG), (const char*)(lws(p.ws) + O_WOUT), 2048, 16, G, c, 0}; EpiResT<false> E{(float*)(p.ws + O_X), modl, 5, 1.0f}; pg8::gemm_phase(L, S, E); }
    if (notlast) { pg8::ResSched S{(const char*)(lws(p.ws) + O_PARTM) - (size_t)128 * 256 * 6144, (const char*)(lws(p.ws) + O_WOUT3), 6144, 48, G, c, 1}; EpiPart E{(float*)(lws(p.ws) + O_TT), modl, 5, 1.0f}; pg8::gemm_phase(L, S, E); }
    GSYNC();
#endif
    if (!notlast) { int cur_ = 0; convert_ffn(p, p.w2gu + (size_t)l * 1024 * 2 * DFF, p.w2d + (size_t)l * DFF * 1024, O_WGU2, O_WD2, L, cur_, c, G); }
    norm_phase(X, Hn, ng + 2048, modl, 6, 7, notlast ? (const float*)(lws(p.ws) + O_TT) : nullptr);
    GSYNC();
    { pg8::PlainSched S{(const char*)Hn, (const char*)(lws(p.ws) + O_WGU2), 2048, 2048, 16, nMx, 22, G, c}; EpiUp E{(bf16_t*)(lws(p.ws) + O_ACT)}; pg8::gemm_phase(L, S, E); }
    GSYNC();
    { pg8::ResSched S{(const char*)(lws(p.ws) + O_ACT), (const char*)(lws(p.ws) + O_WD2), DFF * 2, DFF / 64, G, c, 0}; EpiResT<false> E{(float*)(p.ws + O_X), modl, 8, 0.5f}; pg8::gemm_phase(L, S, E); }
    if (notlast) { pg8::ResSched S{(const char*)(lws(p.ws) + O_ACT), (const char*)(lws(p.ws) + O_WD2), DFF * 2, DFF / 64, G, c, 1}; EpiPart E{(float*)(lws(p.ws) + O_TT), modl, 8, 0.5f}; pg8::gemm_phase(L, S, E); }
    GSYNC();
  }
  final_norm(X, p.out, p.final_gain);
}

extern "C" void kernel_launch(void* const* d_in, const int* in_sizes, int n_in, void* d_out, int out_size, void* d_ws, size_t ws_size, hipStream_t stream) {
  (void)in_sizes; (void)n_in; (void)out_size;
  if (ws_size < WS_NEED) { fprintf(stderr, "workspace too small: %zu < %zu\n", ws_size, (size_t)WS_NEED); return; }
  static int grid_blocks = 0;
  if (!grid_blocks) {
    (void)hipFuncSetAttribute((const void*)fwd_megakernel, hipFuncAttributeMaxDynamicSharedMemorySize, LDS_BYTES);
    int dev = 0, cus = 0, per_cu = 0; (void)hipGetDevice(&dev); (void)hipDeviceGetAttribute(&cus, hipDeviceAttributeMultiprocessorCount, dev);
    (void)hipOccupancyMaxActiveBlocksPerMultiprocessor(&per_cu, fwd_megakernel, NTHR, LDS_BYTES);
    grid_blocks = cus * (per_cu > 0 ? 1 : 0);
    if (grid_blocks != 256) fprintf(stderr, "unexpected grid %d (cus %d per_cu %d)\n", grid_blocks, cus, per_cu);
  }
  Params p{};
  const float** f = (const float**)&p;
  for (int i = 0; i < 22; ++i) f[i] = (const float*)d_in[i];
  p.out = (float*)d_out; p.ws = (unsigned char*)d_ws;
  (void)hipMemsetAsync((unsigned char*)d_ws + O_BAR, 0, 16384, stream);
  void* args[] = {&p};
  hipError_t e = hipLaunchCooperativeKernel((void*)fwd_megakernel, dim3(grid_blocks), dim3(NTHR), args, LDS_BYTES, stream);
  if (e != hipSuccess) fprintf(stderr, "cooperative launch failed: %s (grid %d)\n", hipGetErrorString(e), grid_blocks);
}
```

```cpp
#include <hip/hip_runtime.h>
#include <hip/hip_cooperative_groups.h>
#include <cstdio>

namespace cg = cooperative_groups;

#define LAS __attribute__((address_space(3)))
typedef LAS unsigned char* ldsp;
typedef unsigned short bf16_t;
typedef short bf16x8 __attribute__((ext_vector_type(8)));
typedef float f32x4 __attribute__((ext_vector_type(4)));
typedef unsigned u32x4 __attribute__((ext_vector_type(4)));
typedef unsigned u32x2 __attribute__((ext_vector_type(2)));

constexpr int DM = 1024, NB = 8, SEQ = 4096, CTX = 256, DEPTH = 4;
constexpr int RLAT = NB * SEQ, ROWS = RLAT + NB * CTX;
constexpr int DFF = 2816, NMOD = 9, DPROJ = 5648;
constexpr int NCH = ROWS / 64;
constexpr int NINP = 2816;
constexpr int LDS_BYTES = 163840;
constexpr int NTHR = 512;

constexpr size_t al256(size_t x) { return (x + 255) & ~(size_t)255; }
constexpr size_t O_X = 0;
constexpr size_t O_MOD = O_X + (size_t)ROWS * DM * 4;
constexpr size_t O_DFT = al256(O_MOD + (size_t)DEPTH * 9 * 9216 * 4);
constexpr size_t O_WGU = O_DFT + (size_t)4096 * 4096 * 2;
constexpr size_t O_WD = O_WGU + (size_t)5632 * 1024 * 2;
constexpr size_t O_WIN = O_WD + (size_t)1024 * 2816 * 2;
constexpr size_t O_WG = O_WIN + (size_t)NINP * 1024 * 2;
constexpr size_t O_WCAT = O_WG + (size_t)3072 * 1024 * 2;
constexpr size_t O_WOUT = O_WCAT + (size_t)1024 * 1024 * 2;
constexpr size_t O_R = O_WOUT + (size_t)1024 * 1024 * 2;
constexpr size_t SZ_H = (size_t)ROWS * 1024 * 2;
constexpr size_t SZ_Q = (size_t)ROWS * 512 * 2;
constexpr size_t O_HN = O_R;
constexpr size_t O_ACT = O_R + SZ_H;
constexpr size_t O_QN = O_R;
constexpr size_t O_KN = O_R + SZ_Q;
constexpr size_t O_QKV = O_R + SZ_H;
constexpr size_t O_O = O_QKV;
constexpr size_t O_SCR = O_QKV;
constexpr size_t O_Z = O_QKV + (size_t)ROWS * 1536 * 2;
constexpr size_t O_PI = O_Z + SZ_Q;
constexpr size_t O_FI = O_PI + (size_t)ROWS * 256 * 2;
constexpr size_t O_AB = O_FI + (size_t)ROWS * 256 * 2;
constexpr size_t O_KNT = al256(O_AB + (size_t)ROWS * 16 * 4);
constexpr size_t O_VNT = O_KNT + SZ_Q;
constexpr size_t O_MRG = O_KNT;
constexpr size_t O_TT = O_VNT + SZ_Q;
constexpr size_t O_OF = O_TT;
constexpr size_t O_GC = O_TT + SZ_H;
constexpr size_t O_FBT = al256(O_GC + (size_t)NCH * 4 * 2 * 64 * 4);
constexpr size_t O_UCS = O_FBT + (size_t)NB * 256 * 4096 * 2;
constexpr size_t O_PPF = al256(O_UCS + (size_t)NB * CTX * 512 * 4);
constexpr size_t O_WGU2 = al256(O_PPF + SZ_Q);
constexpr size_t O_WD2 = O_WGU2 + (size_t)5632 * 1024 * 2;
constexpr size_t O_WOUT3 = al256(O_WD2 + (size_t)1024 * 2816 * 2);
constexpr size_t O_BAR = al256(O_WOUT3 + (size_t)1024 * 3072 * 2);
constexpr size_t O_PARTM = O_Z;
constexpr size_t WS_NEED = O_BAR + 16384;
static_assert(O_SCR + (size_t)256 * 2 * 262144 <= O_PI, "merge scratch overlaps");

struct Params {
  const float *x, *c, *ctx, *c_ctx, *w_ada, *b_ada, *norm_gain, *w1gu, *w1d, *w2gu, *w2d, *w_in, *conv_w, *a_log, *dt_bias, *o_gain, *w_a, *w_b,
      *pool_scale, *w_c, *w_out, *final_gain;
  float* out;
  unsigned char* ws;
};

typedef float f32x2_ __attribute__((ext_vector_type(2)));
typedef __bf16 bf16x2_ __attribute__((ext_vector_type(2)));
__device__ __forceinline__ unsigned cvt_pk_bf16(float lo, float hi) { const f32x2_ v = {lo, hi}; const bf16x2_ b = __builtin_convertvector(v, bf16x2_); return __builtin_bit_cast(unsigned, b); }
__device__ __forceinline__ float bflo(unsigned w) { return __uint_as_float(w << 16); }
__device__ __forceinline__ float bfhi(unsigned w) { return __uint_as_float(w & 0xffff0000u); }
__device__ __forceinline__ float sigmoidf_(float x) { return __builtin_amdgcn_rcpf(1.0f + __expf(-x)); }
__device__ __forceinline__ float siluf_(float x) { return x * __builtin_amdgcn_rcpf(1.0f + __expf(-x)); }
template <class T> __device__ __forceinline__ T ldsld(ldsp b, int off) { return *(const LAS T*)(b + off); }
template <class T> __device__ __forceinline__ void ldsst(ldsp b, int off, T v) { *(LAS T*)(b + off) = v; }
__device__ __forceinline__ f32x4 mma(bf16x8 a, bf16x8 b, f32x4 c) { return __builtin_amdgcn_mfma_f32_16x16x32_bf16(a, b, c, 0, 0, 0); }
__device__ __forceinline__ u32x2 pack4(f32x4 v) { u32x2 r; r.x = cvt_pk_bf16(v[0], v[1]); r.y = cvt_pk_bf16(v[2], v[3]); return r; }
__device__ __forceinline__ int otid() { int t = threadIdx.x; asm volatile("" : "+v"(t)); return t; }
extern __shared__ __attribute__((aligned(16))) unsigned char g_shm[];
__device__ __forceinline__ unsigned char* lws(unsigned char*) { ldsp Lb = (ldsp)g_shm; unsigned lo = *(volatile LAS unsigned*)(Lb + LDS_BYTES - 32), hi = *(volatile LAS unsigned*)(Lb + LDS_BYTES - 28);
  lo = __builtin_amdgcn_readfirstlane(lo); hi = __builtin_amdgcn_readfirstlane(hi); return (unsigned char*)(((unsigned long long)hi << 32) | (unsigned long long)lo); }
__device__ __forceinline__ void atomic_add_f32(float* q, float v) { asm volatile("global_atomic_add_f32 %0, %1, off sc1" : : "v"(q), "v"(v) : "memory"); }
__device__ __forceinline__ int modidx(int pm) { return pm < 128 ? (pm >> 4) : 8; }

namespace pg8 {
constexpr int BM = 256, BK = 64, HALF = 128, HTB = HALF * BK * 2, NXCD = 8, WGM = 8;
__device__ __forceinline__ int lds_byte(int r, int c) { const int st = (r >> 4) * 2 + (c >> 5), rr = r & 15, cc = c & 31, ob = rr * 64 + cc * 2; return st * 1024 + (ob ^ (((ob >> 9) & 1) << 5)); }
__device__ __forceinline__ void stage_rc(int b, int& R, int& C) { const int st = b / 1024, sb = b % 1024, swz = sb ^ (((sb >> 9) & 1) << 5); R = (st >> 1) * 16 + swz / 64; C = (st & 1) * 32 + (swz % 64) / 2; }
__device__ __forceinline__ int perm32(int rho) { const int n = rho >> 4, i = rho & 15; return 8 * (i >> 2) + 4 * n + (i & 3); }

struct Unit { const char* A; const char* B; int lda, ldb, nt, pm, pn, seg; };

__device__ __forceinline__ bool tile_of(int nM, int nN, int G, int c, int i, int& pm, int& pn) {
  const int nwg = nM * nN; const long Lq = (long)i * G + c; if (Lq >= nwg) return false;
  int wgid = (int)Lq; { const int q = nwg / NXCD, r = nwg % NXCD, xcd = wgid % NXCD, off = wgid / NXCD; wgid = (xcd < r ? xcd * (q + 1) : r * (q + 1) + (xcd - r) * q) + off; }
  const int nig = WGM * nN, gid = wgid / nig, fm = gid * WGM, gsz = (nM - fm) < WGM ? (nM - fm) : WGM;
  pm = fm + ((wgid % nig) % gsz); pn = (wgid % nig) / gsz; return true;
}
struct PlainSched {
  static constexpr bool VARLDA = false;
  const char* A; const char* B; int lda, ldb, nt, nM, nN, G, c;
  __device__ __forceinline__ bool next(int i, Unit& u) const {
    int pm, pn; if (!tile_of(nM, nN, G, c, i, pm, pn)) return false;
    u.A = A + (size_t)pm * 256 * lda; u.B = B + (size_t)pn * 256 * ldb; u.lda = lda; u.ldb = ldb; u.nt = nt; u.pm = pm; u.pn = pn; u.seg = 0; return true;
  }
};

struct ResSched {
  static constexpr bool VARLDA = false;
  const char* A; const char* B; int ld, nt, G, c, mode;
  __device__ __forceinline__ bool next(int i, Unit& u) const {
    u.lda = ld; u.ldb = ld;
    if (mode == 0) { int pm, pn; if (i >= 2 || !tile_of(128, 4, G, c, i, pm, pn)) return false;
      u.A = A + (size_t)pm * 256 * ld; u.B = B + (size_t)pn * 256 * ld; u.nt = nt; u.pm = pm; u.pn = pn; u.seg = 0; return true; }
#ifdef NO_SPLITK
    if (i > 0 || c >= 32) return false;
    { const int pm = 128 + (c >> 2), pn = c & 3; u.A = A + (size_t)pm * 256 * ld; u.B = B + (size_t)pn * 256 * ld; u.nt = nt; u.pm = pm; u.pn = pn; u.seg = 0; return true; }
#endif
    if (i > 0 || c >= 256) return false;
    const int pm = 128 + (c >> 5), pn = (c >> 3) & 3, kp = c & 7;
    const int base = (nt / 16) * 2, extra = (nt - base * 8) / 2;
    const int k0 = kp * base + 2 * (kp < extra ? kp : extra), np = base + (kp < extra ? 2 : 0);
    u.A = A + (size_t)pm * 256 * ld + (size_t)k0 * 128; u.B = B + (size_t)pn * 256 * ld + (size_t)k0 * 128; u.nt = np; u.pm = pm; u.pn = pn; u.seg = kp; return true;
  }
};
template <class Epi, class Sched>
__device__ __forceinline__ void gemm_phase(ldsp lds, const Sched& S, const Epi& E) {
  const int tid = otid(), wid = __builtin_amdgcn_readfirstlane(tid >> 6), lane = tid & 63, wr = wid >> 2, wc = wid & 3, fr = lane & 15, fq = lane >> 4;
  unsigned rA[2], rB[2], c2[2];
#pragma unroll
  for (int i = 0; i < 2; ++i) { int R, C; stage_rc(tid * 16 + i * 8192, R, C); rA[i] = (unsigned)R; rB[i] = (unsigned)(Epi::PERM ? ((R & ~31) + perm32(R & 31)) : R); c2[i] = (unsigned)C * 2u; }
  const size_t kstep = (size_t)(BK * 2);
  const unsigned ldsw = (unsigned)wid * 1024u;
  const int aoff = lds_byte(wr * 64 + fr, fq * 8), boff = lds_byte(wc * 32 + fr, fq * 8);
#define PG8_SA(b, h) (((b) * 2 + (h)) * HTB)
#define PG8_SB(b, h) ((4 + (b) * 2 + (h)) * HTB)
#define PG8_STAGE(bufoff, gbase, voff) do { _Pragma("unroll") for (int _i = 0; _i < 2; ++_i) \
    __builtin_amdgcn_global_load_lds((const unsigned*)((const char*)(gbase) + (voff)[_i]), (LAS unsigned*)(lds + (bufoff) + ldsw + _i * 8192), 16, 0, 0); } while (0)
#define PG8_LDA(dst, b, h) do { _Pragma("unroll") for (int m = 0; m < 4; ++m) _Pragma("unroll") for (int k = 0; k < 2; ++k) dst[m][k] = *(const LAS bf16x8*)(lds + PG8_SA(b, h) + aoff + m * 2048 + k * 1024); } while (0)
#define PG8_LDB(dst, b, h) do { _Pragma("unroll") for (int n = 0; n < 2; ++n) _Pragma("unroll") for (int k = 0; k < 2; ++k) dst[n][k] = *(const LAS bf16x8*)(lds + PG8_SB(b, h) + boff + n * 2048 + k * 1024); } while (0)
#define PG8_MMA(ai, bj, At, Bt) do { __builtin_amdgcn_s_setprio(1); _Pragma("unroll") for (int m = 0; m < 4; ++m) _Pragma("unroll") for (int n = 0; n < 2; ++n) _Pragma("unroll") for (int k = 0; k < 2; ++k) \
    acc[ai][bj][m][n] = __builtin_amdgcn_mfma_f32_16x16x32_bf16(Bt[n][k], At[m][k], acc[ai][bj][m][n], 0, 0, 0); __builtin_amdgcn_s_setprio(0); } while (0)
#define PG8_WAIT_V(n) asm volatile("s_waitcnt vmcnt(" #n ")" ::: "memory")
#define PG8_WAIT_L(n) asm volatile("s_waitcnt lgkmcnt(" #n ")" ::: "memory")
#define PG8_BAR __builtin_amdgcn_s_barrier()
#define PG8_SCHED __builtin_amdgcn_sched_barrier(0)
  Unit cur, nxt; int ui = 0;
  if (!S.next(0, cur)) return;
  float zz_; asm volatile("v_mov_b32 %0, 0" : "=v"(zz_));
  f32x4 acc[2][2][4][2];
#pragma unroll
  for (int a = 0; a < 2; ++a)
#pragma unroll
    for (int b = 0; b < 2; ++b)
#pragma unroll
      for (int m = 0; m < 4; ++m)
#pragma unroll
        for (int n = 0; n < 2; ++n) acc[a][b][m][n] = (f32x4){zz_, zz_, zz_, zz_};
  bf16x8 At[4][2], B0[2][2], B1[2][2];
  const char* cA = cur.A; const char* cB = cur.B; int ldA = cur.lda; const int ldB = cur.ldb;
  unsigned voffA[2], voffB[2];
#pragma unroll
  for (int i = 0; i < 2; ++i) { voffA[i] = rA[i] * (unsigned)ldA + c2[i]; voffB[i] = rB[i] * (unsigned)ldB + c2[i]; }
  const size_t hB = (size_t)HALF * ldB;
  {
    const size_t hA = (size_t)HALF * ldA;
    PG8_STAGE(PG8_SB(0, 0), cB, voffB); PG8_STAGE(PG8_SA(0, 0), cA, voffA); PG8_STAGE(PG8_SB(0, 1), cB + hB, voffB); PG8_STAGE(PG8_SA(0, 1), cA + hA, voffA);
    if (wr == 1) PG8_BAR;
    PG8_WAIT_V(4); PG8_BAR;
    PG8_STAGE(PG8_SB(1, 0), cB + kstep, voffB); PG8_STAGE(PG8_SA(1, 0), cA + kstep, voffA); PG8_STAGE(PG8_SB(1, 1), cB + hB + kstep, voffB);
    PG8_WAIT_V(6); PG8_BAR;
  }
  for (;;) {
    const bool has_next = S.next(ui + 1, nxt);
    const char* nA = has_next ? nxt.A : cA; const char* nB = has_next ? nxt.B : cB;
    const int nldA = has_next ? nxt.lda : ldA;
    const int nt = cur.nt;
    const size_t hA = (size_t)HALF * ldA;
    for (int t = 0; t < nt; t += 2) {
      const bool last = (t == nt - 2);
      const char* a1 = cA + (size_t)(t + 1) * kstep;
      const char* a2 = last ? nA : cA + (size_t)(t + 2) * kstep; const char* b2 = last ? nB : cB + (size_t)(t + 2) * kstep;
      const size_t h2A = (size_t)HALF * (last ? nldA : ldA);
      const char* a3 = a2 + kstep; const char* b3 = b2 + kstep;
      PG8_LDB(B0, 0, 0); PG8_SCHED; PG8_LDA(At, 0, 0); PG8_STAGE(PG8_SA(1, 1), a1 + hA, voffA);
      if (Sched::VARLDA) { if (last) {
#pragma unroll
        for (int i = 0; i < 2; ++i) voffA[i] = rA[i] * (unsigned)nldA + c2[i]; } }
      PG8_WAIT_L(8); PG8_BAR; PG8_WAIT_L(0); PG8_MMA(0, 0, At, B0); PG8_BAR; PG8_SCHED;
      PG8_LDB(B1, 0, 1); PG8_STAGE(PG8_SB(0, 0), b2, voffB);
      PG8_BAR; PG8_WAIT_L(0); PG8_MMA(0, 1, At, B1); PG8_BAR;
      PG8_LDA(At, 0, 1); PG8_STAGE(PG8_SA(0, 0), a2, voffA);
      PG8_BAR; PG8_WAIT_L(0); PG8_MMA(1, 0, At, B0); PG8_BAR; PG8_SCHED;
      PG8_STAGE(PG8_SB(0, 1), b2 + hB, voffB);
      PG8_WAIT_V(6); PG8_BAR; PG8_MMA(1, 1, At, B1); PG8_BAR;
      PG8_LDB(B0, 1, 0); PG8_SCHED; PG8_LDA(At, 1, 0); PG8_STAGE(PG8_SA(0, 1), a2 + h2A, voffA);
      PG8_WAIT_L(8); PG8_BAR; PG8_WAIT_L(0); PG8_MMA(0, 0, At, B0); PG8_BAR; PG8_SCHED;
      PG8_LDB(B1, 1, 1); PG8_STAGE(PG8_SB(1, 0), b3, voffB);
      PG8_BAR; PG8_WAIT_L(0); PG8_MMA(0, 1, At, B1); PG8_BAR;
      PG8_LDA(At, 1, 1); PG8_STAGE(PG8_SA(1, 0), a3, voffA);
      PG8_BAR; PG8_WAIT_L(0); PG8_MMA(1, 0, At, B0); PG8_BAR; PG8_SCHED;
      PG8_STAGE(PG8_SB(1, 1), b3 + hB, voffB);
      PG8_WAIT_V(6); PG8_BAR; PG8_MMA(1, 1, At, B1); PG8_BAR;
    }
    E(acc, cur, wr, wc, fr, fq);
    if (!has_next) break;
#pragma unroll
    for (int a = 0; a < 2; ++a)
#pragma unroll
      for (int b = 0; b < 2; ++b)
#pragma unroll
        for (int m = 0; m < 4; ++m)
#pragma unroll
          for (int n = 0; n < 2; ++n) acc[a][b][m][n] = (f32x4){zz_, zz_, zz_, zz_};
    cur = nxt; cA = nA; cB = nB; ldA = nldA; ++ui;
  }
  PG8_WAIT_V(0);
  if (wr == 0) PG8_BAR;
  PG8_BAR;
#undef PG8_SA
#undef PG8_SB
#undef PG8_STAGE
#undef PG8_LDA
#undef PG8_LDB
#undef PG8_MMA
#undef PG8_WAIT_V
#undef PG8_WAIT_L
#undef PG8_BAR
#undef PG8_SCHED
}
}
using pg8::Unit;
typedef f32x4 AccT[2][2][4][2];

struct EpiUp {
  static constexpr bool PERM = true;
  bf16_t* act;
  __device__ __forceinline__ void operator()(const AccT& acc, const Unit& u, int wr, int wc, int fr, int fq) const {
    const int row0 = u.pm * 256 + wr * 64 + fr, col0 = u.pn * 128 + wc * 32 + 8 * fq;
#pragma unroll
    for (int ai = 0; ai < 2; ++ai)
#pragma unroll
      for (int m = 0; m < 4; ++m) {
        const f32x4 a0 = acc[ai][0][m][0], a1 = acc[ai][0][m][1], u0 = acc[ai][1][m][0], u1 = acc[ai][1][m][1];
        u32x4 w;
        w.x = cvt_pk_bf16(siluf_(a0[0]) * u0[0], siluf_(a0[1]) * u0[1]); w.y = cvt_pk_bf16(siluf_(a0[2]) * u0[2], siluf_(a0[3]) * u0[3]);
        w.z = cvt_pk_bf16(siluf_(a1[0]) * u1[0], siluf_(a1[1]) * u1[1]); w.w = cvt_pk_bf16(siluf_(a1[2]) * u1[2], siluf_(a1[3]) * u1[3]);
        *(u32x4*)(act + (size_t)(row0 + ai * 128 + m * 16) * DFF + col0) = w;
      }
  }
};
template <bool ATOMIC> struct EpiResT {
  static constexpr bool PERM = false;
  float* X; const float* modl; int gidx; float scale;
  __device__ __forceinline__ void operator()(const AccT& acc, const Unit& u, int wr, int wc, int fr, int fq) const {
    const int row0 = u.pm * 256 + wr * 64 + fr, col0 = u.pn * 256 + wc * 32 + 4 * fq;
    const float* g = modl + (size_t)(modidx(u.pm) * 9 + gidx) * 1024 + col0;
    f32x4 gv[2][2];
#pragma unroll
    for (int bj = 0; bj < 2; ++bj)
#pragma unroll
      for (int n = 0; n < 2; ++n) gv[bj][n] = *(const f32x4*)(g + bj * 128 + n * 16) * scale;
#pragma unroll
    for (int ai = 0; ai < 2; ++ai)
#pragma unroll
      for (int mh = 0; mh < 2; ++mh) {
        f32x4 xv[2][2][2];
#pragma unroll
        for (int m2 = 0; m2 < 2; ++m2)
#pragma unroll
          for (int bj = 0; bj < 2; ++bj)
#pragma unroll
            for (int n = 0; n < 2; ++n) xv[m2][bj][n] = *(const f32x4*)(X + (size_t)(row0 + ai * 128 + (mh * 2 + m2) * 16) * DM + col0 + bj * 128 + n * 16);
        asm volatile("" ::: "memory");
#pragma unroll
        for (int m2 = 0; m2 < 2; ++m2)
#pragma unroll
          for (int bj = 0; bj < 2; ++bj)
#pragma unroll
            for (int n = 0; n < 2; ++n) *(f32x4*)(X + (size_t)(row0 + ai * 128 + (mh * 2 + m2) * 16) * DM + col0 + bj * 128 + n * 16) = xv[m2][bj][n] + gv[bj][n] * acc[ai][bj][mh * 2 + m2][n];
        asm volatile("" ::: "memory");
      }
  }
};
struct EpiPart {
  static constexpr bool PERM = false;
  float* part; const float* modl; int gidx; float scale;
  __device__ __forceinline__ void operator()(const AccT& acc, const Unit& u, int wr, int wc, int fr, int fq) const {
    const int row0 = (u.pm - 128) * 256 + wr * 64 + fr, col0 = u.pn * 256 + wc * 32 + 4 * fq;
    const float* g = modl + (size_t)(8 * 9 + gidx) * 1024 + col0;
    float* pb = part + (size_t)u.seg * 2048 * 1024;
    f32x4 gv[2][2];
#pragma unroll
    for (int bj = 0; bj < 2; ++bj)
#pragma unroll
      for (int n = 0; n < 2; ++n) gv[bj][n] = *(const f32x4*)(g + bj * 128 + n * 16) * scale;
#pragma unroll
    for (int ai = 0; ai < 2; ++ai)
#pragma unroll
      for (int m = 0; m < 4; ++m) {
        float* rowp = pb + (size_t)(row0 + ai * 128 + m * 16) * DM + col0;
#pragma unroll
        for (int bj = 0; bj < 2; ++bj)
#pragma unroll
          for (int n = 0; n < 2; ++n) *(f32x4*)(rowp + bj * 128 + n * 16) = gv[bj][n] * acc[ai][bj][m][n];
      }
  }
};
struct EpiIn {
  static constexpr bool PERM = true;
  bf16_t *qkv, *z, *pi, *fi; float* ab;
  __device__ __forceinline__ void operator()(const AccT& acc, const Unit& u, int wr, int wc, int fr, int fq) const {
    const int row0 = u.pm * 256 + wr * 64 + fr;
    if (u.pn == 10) {
      if (wc == 0 && fq < 2) {
#pragma unroll
        for (int ai = 0; ai < 2; ++ai)
#pragma unroll
          for (int m = 0; m < 4; ++m) {
            float* rp = ab + (size_t)(row0 + ai * 128 + m * 16) * 16 + 8 * fq;
            *(f32x4*)(rp) = acc[ai][0][m][0]; *(f32x4*)(rp + 4) = acc[ai][0][m][1];
          }
      }
      return;
    }
    bf16_t* base; int ld, ct;
    if (u.pn < 6) { base = qkv; ld = 1536; ct = u.pn * 256; } else if (u.pn < 8) { base = z; ld = 512; ct = (u.pn - 6) * 256; } else if (u.pn == 8) { base = pi; ld = 256; ct = 0; } else { base = fi; ld = 256; ct = 0; }
    const int col0 = ct + wc * 32 + 8 * fq;
#pragma unroll
    for (int ai = 0; ai < 2; ++ai)
#pragma unroll
      for (int m = 0; m < 4; ++m) {
        bf16_t* rowp = base + (size_t)(row0 + ai * 128 + m * 16) * ld + col0;
#pragma unroll
        for (int bj = 0; bj < 2; ++bj) { const f32x4 v0 = acc[ai][bj][m][0], v1 = acc[ai][bj][m][1]; u32x4 w; w.x = cvt_pk_bf16(v0[0], v0[1]); w.y = cvt_pk_bf16(v0[2], v0[3]); w.z = cvt_pk_bf16(v1[0], v1[1]); w.w = cvt_pk_bf16(v1[2], v1[3]);
          *(u32x4*)(rowp + bj * 128) = w; }
      }
  }
};
struct EpiBf {
  static constexpr bool PERM = true;
  bf16_t* O; int ld;
  __device__ __forceinline__ void operator()(const AccT& acc, const Unit& u, int wr, int wc, int fr, int fq) const {
    const int row0 = u.pm * 256 + wr * 64 + fr, col0 = u.pn * 256 + wc * 32 + 8 * fq;
#pragma unroll
    for (int ai = 0; ai < 2; ++ai)
#pragma unroll
      for (int m = 0; m < 4; ++m) {
        bf16_t* rowp = O + (size_t)(row0 + ai * 128 + m * 16) * ld + col0;
#pragma unroll
        for (int bj = 0; bj < 2; ++bj) { const f32x4 v0 = acc[ai][bj][m][0], v1 = acc[ai][bj][m][1]; u32x4 w; w.x = cvt_pk_bf16(v0[0], v0[1]); w.y = cvt_pk_bf16(v0[2], v0[3]); w.z = cvt_pk_bf16(v1[0], v1[1]); w.w = cvt_pk_bf16(v1[2], v1[3]);
          *(u32x4*)(rowp + bj * 128) = w; }
      }
  }
};
struct EpiMerge {
  static constexpr bool PERM = true;
  unsigned* scr;
  bf16_t* mrg;
  __device__ __forceinline__ void operator()(const AccT& acc, const Unit& u, int wr, int wc, int fr, int fq) const {
    const int tid_ = otid(); u32x4* S1 = (u32x4*)scr + tid_; u32x4* Mx = (u32x4*)scr + 16 * 512 + tid_;
    const int seg = u.seg;
    if ((seg & 1) == 0) {
#pragma unroll
      for (int ai = 0; ai < 2; ++ai)
#pragma unroll
        for (int bj = 0; bj < 2; ++bj)
#pragma unroll
          for (int m = 0; m < 4; ++m) { const f32x4 v0 = acc[ai][bj][m][0], v1 = acc[ai][bj][m][1]; u32x4 w;
            w.x = cvt_pk_bf16(sigmoidf_(v0[0]), sigmoidf_(v0[1])); w.y = cvt_pk_bf16(sigmoidf_(v0[2]), sigmoidf_(v0[3])); w.z = cvt_pk_bf16(sigmoidf_(v1[0]), sigmoidf_(v1[1])); w.w = cvt_pk_bf16(sigmoidf_(v1[2]), sigmoidf_(v1[3]));
            S1[((ai * 2 + bj) * 4 + m) * 512] = w; }
    } else {
      const int row0 = u.pm * 256 + wr * 64 + fr, col0 = u.pn * 256 + wc * 32 + 8 * fq;
#pragma unroll
      for (int ai = 0; ai < 2; ++ai)
#pragma unroll
        for (int bj = 0; bj < 2; ++bj) {
          u32x4 gq[4], mq[4];
#pragma unroll
          for (int m = 0; m < 4; ++m) { const int ix = ((ai * 2 + bj) * 4 + m) * 512; gq[m] = S1[ix]; mq[m] = (seg >= 3) ? Mx[ix] : (u32x4){0u, 0u, 0u, 0u}; }
          asm volatile("" ::: "memory");
#pragma unroll
          for (int m = 0; m < 4; ++m) {
            const int ix = ((ai * 2 + bj) * 4 + m) * 512; const u32x4 g = gq[m], q = mq[m]; const f32x4 v0 = acc[ai][bj][m][0], v1 = acc[ai][bj][m][1];
            float t[8] = {bflo(g.x) * v0[0], bfhi(g.x) * v0[1], bflo(g.y) * v0[2], bfhi(g.y) * v0[3], bflo(g.z) * v1[0], bfhi(g.z) * v1[1], bflo(g.w) * v1[2], bfhi(g.w) * v1[3]};
            t[0] += bflo(q.x); t[1] += bfhi(q.x); t[2] += bflo(q.y); t[3] += bfhi(q.y); t[4] += bflo(q.z); t[5] += bfhi(q.z); t[6] += bflo(q.w); t[7] += bfhi(q.w);
            u32x4 w; w.x = cvt_pk_bf16(t[0], t[1]); w.y = cvt_pk_bf16(t[2], t[3]); w.z = cvt_pk_bf16(t[4], t[5]); w.w = cvt_pk_bf16(t[6], t[7]);
            if (seg < 5) Mx[ix] = w; else *(u32x4*)(mrg + (size_t)(row0 + ai * 128 + m * 16) * DM + col0 + bj * 128) = w;
          }
          asm volatile("" ::: "memory");
        }
    }
  }
};
struct MergeSched {
  static constexpr bool VARLDA = true;
  const char *hn, *of, *ppf, *wg, *wcat; int G, c, nM;
  __device__ __forceinline__ bool next(int i, Unit& u) const {
    const int round = i / 6, seg = i - round * 6; int pm, pn; if (!pg8::tile_of(nM, 4, G, c, round, pm, pn)) return false;
    const int br = seg >> 1;
    u.pm = pm; u.pn = pn; u.seg = seg; u.ldb = 2048;
    if ((seg & 1) == 0) { u.A = hn + (size_t)pm * 256 * 2048; u.lda = 2048; u.B = wg + (size_t)(br * 1024 + pn * 256) * 2048; u.nt = 16; }
    else {
      u.lda = 1024;
      if (br == 0) { u.A = of + (size_t)pm * 256 * 1024; u.B = wcat + (size_t)pn * 256 * 2048; u.nt = 8; }
      else if (br == 1) { u.A = ppf + (size_t)pm * 256 * 1024; u.B = wcat + (size_t)pn * 256 * 2048 + 512 * 2; u.nt = 4; }
      else { u.A = ppf + (size_t)pm * 256 * 1024 + 256 * 2; u.B = wcat + (size_t)pn * 256 * 2048 + 768 * 2; u.nt = 4; }
    }
    return true;
  }
};
struct MergeCtxSched {
  static constexpr bool VARLDA = true;
  const char *hn, *of, *ppf, *wg, *wcat; int c;
  __device__ __forceinline__ bool next(int i, Unit& u) const {
    if (i > 1 || c >= 96) return false;
    const int tile = c / 3, br = c - tile * 3, pm = 128 + (tile >> 2), pn = tile & 3;
    u.pm = pm; u.pn = pn; u.seg = br * 2 + i; u.ldb = 2048;
    if (i == 0) { u.A = hn + (size_t)pm * 256 * 2048; u.lda = 2048; u.B = wg + (size_t)(br * 1024 + pn * 256) * 2048; u.nt = 16; }
    else { u.lda = 1024;
      if (br == 0) { u.A = of + (size_t)pm * 256 * 1024; u.B = wcat + (size_t)pn * 256 * 2048; u.nt = 8; }
      else if (br == 1) { u.A = ppf + (size_t)pm * 256 * 1024; u.B = wcat + (size_t)pn * 256 * 2048 + 512 * 2; u.nt = 4; }
      else { u.A = ppf + (size_t)pm * 256 * 1024 + 256 * 2; u.B = wcat + (size_t)pn * 256 * 2048 + 768 * 2; u.nt = 4; } }
    return true;
  }
};
struct EpiMergeCtx {
  static constexpr bool PERM = true;
  unsigned* scr; bf16_t* partm;
  __device__ __forceinline__ void operator()(const AccT& acc, const Unit& u, int wr, int wc, int fr, int fq) const {
    const int tid_ = otid(); u32x4* S1 = (u32x4*)scr + tid_;
    if ((u.seg & 1) == 0) {
#pragma unroll
      for (int ai = 0; ai < 2; ++ai)
#pragma unroll
        for (int bj = 0; bj < 2; ++bj)
#pragma unroll
          for (int m = 0; m < 4; ++m) { const f32x4 v0 = acc[ai][bj][m][0], v1 = acc[ai][bj][m][1]; u32x4 w;
            w.x = cvt_pk_bf16(sigmoidf_(v0[0]), sigmoidf_(v0[1])); w.y = cvt_pk_bf16(sigmoidf_(v0[2]), sigmoidf_(v0[3])); w.z = cvt_pk_bf16(sigmoidf_(v1[0]), sigmoidf_(v1[1])); w.w = cvt_pk_bf16(sigmoidf_(v1[2]), sigmoidf_(v1[3]));
            S1[((ai * 2 + bj) * 4 + m) * 512] = w; }
    } else {
      const int br = u.seg >> 1, row0 = (u.pm - 128) * 256 + wr * 64 + fr, col0 = br * 1024 + u.pn * 256 + wc * 32 + 8 * fq;
#pragma unroll
      for (int ai = 0; ai < 2; ++ai) {
        u32x4 gq[2][4];
#pragma unroll
        for (int bj = 0; bj < 2; ++bj)
#pragma unroll
          for (int m = 0; m < 4; ++m) gq[bj][m] = S1[((ai * 2 + bj) * 4 + m) * 512];
        asm volatile("" ::: "memory");
#pragma unroll
        for (int m = 0; m < 4; ++m)
#pragma unroll
          for (int bj = 0; bj < 2; ++bj) {
            const u32x4 g = gq[bj][m]; const f32x4 v0 = acc[ai][bj][m][0], v1 = acc[ai][bj][m][1];
            u32x4 w; w.x = cvt_pk_bf16(bflo(g.x) * v0[0], bfhi(g.x) * v0[1]); w.y = cvt_pk_bf16(bflo(g.y) * v0[2], bfhi(g.y) * v0[3]); w.z = cvt_pk_bf16(bflo(g.z) * v1[0], bfhi(g.z) * v1[1]); w.w = cvt_pk_bf16(bflo(g.w) * v1[2], bfhi(g.w) * v1[3]);
            *(u32x4*)(partm + (size_t)(row0 + ai * 128 + m * 16) * 3072 + col0 + bj * 128) = w;
          }
      }
    }
  }
};
struct FourSched {
  static constexpr bool VARLDA = false;
  const char *dft, *fbt; int c;
  __device__ __forceinline__ bool next(int i, Unit& u) const {
    if (i > 0) return false;
    const int b = c >> 4, pm = c & 15;
    u.A = dft + (size_t)pm * 256 * 8192; u.B = fbt + (size_t)b * 256 * 8192; u.lda = 8192; u.ldb = 8192; u.nt = 64; u.pm = b * 16 + pm; u.pn = 0; u.seg = 0; return true;
  }
};

template <class F>
__device__ __forceinline__ void convT(const float* W, int ldw, int K, int nrows, bf16_t* dst, int ldd, int k0d, F srccol, ldsp L, int& cursor, int wg, int G) {
  const int tid = otid(), ntk = K >> 6, ntiles = (nrows >> 6) * ntk;
  int t0 = (wg - cursor % G + G) % G;
  for (; t0 < ntiles; t0 += 4 * G) {
    float v[4][8];
#pragma unroll
    for (int u = 0; u < 4; ++u) {
      const int t = t0 + u * G;
      if (t < ntiles) {
        const int tr = t / ntk, tk = t - tr * ntk, r0 = tr * 64, kk0 = tk * 64; const int i = tid & 63, sc = srccol(r0 + i);
#pragma unroll
        for (int it = 0; it < 8; ++it) { const int kk = (tid >> 6) + 8 * it; v[u][it] = sc >= 0 ? W[(size_t)(kk0 + kk) * ldw + sc] : 0.f; }
      }
    }
#pragma unroll
    for (int u = 0; u < 4; ++u) { if (t0 + u * G < ntiles) {
#pragma unroll
      for (int it = 0; it < 8; ++it) ldsst<float>(L, u * 16640 + (((tid >> 6) + 8 * it) * 65 + (tid & 63)) * 4, v[u][it]); } }
    __syncthreads();
#pragma unroll
    for (int u = 0; u < 4; ++u) {
      const int t = t0 + u * G;
      if (t < ntiles) {
        const int tr = t / ntk, tk = t - tr * ntk, r0 = tr * 64, kk0 = tk * 64; const int ii = tid >> 3, kv = (tid & 7) * 8; float o[8];
#pragma unroll
        for (int e = 0; e < 8; ++e) o[e] = ldsld<float>(L, u * 16640 + ((kv + e) * 65 + ii) * 4);
        u32x4 w; w.x = cvt_pk_bf16(o[0], o[1]); w.y = cvt_pk_bf16(o[2], o[3]); w.z = cvt_pk_bf16(o[4], o[5]); w.w = cvt_pk_bf16(o[6], o[7]);
        *(u32x4*)(dst + (size_t)(r0 + ii) * ldd + k0d + kk0 + kv) = w;
      }
    }
    __syncthreads();
  }
  cursor += ntiles;
}

__device__ __forceinline__ void convert_ffn(const Params& p, const float* wgu, const float* wd, size_t o_gu, size_t o_d, ldsp L, int& cur, int wg, int nwg) {
  convT(wgu, 2 * DFF, 1024, 2 * DFF, (bf16_t*)(lws(p.ws) + o_gu), 1024, 0, [](int r) { const int t = r >> 8, q = r & 255; return q < 128 ? t * 128 + q : DFF + t * 128 + (q - 128); }, L, cur, wg, nwg);
  convT(wd, 1024, DFF, 1024, (bf16_t*)(lws(p.ws) + o_d), DFF, 0, [](int r) { return r; }, L, cur, wg, nwg);
}
__device__ __forceinline__ void convert_win(const Params& p, int l, ldsp L, int& cur, int wg, int nwg) {
  const float* win = p.w_in + (size_t)l * 1024 * DPROJ;
  convT(win, DPROJ, 1024, NINP, (bf16_t*)(lws(p.ws) + O_WIN), 1024, 0, [](int r) { return r < 2048 ? r : (r < 2560 ? r + 16 : (r < 2576 ? r - 512 : -1)); }, L, cur, wg, nwg);
}
__device__ __forceinline__ void convert_mixer(const Params& p, int l, ldsp L, int& cur) {
  const int wg = blockIdx.x, nwg = gridDim.x;
  const float* win = p.w_in + (size_t)l * 1024 * DPROJ;
  convT(win, DPROJ, 1024, 3072, (bf16_t*)(lws(p.ws) + O_WG), 1024, 0, [](int r) { return 2576 + r; }, L, cur, wg, nwg);
  convT(p.w_a + (size_t)l * 512 * 1024, 1024, 512, 1024, (bf16_t*)(lws(p.ws) + O_WCAT), 1024, 0, [](int r) { return r; }, L, cur, wg, nwg);
  convT(p.w_c + (size_t)l * 256 * 1024, 1024, 256, 1024, (bf16_t*)(lws(p.ws) + O_WCAT), 1024, 768, [](int r) { return r; }, L, cur, wg, nwg);
  convT(p.w_out + (size_t)l * 1024 * 1024, 1024, 1024, 1024, (bf16_t*)(lws(p.ws) + O_WOUT), 1024, 0, [](int r) { return r; }, L, cur, wg, nwg);
  for (int rp = 0; rp < 3; ++rp) convT(p.w_out + (size_t)l * 1024 * 1024, 1024, 1024, 1024, (bf16_t*)(lws(p.ws) + O_WOUT3), 3072, rp * 1024, [](int r) { return r; }, L, cur, wg, nwg);
  const float* wb = p.w_b + (size_t)l * 4 * 64 * 256; const float* ps = p.pool_scale + (size_t)l * 1024; bf16_t* wcat = (bf16_t*)(lws(p.ws) + O_WCAT);
  for (int idx = blockIdx.x * NTHR + otid(); idx < 1024 * 256; idx += gridDim.x * NTHR) {
    const int row = idx & 1023, kk = idx >> 10, g = row >> 8;
    const float v = ((kk >> 6) == g) ? wb[((size_t)g * 64 + (kk & 63)) * 256 + (row & 255)] * ps[row] : 0.f;
    wcat[(size_t)row * 1024 + 512 + kk] = (bf16_t)(cvt_pk_bf16(v, 0.f) & 0xffffu);
  }
}

__device__ __forceinline__ void norm_phase(float* X, bf16_t* Hn, const float* gain, const float* modl, int ishift, int iscale, const float* part) {
  const int tid_ = otid(), lane = tid_ & 63, gw = blockIdx.x * 8 + (tid_ >> 6), nw = gridDim.x * 8;
  for (int r0 = gw; r0 < ROWS; r0 += 2 * nw) {
    f32x4 v[2][4]; float ss[2];
#pragma unroll
    for (int q = 0; q < 2; ++q) { const int r = r0 + q * nw; const int rr = r < ROWS ? r : r0; const float* xr = X + (size_t)rr * DM;
#pragma unroll
      for (int i = 0; i < 2; ++i) { v[q][2 * i] = *(const f32x4*)(xr + lane * 8 + 512 * i); v[q][2 * i + 1] = *(const f32x4*)(xr + lane * 8 + 512 * i + 4); } }
#pragma unroll
    for (int q = 0; q < 2; ++q) {
      const int r = r0 + q * nw;
      if (part != nullptr && r >= RLAT && r < ROWS) {
        float* xr = X + (size_t)r * DM; const float* pr_ = part + (size_t)(r - RLAT) * DM + lane * 8;
#pragma unroll
        for (int kp = 0; kp < 8; ++kp)
#pragma unroll
          for (int i = 0; i < 2; ++i) { v[q][2 * i] = v[q][2 * i] + *(const f32x4*)(pr_ + (size_t)kp * 2048 * 1024 + 512 * i); v[q][2 * i + 1] = v[q][2 * i + 1] + *(const f32x4*)(pr_ + (size_t)kp * 2048 * 1024 + 512 * i + 4); }
#pragma unroll
        for (int i = 0; i < 2; ++i) { *(f32x4*)(xr + lane * 8 + 512 * i) = v[q][2 * i]; *(f32x4*)(xr + lane * 8 + 512 * i + 4) = v[q][2 * i + 1]; }
      }
      float s_ = 0.f;
#pragma unroll
      for (int i = 0; i < 4; ++i) s_ += v[q][i][0] * v[q][i][0] + v[q][i][1] * v[q][i][1] + v[q][i][2] * v[q][i][2] + v[q][i][3] * v[q][i][3];
      ss[q] = s_;
    }
#pragma unroll
    for (int o = 32; o >= 1; o >>= 1) { ss[0] += __shfl_xor(ss[0], o); ss[1] += __shfl_xor(ss[1], o); }
#pragma unroll
    for (int q = 0; q < 2; ++q) {
      const int r = r0 + q * nw; if (r >= ROWS) continue;
      const int j = r < RLAT ? (r >> 12) : 8;
      const float* sh = modl + (size_t)(j * 9 + ishift) * 1024; const float* sc = modl + (size_t)(j * 9 + iscale) * 1024;
      const float rstd = rsqrtf(ss[q] * (1.0f / 1024.0f) + 1e-6f);
#pragma unroll
      for (int i = 0; i < 2; ++i) {
        const int c0 = lane * 8 + 512 * i; float o[8];
#pragma unroll
        for (int hh = 0; hh < 2; ++hh) { const f32x4 g = *(const f32x4*)(gain + c0 + 4 * hh), s1 = *(const f32x4*)(sc + c0 + 4 * hh), s0 = *(const f32x4*)(sh + c0 + 4 * hh); const f32x4 y = v[q][2 * i + hh] * rstd * g * (s1 + 1.0f) + s0;
          o[4 * hh] = y[0]; o[4 * hh + 1] = y[1]; o[4 * hh + 2] = y[2]; o[4 * hh + 3] = y[3]; }
        u32x4 w; w.x = cvt_pk_bf16(o[0], o[1]); w.y = cvt_pk_bf16(o[2], o[3]); w.z = cvt_pk_bf16(o[4], o[5]); w.w = cvt_pk_bf16(o[6], o[7]);
        *(u32x4*)(Hn + (size_t)r * DM + c0) = w;
      }
    }
  }
}
__device__ __forceinline__ void final_norm(const float* X, float* out, const float* gain) {
  const int tid_ = otid(), lane = tid_ & 63, gw = blockIdx.x * 8 + (tid_ >> 6), nw = gridDim.x * 8;
  for (int r = gw; r < RLAT; r += nw) {
    const float* xr = X + (size_t)r * DM; f32x4 v[4]; float ss = 0.f;
#pragma unroll
    for (int i = 0; i < 4; ++i) { v[i] = *(const f32x4*)(xr + lane * 4 + 256 * i); ss += v[i][0] * v[i][0] + v[i][1] * v[i][1] + v[i][2] * v[i][2] + v[i][3] * v[i][3]; }
#pragma unroll
    for (int o = 32; o >= 1; o >>= 1) ss += __shfl_xor(ss, o);
    const float rstd = rsqrtf(ss * (1.0f / 1024.0f) + 1e-6f);
#pragma unroll
    for (int i = 0; i < 4; ++i) { const f32x4 g = *(const f32x4*)(gain + lane * 4 + 256 * i); *(f32x4*)(out + (size_t)r * DM + lane * 4 + 256 * i) = v[i] * rstd * g; }
  }
}

__device__ __forceinline__ void phase0(const Params& p, ldsp L) {
  const int tid = otid(); const size_t gt = (size_t)blockIdx.x * NTHR + tid, gs = (size_t)gridDim.x * NTHR;
  { f32x4* X = (f32x4*)(lws(p.ws) + O_X); const f32x4* xs = (const f32x4*)p.x; const f32x4* cs = (const f32x4*)p.ctx; const size_t n1 = (size_t)RLAT * DM / 4, n2 = (size_t)ROWS * DM / 4;
    for (size_t i = gt; i < n2; i += gs) X[i] = i < n1 ? xs[i] : cs[i - n1]; }
  { bf16_t* D = (bf16_t*)(lws(p.ws) + O_DFT);
    for (size_t v = gt; v < (size_t)4096 * 512; v += gs) { const int k = (int)(v >> 9), j0 = (int)(v & 511) * 8; float o[8];
#pragma unroll
      for (int e = 0; e < 8; ++e) { const int j = j0 + e; const bool cs_ = j <= 2048; const int t = cs_ ? j : j - 2048; const int r = (k * t) & 4095; const float a = (float)r * (1.0f / 2048.0f);
        o[e] = cs_ ? cospif(a) * (1.0f / 64.0f) : -sinpif(a) * (1.0f / 64.0f); }
      u32x4 w; w.x = cvt_pk_bf16(o[0], o[1]); w.y = cvt_pk_bf16(o[2], o[3]); w.z = cvt_pk_bf16(o[4], o[5]); w.w = cvt_pk_bf16(o[6], o[7]);
      *(u32x4*)(D + (size_t)k * 4096 + j0) = w; } }
  for (int idx = tid; idx < 9 * 1024; idx += NTHR) { const int j = idx >> 10, k = idx & 1023; const float v = j < 8 ? p.c[j * 1024 + k] : p.c_ctx[k]; ldsst<float>(L, idx * 4, siluf_(v)); }
  __syncthreads();
  float* MOD = (float*)(lws(p.ws) + O_MOD);
  for (int item = blockIdx.x; item < DEPTH * 144; item += gridDim.x) {
    const int l = item / 144, n0 = (item - l * 144) * 64, ks = tid >> 6, cn = tid & 63;
    float acc[9];
#pragma unroll
    for (int j = 0; j < 9; ++j) acc[j] = 0.f;
    const float* wp = p.w_ada + ((size_t)l * 1024 + ks * 128) * 9216 + n0 + cn;
#pragma unroll 4
    for (int k = 0; k < 128; ++k) { const float w = wp[(size_t)k * 9216];
#pragma unroll
      for (int j = 0; j < 9; ++j) acc[j] += ldsld<float>(L, (j * 1024 + ks * 128 + k) * 4) * w; }
#pragma unroll
    for (int j = 0; j < 9; ++j) ldsst<float>(L, 36864 + ((ks * 9 + j) * 64 + cn) * 4, acc[j]);
    __syncthreads();
    for (int o = tid; o < 576; o += NTHR) { const int j = o >> 6, c = o & 63; float s = p.b_ada[(size_t)l * 9216 + n0 + c];
#pragma unroll
      for (int q = 0; q < 8; ++q) s += ldsld<float>(L, 36864 + ((q * 9 + j) * 64 + c) * 4);
      MOD[((size_t)l * 9 + j) * 9216 + n0 + c] = s; }
    __syncthreads();
  }
}

__device__ __forceinline__ void prep_phase(const Params& p, int l, ldsp L) {
  const int tid = otid(), lane = tid & 63, wid = tid >> 6, fr = lane & 15, fq = lane >> 4;
  constexpr int KSB = 0, KTL = 17408, VTL = 35840, GL = 54272, AL = 71680, GCL = 104448, BTL = 104960, TOL = 105472;
  const bf16_t* QKV = (const bf16_t*)(lws(p.ws) + O_QKV); const float* AB = (const float*)(lws(p.ws) + O_AB);
  bf16_t* QN = (bf16_t*)(lws(p.ws) + O_QN); bf16_t* KN = (bf16_t*)(lws(p.ws) + O_KN); bf16_t* KNT = (bf16_t*)(lws(p.ws) + O_KNT); bf16_t* VNT = (bf16_t*)(lws(p.ws) + O_VNT);
  bf16_t* TT = (bf16_t*)(lws(p.ws) + O_TT); float* GC = (float*)(lws(p.ws) + O_GC);
  const float* cw = p.conv_w + (size_t)l * 3 * 1536;
  for (int item = blockIdx.x; item < NCH * 4; item += gridDim.x) {
    const int n = item >> 2, h = item & 3, R0 = n * 64;
    { const int row = tid >> 3, cs = tid & 7, r = R0 + row, c0 = cs * 16;
      const int t = r < RLAT ? (r & 4095) : ((r - RLAT) & 255), Ls = r < RLAT ? 4096 : 256;
      const bool hp = t > 0, hn = t < Ls - 1;
#pragma unroll
      for (int mtx = 0; mtx < 3; ++mtx) {
        const int cc = mtx * 512 + h * 128 + c0; const bf16_t* bp = QKV + (size_t)r * 1536 + cc;
        u32x4 a0 = {0, 0, 0, 0}, a1 = {0, 0, 0, 0}, c0v = {0, 0, 0, 0}, c1v = {0, 0, 0, 0};
        const u32x4 b0 = *(const u32x4*)(bp), b1 = *(const u32x4*)(bp + 8);
        if (hp) { a0 = *(const u32x4*)(bp - 1536); a1 = *(const u32x4*)(bp - 1536 + 8); }
        if (hn) { c0v = *(const u32x4*)(bp + 1536); c1v = *(const u32x4*)(bp + 1536 + 8); }
        float val[16]; float ss = 0.f;
#pragma unroll
        for (int e = 0; e < 16; ++e) {
          const unsigned wa = e < 8 ? a0[e >> 1] : a1[(e - 8) >> 1], wb = e < 8 ? b0[e >> 1] : b1[(e - 8) >> 1], wc_ = e < 8 ? c0v[e >> 1] : c1v[(e - 8) >> 1];
          const float xa = (e & 1) ? bfhi(wa) : bflo(wa), xb = (e & 1) ? bfhi(wb) : bflo(wb), xc = (e & 1) ? bfhi(wc_) : bflo(wc_);
          const float y = xa * cw[cc + e] + xb * cw[1536 + cc + e] + xc * cw[3072 + cc + e];
          val[e] = siluf_(y); ss += val[e] * val[e];
        }
        if (mtx < 2) { ss += __shfl_xor(ss, 1); ss += __shfl_xor(ss, 2); ss += __shfl_xor(ss, 4); const float sc = rsqrtf(ss + 1e-6f) * (mtx == 0 ? 0.08838834764831845f : 1.0f);
#pragma unroll
          for (int e = 0; e < 16; ++e) val[e] *= sc; }
        u32x4 w0, w1; w0.x = cvt_pk_bf16(val[0], val[1]); w0.y = cvt_pk_bf16(val[2], val[3]); w0.z = cvt_pk_bf16(val[4], val[5]); w0.w = cvt_pk_bf16(val[6], val[7]);
        w1.x = cvt_pk_bf16(val[8], val[9]); w1.y = cvt_pk_bf16(val[10], val[11]); w1.z = cvt_pk_bf16(val[12], val[13]); w1.w = cvt_pk_bf16(val[14], val[15]);
        if (mtx == 0) { bf16_t* o = QN + (size_t)r * 512 + h * 128 + c0; *(u32x4*)o = w0; *(u32x4*)(o + 8) = w1; }
        else if (mtx == 1) { bf16_t* o = KN + (size_t)r * 512 + h * 128 + c0; *(u32x4*)o = w0; *(u32x4*)(o + 8) = w1;
          ldsst<u32x4>(L, KSB + row * 272 + c0 * 2, w0); ldsst<u32x4>(L, KSB + row * 272 + c0 * 2 + 16, w1);
#pragma unroll
          for (int e = 0; e < 16; ++e) { const unsigned wv = e < 8 ? w0[e >> 1] : w1[(e - 8) >> 1]; ldsst<bf16_t>(L, KTL + (c0 + e) * 144 + row * 2, (bf16_t)((e & 1) ? (wv >> 16) : (wv & 0xffffu))); } }
        else {
#pragma unroll
          for (int e = 0; e < 16; ++e) { const unsigned wv = e < 8 ? w0[e >> 1] : w1[(e - 8) >> 1]; ldsst<bf16_t>(L, VTL + (c0 + e) * 144 + row * 2, (bf16_t)((e & 1) ? (wv >> 16) : (wv & 0xffffu))); } }
      }
    }
    if (wid < 2) {
      const int d = wid, r = R0 + lane;
      const float braw = AB[(size_t)r * 16 + d * 4 + h], araw = AB[(size_t)r * 16 + 8 + d * 4 + h];
      const float beta = sigmoidf_(braw);
      const float xs = araw + p.dt_bias[(l * 2 + d) * 4 + h];
      const float sp = fmaxf(xs, 0.f) + log1pf(__expf(-fabsf(xs)));
      const float g = -__expf(p.a_log[(l * 2 + d) * 4 + h]) * sp;
      float pre = g;
#pragma unroll
      for (int o = 1; o < 64; o <<= 1) { const float t2 = __shfl_up(pre, o); if (lane >= o) pre += t2; }
      const float tot = __shfl(pre, 63);
      const float gc = d == 0 ? pre : (tot - pre + g);
      ldsst<float>(L, GCL + (d * 64 + lane) * 4, gc); ldsst<float>(L, BTL + (d * 64 + lane) * 4, beta);
      GC[((size_t)item * 2 + d) * 64 + lane] = gc;
    }
    __syncthreads();
    { const int ti = wid >> 1;
#pragma unroll
      for (int q = 0; q < 2; ++q) { const int tj = 2 * (wid & 1) + q; f32x4 a = {0.f, 0.f, 0.f, 0.f};
#pragma unroll
        for (int kk = 0; kk < 4; ++kk) a = mma(ldsld<bf16x8>(L, KSB + (16 * tj + fr) * 272 + kk * 64 + fq * 16), ldsld<bf16x8>(L, KSB + (16 * ti + fr) * 272 + kk * 64 + fq * 16), a);
        ldsst<f32x4>(L, GL + ((16 * ti + fr) * 68 + 16 * tj + 4 * fq) * 4, a); }
    }
    {
#pragma unroll
      for (int it = 0; it < 2; ++it) { const int v = tid + 512 * it, c = v >> 3, sg = (v & 7) * 8;
        *(u32x4*)(KNT + (size_t)item * 8192 + c * 64 + sg) = ldsld<u32x4>(L, KTL + c * 144 + sg * 2);
        *(u32x4*)(VNT + (size_t)item * 8192 + c * 64 + sg) = ldsld<u32x4>(L, VTL + c * 144 + sg * 2); } }
    __syncthreads();
    { const int d = tid >> 8, a = (tid & 255) >> 2, jq = tid & 3;
      const int pi_ = d ? 63 - a : a; const float bi = ldsld<float>(L, BTL + (d * 64 + pi_) * 4), gi = ldsld<float>(L, GCL + (d * 64 + pi_) * 4);
#pragma unroll
      for (int e = 0; e < 16; ++e) { const int bb = jq * 16 + e, pr = d ? 63 - bb : bb;
        float v = 0.f;
        if (a > bb) v = bi * ldsld<float>(L, GL + (pi_ * 68 + pr) * 4) * __expf(gi - ldsld<float>(L, GCL + (d * 64 + pr) * 4));
        ldsst<float>(L, AL + ((d * 64 + a) * 64 + bb) * 4, v); } }
    __syncthreads();
    { constexpr int XL = 0, ML = GL; int tid5 = tid; asm volatile("" : "+v"(tid5)); const int wid5 = tid5 >> 6, lane5 = tid5 & 63;
#define XLA(d_, r_, c_) (XL + (((d_) * 64 + (r_)) * 64 + (c_)) * 4)
#define ALA(d_, r_, c_) (AL + (((d_) * 64 + (r_)) * 64 + (c_)) * 4)
      if (wid5 < 2) {
        const int d = wid5, bb = lane5 >> 4, cc = lane5 & 15; float xb[16];
#pragma unroll
        for (int ii = 0; ii < 16; ++ii) {
          float t = (ii == cc) ? 1.f : 0.f;
#pragma unroll
          for (int j4 = 0; j4 < (ii + 3) / 4; ++j4) { const f32x4 av = ldsld<f32x4>(L, ALA(d, 16 * bb + ii, 16 * bb + j4 * 4));
#pragma unroll
            for (int e = 0; e < 4; ++e) if (j4 * 4 + e < ii) t -= av[e] * xb[j4 * 4 + e]; }
          xb[ii] = t; ldsst<float>(L, XLA(d, 16 * bb + ii, 16 * bb + cc), t);
        }
      }
      __syncthreads();
#pragma unroll
      for (int lev = 1; lev <= 3; ++lev) {
        const int nblk = 2 * (4 - lev), nel = nblk * 256;
        for (int o = tid5; o < nel; o += NTHR) {
          const int bl = o >> 8, d = bl & 1, i = lev + (bl >> 1), j = i - lev, r = (o >> 4) & 15, c = o & 15; float acc_ = 0.f;
          for (int m = 0; m < lev; ++m) {
#pragma unroll
            for (int k4 = 0; k4 < 4; ++k4) { const f32x4 av = ldsld<f32x4>(L, ALA(d, 16 * i + r, 16 * (j + m) + 4 * k4));
#pragma unroll
              for (int e = 0; e < 4; ++e) acc_ += av[e] * ldsld<float>(L, XLA(d, 16 * (j + m) + 4 * k4 + e, 16 * j + c)); }
          }
          ldsst<float>(L, ML + o * 4, acc_);
        }
        __syncthreads();
        for (int o = tid5; o < nel; o += NTHR) {
          const int bl = o >> 8, d = bl & 1, i = lev + (bl >> 1), j = i - lev, r = (o >> 4) & 15, c = o & 15; float acc_ = 0.f;
#pragma unroll
          for (int k4 = 0; k4 < 4; ++k4) { const f32x4 dv = ldsld<f32x4>(L, XLA(d, 16 * i + r, 16 * i + 4 * k4));
#pragma unroll
            for (int e = 0; e < 4; ++e) acc_ += dv[e] * ldsld<float>(L, ML + ((bl << 8) + ((4 * k4 + e) << 4) + c) * 4); }
          ldsst<float>(L, XLA(d, 16 * i + r, 16 * j + c), -acc_);
        }
        __syncthreads();
      }
      { const int d = tid5 >> 8, i = (tid5 >> 2) & 63, cq = tid5 & 3, pp = d ? 63 - i : i; float tw[16], tu[16];
#pragma unroll
        for (int e = 0; e < 16; ++e) { const int c = cq * 16 + e, pr = d ? 63 - c : c;
          const float x = ((i >> 4) > cq || ((i >> 4) == cq)) ? ldsld<float>(L, XLA(d, i, c)) : 0.f;
          const float bc = ldsld<float>(L, BTL + (d * 64 + pr) * 4), fw = bc * __expf(ldsld<float>(L, GCL + (d * 64 + pr) * 4));
          tw[e] = x * fw; tu[e] = x * bc; }
#pragma unroll
        for (int e = 0; e < 8; ++e) { const float a0 = tw[e], a1 = tw[15 - e], b0 = tu[e], b1 = tu[15 - e]; tw[e] = d ? a1 : a0; tw[15 - e] = d ? a0 : a1; tu[e] = d ? b1 : b0; tu[15 - e] = d ? b0 : b1; }
        const int pr0 = d ? 63 - (cq * 16 + 15) : cq * 16;
        u32x4 w0, w1;
        w0.x = cvt_pk_bf16(tw[0], tw[1]); w0.y = cvt_pk_bf16(tw[2], tw[3]); w0.z = cvt_pk_bf16(tw[4], tw[5]); w0.w = cvt_pk_bf16(tw[6], tw[7]);
        w1.x = cvt_pk_bf16(tw[8], tw[9]); w1.y = cvt_pk_bf16(tw[10], tw[11]); w1.z = cvt_pk_bf16(tw[12], tw[13]); w1.w = cvt_pk_bf16(tw[14], tw[15]);
        ldsst<u32x4>(L, TOL + ((d * 2 + 0) * 64 + pp) * 144 + pr0 * 2, w0); ldsst<u32x4>(L, TOL + ((d * 2 + 0) * 64 + pp) * 144 + pr0 * 2 + 16, w1);
        w0.x = cvt_pk_bf16(tu[0], tu[1]); w0.y = cvt_pk_bf16(tu[2], tu[3]); w0.z = cvt_pk_bf16(tu[4], tu[5]); w0.w = cvt_pk_bf16(tu[6], tu[7]);
        w1.x = cvt_pk_bf16(tu[8], tu[9]); w1.y = cvt_pk_bf16(tu[10], tu[11]); w1.z = cvt_pk_bf16(tu[12], tu[13]); w1.w = cvt_pk_bf16(tu[14], tu[15]);
        ldsst<u32x4>(L, TOL + ((d * 2 + 1) * 64 + pp) * 144 + pr0 * 2, w0); ldsst<u32x4>(L, TOL + ((d * 2 + 1) * 64 + pp) * 144 + pr0 * 2 + 16, w1);
      }
#undef XLA
#undef ALA
    }
    __syncthreads();
#pragma unroll
    for (int it = 0; it < 4; ++it) { const int v = tid + 512 * it, mtx = v >> 9, row = (v >> 3) & 63, sg = (v & 7) * 8;
      *(u32x4*)(TT + ((size_t)item * 4 + mtx) * 4096 + row * 64 + sg) = ldsld<u32x4>(L, TOL + (mtx * 64 + row) * 144 + sg * 2); }
    __syncthreads();
  }
}

__device__ __forceinline__ void fourier_prep(const Params& p, ldsp L) {
  const int tid = otid(), lane = tid & 63, wid = tid >> 6, fr = lane & 15, fq = lane >> 4;
  constexpr int UA = 0, UB = 33792, DC = 67584;
  const bf16_t* FI = (const bf16_t*)(lws(p.ws) + O_FI); bf16_t* FBT = (bf16_t*)(lws(p.ws) + O_FBT); float* UCS = (float*)(lws(p.ws) + O_UCS);
  for (int idx = tid; idx < 128 * 64; idx += NTHR) { const int rr = idx >> 6, c = idx & 63, m = rr & 63; const float a = (float)((m * c) & 63) * (1.0f / 32.0f);
    const float v = (rr < 64 ? cospif(a) : sinpif(a)) * 0.125f; ldsst<bf16_t>(L, DC + rr * 144 + c * 2, (bf16_t)(cvt_pk_bf16(v, 0.f) & 0xffffu)); }
  __syncthreads();
  for (int item = (int)gridDim.x - 1 - (int)blockIdx.x; item < 288; item += gridDim.x) {
    const bool lat = item < 256; const int b = lat ? item >> 5 : 0, jb = item & 31;
#pragma unroll
    for (int it = 0; it < 4; ++it) { const int v = tid + 512 * it, row = v >> 5, sg = (v & 31) * 8;
      int ra, rb;
      if (lat) { const int t = 64 * jb + row; ra = b * 4096 + t; rb = b * 4096 + (t == 0 ? 2048 : 4096 - t); } else { ra = RLAT + (item - 256) * 64 + row; rb = ra; }
      ldsst<u32x4>(L, UA + row * 528 + sg * 2, *(const u32x4*)(FI + (size_t)ra * 256 + sg));
      ldsst<u32x4>(L, UB + row * 528 + sg * 2, *(const u32x4*)(FI + (size_t)rb * 256 + sg)); }
    __syncthreads();
    for (int q = 0; q < 8; ++q) {
      const int combo = wid * 8 + q, g = combo >> 4, ti = (combo >> 2) & 3, tm = combo & 3;
      f32x4 ac = {0.f, 0.f, 0.f, 0.f}, as = ac, bc = ac, bs = ac;
#pragma unroll
      for (int kk = 0; kk < 2; ++kk) {
        const bf16x8 xa = ldsld<bf16x8>(L, UA + (16 * ti + fr) * 528 + (g * 64 + kk * 32 + fq * 8) * 2), xb = ldsld<bf16x8>(L, UB + (16 * ti + fr) * 528 + (g * 64 + kk * 32 + fq * 8) * 2);
        const bf16x8 yc = ldsld<bf16x8>(L, DC + (16 * tm + fr) * 144 + kk * 64 + fq * 16), ys = ldsld<bf16x8>(L, DC + (64 + 16 * tm + fr) * 144 + kk * 64 + fq * 16);
        ac = mma(xa, yc, ac); as = mma(xa, ys, as); bc = mma(xb, yc, bc); bs = mma(xb, ys, bs);
      }
      const int mp = g * 64 + 16 * tm + fr, i0 = 16 * ti + 4 * fq;
      if (lat) {
        f32x4 cv = ac + bc, sv = as - bs;
        if (jb == 0 && i0 == 0) { cv[0] = ac[0]; sv[0] = bc[0]; }
        bf16_t* o = FBT + ((size_t)b * 256 + mp) * 4096 + 64 * jb + i0;
        *(u32x2*)o = pack4(cv); *(u32x2*)(o + 2048) = pack4(sv);
      } else {
#pragma unroll
        for (int e = 0; e < 4; ++e) { float* o = UCS + (size_t)((item - 256) * 64 + i0 + e) * 512; o[mp] = ac[e]; o[256 + mp] = as[e]; }
      }
    }
    __syncthreads();
  }
}

__device__ __forceinline__ void ctx_fourier(const Params& p, ldsp L, int wg, int nwg) {
  const int tid = otid(); const float* UCS = (const float*)(lws(p.ws) + O_UCS); bf16_t* PPF = (bf16_t*)(lws(p.ws) + O_PPF);
  for (int idx = tid; idx < 256; idx += NTHR) { const float a = (float)idx * (1.0f / 128.0f); ldsst<float>(L, idx * 4, cospif(a) * (1.0f / 16.0f)); ldsst<float>(L, 1024 + idx * 4, sinpif(a) * (1.0f / 16.0f)); }
  __syncthreads();
  for (int o = wg * NTHR + tid; o < NB * 32 * 256; o += nwg * NTHR) {
    const int mp = o & 255, kq = (o >> 8) & 31, b = o >> 13; const float* u = UCS + (size_t)b * 256 * 512 + mp; float s8[8];
#pragma unroll
    for (int e = 0; e < 8; ++e) s8[e] = 0.f;
#pragma unroll 16
    for (int t = 0; t < 256; ++t) { const float uc = u[(size_t)t * 512], us = u[(size_t)t * 512 + 256];
#pragma unroll
      for (int e = 0; e < 8; ++e) { const int r = ((8 * kq + e) * t) & 255; s8[e] += ldsld<float>(L, r * 4) * uc - ldsld<float>(L, 1024 + r * 4) * us; } }
#pragma unroll
    for (int e = 0; e < 8; ++e) PPF[(size_t)(RLAT + b * 256 + 8 * kq + e) * 512 + 256 + mp] = (bf16_t)(cvt_pk_bf16(s8[e], 0.f) & 0xffffu);
  }
  __syncthreads();
}
__device__ __forceinline__ void pool_phase(const Params& p, ldsp L, int wg, int nwg) {
  const int tid_ = otid(), lane = tid_ & 63, wv = tid_ >> 6, gw = wg * 8 + wv, nw = nwg * 8;
  const bf16_t* PI = (const bf16_t*)(lws(p.ws) + O_PI); bf16_t* PPF = (bf16_t*)(lws(p.ws) + O_PPF);
  const int LP = wv * 16640;
  for (int idx = gw; idx < 2048; idx += nw) {
    const int g = 3 - (idx >> 9), b = (idx >> 6) & 7, r = idx & 63;
    const int win = 2 << g, hw = win >> 1, sr = max(r - hw, 0), er = min(r - hw + win, 64);
    const bf16_t* base = PI + (size_t)b * 4096 * 256 + g * 64 + lane;
    ldsst<float>(L, LP + lane * 4, 0.f);
    { const int ci = lane >> 3, ch0 = (lane & 7) * 8;
      const bf16_t* bq = PI + (size_t)b * 4096 * 256 + g * 64 + ch0;
      const int ncb = 16 >> (g + 1);
#pragma unroll 1
      for (int cb0 = 0; cb0 < 8; cb0 += ncb) {
        u32x4 vv[16];
#pragma unroll
        for (int q = 0; q < 16; ++q) { const int cbq = q >> (g + 1), rr = sr + (q & (win - 1)), cc = (cb0 + cbq) * 8 + ci; vv[q] = (u32x4){0u, 0u, 0u, 0u}; if (rr < er) vv[q] = *(const u32x4*)(bq + (size_t)(rr * 64 + cc) * 256); }
        float ac[8];
        for (int cbq = 0; cbq < ncb; ++cbq) {
#pragma unroll
          for (int e = 0; e < 8; ++e) ac[e] = 0.f;
#pragma unroll
          for (int q = 0; q < 16; ++q) { const bool mine = (q >> (g + 1)) == cbq;
#pragma unroll
            for (int e = 0; e < 4; ++e) { ac[2 * e] += mine ? bflo(vv[q][e]) : 0.f; ac[2 * e + 1] += mine ? bfhi(vv[q][e]) : 0.f; } }
          const int cc = (cb0 + cbq) * 8 + ci;
          ldsst<f32x4>(L, LP + ((cc + 1) * 64 + ch0) * 4, (f32x4){ac[0], ac[1], ac[2], ac[3]}); ldsst<f32x4>(L, LP + ((cc + 1) * 64 + ch0 + 4) * 4, (f32x4){ac[4], ac[5], ac[6], ac[7]});
        }
      }
      float run = 0.f;
#pragma unroll 8
      for (int cc = 1; cc <= 64; ++cc) { run += ldsld<float>(L, LP + (cc * 64 + lane) * 4); ldsst<float>(L, LP + (cc * 64 + lane) * 4, run); }
    }
    const float rinv = 1.0f / (float)(er - sr);
    {
      const int ci = lane >> 3, ch0 = (lane & 7) * 8;
      u32x4 sv[8];
#pragma unroll
      for (int cb = 0; cb < 8; ++cb) sv[cb] = *(const u32x4*)(PI + ((size_t)b * 4096 + r * 64 + cb * 8 + ci) * 256 + g * 64 + ch0);
#pragma unroll
      for (int cb = 0; cb < 8; ++cb) {
        const int c = cb * 8 + ci, sc = max(c - hw, 0), ec = min(c - hw + win, 64); const float sca = rinv / (float)(ec - sc);
        const f32x4 e0 = ldsld<f32x4>(L, LP + (ec * 64 + ch0) * 4), e1 = ldsld<f32x4>(L, LP + (ec * 64 + ch0 + 4) * 4), s0 = ldsld<f32x4>(L, LP + (sc * 64 + ch0) * 4), s1 = ldsld<f32x4>(L, LP + (sc * 64 + ch0 + 4) * 4);
        const f32x4 b0 = (e0 - s0) * sca, b1 = (e1 - s1) * sca; const u32x4 sf = sv[cb];
        u32x4 w; w.x = cvt_pk_bf16(b0[0] - bflo(sf.x), b0[1] - bfhi(sf.x)); w.y = cvt_pk_bf16(b0[2] - bflo(sf.y), b0[3] - bfhi(sf.y)); w.z = cvt_pk_bf16(b1[0] - bflo(sf.z), b1[1] - bfhi(sf.z)); w.w = cvt_pk_bf16(b1[2] - bflo(sf.w), b1[3] - bfhi(sf.w));
        *(u32x4*)(PPF + ((size_t)b * 4096 + r * 64 + c) * 512 + g * 64 + ch0) = w;
      }
    }
  }
  for (int r = RLAT + gw; r < ROWS; r += nw) {
    const int base = r & ~255, t = r - base;
#pragma unroll
    for (int g = 0; g < 4; ++g) {
      const int win = 2 << g, hw = win >> 1, sc = max(t - hw, 0), ec = min(t - hw + win, 256);
      float s_ = 0.f;
#pragma unroll
      for (int q = 0; q < (2 << g); ++q) { const int c = sc + q; if (c < ec) s_ += __uint_as_float((unsigned)PI[(size_t)(base + c) * 256 + g * 64 + lane] << 16); }
      const float self = __uint_as_float((unsigned)PI[(size_t)r * 256 + g * 64 + lane] << 16);
      PPF[(size_t)r * 512 + g * 64 + lane] = (bf16_t)(cvt_pk_bf16(s_ / (float)(ec - sc) - self, 0.f) & 0xffffu);
    }
  }
}

__device__ __forceinline__ void scan_phase(const Params& p, ldsp L, int item) {
  const int tid = otid(), lane = tid & 63, wid = tid >> 6, fr = lane & 15, fq = lane >> 4;
  const int es = item & 1, d = (item >> 1) & 1, h = (item >> 2) & 3, b = item >> 4;
  const int ti = wid >> 1, half = wid & 1;
  constexpr int QS = 0, KS = 17408, KTS = 34816, VTS = 53248, TW = 62464, TU = 71680, AT = 80896, WL = 90112, VNT_ = 107520, VNS = 116736, STL = 125952, GCL0 = 143360, KTS0 = KTS, KTS1 = 143616, GCL1 = 162048;
  const bf16_t* QN = (const bf16_t*)(lws(p.ws) + O_QN); const bf16_t* KN = (const bf16_t*)(lws(p.ws) + O_KN); const bf16_t* KNT = (const bf16_t*)(lws(p.ws) + O_KNT); const bf16_t* VNT = (const bf16_t*)(lws(p.ws) + O_VNT);
  const bf16_t* TT = (const bf16_t*)(lws(p.ws) + O_TT); const float* GC = (const float*)(lws(p.ws) + O_GC); bf16_t* O = (bf16_t*)(lws(p.ws) + O_O) + (size_t)d * ROWS * 512;
  { unsigned zz_; asm volatile("v_mov_b32 %0, 0" : "=v"(zz_)); for (int o = tid * 16; o < 17408; o += NTHR * 16) ldsst<u32x4>(L, STL + o, (u32x4){zz_, zz_, zz_, zz_}); }
  f32x4 accS[4];
#pragma unroll
  for (int q = 0; q < 4; ++q) accS[q] = (f32x4){0.f, 0.f, 0.f, 0.f};
  u32x4 rq[2], rk[2], rkt[2], rvt, rtw, rtu; float rgc = 0.f;
#define SCAN_CHUNK(s) ((s) < 4 ? (NB * 64 + b * 4 + (d ? 3 - (s) : (s))) : (b * 64 + (d ? 67 - (s) : (s) - 4)))
#define SCAN_GLOAD(s) do { const int n_ = SCAN_CHUNK(s), it2_ = n_ * 4 + h; \
    _Pragma("unroll") for (int it = 0; it < 2; ++it) { const int v = tid + 512 * it; \
      rq[it] = *(const u32x4*)(QN + (size_t)(64 * n_ + (v >> 4)) * 512 + h * 128 + (v & 15) * 8); rk[it] = *(const u32x4*)(KN + (size_t)(64 * n_ + (v >> 4)) * 512 + h * 128 + (v & 15) * 8); \
      rkt[it] = *(const u32x4*)(KNT + (size_t)it2_ * 8192 + (v >> 3) * 64 + (v & 7) * 8); } \
    rvt = *(const u32x4*)(VNT + (size_t)it2_ * 8192 + (es * 64 + (tid >> 3)) * 64 + (tid & 7) * 8); \
    rtw = *(const u32x4*)(TT + ((size_t)it2_ * 4 + d * 2 + 0) * 4096 + (tid >> 3) * 64 + (tid & 7) * 8); rtu = *(const u32x4*)(TT + ((size_t)it2_ * 4 + d * 2 + 1) * 4096 + (tid >> 3) * 64 + (tid & 7) * 8); \
    if (tid < 64) rgc = GC[((size_t)it2_ * 2 + d) * 64 + tid]; } while (0)
#define SCAN_LSTORE(KTSW, GCLW) do { \
    _Pragma("unroll") for (int it = 0; it < 2; ++it) { const int v = tid + 512 * it; \
      ldsst<u32x4>(L, QS + (v >> 4) * 272 + (v & 15) * 16, rq[it]); ldsst<u32x4>(L, KS + (v >> 4) * 272 + (v & 15) * 16, rk[it]); ldsst<u32x4>(L, (KTSW) + (v >> 3) * 144 + (v & 7) * 16, rkt[it]); } \
    ldsst<u32x4>(L, VTS + (tid >> 3) * 144 + (tid & 7) * 16, rvt); ldsst<u32x4>(L, TW + (tid >> 3) * 144 + (tid & 7) * 16, rtw); ldsst<u32x4>(L, TU + (tid >> 3) * 144 + (tid & 7) * 16, rtu); \
    if (tid < 64) ldsst<float>(L, (GCLW) + tid * 4, rgc); } while (0)
  SCAN_GLOAD(0); SCAN_LSTORE(KTS0, GCL0); __syncthreads();
  for (int s = 0; s < 68; ++s) {
    const int n = SCAN_CHUNK(s);
    const int KTSc = (s & 1) ? KTS1 : KTS0, GCL = (s & 1) ? GCL1 : GCL0, KTSn = (s & 1) ? KTS0 : KTS1, GCLn = (s & 1) ? GCL0 : GCL1;
    if (s + 1 < 68) SCAN_GLOAD(s + 1);
    const float gtot = ldsld<float>(L, GCL + (d ? 0 : 63) * 4);
    f32x4 uacc[2], qacc[2];
    {
      bf16x8 qf[4], kf[2][4], twf[2], tuf[2], vtf[2][2], ktf[4][2], sf[2][4];
#pragma unroll
      for (int kk = 0; kk < 4; ++kk) qf[kk] = ldsld<bf16x8>(L, QS + (16 * ti + fr) * 272 + kk * 64 + fq * 16);
#pragma unroll
      for (int q = 0; q < 2; ++q)
#pragma unroll
        for (int kk = 0; kk < 4; ++kk) { kf[q][kk] = ldsld<bf16x8>(L, KS + (16 * (2 * half + q) + fr) * 272 + kk * 64 + fq * 16); sf[q][kk] = ldsld<bf16x8>(L, STL + (16 * (2 * half + q) + fr) * 272 + kk * 64 + fq * 16); }
      f32x4 at[2], wv[4];
#pragma unroll
      for (int q = 0; q < 2; ++q) { at[q] = (f32x4){0.f, 0.f, 0.f, 0.f}; qacc[q] = at[q]; uacc[q] = at[q]; }
#pragma unroll
      for (int q = 0; q < 4; ++q) wv[q] = (f32x4){0.f, 0.f, 0.f, 0.f};
#pragma unroll
      for (int kk = 0; kk < 4; ++kk)
#pragma unroll
        for (int q = 0; q < 2; ++q) { at[q] = mma(kf[q][kk], qf[kk], at[q]); qacc[q] = mma(sf[q][kk], qf[kk], qacc[q]); }
      __builtin_amdgcn_sched_barrier(0);
#pragma unroll
      for (int kk = 0; kk < 2; ++kk) { twf[kk] = ldsld<bf16x8>(L, TW + (16 * ti + fr) * 144 + kk * 64 + fq * 16); tuf[kk] = ldsld<bf16x8>(L, TU + (16 * ti + fr) * 144 + kk * 64 + fq * 16); }
#pragma unroll
      for (int q = 0; q < 4; ++q)
#pragma unroll
        for (int kk = 0; kk < 2; ++kk) ktf[q][kk] = ldsld<bf16x8>(L, KTSc + (16 * (4 * half + q) + fr) * 144 + kk * 64 + fq * 16);
#pragma unroll
      for (int q = 0; q < 2; ++q)
#pragma unroll
        for (int kk = 0; kk < 2; ++kk) vtf[q][kk] = ldsld<bf16x8>(L, VTS + (16 * (2 * half + q) + fr) * 144 + kk * 64 + fq * 16);
#pragma unroll
      for (int kk = 0; kk < 2; ++kk) {
#pragma unroll
        for (int q = 0; q < 4; ++q) wv[q] = mma(ktf[q][kk], twf[kk], wv[q]);
#pragma unroll
        for (int q = 0; q < 2; ++q) uacc[q] = mma(tuf[kk], vtf[q][kk], uacc[q]);
      }
      const int i = 16 * ti + fr; const float gi = ldsld<float>(L, GCL + i * 4);
#pragma unroll
      for (int q = 0; q < 2; ++q) {
        const int j0 = 16 * (2 * half + q) + 4 * fq; f32x4 a = at[q];
#pragma unroll
        for (int e = 0; e < 4; ++e) { const int j = j0 + e; const bool keep = d ? (i <= j) : (i >= j); const float ar = keep ? gi - ldsld<float>(L, GCL + j * 4) : 0.f; a[e] = keep ? a[e] * __expf(ar) : 0.f; }
        ldsst<u32x2>(L, AT + i * 144 + j0 * 2, pack4(a));
      }
#pragma unroll
      for (int q = 0; q < 4; ++q) ldsst<u32x2>(L, WL + (16 * ti + fr) * 272 + (16 * (4 * half + q) + 4 * fq) * 2, pack4(wv[q]));
    }
    __syncthreads();
    {
      bf16x8 wf[4], sf[2][4];
#pragma unroll
      for (int kk = 0; kk < 4; ++kk) { wf[kk] = ldsld<bf16x8>(L, WL + (16 * ti + fr) * 272 + kk * 64 + fq * 16);
#pragma unroll
        for (int q = 0; q < 2; ++q) sf[q][kk] = ldsld<bf16x8>(L, STL + (16 * (2 * half + q) + fr) * 272 + kk * 64 + fq * 16); }
      f32x4 a[2];
#pragma unroll
      for (int q = 0; q < 2; ++q) a[q] = (f32x4){0.f, 0.f, 0.f, 0.f};
#pragma unroll
      for (int kk = 0; kk < 4; ++kk)
#pragma unroll
        for (int q = 0; q < 2; ++q) a[q] = mma(wf[kk], sf[q][kk], a[q]);
      const int i0 = 16 * ti + 4 * fq; float sc4[4];
#pragma unroll
      for (int e = 0; e < 4; ++e) sc4[e] = __expf(gtot - ldsld<float>(L, GCL + (i0 + e) * 4));
#pragma unroll
      for (int q = 0; q < 2; ++q) {
        const int te = 2 * half + q; const f32x4 vn = uacc[q] - a[q]; f32x4 vs;
#pragma unroll
        for (int e = 0; e < 4; ++e) vs[e] = vn[e] * sc4[e];
        ldsst<u32x2>(L, VNT_ + (16 * te + fr) * 144 + i0 * 2, pack4(vn)); ldsst<u32x2>(L, VNS + (16 * te + fr) * 144 + i0 * 2, pack4(vs));
      }
    }
    __syncthreads();
    {
      bf16x8 af[2], vf[2][2], nsf[2], ktf[4][2];
#pragma unroll
      for (int q = 0; q < 4; ++q)
#pragma unroll
        for (int kk = 0; kk < 2; ++kk) ktf[q][kk] = ldsld<bf16x8>(L, KTSc + (16 * (4 * half + q) + fr) * 144 + kk * 64 + fq * 16);
#pragma unroll
      for (int kk = 0; kk < 2; ++kk) { af[kk] = ldsld<bf16x8>(L, AT + (16 * ti + fr) * 144 + kk * 64 + fq * 16); nsf[kk] = ldsld<bf16x8>(L, VNS + (16 * ti + fr) * 144 + kk * 64 + fq * 16);
#pragma unroll
        for (int q = 0; q < 2; ++q) vf[q][kk] = ldsld<bf16x8>(L, VNT_ + (16 * (2 * half + q) + fr) * 144 + kk * 64 + fq * 16); }
      const float cd = __expf(gtot);
      f32x4 ov[2];
#pragma unroll
      for (int q = 0; q < 2; ++q) ov[q] = (f32x4){0.f, 0.f, 0.f, 0.f};
#pragma unroll
      for (int q = 0; q < 4; ++q) accS[q] = accS[q] * cd;
#pragma unroll
      for (int kk = 0; kk < 2; ++kk) {
#pragma unroll
        for (int q = 0; q < 2; ++q) ov[q] = mma(vf[q][kk], af[kk], ov[q]);
#pragma unroll
        for (int q = 0; q < 4; ++q) accS[q] = mma(ktf[q][kk], nsf[kk], accS[q]);
      }
      const int i = 16 * ti + fr; const float eg = __expf(ldsld<float>(L, GCL + i * 4));
#pragma unroll
      for (int q = 0; q < 2; ++q) { const f32x4 o4 = qacc[q] * eg + ov[q];
        *(u32x2*)(O + (size_t)(64 * n + i) * 512 + h * 128 + es * 64 + 16 * (2 * half + q) + 4 * fq) = pack4(o4); }
    }
#pragma unroll
    for (int q = 0; q < 4; ++q) ldsst<u32x2>(L, STL + (16 * ti + fr) * 272 + (16 * (4 * half + q) + 4 * fq) * 2, pack4(accS[q]));
    if (s + 1 < 68) SCAN_LSTORE(KTSn, GCLn);
    __syncthreads();
  }
#undef SCAN_CHUNK
#undef SCAN_GLOAD
#undef SCAN_LSTORE
}

__device__ __forceinline__ void ofprep_phase(const Params& p, int l) {
  const int tid_ = otid(), lane = tid_ & 63, gw = blockIdx.x * 8 + (tid_ >> 6), nw = gridDim.x * 8;
  const bf16_t* O0 = (const bf16_t*)(lws(p.ws) + O_O); const bf16_t* O1 = O0 + (size_t)ROWS * 512; const bf16_t* Z = (const bf16_t*)(lws(p.ws) + O_Z); bf16_t* OF = (bf16_t*)(lws(p.ws) + O_OF);
  const float* og = p.o_gain + (size_t)l * 128 + (lane & 15) * 8;
  for (int r0 = gw; r0 < ROWS; r0 += 2 * nw) {
    u32x4 av[2], bv[2], zv[2];
#pragma unroll
    for (int q = 0; q < 2; ++q) { const int r = (r0 + q * nw) < ROWS ? (r0 + q * nw) : r0;
      av[q] = *(const u32x4*)(O0 + (size_t)r * 512 + lane * 8); bv[q] = *(const u32x4*)(O1 + (size_t)r * 512 + lane * 8); zv[q] = *(const u32x4*)(Z + (size_t)r * 512 + lane * 8); }
#pragma unroll
    for (int q = 0; q < 2; ++q) {
      const int r = r0 + q * nw; if (r >= ROWS) continue;
      const u32x4 a = av[q], bq = bv[q], zq = zv[q];
      float o[8]; float ss = 0.f;
#pragma unroll
      for (int e = 0; e < 4; ++e) { o[2 * e] = bflo(a[e]) + bflo(bq[e]); o[2 * e + 1] = bfhi(a[e]) + bfhi(bq[e]); ss += o[2 * e] * o[2 * e] + o[2 * e + 1] * o[2 * e + 1]; }
      ss += __shfl_xor(ss, 1); ss += __shfl_xor(ss, 2); ss += __shfl_xor(ss, 4); ss += __shfl_xor(ss, 8);
      const float rstd = rsqrtf(ss * (1.0f / 128.0f) + 1e-6f);
      float y[8];
#pragma unroll
      for (int e = 0; e < 4; ++e) { y[2 * e] = o[2 * e] * rstd * og[2 * e] * siluf_(bflo(zq[e])); y[2 * e + 1] = o[2 * e + 1] * rstd * og[2 * e + 1] * siluf_(bfhi(zq[e])); }
      u32x4 w; w.x = cvt_pk_bf16(y[0], y[1]); w.y = cvt_pk_bf16(y[2], y[3]); w.z = cvt_pk_bf16(y[4], y[5]); w.w = cvt_pk_bf16(y[6], y[7]);
      *(u32x4*)(OF + (size_t)r * 512 + lane * 8) = w;
    }
  }
}

#define XB_TMO      128
#define XB_XCNT(j)  (256  + 64 * (j))
#define XB_XSUB(j)  (1280 + 64 * (j))
#define XB_XGEN(j)  (2304 + 64 * (j))
#define XB_TOP      3328
#define XB_TOPGEN   3392
#define XCD_BAR_WORDS 3456
#define XB_SPIN_CAP (1u << 18)

__device__ __forceinline__ unsigned xb_ld(unsigned* p)              { return __hip_atomic_load(p, __ATOMIC_RELAXED, __HIP_MEMORY_SCOPE_AGENT); }
__device__ __forceinline__ unsigned xb_add(unsigned* p, unsigned v) { return __hip_atomic_fetch_add(p, v, __ATOMIC_RELAXED, __HIP_MEMORY_SCOPE_AGENT); }
__device__ __forceinline__ unsigned xb_xcc_id() { return (unsigned)__builtin_amdgcn_s_getreg((3 << 11) | 20) & 0xFu; }
#define XB_SPIN(cond, bar) do { unsigned _sp = 0; while (cond) { __builtin_amdgcn_s_sleep(1); \
    if ((++_sp & 255u) == 0u) { if (xb_ld(&(bar)[XB_TMO])) break; if (_sp > XB_SPIN_CAP) { atomicAdd(&(bar)[XB_TMO], 1u); break; } } } } while (0)

struct XcdBarrier {
    unsigned* bar; unsigned x;
    volatile LAS unsigned* st;
};

__device__ __forceinline__ XcdBarrier xcd_barrier_post(unsigned* bar, volatile LAS unsigned* st) {
    XcdBarrier b; b.bar = bar; b.x = xb_xcc_id(); b.st = st;
    if (threadIdx.x == 0) (void)xb_add(&bar[XB_XCNT(b.x)], 1u);
    return b;
}
__device__ __forceinline__ void xcd_barrier_complete(unsigned* bar, unsigned x, unsigned& nloc, unsigned& nx) {
    const unsigned G = gridDim.x * gridDim.y * gridDim.z;
    unsigned sum, cnt, mine, sp = 0u;
    for (;;) {
        sum = 0u; cnt = 0u; mine = 0u;
#pragma unroll
        for (unsigned j = 0; j < 16; ++j) { const unsigned c = xb_ld(&bar[XB_XCNT(j)]); sum += c; cnt += (c > 0u) ? 1u : 0u; mine = (j == x) ? c : mine; }
        if (sum == G) break;
        __builtin_amdgcn_s_sleep(1);
        if ((++sp & 255u) == 0u) { if (xb_ld(&bar[XB_TMO])) break; if (sp > XB_SPIN_CAP) { atomicAdd(&bar[XB_TMO], 1u); break; } }
    }
    nloc = mine > 0u ? mine : 1u; nx = cnt > 0u ? cnt : 1u;
}

__device__ __forceinline__ void xcd_barrier(const XcdBarrier& b) {
    asm volatile("s_waitcnt vmcnt(0)" ::: "memory");
    __syncthreads();
    if (threadIdx.x == 0) {
        unsigned* bar = b.bar;
        __builtin_amdgcn_s_waitcnt(0);
        unsigned nloc = b.st[0], nx = b.st[1];
        if (nloc == 0u) { xcd_barrier_complete(bar, b.x, nloc, nx); b.st[0] = nloc; b.st[1] = nx; }
        const unsigned old = xb_add(&bar[XB_XSUB(b.x)], 1u);
        const unsigned gen = old / nloc;
        if (old + 1u == (gen + 1u) * nloc) {
            __builtin_amdgcn_fence(__ATOMIC_RELEASE, "agent");
            asm volatile("s_waitcnt vmcnt(0)" ::: "memory");
            const unsigned og = xb_add(&bar[XB_TOP], 1u);
            const unsigned tg = og / nx;
            if (og + 1u == (tg + 1u) * nx) xb_add(&bar[XB_TOPGEN], 1u);
            else XB_SPIN(xb_ld(&bar[XB_TOPGEN]) == tg, bar);
            __builtin_amdgcn_fence(__ATOMIC_ACQUIRE, "agent");
            xb_add(&bar[XB_XGEN(b.x)], 1u);
            asm volatile("s_waitcnt vmcnt(0)" ::: "memory");
        } else {
            XB_SPIN(xb_ld(&bar[XB_XGEN(b.x)]) == gen, bar);
            __builtin_amdgcn_fence(__ATOMIC_ACQUIRE, "agent");
            asm volatile("s_waitcnt vmcnt(0)" ::: "memory");
        }
    }
    __syncthreads();
}


__device__ __forceinline__ float rdb(const bf16_t* s_, size_t n, size_t i) { float a = 0.f; for (size_t j = i; j < n; j += (size_t)RLAT * DM) a += __uint_as_float((unsigned)s_[j] << 16); return a; }
__device__ __forceinline__ float rdf(const float* s_, size_t n, size_t i) { float a = 0.f; for (size_t j = i; j < n; j += (size_t)RLAT * DM) a += s_[j]; return a; }
__device__ __forceinline__ void dump_phase(const Params& p, int which) {
  const size_t NO = (size_t)RLAT * DM; unsigned char* ws = lws(p.ws);
  for (size_t i = (size_t)blockIdx.x * NTHR + otid(); i < NO; i += (size_t)gridDim.x * NTHR) {
    float a = 0.f;
    if (which == 1) { a = rdb((const bf16_t*)(ws + O_QKV), (size_t)ROWS * 1536, i) + rdb((const bf16_t*)(ws + O_Z), (size_t)ROWS * 512, i) + rdb((const bf16_t*)(ws + O_PI), (size_t)ROWS * 256, i) + rdb((const bf16_t*)(ws + O_FI), (size_t)ROWS * 256, i) + rdf((const float*)(ws + O_AB), (size_t)ROWS * 16, i); }
    if (which == 2) { a = rdb((const bf16_t*)(ws + O_QN), (size_t)ROWS * 512, i) + rdb((const bf16_t*)(ws + O_KN), (size_t)ROWS * 512, i) + rdb((const bf16_t*)(ws + O_KNT), (size_t)ROWS * 512, i) + rdb((const bf16_t*)(ws + O_VNT), (size_t)ROWS * 512, i) + rdb((const bf16_t*)(ws + O_TT), (size_t)ROWS * 1024, i) + rdf((const float*)(ws + O_GC), (size_t)NCH * 4 * 2 * 64, i)
          + rdb((const bf16_t*)(ws + O_FBT), (size_t)NB * 256 * 4096, i) + rdf((const float*)(ws + O_UCS), (size_t)NB * CTX * 512, i); }
    if (which == 3) { a = rdb((const bf16_t*)(ws + O_O), (size_t)ROWS * 1024, i); }
    if (which == 4) { a = rdb((const bf16_t*)(ws + O_OF), (size_t)ROWS * 512, i) + rdb((const bf16_t*)(ws + O_HN), (size_t)ROWS * 1024, i); }
    if (which == 5) { a = rdb((const bf16_t*)(ws + O_MRG), (size_t)ROWS * 1024, i); }
    if ((__float_as_uint(a) & 0xffff0000u) == 0xaaaa0000u) a = 1234.5f;
    if (!(a == a) || fabsf(a) > 1e30f) a = 777.0f;
    a = a * 0.5f + 0.12345678f;
    p.out[i] = a;
  }
}
__global__ void __launch_bounds__(NTHR) fwd_megakernel(Params p) {
  ldsp L = (ldsp)g_shm;
  cg::grid_group grid = cg::this_grid();
  volatile LAS unsigned* xst = (volatile LAS unsigned*)(L + LDS_BYTES - 16);
  if (threadIdx.x < 4) xst[threadIdx.x] = 0u;
  if (threadIdx.x == 0) { const unsigned long long wa_ = (unsigned long long)p.ws; *(volatile LAS unsigned*)(L + LDS_BYTES - 32) = (unsigned)wa_; *(volatile LAS unsigned*)(L + LDS_BYTES - 28) = (unsigned)(wa_ >> 32); }
  __syncthreads();
  XcdBarrier xbar = xcd_barrier_post((unsigned*)(p.ws + O_BAR), xst);
#define GSYNC0() do { asm volatile("s_waitcnt vmcnt(0) lgkmcnt(0)" ::: "memory"); __builtin_amdgcn_fence(__ATOMIC_RELEASE, "agent"); grid.sync(); __builtin_amdgcn_fence(__ATOMIC_ACQUIRE, "agent"); } while (0)
#define GSYNC() xcd_barrier(xbar)
  const int G = gridDim.x, c = blockIdx.x;
#define X ((float*)(lws(p.ws) + O_X))
#define MOD ((const float*)(lws(p.ws) + O_MOD))
#define Hn ((bf16_t*)(lws(p.ws) + O_HN))
#ifndef NO_P0
  phase0(p, L);
#endif
  GSYNC0();
  for (int l = 0; l < DEPTH; ++l) {
    const float* modl = MOD + (size_t)l * 9 * 9216; const float* ng = p.norm_gain + (size_t)l * 3 * 1024; const int notlast = (l != DEPTH - 1) ? 1 : 0, nMx = notlast ? ROWS / 256 : RLAT / 256;
#ifndef PROBE_CONV
#define PROBE_CONV 1
#endif
    { int cur_ = 0;
      if (l == 0) { convert_ffn(p, p.w1gu, p.w1d, O_WGU, O_WD, L, cur_, c, G); convert_win(p, 0, L, cur_, c, G); }
      convert_mixer(p, l, L, cur_); }
    norm_phase(X, Hn, ng, modl, 0, 1, l > 0 ? (const float*)(lws(p.ws) + O_TT) : nullptr);
    GSYNC();
#ifndef PROBE_UP
#define PROBE_UP 1
#endif
    for (int rep_ = 0; rep_ < PROBE_UP; ++rep_)
    { pg8::PlainSched S{(const char*)Hn, (const char*)(lws(p.ws) + O_WGU), 2048, 2048, 16, ROWS / 256, 22, G, c}; EpiUp E{(bf16_t*)(lws(p.ws) + O_ACT)}; pg8::gemm_phase(L, S, E); }
    GSYNC();
    { pg8::ResSched S{(const char*)(lws(p.ws) + O_ACT), (const char*)(lws(p.ws) + O_WD), DFF * 2, DFF / 64, G, c, 0}; EpiResT<false> E{(float*)(p.ws + O_X), modl, 2, 0.5f}; pg8::gemm_phase(L, S, E); }
    if (1) { pg8::ResSched S{(const char*)(lws(p.ws) + O_ACT), (const char*)(lws(p.ws) + O_WD), DFF * 2, DFF / 64, G, c, 1}; EpiPart E{(float*)(lws(p.ws) + O_TT), modl, 2, 0.5f}; pg8::gemm_phase(L, S, E); }
    GSYNC();
#ifndef NO_MIXER
    norm_phase(X, Hn, ng + 1024, modl, 3, 4, (const float*)(lws(p.ws) + O_TT));
    GSYNC();
#ifndef PROBE_IN
#define PROBE_IN 1
#endif
    for (int rep_ = 0; rep_ < PROBE_IN; ++rep_)
    { pg8::PlainSched S{(const char*)Hn, (const char*)(lws(p.ws) + O_WIN), 2048, 2048, 16, ROWS / 256, NINP / 256, G, c};
      EpiIn E{(bf16_t*)(lws(p.ws) + O_QKV), (bf16_t*)(lws(p.ws) + O_Z), (bf16_t*)(lws(p.ws) + O_PI), (bf16_t*)(lws(p.ws) + O_FI), (float*)(lws(p.ws) + O_AB)}; pg8::gemm_phase(L, S, E); }
    GSYNC();
#ifndef PROBE_PREP
#define PROBE_PREP 1
#endif
    for (int rep_ = 0; rep_ < PROBE_PREP; ++rep_) {
    prep_phase(p, l, L);
    }
#ifndef NO_FPREP
    fourier_prep(p, L);
#endif
    GSYNC();
#if defined(DUMP) && DUMP == 2
    dump_phase(p, 2); return;
#endif
#ifndef PROBE_SCAN
#define PROBE_SCAN 1
#endif
#ifndef PROBE_OTHER
#define PROBE_OTHER 1
#endif
    for (int rep_ = 0; rep_ < PROBE_SCAN; ++rep_) {
#ifndef NO_SCAN
    if (c < 128) scan_phase(p, L, c);
#else
    if (c < 128) {}
#endif
    else for (int rep2_ = 0; rep2_ < PROBE_OTHER; ++rep2_) {
      __syncthreads();
      { FourSched S{(const char*)(lws(p.ws) + O_DFT), (const char*)(lws(p.ws) + O_FBT), c - 128}; EpiBf E{(bf16_t*)(lws(p.ws) + O_PPF) + 256, 512}; pg8::gemm_phase(L, S, E); }
      __syncthreads();
      ctx_fourier(p, L, c - 128, G - 128);
      pool_phase(p, L, c - 128, G - 128);
    }
    __syncthreads();
    }
    GSYNC();
#if defined(DUMP) && DUMP == 3
    dump_phase(p, 3); return;
#endif
#ifndef PROBE_OFP
#define PROBE_OFP 1
#endif
    for (int rep_ = 0; rep_ < PROBE_OFP; ++rep_) {
    ofprep_phase(p, l);
    norm_phase(X, Hn, ng + 1024, modl, 3, 4, nullptr);
    }
    GSYNC();
#if defined(DUMP) && DUMP == 4
    dump_phase(p, 4); return;
#endif
#ifndef PROBE_MRG
#define PROBE_MRG 1
#endif
    for (int rep_ = 0; rep_ < PROBE_MRG; ++rep_)
    { MergeSched S{(const char*)Hn, (const char*)(lws(p.ws) + O_OF), (const char*)(lws(p.ws) + O_PPF), (const char*)(lws(p.ws) + O_WG), (const char*)(lws(p.ws) + O_WCAT), G, c, RLAT / 256};
      EpiMerge E{(unsigned*)(lws(p.ws) + O_SCR) + (size_t)c * 2 * 32768, (bf16_t*)(lws(p.ws) + O_MRG)}; pg8::gemm_phase(L, S, E); }
    if (notlast) { MergeCtxSched S{(const char*)Hn, (const char*)(lws(p.ws) + O_OF), (const char*)(lws(p.ws) + O_PPF), (const char*)(lws(p.ws) + O_WG), (const char*)(lws(p.ws) + O_WCAT), c};
      EpiMergeCtx E{(unsigned*)(lws(p.ws) + O_SCR) + (size_t)c * 2 * 32768, (bf16_t*)(lws(p.ws) + O_PARTM)}; pg8::gemm_phase(L, S, E); }
    if (notlast && c >= 96) {
      int cur_ = 0; convert_ffn(p, p.w2gu + (size_t)l * 1024 * 2 * DFF, p.w2d + (size_t)l * DFF * 1024, O_WGU2, O_WD2, L, cur_, c - 96, G - 96);
      convert_ffn(p, p.w1gu + (size_t)(l + 1) * 1024 * 2 * DFF, p.w1d + (size_t)(l + 1) * DFF * 1024, O_WGU, O_WD, L, cur_, c - 96, G - 96);
      convert_win(p, l + 1, L, cur_, c - 96, G - 96); }
    GSYNC();
#if defined(DUMP) && DUMP == 5
    dump_phase(p, 5); return;
#endif
    { pg8::ResSched S{(const char*)(lws(p.ws) + O_MRG), (const char*)(lws(p.ws) + O_WOUT), 2048, 16, G, c, 0}; EpiResT<false> E{(float*)(p.ws + O_X), modl, 5, 1.0f}; pg8::gemm_phase(L, S, E); }
    if (notlast) { pg8::ResSched S{(const char*)(lws(p.ws) + O_PARTM) - (size_t)128 * 256 * 6144, (const char*)(lws(p.ws) + O_WOUT3), 6144, 48, G, c, 1}; EpiPart E{(float*)(lws(p.ws) + O_TT), modl, 5, 1.0f}; pg8::gemm_phase(L, S, E); }
    GSYNC();
#endif
    if (!notlast) { int cur_ = 0; convert_ffn(p, p.w2gu + (size_t)l * 1024 * 2 * DFF, p.w2d + (size_t)l * DFF * 1024, O_WGU2, O_WD2, L, cur_, c, G); }
    norm_phase(X, Hn, ng + 2048, modl, 6, 7, notlast ? (const float*)(lws(p.ws) + O_TT) : nullptr);
    GSYNC();
    { pg8::PlainSched S{(const char*)Hn, (const char*)(lws(p.ws) + O_WGU2), 2048, 2048, 16, nMx, 22, G, c}; EpiUp E{(bf16_t*)(lws(p.ws) + O_ACT)}; pg8::gemm_phase(L, S, E); }
    GSYNC();
    { pg8::ResSched S{(const char*)(lws(p.ws) + O_ACT), (const char*)(lws(p.ws) + O_WD2), DFF * 2, DFF / 64, G, c, 0}; EpiResT<false> E{(float*)(p.ws + O_X), modl, 8, 0.5f}; pg8::gemm_phase(L, S, E); }
    if (notlast) { pg8::ResSched S{(const char*)(lws(p.ws) + O_ACT), (const char*)(lws(p.ws) + O_WD2), DFF * 2, DFF / 64, G, c, 1}; EpiPart E{(float*)(lws(p.ws) + O_TT), modl, 8, 0.5f}; pg8::gemm_phase(L, S, E); }
    GSYNC();
  }
  final_norm(X, p.out, p.final_gain);
}

extern "C" void kernel_launch(void* const* d_in, const int* in_sizes, int n_in, void* d_out, int out_size, void* d_ws, size_t ws_size, hipStream_t stream) {
  (void)in_sizes; (void)n_in; (void)out_size;
  if (ws_size < WS_NEED) { fprintf(stderr, "workspace too small: %zu < %zu\n", ws_size, (size_t)WS_NEED); return; }
  static int grid_blocks = 0;
  if (!grid_blocks) {
    (void)hipFuncSetAttribute((const void*)fwd_megakernel, hipFuncAttributeMaxDynamicSharedMemorySize, LDS_BYTES);
    int dev = 0, cus = 0, per_cu = 0; (void)hipGetDevice(&dev); (void)hipDeviceGetAttribute(&cus, hipDeviceAttributeMultiprocessorCount, dev);
    (void)hipOccupancyMaxActiveBlocksPerMultiprocessor(&per_cu, fwd_megakernel, NTHR, LDS_BYTES);
    grid_blocks = cus * (per_cu > 0 ? 1 : 0);
    if (grid_blocks != 256) fprintf(stderr, "unexpected grid %d (cus %d per_cu %d)\n", grid_blocks, cus, per_cu);
  }
  Params p{};
  const float** f = (const float**)&p;
  for (int i = 0; i < 22; ++i) f[i] = (const float*)d_in[i];
  p.out = (float*)d_out; p.ws = (unsigned char*)d_ws;
  (void)hipMemsetAsync((unsigned char*)d_ws + O_BAR, 0, 16384, stream);
  void* args[] = {&p};
  hipError_t e = hipLaunchCooperativeKernel((void*)fwd_megakernel, dim3(grid_blocks), dim3(NTHR), args, LDS_BYTES, stream);
  if (e != hipSuccess) fprintf(stderr, "cooperative launch failed: %s (grid %d)\n", hipGetErrorString(e), grid_blocks);
}
```

```cpp
#include <hip/hip_runtime.h>
#include <hip/hip_cooperative_groups.h>
#include <cstdio>

namespace cg = cooperative_groups;

#define LAS __attribute__((address_space(3)))
typedef LAS unsigned char* ldsp;
typedef unsigned short bf16_t;
typedef short bf16x8 __attribute__((ext_vector_type(8)));
typedef float f32x4 __attribute__((ext_vector_type(4)));
typedef unsigned u32x4 __attribute__((ext_vector_type(4)));
typedef unsigned u32x2 __attribute__((ext_vector_type(2)));

constexpr int DM = 1024, NB = 8, SEQ = 4096, CTX = 256, DEPTH = 4;
constexpr int RLAT = NB * SEQ, ROWS = RLAT + NB * CTX;
constexpr int DFF = 2816, NMOD = 9, DPROJ = 5648;
constexpr int NCH = ROWS / 64;
constexpr int NINP = 2816;
constexpr int LDS_BYTES = 163840;
constexpr int NTHR = 512;

constexpr size_t al256(size_t x) { return (x + 255) & ~(size_t)255; }
constexpr size_t O_X = 0;
constexpr size_t O_MOD = O_X + (size_t)ROWS * DM * 4;
constexpr size_t O_DFT = al256(O_MOD + (size_t)DEPTH * 9 * 9216 * 4);
constexpr size_t O_WGU = O_DFT + (size_t)4096 * 4096 * 2;
constexpr size_t O_WD = O_WGU + (size_t)5632 * 1024 * 2;
constexpr size_t O_WIN = O_WD + (size_t)1024 * 2816 * 2;
constexpr size_t O_WG = O_WIN + (size_t)NINP * 1024 * 2;
constexpr size_t O_WCAT = O_WG + (size_t)3072 * 1024 * 2;
constexpr size_t O_WOUT = O_WCAT + (size_t)1024 * 1024 * 2;
constexpr size_t O_R = O_WOUT + (size_t)1024 * 1024 * 2;
constexpr size_t SZ_H = (size_t)ROWS * 1024 * 2;
constexpr size_t SZ_Q = (size_t)ROWS * 512 * 2;
constexpr size_t O_HN = O_R;
constexpr size_t O_ACT = O_R + SZ_H;
constexpr size_t O_QN = O_R;
constexpr size_t O_KN = O_R + SZ_Q;
constexpr size_t O_QKV = O_R + SZ_H;
constexpr size_t O_O = O_QKV;
constexpr size_t O_SCR = O_QKV;
constexpr size_t O_Z = O_QKV + (size_t)ROWS * 1536 * 2;
constexpr size_t O_PI = O_Z + SZ_Q;
constexpr size_t O_FI = O_PI + (size_t)ROWS * 256 * 2;
constexpr size_t O_AB = O_FI + (size_t)ROWS * 256 * 2;
constexpr size_t O_KNT = al256(O_AB + (size_t)ROWS * 16 * 4);
constexpr size_t O_VNT = O_KNT + SZ_Q;
constexpr size_t O_MRG = O_KNT;
constexpr size_t O_TT = O_VNT + SZ_Q;
constexpr size_t O_OF = O_TT;
constexpr size_t O_GC = O_TT + SZ_H;
constexpr size_t O_FBT = al256(O_GC + (size_t)NCH * 4 * 2 * 64 * 4);
constexpr size_t O_UCS = O_FBT + (size_t)NB * 256 * 4096 * 2;
constexpr size_t O_PPF = al256(O_UCS + (size_t)NB * CTX * 512 * 4);
constexpr size_t O_WGU2 = al256(O_PPF + SZ_Q);
constexpr size_t O_WD2 = O_WGU2 + (size_t)5632 * 1024 * 2;
constexpr size_t O_WOUT3 = al256(O_WD2 + (size_t)1024 * 2816 * 2);
constexpr size_t O_BAR = al256(O_WOUT3 + (size_t)1024 * 3072 * 2);
constexpr size_t O_PARTM = O_Z;
constexpr size_t WS_NEED = O_BAR + 16384;
static_assert(O_SCR + (size_t)256 * 2 * 262144 <= O_PI, "merge scratch overlaps");

struct Params {
  const float *x, *c, *ctx, *c_ctx, *w_ada, *b_ada, *norm_gain, *w1gu, *w1d, *w2gu, *w2d, *w_in, *conv_w, *a_log, *dt_bias, *o_gain, *w_a, *w_b,
      *pool_scale, *w_c, *w_out, *final_gain;
  float* out;
  unsigned char* ws;
};

typedef float f32x2_ __attribute__((ext_vector_type(2)));
typedef __bf16 bf16x2_ __attribute__((ext_vector_type(2)));
__device__ __forceinline__ unsigned cvt_pk_bf16(float lo, float hi) { const f32x2_ v = {lo, hi}; const bf16x2_ b = __builtin_convertvector(v, bf16x2_); return __builtin_bit_cast(unsigned, b); }
__device__ __forceinline__ float bflo(unsigned w) { return __uint_as_float(w << 16); }
__device__ __forceinline__ float bfhi(unsigned w) { return __uint_as_float(w & 0xffff0000u); }
__device__ __forceinline__ float sigmoidf_(float x) { return __builtin_amdgcn_rcpf(1.0f + __expf(-x)); }
__device__ __forceinline__ float siluf_(float x) { return x * __builtin_amdgcn_rcpf(1.0f + __expf(-x)); }
template <class T> __device__ __forceinline__ T ldsld(ldsp b, int off) { return *(const LAS T*)(b + off); }
template <class T> __device__ __forceinline__ void ldsst(ldsp b, int off, T v) { *(LAS T*)(b + off) = v; }
__device__ __forceinline__ f32x4 mma(bf16x8 a, bf16x8 b, f32x4 c) { return __builtin_amdgcn_mfma_f32_16x16x32_bf16(a, b, c, 0, 0, 0); }
__device__ __forceinline__ u32x2 pack4(f32x4 v) { u32x2 r; r.x = cvt_pk_bf16(v[0], v[1]); r.y = cvt_pk_bf16(v[2], v[3]); return r; }
__device__ __forceinline__ int otid() { int t = threadIdx.x; asm volatile("" : "+v"(t)); return t; }
extern __shared__ __attribute__((aligned(16))) unsigned char g_shm[];
__device__ __forceinline__ unsigned char* lws(unsigned char*) { ldsp Lb = (ldsp)g_shm; unsigned lo = *(volatile LAS unsigned*)(Lb + LDS_BYTES - 32), hi = *(volatile LAS unsigned*)(Lb + LDS_BYTES - 28);
  lo = __builtin_amdgcn_readfirstlane(lo); hi = __builtin_amdgcn_readfirstlane(hi); return (unsigned char*)(((unsigned long long)hi << 32) | (unsigned long long)lo); }
__device__ __forceinline__ void atomic_add_f32(float* q, float v) { asm volatile("global_atomic_add_f32 %0, %1, off sc1" : : "v"(q), "v"(v) : "memory"); }
__device__ __forceinline__ int modidx(int pm) { return pm < 128 ? (pm >> 4) : 8; }

namespace pg8 {
constexpr int BM = 256, BK = 64, HALF = 128, HTB = HALF * BK * 2, NXCD = 8, WGM = 8;
__device__ __forceinline__ int lds_byte(int r, int c) { const int st = (r >> 4) * 2 + (c >> 5), rr = r & 15, cc = c & 31, ob = rr * 64 + cc * 2; return st * 1024 + (ob ^ (((ob >> 9) & 1) << 5)); }
__device__ __forceinline__ void stage_rc(int b, int& R, int& C) { const int st = b / 1024, sb = b % 1024, swz = sb ^ (((sb >> 9) & 1) << 5); R = (st >> 1) * 16 + swz / 64; C = (st & 1) * 32 + (swz % 64) / 2; }
__device__ __forceinline__ int perm32(int rho) { const int n = rho >> 4, i = rho & 15; return 8 * (i >> 2) + 4 * n + (i & 3); }

struct Unit { const char* A; const char* B; int lda, ldb, nt, pm, pn, seg; };

__device__ __forceinline__ bool tile_of(int nM, int nN, int G, int c, int i, int& pm, int& pn) {
  const int nwg = nM * nN; const long Lq = (long)i * G + c; if (Lq >= nwg) return false;
  int wgid = (int)Lq; { const int q = nwg / NXCD, r = nwg % NXCD, xcd = wgid % NXCD, off = wgid / NXCD; wgid = (xcd < r ? xcd * (q + 1) : r * (q + 1) + (xcd - r) * q) + off; }
  const int nig = WGM * nN, gid = wgid / nig, fm = gid * WGM, gsz = (nM - fm) < WGM ? (nM - fm) : WGM;
  pm = fm + ((wgid % nig) % gsz); pn = (wgid % nig) / gsz; return true;
}
struct PlainSched {
  static constexpr bool VARLDA = false;
  const char* A; const char* B; int lda, ldb, nt, nM, nN, G, c;
  __device__ __forceinline__ bool next(int i, Unit& u) const {
    int pm, pn; if (!tile_of(nM, nN, G, c, i, pm, pn)) return false;
    u.A = A + (size_t)pm * 256 * lda; u.B = B + (size_t)pn * 256 * ldb; u.lda = lda; u.ldb = ldb; u.nt = nt; u.pm = pm; u.pn = pn; u.seg = 0; return true;
  }
};

struct ResSched {
  static constexpr bool VARLDA = false;
  const char* A; const char* B; int ld, nt, G, c, mode;
  __device__ __forceinline__ bool next(int i, Unit& u) const {
    u.lda = ld; u.ldb = ld;
    if (mode == 0) { int pm, pn; if (i >= 2 || !tile_of(128, 4, G, c, i, pm, pn)) return false;
      u.A = A + (size_t)pm * 256 * ld; u.B = B + (size_t)pn * 256 * ld; u.nt = nt; u.pm = pm; u.pn = pn; u.seg = 0; return true; }
#ifdef NO_SPLITK
    if (i > 0 || c >= 32) return false;
    { const int pm = 128 + (c >> 2), pn = c & 3; u.A = A + (size_t)pm * 256 * ld; u.B = B + (size_t)pn * 256 * ld; u.nt = nt; u.pm = pm; u.pn = pn; u.seg = 0; return true; }
#endif
    if (i > 0 || c >= 256) return false;
    const int pm = 128 + (c >> 5), pn = (c >> 3) & 3, kp = c & 7;
    const int base = (nt / 16) * 2, extra = (nt - base * 8) / 2;
    const int k0 = kp * base + 2 * (kp < extra ? kp : extra), np = base + (kp < extra ? 2 : 0);
    u.A = A + (size_t)pm * 256 * ld + (size_t)k0 * 128; u.B = B + (size_t)pn * 256 * ld + (size_t)k0 * 128; u.nt = np; u.pm = pm; u.pn = pn; u.seg = kp; return true;
  }
};
template <class Epi, class Sched>
__device__ __forceinline__ void gemm_phase(ldsp lds, const Sched& S, const Epi& E) {
  const int tid = otid(), wid = __builtin_amdgcn_readfirstlane(tid >> 6), lane = tid & 63, wr = wid >> 2, wc = wid & 3, fr = lane & 15, fq = lane >> 4;
  unsigned rA[2], rB[2], c2[2];
#pragma unroll
  for (int i = 0; i < 2; ++i) { int R, C; stage_rc(tid * 16 + i * 8192, R, C); rA[i] = (unsigned)R; rB[i] = (unsigned)(Epi::PERM ? ((R & ~31) + perm32(R & 31)) : R); c2[i] = (unsigned)C * 2u; }
  const size_t kstep = (size_t)(BK * 2);
  const unsigned ldsw = (unsigned)wid * 1024u;
  const int aoff = lds_byte(wr * 64 + fr, fq * 8), boff = lds_byte(wc * 32 + fr, fq * 8);
#define PG8_SA(b, h) (((b) * 2 + (h)) * HTB)
#define PG8_SB(b, h) ((4 + (b) * 2 + (h)) * HTB)
#define PG8_STAGE(bufoff, gbase, voff) do { _Pragma("unroll") for (int _i = 0; _i < 2; ++_i) \
    __builtin_amdgcn_global_load_lds((const unsigned*)((const char*)(gbase) + (voff)[_i]), (LAS unsigned*)(lds + (bufoff) + ldsw + _i * 8192), 16, 0, 0); } while (0)
#define PG8_LDA(dst, b, h) do { _Pragma("unroll") for (int m = 0; m < 4; ++m) _Pragma("unroll") for (int k = 0; k < 2; ++k) dst[m][k] = *(const LAS bf16x8*)(lds + PG8_SA(b, h) + aoff + m * 2048 + k * 1024); } while (0)
#define PG8_LDB(dst, b, h) do { _Pragma("unroll") for (int n = 0; n < 2; ++n) _Pragma("unroll") for (int k = 0; k < 2; ++k) dst[n][k] = *(const LAS bf16x8*)(lds + PG8_SB(b, h) + boff + n * 2048 + k * 1024); } while (0)
#define PG8_MMA(ai, bj, At, Bt) do { __builtin_amdgcn_s_setprio(1); _Pragma("unroll") for (int m = 0; m < 4; ++m) _Pragma("unroll") for (int n = 0; n < 2; ++n) _Pragma("unroll") for (int k = 0; k < 2; ++k) \
    acc[ai][bj][m][n] = __builtin_amdgcn_mfma_f32_16x16x32_bf16(Bt[n][k], At[m][k], acc[ai][bj][m][n], 0, 0, 0); __builtin_amdgcn_s_setprio(0); } while (0)
#define PG8_WAIT_V(n) asm volatile("s_waitcnt vmcnt(" #n ")" ::: "memory")
#define PG8_WAIT_L(n) asm volatile("s_waitcnt lgkmcnt(" #n ")" ::: "memory")
#define PG8_BAR __builtin_amdgcn_s_barrier()
#define PG8_SCHED __builtin_amdgcn_sched_barrier(0)
  Unit cur, nxt; int ui = 0;
  if (!S.next(0, cur)) return;
  float zz_; asm volatile("v_mov_b32 %0, 0" : "=v"(zz_));
  f32x4 acc[2][2][4][2];
#pragma unroll
  for (int a = 0; a < 2; ++a)
#pragma unroll
    for (int b = 0; b < 2; ++b)
#pragma unroll
      for (int m = 0; m < 4; ++m)
#pragma unroll
        for (int n = 0; n < 2; ++n) acc[a][b][m][n] = (f32x4){zz_, zz_, zz_, zz_};
  bf16x8 At[4][2], B0[2][2], B1[2][2];
  const char* cA = cur.A; const char* cB = cur.B; int ldA = cur.lda; const int ldB = cur.ldb;
  unsigned voffA[2], voffB[2];
#pragma unroll
  for (int i = 0; i < 2; ++i) { voffA[i] = rA[i] * (unsigned)ldA + c2[i]; voffB[i] = rB[i] * (unsigned)ldB + c2[i]; }
  const size_t hB = (size_t)HALF * ldB;
  {
    const size_t hA = (size_t)HALF * ldA;
    PG8_STAGE(PG8_SB(0, 0), cB, voffB); PG8_STAGE(PG8_SA(0, 0), cA, voffA); PG8_STAGE(PG8_SB(0, 1), cB + hB, voffB); PG8_STAGE(PG8_SA(0, 1), cA + hA, voffA);
    if (wr == 1) PG8_BAR;
    PG8_WAIT_V(4); PG8_BAR;
    PG8_STAGE(PG8_SB(1, 0), cB + kstep, voffB); PG8_STAGE(PG8_SA(1, 0), cA + kstep, voffA); PG8_STAGE(PG8_SB(1, 1), cB + hB + kstep, voffB);
    PG8_WAIT_V(6); PG8_BAR;
  }
  for (;;) {
    const bool has_next = S.next(ui + 1, nxt);
    const char* nA = has_next ? nxt.A : cA; const char* nB = has_next ? nxt.B : cB;
    const int nldA = has_next ? nxt.lda : ldA;
    const int nt = cur.nt;
    const size_t hA = (size_t)HALF * ldA;
    for (int t = 0; t < nt; t += 2) {
      const bool last = (t == nt - 2);
      const char* a1 = cA + (size_t)(t + 1) * kstep;
      const char* a2 = last ? nA : cA + (size_t)(t + 2) * kstep; const char* b2 = last ? nB : cB + (size_t)(t + 2) * kstep;
      const size_t h2A = (size_t)HALF * (last ? nldA : ldA);
      const char* a3 = a2 + kstep; const char* b3 = b2 + kstep;
      PG8_LDB(B0, 0, 0); PG8_SCHED; PG8_LDA(At, 0, 0); PG8_STAGE(PG8_SA(1, 1), a1 + hA, voffA);
      if (Sched::VARLDA) { if (last) {
#pragma unroll
        for (int i = 0; i < 2; ++i) voffA[i] = rA[i] * (unsigned)nldA + c2[i]; } }
      PG8_WAIT_L(8); PG8_BAR; PG8_WAIT_L(0); PG8_MMA(0, 0, At, B0); PG8_BAR; PG8_SCHED;
      PG8_LDB(B1, 0, 1); PG8_STAGE(PG8_SB(0, 0), b2, voffB);
      PG8_BAR; PG8_WAIT_L(0); PG8_MMA(0, 1, At, B1); PG8_BAR;
      PG8_LDA(At, 0, 1); PG8_STAGE(PG8_SA(0, 0), a2, voffA);
      PG8_BAR; PG8_WAIT_L(0); PG8_MMA(1, 0, At, B0); PG8_BAR; PG8_SCHED;
      PG8_STAGE(PG8_SB(0, 1), b2 + hB, voffB);
      PG8_WAIT_V(6); PG8_BAR; PG8_MMA(1, 1, At, B1); PG8_BAR;
      PG8_LDB(B0, 1, 0); PG8_SCHED; PG8_LDA(At, 1, 0); PG8_STAGE(PG8_SA(0, 1), a2 + h2A, voffA);
      PG8_WAIT_L(8); PG8_BAR; PG8_WAIT_L(0); PG8_MMA(0, 0, At, B0); PG8_BAR; PG8_SCHED;
      PG8_LDB(B1, 1, 1); PG8_STAGE(PG8_SB(1, 0), b3, voffB);
      PG8_BAR; PG8_WAIT_L(0); PG8_MMA(0, 1, At, B1); PG8_BAR;
      PG8_LDA(At, 1, 1); PG8_STAGE(PG8_SA(1, 0), a3, voffA);
      PG8_BAR; PG8_WAIT_L(0); PG8_MMA(1, 0, At, B0); PG8_BAR; PG8_SCHED;
      PG8_STAGE(PG8_SB(1, 1), b3 + hB, voffB);
      PG8_WAIT_V(6); PG8_BAR; PG8_MMA(1, 1, At, B1); PG8_BAR;
    }
    E(acc, cur, wr, wc, fr, fq);
    if (!has_next) break;
#pragma unroll
    for (int a = 0; a < 2; ++a)
#pragma unroll
      for (int b = 0; b < 2; ++b)
#pragma unroll
        for (int m = 0; m < 4; ++m)
#pragma unroll
          for (int n = 0; n < 2; ++n) acc[a][b][m][n] = (f32x4){zz_, zz_, zz_, zz_};
    cur = nxt; cA = nA; cB = nB; ldA = nldA; ++ui;
  }
  PG8_WAIT_V(0);
  if (wr == 0) PG8_BAR;
  PG8_BAR;
#undef PG8_SA
#undef PG8_SB
#undef PG8_STAGE
#undef PG8_LDA
#undef PG8_LDB
#undef PG8_MMA
#undef PG8_WAIT_V
#undef PG8_WAIT_L
#undef PG8_BAR
#undef PG8_SCHED
}
}
using pg8::Unit;
typedef f32x4 AccT[2][2][4][2];

struct EpiUp {
  static constexpr bool PERM = true;
  bf16_t* act;
  __device__ __forceinline__ void operator()(const AccT& acc, const Unit& u, int wr, int wc, int fr, int fq) const {
    const int row0 = u.pm * 256 + wr * 64 + fr, col0 = u.pn * 128 + wc * 32 + 8 * fq;
#pragma unroll
    for (int ai = 0; ai < 2; ++ai)
#pragma unroll
      for (int m = 0; m < 4; ++m) {
        const f32x4 a0 = acc[ai][0][m][0], a1 = acc[ai][0][m][1], u0 = acc[ai][1][m][0], u1 = acc[ai][1][m][1];
        u32x4 w;
        w.x = cvt_pk_bf16(siluf_(a0[0]) * u0[0], siluf_(a0[1]) * u0[1]); w.y = cvt_pk_bf16(siluf_(a0[2]) * u0[2], siluf_(a0[3]) * u0[3]);
        w.z = cvt_pk_bf16(siluf_(a1[0]) * u1[0], siluf_(a1[1]) * u1[1]); w.w = cvt_pk_bf16(siluf_(a1[2]) * u1[2], siluf_(a1[3]) * u1[3]);
        *(u32x4*)(act + (size_t)(row0 + ai * 128 + m * 16) * DFF + col0) = w;
      }
  }
};
template <bool ATOMIC> struct EpiResT {
  static constexpr bool PERM = false;
  float* X; const float* modl; int gidx; float scale;
  __device__ __forceinline__ void operator()(const AccT& acc, const Unit& u, int wr, int wc, int fr, int fq) const {
    const int row0 = u.pm * 256 + wr * 64 + fr, col0 = u.pn * 256 + wc * 32 + 4 * fq;
    const float* g = modl + (size_t)(modidx(u.pm) * 9 + gidx) * 1024 + col0;
    f32x4 gv[2][2];
#pragma unroll
    for (int bj = 0; bj < 2; ++bj)
#pragma unroll
      for (int n = 0; n < 2; ++n) gv[bj][n] = *(const f32x4*)(g + bj * 128 + n * 16) * scale;
#pragma unroll
    for (int ai = 0; ai < 2; ++ai)
#pragma unroll
      for (int mh = 0; mh < 2; ++mh) {
        f32x4 xv[2][2][2];
#pragma unroll
        for (int m2 = 0; m2 < 2; ++m2)
#pragma unroll
          for (int bj = 0; bj < 2; ++bj)
#pragma unroll
            for (int n = 0; n < 2; ++n) xv[m2][bj][n] = *(const f32x4*)(X + (size_t)(row0 + ai * 128 + (mh * 2 + m2) * 16) * DM + col0 + bj * 128 + n * 16);
        asm volatile("" ::: "memory");
#pragma unroll
        for (int m2 = 0; m2 < 2; ++m2)
#pragma unroll
          for (int bj = 0; bj < 2; ++bj)
#pragma unroll
            for (int n = 0; n < 2; ++n) *(f32x4*)(X + (size_t)(row0 + ai * 128 + (mh * 2 + m2) * 16) * DM + col0 + bj * 128 + n * 16) = xv[m2][bj][n] + gv[bj][n] * acc[ai][bj][mh * 2 + m2][n];
        asm volatile("" ::: "memory");
      }
  }
};
struct EpiPart {
  static constexpr bool PERM = false;
  float* part; const float* modl; int gidx; float scale;
  __device__ __forceinline__ void operator()(const AccT& acc, const Unit& u, int wr, int wc, int fr, int fq) const {
    const int row0 = (u.pm - 128) * 256 + wr * 64 + fr, col0 = u.pn * 256 + wc * 32 + 4 * fq;
    const float* g = modl + (size_t)(8 * 9 + gidx) * 1024 + col0;
    float* pb = part + (size_t)u.seg * 2048 * 1024;
    f32x4 gv[2][2];
#pragma unroll
    for (int bj = 0; bj < 2; ++bj)
#pragma unroll
      for (int n = 0; n < 2; ++n) gv[bj][n] = *(const f32x4*)(g + bj * 128 + n * 16) * scale;
#pragma unroll
    for (int ai = 0; ai < 2; ++ai)
#pragma unroll
      for (int m = 0; m < 4; ++m) {
        float* rowp = pb + (size_t)(row0 + ai * 128 + m * 16) * DM + col0;
#pragma unroll
        for (int bj = 0; bj < 2; ++bj)
#pragma unroll
          for (int n = 0; n < 2; ++n) *(f32x4*)(rowp + bj * 128 + n * 16) = gv[bj][n] * acc[ai][bj][m][n];
      }
  }
};
struct EpiIn {
  static constexpr bool PERM = true;
  bf16_t *qkv, *z, *pi, *fi; float* ab;
  __device__ __forceinline__ void operator()(const AccT& acc, const Unit& u, int wr, int wc, int fr, int fq) const {
    const int row0 = u.pm * 256 + wr * 64 + fr;
    if (u.pn == 10) {
      if (wc == 0 && fq < 2) {
#pragma unroll
        for (int ai = 0; ai < 2; ++ai)
#pragma unroll
          for (int m = 0; m < 4; ++m) {
            float* rp = ab + (size_t)(row0 + ai * 128 + m * 16) * 16 + 8 * fq;
            *(f32x4*)(rp) = acc[ai][0][m][0]; *(f32x4*)(rp + 4) = acc[ai][0][m][1];
          }
      }
      return;
    }
    bf16_t* base; int ld, ct;
    if (u.pn < 6) { base = qkv; ld = 1536; ct = u.pn * 256; } else if (u.pn < 8) { base = z; ld = 512; ct = (u.pn - 6) * 256; } else if (u.pn == 8) { base = pi; ld = 256; ct = 0; } else { base = fi; ld = 256; ct = 0; }
    const int col0 = ct + wc * 32 + 8 * fq;
#pragma unroll
    for (int ai = 0; ai < 2; ++ai)
#pragma unroll
      for (int m = 0; m < 4; ++m) {
        bf16_t* rowp = base + (size_t)(row0 + ai * 128 + m * 16) * ld + col0;
#pragma unroll
        for (int bj = 0; bj < 2; ++bj) { const f32x4 v0 = acc[ai][bj][m][0], v1 = acc[ai][bj][m][1]; u32x4 w; w.x = cvt_pk_bf16(v0[0], v0[1]); w.y = cvt_pk_bf16(v0[2], v0[3]); w.z = cvt_pk_bf16(v1[0], v1[1]); w.w = cvt_pk_bf16(v1[2], v1[3]);
          *(u32x4*)(rowp + bj * 128) = w; }
      }
  }
};
struct EpiBf {
  static constexpr bool PERM = true;
  bf16_t* O; int ld;
  __device__ __forceinline__ void operator()(const AccT& acc, const Unit& u, int wr, int wc, int fr, int fq) const {
    const int row0 = u.pm * 256 + wr * 64 + fr, col0 = u.pn * 256 + wc * 32 + 8 * fq;
#pragma unroll
    for (int ai = 0; ai < 2; ++ai)
#pragma unroll
      for (int m = 0; m < 4; ++m) {
        bf16_t* rowp = O + (size_t)(row0 + ai * 128 + m * 16) * ld + col0;
#pragma unroll
        for (int bj = 0; bj < 2; ++bj) { const f32x4 v0 = acc[ai][bj][m][0], v1 = acc[ai][bj][m][1]; u32x4 w; w.x = cvt_pk_bf16(v0[0], v0[1]); w.y = cvt_pk_bf16(v0[2], v0[3]); w.z = cvt_pk_bf16(v1[0], v1[1]); w.w = cvt_pk_bf16(v1[2], v1[3]);
          *(u32x4*)(rowp + bj * 128) = w; }
      }
  }
};
struct EpiMerge {
  static constexpr bool PERM = true;
  unsigned* scr;
  bf16_t* mrg;
  __device__ __forceinline__ void operator()(const AccT& acc, const Unit& u, int wr, int wc, int fr, int fq) const {
    const int tid_ = otid(); u32x4* S1 = (u32x4*)scr + tid_; u32x4* Mx = (u32x4*)scr + 16 * 512 + tid_;
    const int seg = u.seg;
    if ((seg & 1) == 0) {
#pragma unroll
      for (int ai = 0; ai < 2; ++ai)
#pragma unroll
        for (int bj = 0; bj < 2; ++bj)
#pragma unroll
          for (int m = 0; m < 4; ++m) { const f32x4 v0 = acc[ai][bj][m][0], v1 = acc[ai][bj][m][1]; u32x4 w;
            w.x = cvt_pk_bf16(sigmoidf_(v0[0]), sigmoidf_(v0[1])); w.y = cvt_pk_bf16(sigmoidf_(v0[2]), sigmoidf_(v0[3])); w.z = cvt_pk_bf16(sigmoidf_(v1[0]), sigmoidf_(v1[1])); w.w = cvt_pk_bf16(sigmoidf_(v1[2]), sigmoidf_(v1[3]));
            S1[((ai * 2 + bj) * 4 + m) * 512] = w; }
    } else {
      const int row0 = u.pm * 256 + wr * 64 + fr, col0 = u.pn * 256 + wc * 32 + 8 * fq;
#pragma unroll
      for (int ai = 0; ai < 2; ++ai)
#pragma unroll
        for (int bj = 0; bj < 2; ++bj) {
          u32x4 gq[4], mq[4];
#pragma unroll
          for (int m = 0; m < 4; ++m) { const int ix = ((ai * 2 + bj) * 4 + m) * 512; gq[m] = S1[ix]; mq[m] = (seg >= 3) ? Mx[ix] : (u32x4){0u, 0u, 0u, 0u}; }
          asm volatile("" ::: "memory");
#pragma unroll
          for (int m = 0; m < 4; ++m) {
            const int ix = ((ai * 2 + bj) * 4 + m) * 512; const u32x4 g = gq[m], q = mq[m]; const f32x4 v0 = acc[ai][bj][m][0], v1 = acc[ai][bj][m][1];
            float t[8] = {bflo(g.x) * v0[0], bfhi(g.x) * v0[1], bflo(g.y) * v0[2], bfhi(g.y) * v0[3], bflo(g.z) * v1[0], bfhi(g.z) * v1[1], bflo(g.w) * v1[2], bfhi(g.w) * v1[3]};
            t[0] += bflo(q.x); t[1] += bfhi(q.x); t[2] += bflo(q.y); t[3] += bfhi(q.y); t[4] += bflo(q.z); t[5] += bfhi(q.z); t[6] += bflo(q.w); t[7] += bfhi(q.w);
            u32x4 w; w.x = cvt_pk_bf16(t[0], t[1]); w.y = cvt_pk_bf16(t[2], t[3]); w.z = cvt_pk_bf16(t[4], t[5]); w.w = cvt_pk_bf16(t[6], t[7]);
            if (seg < 5) Mx[ix] = w; else *(u32x4*)(mrg + (size_t)(row0 + ai * 128 + m * 16) * DM + col0 + bj * 128) = w;
          }
          asm volatile("" ::: "memory");
        }
    }
  }
};
struct MergeSched {
  static constexpr bool VARLDA = true;
  const char *hn, *of, *ppf, *wg, *wcat; int G, c, nM;
  __device__ __forceinline__ bool next(int i, Unit& u) const {
    const int round = i / 6, seg = i - round * 6; int pm, pn; if (!pg8::tile_of(nM, 4, G, c, round, pm, pn)) return false;
    const int br = seg >> 1;
    u.pm = pm; u.pn = pn; u.seg = seg; u.ldb = 2048;
    if ((seg & 1) == 0) { u.A = hn + (size_t)pm * 256 * 2048; u.lda = 2048; u.B = wg + (size_t)(br * 1024 + pn * 256) * 2048; u.nt = 16; }
    else {
      u.lda = 1024;
      if (br == 0) { u.A = of + (size_t)pm * 256 * 1024; u.B = wcat + (size_t)pn * 256 * 2048; u.nt = 8; }
      else if (br == 1) { u.A = ppf + (size_t)pm * 256 * 1024 + (pn >> 1) * 256; u.B = wcat + (size_t)pn * 256 * 2048 + 512 * 2 + (pn >> 1) * 256; u.nt = 2; }
      else { u.A = ppf + (size_t)pm * 256 * 1024 + 256 * 2; u.B = wcat + (size_t)pn * 256 * 2048 + 768 * 2; u.nt = 4; }
    }
    return true;
  }
};
struct MergeCtxSched {
  static constexpr bool VARLDA = true;
  const char *hn, *of, *ppf, *wg, *wcat; int c;
  __device__ __forceinline__ bool next(int i, Unit& u) const {
    if (i > 1 || c >= 96) return false;
    const int tile = c / 3, br = c - tile * 3, pm = 128 + (tile >> 2), pn = tile & 3;
    u.pm = pm; u.pn = pn; u.seg = br * 2 + i; u.ldb = 2048;
    if (i == 0) { u.A = hn + (size_t)pm * 256 * 2048; u.lda = 2048; u.B = wg + (size_t)(br * 1024 + pn * 256) * 2048; u.nt = 16; }
    else { u.lda = 1024;
      if (br == 0) { u.A = of + (size_t)pm * 256 * 1024; u.B = wcat + (size_t)pn * 256 * 2048; u.nt = 8; }
      else if (br == 1) { u.A = ppf + (size_t)pm * 256 * 1024 + (pn >> 1) * 256; u.B = wcat + (size_t)pn * 256 * 2048 + 512 * 2 + (pn >> 1) * 256; u.nt = 2; }
      else { u.A = ppf + (size_t)pm * 256 * 1024 + 256 * 2; u.B = wcat + (size_t)pn * 256 * 2048 + 768 * 2; u.nt = 4; } }
    return true;
  }
};
struct EpiMergeCtx {
  static constexpr bool PERM = true;
  unsigned* scr; bf16_t* partm;
  __device__ __forceinline__ void operator()(const AccT& acc, const Unit& u, int wr, int wc, int fr, int fq) const {
    const int tid_ = otid(); u32x4* S1 = (u32x4*)scr + tid_;
    if ((u.seg & 1) == 0) {
#pragma unroll
      for (int ai = 0; ai < 2; ++ai)
#pragma unroll
        for (int bj = 0; bj < 2; ++bj)
#pragma unroll
          for (int m = 0; m < 4; ++m) { const f32x4 v0 = acc[ai][bj][m][0], v1 = acc[ai][bj][m][1]; u32x4 w;
            w.x = cvt_pk_bf16(sigmoidf_(v0[0]), sigmoidf_(v0[1])); w.y = cvt_pk_bf16(sigmoidf_(v0[2]), sigmoidf_(v0[3])); w.z = cvt_pk_bf16(sigmoidf_(v1[0]), sigmoidf_(v1[1])); w.w = cvt_pk_bf16(sigmoidf_(v1[2]), sigmoidf_(v1[3]));
            S1[((ai * 2 + bj) * 4 + m) * 512] = w; }
    } else {
      const int br = u.seg >> 1, row0 = (u.pm - 128) * 256 + wr * 64 + fr, col0 = br * 1024 + u.pn * 256 + wc * 32 + 8 * fq;
#pragma unroll
      for (int ai = 0; ai < 2; ++ai) {
        u32x4 gq[2][4];
#pragma unroll
        for (int bj = 0; bj < 2; ++bj)
#pragma unroll
          for (int m = 0; m < 4; ++m) gq[bj][m] = S1[((ai * 2 + bj) * 4 + m) * 512];
        asm volatile("" ::: "memory");
#pragma unroll
        for (int m = 0; m < 4; ++m)
#pragma unroll
          for (int bj = 0; bj < 2; ++bj) {
            const u32x4 g = gq[bj][m]; const f32x4 v0 = acc[ai][bj][m][0], v1 = acc[ai][bj][m][1];
            u32x4 w; w.x = cvt_pk_bf16(bflo(g.x) * v0[0], bfhi(g.x) * v0[1]); w.y = cvt_pk_bf16(bflo(g.y) * v0[2], bfhi(g.y) * v0[3]); w.z = cvt_pk_bf16(bflo(g.z) * v1[0], bfhi(g.z) * v1[1]); w.w = cvt_pk_bf16(bflo(g.w) * v1[2], bfhi(g.w) * v1[3]);
            *(u32x4*)(partm + (size_t)(row0 + ai * 128 + m * 16) * 3072 + col0 + bj * 128) = w;
          }
      }
    }
  }
};
struct FourSched {
  static constexpr bool VARLDA = false;
  const char *dft, *fbt; int c;
  __device__ __forceinline__ bool next(int i, Unit& u) const {
    if (i > 0) return false;
    const int b = c >> 4, pm = c & 15;
    u.A = dft + (size_t)pm * 256 * 8192; u.B = fbt + (size_t)b * 256 * 8192; u.lda = 8192; u.ldb = 8192; u.nt = 64; u.pm = b * 16 + pm; u.pn = 0; u.seg = 0; return true;
  }
};

template <class F>
__device__ __forceinline__ void convT(const float* W, int ldw, int K, int nrows, bf16_t* dst, int ldd, int k0d, F srccol, ldsp L, int& cursor, int wg, int G) {
  const int tid = otid(), ntk = K >> 6, ntiles = (nrows >> 6) * ntk;
  int t0 = (wg - cursor % G + G) % G;
  for (; t0 < ntiles; t0 += 4 * G) {
    float v[4][8];
#pragma unroll
    for (int u = 0; u < 4; ++u) {
      const int t = t0 + u * G;
      if (t < ntiles) {
        const int tr = t / ntk, tk = t - tr * ntk, r0 = tr * 64, kk0 = tk * 64; const int i = tid & 63, sc = srccol(r0 + i);
#pragma unroll
        for (int it = 0; it < 8; ++it) { const int kk = (tid >> 6) + 8 * it; v[u][it] = sc >= 0 ? W[(size_t)(kk0 + kk) * ldw + sc] : 0.f; }
      }
    }
#pragma unroll
    for (int u = 0; u < 4; ++u) { if (t0 + u * G < ntiles) {
#pragma unroll
      for (int it = 0; it < 8; ++it) ldsst<float>(L, u * 16640 + (((tid >> 6) + 8 * it) * 65 + (tid & 63)) * 4, v[u][it]); } }
    __syncthreads();
#pragma unroll
    for (int u = 0; u < 4; ++u) {
      const int t = t0 + u * G;
      if (t < ntiles) {
        const int tr = t / ntk, tk = t - tr * ntk, r0 = tr * 64, kk0 = tk * 64; const int ii = tid >> 3, kv = (tid & 7) * 8; float o[8];
#pragma unroll
        for (int e = 0; e < 8; ++e) o[e] = ldsld<float>(L, u * 16640 + ((kv + e) * 65 + ii) * 4);
        u32x4 w; w.x = cvt_pk_bf16(o[0], o[1]); w.y = cvt_pk_bf16(o[2], o[3]); w.z = cvt_pk_bf16(o[4], o[5]); w.w = cvt_pk_bf16(o[6], o[7]);
        *(u32x4*)(dst + (size_t)(r0 + ii) * ldd + k0d + kk0 + kv) = w;
      }
    }
    __syncthreads();
  }
  cursor += ntiles;
}

__device__ __forceinline__ void convert_ffn(const Params& p, const float* wgu, const float* wd, size_t o_gu, size_t o_d, ldsp L, int& cur, int wg, int nwg) {
  convT(wgu, 2 * DFF, 1024, 2 * DFF, (bf16_t*)(lws(p.ws) + o_gu), 1024, 0, [](int r) { const int t = r >> 8, q = r & 255; return q < 128 ? t * 128 + q : DFF + t * 128 + (q - 128); }, L, cur, wg, nwg);
  convT(wd, 1024, DFF, 1024, (bf16_t*)(lws(p.ws) + o_d), DFF, 0, [](int r) { return r; }, L, cur, wg, nwg);
}
__device__ __forceinline__ void convert_win(const Params& p, int l, ldsp L, int& cur, int wg, int nwg) {
  const float* win = p.w_in + (size_t)l * 1024 * DPROJ;
  convT(win, DPROJ, 1024, NINP, (bf16_t*)(lws(p.ws) + O_WIN), 1024, 0, [](int r) { return r < 2048 ? r : (r < 2560 ? r + 16 : (r < 2576 ? r - 512 : -1)); }, L, cur, wg, nwg);
}
__device__ __forceinline__ void convert_mixer(const Params& p, int l, ldsp L, int& cur) {
  const int wg = blockIdx.x, nwg = gridDim.x;
  const float* win = p.w_in + (size_t)l * 1024 * DPROJ;
  convT(win, DPROJ, 1024, 3072, (bf16_t*)(lws(p.ws) + O_WG), 1024, 0, [](int r) { return 2576 + r; }, L, cur, wg, nwg);
  convT(p.w_a + (size_t)l * 512 * 1024, 1024, 512, 1024, (bf16_t*)(lws(p.ws) + O_WCAT), 1024, 0, [](int r) { return r; }, L, cur, wg, nwg);
  convT(p.w_c + (size_t)l * 256 * 1024, 1024, 256, 1024, (bf16_t*)(lws(p.ws) + O_WCAT), 1024, 768, [](int r) { return r; }, L, cur, wg, nwg);
  convT(p.w_out + (size_t)l * 1024 * 1024, 1024, 1024, 1024, (bf16_t*)(lws(p.ws) + O_WOUT), 1024, 0, [](int r) { return r; }, L, cur, wg, nwg);
  for (int rp = 0; rp < 3; ++rp) convT(p.w_out + (size_t)l * 1024 * 1024, 1024, 1024, 1024, (bf16_t*)(lws(p.ws) + O_WOUT3), 3072, rp * 1024, [](int r) { return r; }, L, cur, wg, nwg);
  const float* wb = p.w_b + (size_t)l * 4 * 64 * 256; const float* ps = p.pool_scale + (size_t)l * 1024; bf16_t* wcat = (bf16_t*)(lws(p.ws) + O_WCAT);
  for (int idx = blockIdx.x * NTHR + otid(); idx < 1024 * 256; idx += gridDim.x * NTHR) {
    const int row = idx & 1023, kk = idx >> 10, g = row >> 8;
    const float v = ((kk >> 6) == g) ? wb[((size_t)g * 64 + (kk & 63)) * 256 + (row & 255)] * ps[row] : 0.f;
    wcat[(size_t)row * 1024 + 512 + kk] = (bf16_t)(cvt_pk_bf16(v, 0.f) & 0xffffu);
  }
}

__device__ __forceinline__ void norm_phase(float* X, bf16_t* Hn, const float* gain, const float* modl, int ishift, int iscale, const float* part) {
  const int tid_ = otid(), lane = tid_ & 63, gw = blockIdx.x * 8 + (tid_ >> 6), nw = gridDim.x * 8;
  for (int r0 = gw; r0 < ROWS; r0 += 2 * nw) {
    f32x4 v[2][4]; float ss[2];
#pragma unroll
    for (int q = 0; q < 2; ++q) { const int r = r0 + q * nw; const int rr = r < ROWS ? r : r0; const float* xr = X + (size_t)rr * DM;
#pragma unroll
      for (int i = 0; i < 2; ++i) { v[q][2 * i] = *(const f32x4*)(xr + lane * 8 + 512 * i); v[q][2 * i + 1] = *(const f32x4*)(xr + lane * 8 + 512 * i + 4); } }
#pragma unroll
    for (int q = 0; q < 2; ++q) {
      const int r = r0 + q * nw;
      if (part != nullptr && r >= RLAT && r < ROWS) {
        float* xr = X + (size_t)r * DM; const float* pr_ = part + (size_t)(r - RLAT) * DM + lane * 8;
#pragma unroll
        for (int kp = 0; kp < 8; ++kp)
#pragma unroll
          for (int i = 0; i < 2; ++i) { v[q][2 * i] = v[q][2 * i] + *(const f32x4*)(pr_ + (size_t)kp * 2048 * 1024 + 512 * i); v[q][2 * i + 1] = v[q][2 * i + 1] + *(const f32x4*)(pr_ + (size_t)kp * 2048 * 1024 + 512 * i + 4); }
#pragma unroll
        for (int i = 0; i < 2; ++i) { *(f32x4*)(xr + lane * 8 + 512 * i) = v[q][2 * i]; *(f32x4*)(xr + lane * 8 + 512 * i + 4) = v[q][2 * i + 1]; }
      }
      float s_ = 0.f;
#pragma unroll
      for (int i = 0; i < 4; ++i) s_ += v[q][i][0] * v[q][i][0] + v[q][i][1] * v[q][i][1] + v[q][i][2] * v[q][i][2] + v[q][i][3] * v[q][i][3];
      ss[q] = s_;
    }
#pragma unroll
    for (int o = 32; o >= 1; o >>= 1) { ss[0] += __shfl_xor(ss[0], o); ss[1] += __shfl_xor(ss[1], o); }
#pragma unroll
    for (int q = 0; q < 2; ++q) {
      const int r = r0 + q * nw; if (r >= ROWS) continue;
      const int j = r < RLAT ? (r >> 12) : 8;
      const float* sh = modl + (size_t)(j * 9 + ishift) * 1024; const float* sc = modl + (size_t)(j * 9 + iscale) * 1024;
      const float rstd = rsqrtf(ss[q] * (1.0f / 1024.0f) + 1e-6f);
#pragma unroll
      for (int i = 0; i < 2; ++i) {
        const int c0 = lane * 8 + 512 * i; float o[8];
#pragma unroll
        for (int hh = 0; hh < 2; ++hh) { const f32x4 g = *(const f32x4*)(gain + c0 + 4 * hh), s1 = *(const f32x4*)(sc + c0 + 4 * hh), s0 = *(const f32x4*)(sh + c0 + 4 * hh); const f32x4 y = v[q][2 * i + hh] * rstd * g * (s1 + 1.0f) + s0;
          o[4 * hh] = y[0]; o[4 * hh + 1] = y[1]; o[4 * hh + 2] = y[2]; o[4 * hh + 3] = y[3]; }
        u32x4 w; w.x = cvt_pk_bf16(o[0], o[1]); w.y = cvt_pk_bf16(o[2], o[3]); w.z = cvt_pk_bf16(o[4], o[5]); w.w = cvt_pk_bf16(o[6], o[7]);
        *(u32x4*)(Hn + (size_t)r * DM + c0) = w;
      }
    }
  }
}
__device__ __forceinline__ void final_norm(const float* X, float* out, const float* gain) {
  const int tid_ = otid(), lane = tid_ & 63, gw = blockIdx.x * 8 + (tid_ >> 6), nw = gridDim.x * 8;
  for (int r = gw; r < RLAT; r += nw) {
    const float* xr = X + (size_t)r * DM; f32x4 v[4]; float ss = 0.f;
#pragma unroll
    for (int i = 0; i < 4; ++i) { v[i] = *(const f32x4*)(xr + lane * 4 + 256 * i); ss += v[i][0] * v[i][0] + v[i][1] * v[i][1] + v[i][2] * v[i][2] + v[i][3] * v[i][3]; }
#pragma unroll
    for (int o = 32; o >= 1; o >>= 1) ss += __shfl_xor(ss, o);
    const float rstd = rsqrtf(ss * (1.0f / 1024.0f) + 1e-6f);
#pragma unroll
    for (int i = 0; i < 4; ++i) { const f32x4 g = *(const f32x4*)(gain + lane * 4 + 256 * i); *(f32x4*)(out + (size_t)r * DM + lane * 4 + 256 * i) = v[i] * rstd * g; }
  }
}

__device__ __forceinline__ void phase0(const Params& p, ldsp L) {
  const int tid = otid(); const size_t gt = (size_t)blockIdx.x * NTHR + tid, gs = (size_t)gridDim.x * NTHR;
  { f32x4* X = (f32x4*)(lws(p.ws) + O_X); const f32x4* xs = (const f32x4*)p.x; const f32x4* cs = (const f32x4*)p.ctx; const size_t n1 = (size_t)RLAT * DM / 4, n2 = (size_t)ROWS * DM / 4;
    for (size_t i = gt; i < n2; i += gs) X[i] = i < n1 ? xs[i] : cs[i - n1]; }
  { bf16_t* D = (bf16_t*)(lws(p.ws) + O_DFT);
    for (size_t v = gt; v < (size_t)4096 * 512; v += gs) { const int k = (int)(v >> 9), j0 = (int)(v & 511) * 8; float o[8];
#pragma unroll
      for (int e = 0; e < 8; ++e) { const int j = j0 + e; const bool cs_ = j <= 2048; const int t = cs_ ? j : j - 2048; const int r = (k * t) & 4095; const float a = (float)r * (1.0f / 2048.0f);
        o[e] = cs_ ? cospif(a) * (1.0f / 64.0f) : -sinpif(a) * (1.0f / 64.0f); }
      u32x4 w; w.x = cvt_pk_bf16(o[0], o[1]); w.y = cvt_pk_bf16(o[2], o[3]); w.z = cvt_pk_bf16(o[4], o[5]); w.w = cvt_pk_bf16(o[6], o[7]);
      *(u32x4*)(D + (size_t)k * 4096 + j0) = w; } }
  for (int idx = tid; idx < 9 * 1024; idx += NTHR) { const int j = idx >> 10, k = idx & 1023; const float v = j < 8 ? p.c[j * 1024 + k] : p.c_ctx[k]; ldsst<float>(L, idx * 4, siluf_(v)); }
  __syncthreads();
  float* MOD = (float*)(lws(p.ws) + O_MOD);
  for (int item = blockIdx.x; item < DEPTH * 144; item += gridDim.x) {
    const int l = item / 144, n0 = (item - l * 144) * 64, ks = tid >> 6, cn = tid & 63;
    float acc[9];
#pragma unroll
    for (int j = 0; j < 9; ++j) acc[j] = 0.f;
    const float* wp = p.w_ada + ((size_t)l * 1024 + ks * 128) * 9216 + n0 + cn;
#pragma unroll 4
    for (int k = 0; k < 128; ++k) { const float w = wp[(size_t)k * 9216];
#pragma unroll
      for (int j = 0; j < 9; ++j) acc[j] += ldsld<float>(L, (j * 1024 + ks * 128 + k) * 4) * w; }
#pragma unroll
    for (int j = 0; j < 9; ++j) ldsst<float>(L, 36864 + ((ks * 9 + j) * 64 + cn) * 4, acc[j]);
    __syncthreads();
    for (int o = tid; o < 576; o += NTHR) { const int j = o >> 6, c = o & 63; float s = p.b_ada[(size_t)l * 9216 + n0 + c];
#pragma unroll
      for (int q = 0; q < 8; ++q) s += ldsld<float>(L, 36864 + ((q * 9 + j) * 64 + c) * 4);
      MOD[((size_t)l * 9 + j) * 9216 + n0 + c] = s; }
    __syncthreads();
  }
}

__device__ __forceinline__ void prep_phase(const Params& p, int l, ldsp L) {
  const int tid = otid(), lane = tid & 63, wid = tid >> 6, fr = lane & 15, fq = lane >> 4;
  constexpr int KSB = 0, KTL = 17408, VTL = 35840, GL = 54272, AL = 71680, GCL = 104448, BTL = 104960, TOL = 105472;
  const bf16_t* QKV = (const bf16_t*)(lws(p.ws) + O_QKV); const float* AB = (const float*)(lws(p.ws) + O_AB);
  bf16_t* QN = (bf16_t*)(lws(p.ws) + O_QN); bf16_t* KN = (bf16_t*)(lws(p.ws) + O_KN); bf16_t* KNT = (bf16_t*)(lws(p.ws) + O_KNT); bf16_t* VNT = (bf16_t*)(lws(p.ws) + O_VNT);
  bf16_t* TT = (bf16_t*)(lws(p.ws) + O_TT); float* GC = (float*)(lws(p.ws) + O_GC);
  const float* cw = p.conv_w + (size_t)l * 3 * 1536;
  for (int item = blockIdx.x; item < NCH * 4; item += gridDim.x) {
    const int n = item >> 2, h = item & 3, R0 = n * 64;
    { const int row = tid >> 3, cs = tid & 7, r = R0 + row, c0 = cs * 16;
      const int t = r < RLAT ? (r & 4095) : ((r - RLAT) & 255), Ls = r < RLAT ? 4096 : 256;
      const bool hp = t > 0, hn = t < Ls - 1;
#pragma unroll
      for (int mtx = 0; mtx < 3; ++mtx) {
        const int cc = mtx * 512 + h * 128 + c0; const bf16_t* bp = QKV + (size_t)r * 1536 + cc;
        u32x4 a0 = {0, 0, 0, 0}, a1 = {0, 0, 0, 0}, c0v = {0, 0, 0, 0}, c1v = {0, 0, 0, 0};
        const u32x4 b0 = *(const u32x4*)(bp), b1 = *(const u32x4*)(bp + 8);
        if (hp) { a0 = *(const u32x4*)(bp - 1536); a1 = *(const u32x4*)(bp - 1536 + 8); }
        if (hn) { c0v = *(const u32x4*)(bp + 1536); c1v = *(const u32x4*)(bp + 1536 + 8); }
        float val[16]; float ss = 0.f;
#pragma unroll
        for (int e = 0; e < 16; ++e) {
          const unsigned wa = e < 8 ? a0[e >> 1] : a1[(e - 8) >> 1], wb = e < 8 ? b0[e >> 1] : b1[(e - 8) >> 1], wc_ = e < 8 ? c0v[e >> 1] : c1v[(e - 8) >> 1];
          const float xa = (e & 1) ? bfhi(wa) : bflo(wa), xb = (e & 1) ? bfhi(wb) : bflo(wb), xc = (e & 1) ? bfhi(wc_) : bflo(wc_);
          const float y = xa * cw[cc + e] + xb * cw[1536 + cc + e] + xc * cw[3072 + cc + e];
          val[e] = siluf_(y); ss += val[e] * val[e];
        }
        if (mtx < 2) { ss += __shfl_xor(ss, 1); ss += __shfl_xor(ss, 2); ss += __shfl_xor(ss, 4); const float sc = rsqrtf(ss + 1e-6f) * (mtx == 0 ? 0.08838834764831845f : 1.0f);
#pragma unroll
          for (int e = 0; e < 16; ++e) val[e] *= sc; }
        u32x4 w0, w1; w0.x = cvt_pk_bf16(val[0], val[1]); w0.y = cvt_pk_bf16(val[2], val[3]); w0.z = cvt_pk_bf16(val[4], val[5]); w0.w = cvt_pk_bf16(val[6], val[7]);
        w1.x = cvt_pk_bf16(val[8], val[9]); w1.y = cvt_pk_bf16(val[10], val[11]); w1.z = cvt_pk_bf16(val[12], val[13]); w1.w = cvt_pk_bf16(val[14], val[15]);
        if (mtx == 0) { bf16_t* o = QN + (size_t)r * 512 + h * 128 + c0; *(u32x4*)o = w0; *(u32x4*)(o + 8) = w1; }
        else if (mtx == 1) { bf16_t* o = KN + (size_t)r * 512 + h * 128 + c0; *(u32x4*)o = w0; *(u32x4*)(o + 8) = w1;
          ldsst<u32x4>(L, KSB + row * 272 + c0 * 2, w0); ldsst<u32x4>(L, KSB + row * 272 + c0 * 2 + 16, w1);
#pragma unroll
          for (int e = 0; e < 16; ++e) { const unsigned wv = e < 8 ? w0[e >> 1] : w1[(e - 8) >> 1]; ldsst<bf16_t>(L, KTL + (e * 8 + cs) * 144 + row * 2, (bf16_t)((e & 1) ? (wv >> 16) : (wv & 0xffffu))); } }
        else {
#pragma unroll
          for (int e = 0; e < 16; ++e) { const unsigned wv = e < 8 ? w0[e >> 1] : w1[(e - 8) >> 1]; ldsst<bf16_t>(L, VTL + (e * 8 + cs) * 144 + row * 2, (bf16_t)((e & 1) ? (wv >> 16) : (wv & 0xffffu))); } }
      }
    }
    if (wid < 2) {
      const int d = wid, r = R0 + lane;
      const float braw = AB[(size_t)r * 16 + d * 4 + h], araw = AB[(size_t)r * 16 + 8 + d * 4 + h];
      const float beta = sigmoidf_(braw);
      const float xs = araw + p.dt_bias[(l * 2 + d) * 4 + h];
      const float sp = fmaxf(xs, 0.f) + log1pf(__expf(-fabsf(xs)));
      const float g = -__expf(p.a_log[(l * 2 + d) * 4 + h]) * sp;
      float pre = g;
#pragma unroll
      for (int o = 1; o < 64; o <<= 1) { const float t2 = __shfl_up(pre, o); if (lane >= o) pre += t2; }
      const float tot = __shfl(pre, 63);
      const float gc = d == 0 ? pre : (tot - pre + g);
      ldsst<float>(L, GCL + (d * 64 + lane) * 4, gc); ldsst<float>(L, BTL + (d * 64 + lane) * 4, beta);
      GC[((size_t)item * 2 + d) * 64 + lane] = gc;
    }
    __syncthreads();
    { const int ti = wid >> 1;
#pragma unroll
      for (int q = 0; q < 2; ++q) { const int tj = 2 * (wid & 1) + q; f32x4 a = {0.f, 0.f, 0.f, 0.f};
#pragma unroll
        for (int kk = 0; kk < 4; ++kk) a = mma(ldsld<bf16x8>(L, KSB + (16 * tj + fr) * 272 + kk * 64 + fq * 16), ldsld<bf16x8>(L, KSB + (16 * ti + fr) * 272 + kk * 64 + fq * 16), a);
        ldsst<f32x4>(L, GL + ((16 * ti + fr) * 68 + 16 * tj + 4 * fq) * 4, a); }
    }
    {
#pragma unroll
      for (int it = 0; it < 2; ++it) { const int v = tid + 512 * it, c = v >> 3, sg = (v & 7) * 8;
        const int sl = (c & 15) * 8 + (c >> 4);
        *(u32x4*)(KNT + (size_t)item * 8192 + c * 64 + sg) = ldsld<u32x4>(L, KTL + sl * 144 + sg * 2);
        *(u32x4*)(VNT + (size_t)item * 8192 + c * 64 + sg) = ldsld<u32x4>(L, VTL + sl * 144 + sg * 2); } }
    __syncthreads();
    { const int d = tid >> 8, a = (tid & 255) >> 2, jq = tid & 3;
      const int pi_ = d ? 63 - a : a; const float bi = ldsld<float>(L, BTL + (d * 64 + pi_) * 4), gi = ldsld<float>(L, GCL + (d * 64 + pi_) * 4);
#pragma unroll
      for (int e = 0; e < 16; ++e) { const int bb = jq * 16 + e, pr = d ? 63 - bb : bb;
        float v = 0.f;
        if (a > bb) v = bi * ldsld<float>(L, GL + (pi_ * 68 + pr) * 4) * __expf(gi - ldsld<float>(L, GCL + (d * 64 + pr) * 4));
        ldsst<float>(L, AL + ((d * 64 + a) * 64 + bb) * 4, v); } }
    __syncthreads();
    { constexpr int XL = 0, ML = GL; int tid5 = tid; asm volatile("" : "+v"(tid5)); const int wid5 = tid5 >> 6, lane5 = tid5 & 63;
#define XLA(d_, r_, c_) (XL + (((d_) * 64 + (r_)) * 64 + (c_)) * 4)
#define ALA(d_, r_, c_) (AL + (((d_) * 64 + (r_)) * 64 + (c_)) * 4)
      if (wid5 < 2) {
        const int d = wid5, bb = lane5 >> 4, cc = lane5 & 15; float xb[16];
#pragma unroll
        for (int ii = 0; ii < 16; ++ii) {
          float t = (ii == cc) ? 1.f : 0.f;
#pragma unroll
          for (int j4 = 0; j4 < (ii + 3) / 4; ++j4) { const f32x4 av = ldsld<f32x4>(L, ALA(d, 16 * bb + ii, 16 * bb + j4 * 4));
#pragma unroll
            for (int e = 0; e < 4; ++e) if (j4 * 4 + e < ii) t -= av[e] * xb[j4 * 4 + e]; }
          xb[ii] = t; ldsst<float>(L, XLA(d, 16 * bb + ii, 16 * bb + cc), t);
        }
      }
      __syncthreads();
#pragma unroll
      for (int lev = 1; lev <= 3; ++lev) {
        const int nblk = 2 * (4 - lev), nel = nblk * 256;
        for (int o = tid5; o < nel; o += NTHR) {
          const int bl = o >> 8, d = bl & 1, i = lev + (bl >> 1), j = i - lev, r = (o >> 4) & 15, c = o & 15; float acc_ = 0.f;
          for (int m = 0; m < lev; ++m) {
#pragma unroll
            for (int k4 = 0; k4 < 4; ++k4) { const f32x4 av = ldsld<f32x4>(L, ALA(d, 16 * i + r, 16 * (j + m) + 4 * k4));
#pragma unroll
              for (int e = 0; e < 4; ++e) acc_ += av[e] * ldsld<float>(L, XLA(d, 16 * (j + m) + 4 * k4 + e, 16 * j + c)); }
          }
          ldsst<float>(L, ML + o * 4, acc_);
        }
        __syncthreads();
        for (int o = tid5; o < nel; o += NTHR) {
          const int bl = o >> 8, d = bl & 1, i = lev + (bl >> 1), j = i - lev, r = (o >> 4) & 15, c = o & 15; float acc_ = 0.f;
#pragma unroll
          for (int k4 = 0; k4 < 4; ++k4) { const f32x4 dv = ldsld<f32x4>(L, XLA(d, 16 * i + r, 16 * i + 4 * k4));
#pragma unroll
            for (int e = 0; e < 4; ++e) acc_ += dv[e] * ldsld<float>(L, ML + ((bl << 8) + ((4 * k4 + e) << 4) + c) * 4); }
          ldsst<float>(L, XLA(d, 16 * i + r, 16 * j + c), -acc_);
        }
        __syncthreads();
      }
      { const int d = tid5 >> 8, i = (tid5 >> 2) & 63, cq = tid5 & 3, pp = d ? 63 - i : i; float tw[16], tu[16];
#pragma unroll
        for (int e = 0; e < 16; ++e) { const int c = cq * 16 + e, pr = d ? 63 - c : c;
          const float x = ((i >> 4) > cq || ((i >> 4) == cq)) ? ldsld<float>(L, XLA(d, i, c)) : 0.f;
          const float bc = ldsld<float>(L, BTL + (d * 64 + pr) * 4), fw = bc * __expf(ldsld<float>(L, GCL + (d * 64 + pr) * 4));
          tw[e] = x * fw; tu[e] = x * bc; }
#pragma unroll
        for (int e = 0; e < 8; ++e) { const float a0 = tw[e], a1 = tw[15 - e], b0 = tu[e], b1 = tu[15 - e]; tw[e] = d ? a1 : a0; tw[15 - e] = d ? a0 : a1; tu[e] = d ? b1 : b0; tu[15 - e] = d ? b0 : b1; }
        const int pr0 = d ? 63 - (cq * 16 + 15) : cq * 16;
        u32x4 w0, w1;
        w0.x = cvt_pk_bf16(tw[0], tw[1]); w0.y = cvt_pk_bf16(tw[2], tw[3]); w0.z = cvt_pk_bf16(tw[4], tw[5]); w0.w = cvt_pk_bf16(tw[6], tw[7]);
        w1.x = cvt_pk_bf16(tw[8], tw[9]); w1.y = cvt_pk_bf16(tw[10], tw[11]); w1.z = cvt_pk_bf16(tw[12], tw[13]); w1.w = cvt_pk_bf16(tw[14], tw[15]);
        ldsst<u32x4>(L, TOL + ((d * 2 + 0) * 64 + pp) * 144 + pr0 * 2, w0); ldsst<u32x4>(L, TOL + ((d * 2 + 0) * 64 + pp) * 144 + pr0 * 2 + 16, w1);
        w0.x = cvt_pk_bf16(tu[0], tu[1]); w0.y = cvt_pk_bf16(tu[2], tu[3]); w0.z = cvt_pk_bf16(tu[4], tu[5]); w0.w = cvt_pk_bf16(tu[6], tu[7]);
        w1.x = cvt_pk_bf16(tu[8], tu[9]); w1.y = cvt_pk_bf16(tu[10], tu[11]); w1.z = cvt_pk_bf16(tu[12], tu[13]); w1.w = cvt_pk_bf16(tu[14], tu[15]);
        ldsst<u32x4>(L, TOL + ((d * 2 + 1) * 64 + pp) * 144 + pr0 * 2, w0); ldsst<u32x4>(L, TOL + ((d * 2 + 1) * 64 + pp) * 144 + pr0 * 2 + 16, w1);
      }
#undef XLA
#undef ALA
    }
    __syncthreads();
#pragma unroll
    for (int it = 0; it < 4; ++it) { const int v = tid + 512 * it, mtx = v >> 9, row = (v >> 3) & 63, sg = (v & 7) * 8;
      *(u32x4*)(TT + ((size_t)item * 4 + mtx) * 4096 + row * 64 + sg) = ldsld<u32x4>(L, TOL + (mtx * 64 + row) * 144 + sg * 2); }
    __syncthreads();
  }
}

__device__ __forceinline__ void fourier_prep(const Params& p, ldsp L) {
  const int tid = otid(), lane = tid & 63, wid = tid >> 6, fr = lane & 15, fq = lane >> 4;
  constexpr int UA = 0, UB = 33792, DC = 67584;
  const bf16_t* FI = (const bf16_t*)(lws(p.ws) + O_FI); bf16_t* FBT = (bf16_t*)(lws(p.ws) + O_FBT); float* UCS = (float*)(lws(p.ws) + O_UCS);
  for (int idx = tid; idx < 128 * 64; idx += NTHR) { const int rr = idx >> 6, c = idx & 63, m = rr & 63; const float a = (float)((m * c) & 63) * (1.0f / 32.0f);
    const float v = (rr < 64 ? cospif(a) : sinpif(a)) * 0.125f; ldsst<bf16_t>(L, DC + rr * 144 + c * 2, (bf16_t)(cvt_pk_bf16(v, 0.f) & 0xffffu)); }
  __syncthreads();
  for (int item = (int)gridDim.x - 1 - (int)blockIdx.x; item < 288; item += gridDim.x) {
    const bool lat = item < 256; const int b = lat ? item >> 5 : 0, jb = item & 31;
#pragma unroll
    for (int it = 0; it < 4; ++it) { const int v = tid + 512 * it, row = v >> 5, sg = (v & 31) * 8;
      int ra, rb;
      if (lat) { const int t = 64 * jb + row; ra = b * 4096 + t; rb = b * 4096 + (t == 0 ? 2048 : 4096 - t); } else { ra = RLAT + (item - 256) * 64 + row; rb = ra; }
      ldsst<u32x4>(L, UA + row * 528 + sg * 2, *(const u32x4*)(FI + (size_t)ra * 256 + sg));
      ldsst<u32x4>(L, UB + row * 528 + sg * 2, *(const u32x4*)(FI + (size_t)rb * 256 + sg)); }
    __syncthreads();
    for (int q = 0; q < 8; ++q) {
      const int combo = wid * 8 + q, g = combo >> 4, ti = (combo >> 2) & 3, tm = combo & 3;
      f32x4 ac = {0.f, 0.f, 0.f, 0.f}, as = ac, bc = ac, bs = ac;
#pragma unroll
      for (int kk = 0; kk < 2; ++kk) {
        const bf16x8 xa = ldsld<bf16x8>(L, UA + (16 * ti + fr) * 528 + (g * 64 + kk * 32 + fq * 8) * 2), xb = ldsld<bf16x8>(L, UB + (16 * ti + fr) * 528 + (g * 64 + kk * 32 + fq * 8) * 2);
        const bf16x8 yc = ldsld<bf16x8>(L, DC + (16 * tm + fr) * 144 + kk * 64 + fq * 16), ys = ldsld<bf16x8>(L, DC + (64 + 16 * tm + fr) * 144 + kk * 64 + fq * 16);
        ac = mma(xa, yc, ac); as = mma(xa, ys, as); bc = mma(xb, yc, bc); bs = mma(xb, ys, bs);
      }
      const int mp = g * 64 + 16 * tm + fr, i0 = 16 * ti + 4 * fq;
      if (lat) {
        f32x4 cv = ac + bc, sv = as - bs;
        if (jb == 0 && i0 == 0) { cv[0] = ac[0]; sv[0] = bc[0]; }
        bf16_t* o = FBT + ((size_t)b * 256 + mp) * 4096 + 64 * jb + i0;
        *(u32x2*)o = pack4(cv); *(u32x2*)(o + 2048) = pack4(sv);
      } else {
#pragma unroll
        for (int e = 0; e < 4; ++e) { float* o = UCS + (size_t)((item - 256) * 64 + i0 + e) * 512; o[mp] = ac[e]; o[256 + mp] = as[e]; }
      }
    }
    __syncthreads();
  }
}

__device__ __forceinline__ void ctx_fourier(const Params& p, ldsp L, int wg, int nwg) {
  const int tid = otid(); const float* UCS = (const float*)(lws(p.ws) + O_UCS); bf16_t* PPF = (bf16_t*)(lws(p.ws) + O_PPF);
  for (int idx = tid; idx < 256; idx += NTHR) { const float a = (float)idx * (1.0f / 128.0f); ldsst<float>(L, idx * 4, cospif(a) * (1.0f / 16.0f)); ldsst<float>(L, 1024 + idx * 4, sinpif(a) * (1.0f / 16.0f)); }
  __syncthreads();
  for (int o = wg * NTHR + tid; o < NB * 32 * 256; o += nwg * NTHR) {
    const int mp = o & 255, kq = (o >> 8) & 31, b = o >> 13; const float* u = UCS + (size_t)b * 256 * 512 + mp; float s8[8];
#pragma unroll
    for (int e = 0; e < 8; ++e) s8[e] = 0.f;
#pragma unroll 16
    for (int t = 0; t < 256; ++t) { const float uc = u[(size_t)t * 512], us = u[(size_t)t * 512 + 256];
#pragma unroll
      for (int e = 0; e < 8; ++e) { const int r = ((8 * kq + e) * t) & 255; s8[e] += ldsld<float>(L, r * 4) * uc - ldsld<float>(L, 1024 + r * 4) * us; } }
#pragma unroll
    for (int e = 0; e < 8; ++e) PPF[(size_t)(RLAT + b * 256 + 8 * kq + e) * 512 + 256 + mp] = (bf16_t)(cvt_pk_bf16(s8[e], 0.f) & 0xffffu);
  }
  __syncthreads();
}
__device__ __forceinline__ void pool_phase(const Params& p, ldsp L, int wg, int nwg) {
  const int tid_ = otid(), lane = tid_ & 63, wv = tid_ >> 6, gw = wg * 8 + wv, nw = nwg * 8;
  const bf16_t* PI = (const bf16_t*)(lws(p.ws) + O_PI); bf16_t* PPF = (bf16_t*)(lws(p.ws) + O_PPF);
  const int LP = wv * 16640;
  for (int idx = gw; idx < 2048; idx += nw) {
    const int g = 3 - (idx >> 9), b = (idx >> 6) & 7, r = idx & 63;
    const int win = 2 << g, hw = win >> 1, sr = max(r - hw, 0), er = min(r - hw + win, 64);
    const bf16_t* base = PI + (size_t)b * 4096 * 256 + g * 64 + lane;
    ldsst<float>(L, LP + lane * 4, 0.f);
    { const int ci = lane >> 3, ch0 = (lane & 7) * 8;
      const bf16_t* bq = PI + (size_t)b * 4096 * 256 + g * 64 + ch0;
      const int ncb = 16 >> (g + 1);
#pragma unroll 1
      for (int cb0 = 0; cb0 < 8; cb0 += ncb) {
        u32x4 vv[16];
#pragma unroll
        for (int q = 0; q < 16; ++q) { const int cbq = q >> (g + 1), rr = sr + (q & (win - 1)), cc = (cb0 + cbq) * 8 + ci; vv[q] = (u32x4){0u, 0u, 0u, 0u}; if (rr < er) vv[q] = *(const u32x4*)(bq + (size_t)(rr * 64 + cc) * 256); }
        float ac[8];
        for (int cbq = 0; cbq < ncb; ++cbq) {
#pragma unroll
          for (int e = 0; e < 8; ++e) ac[e] = 0.f;
#pragma unroll
          for (int q = 0; q < 16; ++q) { const bool mine = (q >> (g + 1)) == cbq;
#pragma unroll
            for (int e = 0; e < 4; ++e) { ac[2 * e] += mine ? bflo(vv[q][e]) : 0.f; ac[2 * e + 1] += mine ? bfhi(vv[q][e]) : 0.f; } }
          const int cc = (cb0 + cbq) * 8 + ci;
          ldsst<f32x4>(L, LP + ((cc + 1) * 64 + ch0) * 4, (f32x4){ac[0], ac[1], ac[2], ac[3]}); ldsst<f32x4>(L, LP + ((cc + 1) * 64 + ch0 + 4) * 4, (f32x4){ac[4], ac[5], ac[6], ac[7]});
        }
      }
      float run = 0.f;
#pragma unroll 8
      for (int cc = 1; cc <= 64; ++cc) { run += ldsld<float>(L, LP + (cc * 64 + lane) * 4); ldsst<float>(L, LP + (cc * 64 + lane) * 4, run); }
    }
    const float rinv = 1.0f / (float)(er - sr);
    {
      const int ci = lane >> 3, ch0 = (lane & 7) * 8;
      u32x4 sv[8];
#pragma unroll
      for (int cb = 0; cb < 8; ++cb) sv[cb] = *(const u32x4*)(PI + ((size_t)b * 4096 + r * 64 + cb * 8 + ci) * 256 + g * 64 + ch0);
#pragma unroll
      for (int cb = 0; cb < 8; ++cb) {
        const int c = cb * 8 + ci, sc = max(c - hw, 0), ec = min(c - hw + win, 64); const float sca = rinv / (float)(ec - sc);
        const f32x4 e0 = ldsld<f32x4>(L, LP + (ec * 64 + ch0) * 4), e1 = ldsld<f32x4>(L, LP + (ec * 64 + ch0 + 4) * 4), s0 = ldsld<f32x4>(L, LP + (sc * 64 + ch0) * 4), s1 = ldsld<f32x4>(L, LP + (sc * 64 + ch0 + 4) * 4);
        const f32x4 b0 = (e0 - s0) * sca, b1 = (e1 - s1) * sca; const u32x4 sf = sv[cb];
        u32x4 w; w.x = cvt_pk_bf16(b0[0] - bflo(sf.x), b0[1] - bfhi(sf.x)); w.y = cvt_pk_bf16(b0[2] - bflo(sf.y), b0[3] - bfhi(sf.y)); w.z = cvt_pk_bf16(b1[0] - bflo(sf.z), b1[1] - bfhi(sf.z)); w.w = cvt_pk_bf16(b1[2] - bflo(sf.w), b1[3] - bfhi(sf.w));
        *(u32x4*)(PPF + ((size_t)b * 4096 + r * 64 + c) * 512 + g * 64 + ch0) = w;
      }
    }
  }
  for (int r = RLAT + gw; r < ROWS; r += nw) {
    const int base = r & ~255, t = r - base;
#pragma unroll
    for (int g = 0; g < 4; ++g) {
      const int win = 2 << g, hw = win >> 1, sc = max(t - hw, 0), ec = min(t - hw + win, 256);
      float s_ = 0.f;
#pragma unroll
      for (int q = 0; q < (2 << g); ++q) { const int c = sc + q; if (c < ec) s_ += __uint_as_float((unsigned)PI[(size_t)(base + c) * 256 + g * 64 + lane] << 16); }
      const float self = __uint_as_float((unsigned)PI[(size_t)r * 256 + g * 64 + lane] << 16);
      PPF[(size_t)r * 512 + g * 64 + lane] = (bf16_t)(cvt_pk_bf16(s_ / (float)(ec - sc) - self, 0.f) & 0xffffu);
    }
  }
}

__device__ __forceinline__ void scan_phase(const Params& p, ldsp L, int item) {
  const int tid = otid(), lane = tid & 63, wid = tid >> 6, fr = lane & 15, fq = lane >> 4;
  const int es = item & 1, d = (item >> 1) & 1, h = (item >> 2) & 3, b = item >> 4;
  const int ti = wid >> 1, half = wid & 1;
  constexpr int QS = 0, KS = 17408, KTS = 34816, VTS = 53248, TW = 62464, TU = 71680, AT = 80896, WL = 90112, VNT_ = 107520, VNS = 116736, STL = 125952, GCL0 = 143360, KTS0 = KTS, KTS1 = 143616, GCL1 = 162048;
  const bf16_t* QN = (const bf16_t*)(lws(p.ws) + O_QN); const bf16_t* KN = (const bf16_t*)(lws(p.ws) + O_KN); const bf16_t* KNT = (const bf16_t*)(lws(p.ws) + O_KNT); const bf16_t* VNT = (const bf16_t*)(lws(p.ws) + O_VNT);
  const bf16_t* TT = (const bf16_t*)(lws(p.ws) + O_TT); const float* GC = (const float*)(lws(p.ws) + O_GC); bf16_t* O = (bf16_t*)(lws(p.ws) + O_O) + (size_t)d * ROWS * 512;
  { unsigned zz_; asm volatile("v_mov_b32 %0, 0" : "=v"(zz_)); for (int o = tid * 16; o < 17408; o += NTHR * 16) ldsst<u32x4>(L, STL + o, (u32x4){zz_, zz_, zz_, zz_}); }
  f32x4 accS[4];
#pragma unroll
  for (int q = 0; q < 4; ++q) accS[q] = (f32x4){0.f, 0.f, 0.f, 0.f};
  u32x4 rq[2], rk[2], rkt[2], rvt, rtw, rtu; float rgc = 0.f;
#define SCAN_CHUNK(s) ((s) < 4 ? (NB * 64 + b * 4 + (d ? 3 - (s) : (s))) : (b * 64 + (d ? 67 - (s) : (s) - 4)))
#define SCAN_GLOAD(s) do { const int n_ = SCAN_CHUNK(s), it2_ = n_ * 4 + h; \
    _Pragma("unroll") for (int it = 0; it < 2; ++it) { const int v = tid + 512 * it; \
      rq[it] = *(const u32x4*)(QN + (size_t)(64 * n_ + (v >> 4)) * 512 + h * 128 + (v & 15) * 8); rk[it] = *(const u32x4*)(KN + (size_t)(64 * n_ + (v >> 4)) * 512 + h * 128 + (v & 15) * 8); \
      rkt[it] = *(const u32x4*)(KNT + (size_t)it2_ * 8192 + (v >> 3) * 64 + (v & 7) * 8); } \
    rvt = *(const u32x4*)(VNT + (size_t)it2_ * 8192 + (es * 64 + (tid >> 3)) * 64 + (tid & 7) * 8); \
    rtw = *(const u32x4*)(TT + ((size_t)it2_ * 4 + d * 2 + 0) * 4096 + (tid >> 3) * 64 + (tid & 7) * 8); rtu = *(const u32x4*)(TT + ((size_t)it2_ * 4 + d * 2 + 1) * 4096 + (tid >> 3) * 64 + (tid & 7) * 8); \
    if (tid < 64) rgc = GC[((size_t)it2_ * 2 + d) * 64 + tid]; } while (0)
#define SCAN_LSTORE(KTSW, GCLW) do { \
    _Pragma("unroll") for (int it = 0; it < 2; ++it) { const int v = tid + 512 * it; \
      ldsst<u32x4>(L, QS + (v >> 4) * 272 + (v & 15) * 16, rq[it]); ldsst<u32x4>(L, KS + (v >> 4) * 272 + (v & 15) * 16, rk[it]); ldsst<u32x4>(L, (KTSW) + (v >> 3) * 144 + (v & 7) * 16, rkt[it]); } \
    ldsst<u32x4>(L, VTS + (tid >> 3) * 144 + (tid & 7) * 16, rvt); ldsst<u32x4>(L, TW + (tid >> 3) * 144 + (tid & 7) * 16, rtw); ldsst<u32x4>(L, TU + (tid >> 3) * 144 + (tid & 7) * 16, rtu); \
    if (tid < 64) ldsst<float>(L, (GCLW) + tid * 4, rgc); } while (0)
  SCAN_GLOAD(0); SCAN_LSTORE(KTS0, GCL0); __syncthreads();
  for (int s = 0; s < 68; ++s) {
    const int n = SCAN_CHUNK(s);
    const int KTSc = (s & 1) ? KTS1 : KTS0, GCL = (s & 1) ? GCL1 : GCL0, KTSn = (s & 1) ? KTS0 : KTS1, GCLn = (s & 1) ? GCL0 : GCL1;
    if (s + 1 < 68) SCAN_GLOAD(s + 1);
    const float gtot = ldsld<float>(L, GCL + (d ? 0 : 63) * 4);
    f32x4 uacc[2], qacc[2];
    {
      bf16x8 qf[4], kf[2][4], twf[2], tuf[2], vtf[2][2], ktf[4][2], sf[2][4];
#pragma unroll
      for (int kk = 0; kk < 4; ++kk) qf[kk] = ldsld<bf16x8>(L, QS + (16 * ti + fr) * 272 + kk * 64 + fq * 16);
#pragma unroll
      for (int q = 0; q < 2; ++q)
#pragma unroll
        for (int kk = 0; kk < 4; ++kk) { kf[q][kk] = ldsld<bf16x8>(L, KS + (16 * (2 * half + q) + fr) * 272 + kk * 64 + fq * 16); sf[q][kk] = ldsld<bf16x8>(L, STL + (16 * (2 * half + q) + fr) * 272 + kk * 64 + fq * 16); }
      f32x4 at[2], wv[4];
#pragma unroll
      for (int q = 0; q < 2; ++q) { at[q] = (f32x4){0.f, 0.f, 0.f, 0.f}; qacc[q] = at[q]; uacc[q] = at[q]; }
#pragma unroll
      for (int q = 0; q < 4; ++q) wv[q] = (f32x4){0.f, 0.f, 0.f, 0.f};
#pragma unroll
      for (int kk = 0; kk < 4; ++kk)
#pragma unroll
        for (int q = 0; q < 2; ++q) { at[q] = mma(kf[q][kk], qf[kk], at[q]); qacc[q] = mma(sf[q][kk], qf[kk], qacc[q]); }
      __builtin_amdgcn_sched_barrier(0);
#pragma unroll
      for (int kk = 0; kk < 2; ++kk) { twf[kk] = ldsld<bf16x8>(L, TW + (16 * ti + fr) * 144 + kk * 64 + fq * 16); tuf[kk] = ldsld<bf16x8>(L, TU + (16 * ti + fr) * 144 + kk * 64 + fq * 16); }
#pragma unroll
      for (int q = 0; q < 4; ++q)
#pragma unroll
        for (int kk = 0; kk < 2; ++kk) ktf[q][kk] = ldsld<bf16x8>(L, KTSc + (16 * (4 * half + q) + fr) * 144 + kk * 64 + fq * 16);
#pragma unroll
      for (int q = 0; q < 2; ++q)
#pragma unroll
        for (int kk = 0; kk < 2; ++kk) vtf[q][kk] = ldsld<bf16x8>(L, VTS + (16 * (2 * half + q) + fr) * 144 + kk * 64 + fq * 16);
#pragma unroll
      for (int kk = 0; kk < 2; ++kk) {
#pragma unroll
        for (int q = 0; q < 4; ++q) wv[q] = mma(ktf[q][kk], twf[kk], wv[q]);
#pragma unroll
        for (int q = 0; q < 2; ++q) uacc[q] = mma(tuf[kk], vtf[q][kk], uacc[q]);
      }
      const int i = 16 * ti + fr; const float gi = ldsld<float>(L, GCL + i * 4);
#pragma unroll
      for (int q = 0; q < 2; ++q) {
        const int j0 = 16 * (2 * half + q) + 4 * fq; f32x4 a = at[q];
#pragma unroll
        for (int e = 0; e < 4; ++e) { const int j = j0 + e; const bool keep = d ? (i <= j) : (i >= j); const float ar = keep ? gi - ldsld<float>(L, GCL + j * 4) : 0.f; a[e] = keep ? a[e] * __expf(ar) : 0.f; }
        ldsst<u32x2>(L, AT + i * 144 + j0 * 2, pack4(a));
      }
#pragma unroll
      for (int q = 0; q < 4; ++q) ldsst<u32x2>(L, WL + (16 * ti + fr) * 272 + (16 * (4 * half + q) + 4 * fq) * 2, pack4(wv[q]));
    }
    __syncthreads();
    {
      bf16x8 wf[4], sf[2][4];
#pragma unroll
      for (int kk = 0; kk < 4; ++kk) { wf[kk] = ldsld<bf16x8>(L, WL + (16 * ti + fr) * 272 + kk * 64 + fq * 16);
#pragma unroll
        for (int q = 0; q < 2; ++q) sf[q][kk] = ldsld<bf16x8>(L, STL + (16 * (2 * half + q) + fr) * 272 + kk * 64 + fq * 16); }
      f32x4 a[2];
#pragma unroll
      for (int q = 0; q < 2; ++q) a[q] = (f32x4){0.f, 0.f, 0.f, 0.f};
#pragma unroll
      for (int kk = 0; kk < 4; ++kk)
#pragma unroll
        for (int q = 0; q < 2; ++q) a[q] = mma(wf[kk], sf[q][kk], a[q]);
      const int i0 = 16 * ti + 4 * fq; float sc4[4];
#pragma unroll
      for (int e = 0; e < 4; ++e) sc4[e] = __expf(gtot - ldsld<float>(L, GCL + (i0 + e) * 4));
#pragma unroll
      for (int q = 0; q < 2; ++q) {
        const int te = 2 * half + q; const f32x4 vn = uacc[q] - a[q]; f32x4 vs;
#pragma unroll
        for (int e = 0; e < 4; ++e) vs[e] = vn[e] * sc4[e];
        ldsst<u32x2>(L, VNT_ + (16 * te + fr) * 144 + i0 * 2, pack4(vn)); ldsst<u32x2>(L, VNS + (16 * te + fr) * 144 + i0 * 2, pack4(vs));
      }
    }
    __syncthreads();
    {
      bf16x8 af[2], vf[2][2], nsf[2], ktf[4][2];
#pragma unroll
      for (int q = 0; q < 4; ++q)
#pragma unroll
        for (int kk = 0; kk < 2; ++kk) ktf[q][kk] = ldsld<bf16x8>(L, KTSc + (16 * (4 * half + q) + fr) * 144 + kk * 64 + fq * 16);
#pragma unroll
      for (int kk = 0; kk < 2; ++kk) { af[kk] = ldsld<bf16x8>(L, AT + (16 * ti + fr) * 144 + kk * 64 + fq * 16); nsf[kk] = ldsld<bf16x8>(L, VNS + (16 * ti + fr) * 144 + kk * 64 + fq * 16);
#pragma unroll
        for (int q = 0; q < 2; ++q) vf[q][kk] = ldsld<bf16x8>(L, VNT_ + (16 * (2 * half + q) + fr) * 144 + kk * 64 + fq * 16); }
      const float cd = __expf(gtot);
      f32x4 ov[2];
#pragma unroll
      for (int q = 0; q < 2; ++q) ov[q] = (f32x4){0.f, 0.f, 0.f, 0.f};
#pragma unroll
      for (int q = 0; q < 4; ++q) accS[q] = accS[q] * cd;
#pragma unroll
      for (int kk = 0; kk < 2; ++kk) {
#pragma unroll
        for (int q = 0; q < 2; ++q) ov[q] = mma(vf[q][kk], af[kk], ov[q]);
#pragma unroll
        for (int q = 0; q < 4; ++q) accS[q] = mma(ktf[q][kk], nsf[kk], accS[q]);
      }
      const int i = 16 * ti + fr; const float eg = __expf(ldsld<float>(L, GCL + i * 4));
#pragma unroll
      for (int q = 0; q < 2; ++q) { const f32x4 o4 = qacc[q] * eg + ov[q];
        *(u32x2*)(O + (size_t)(64 * n + i) * 512 + h * 128 + es * 64 + 16 * (2 * half + q) + 4 * fq) = pack4(o4); }
    }
#pragma unroll
    for (int q = 0; q < 4; ++q) ldsst<u32x2>(L, STL + (16 * ti + fr) * 272 + (16 * (4 * half + q) + 4 * fq) * 2, pack4(accS[q]));
    if (s + 1 < 68) SCAN_LSTORE(KTSn, GCLn);
    __syncthreads();
  }
#undef SCAN_CHUNK
#undef SCAN_GLOAD
#undef SCAN_LSTORE
}

__device__ __forceinline__ void ofprep_norm_phase(const Params& p, int l, float* X, bf16_t* Hn, const float* gain, const float* modl, int ishift, int iscale) {
  const int tid_ = otid(), lane = tid_ & 63, gw = blockIdx.x * 8 + (tid_ >> 6), nw = gridDim.x * 8;
  const bf16_t* O0 = (const bf16_t*)(lws(p.ws) + O_O); const bf16_t* O1 = O0 + (size_t)ROWS * 512; const bf16_t* Z = (const bf16_t*)(lws(p.ws) + O_Z); bf16_t* OF = (bf16_t*)(lws(p.ws) + O_OF);
  const float* og = p.o_gain + (size_t)l * 128 + (lane & 15) * 8;
  for (int r0 = gw; r0 < ROWS; r0 += 2 * nw) {
    u32x4 av[2], bv[2], zv[2]; f32x4 v[2][4]; float ss[2];
#pragma unroll
    for (int q = 0; q < 2; ++q) { const int r = (r0 + q * nw) < ROWS ? (r0 + q * nw) : r0; const float* xr = X + (size_t)r * DM;
      av[q] = *(const u32x4*)(O0 + (size_t)r * 512 + lane * 8); bv[q] = *(const u32x4*)(O1 + (size_t)r * 512 + lane * 8); zv[q] = *(const u32x4*)(Z + (size_t)r * 512 + lane * 8);
#pragma unroll
      for (int i = 0; i < 2; ++i) { v[q][2 * i] = *(const f32x4*)(xr + lane * 8 + 512 * i); v[q][2 * i + 1] = *(const f32x4*)(xr + lane * 8 + 512 * i + 4); } }
#pragma unroll
    for (int q = 0; q < 2; ++q) {
      const int r = r0 + q * nw;
      float s_ = 0.f;
#pragma unroll
      for (int i = 0; i < 4; ++i) s_ += v[q][i][0] * v[q][i][0] + v[q][i][1] * v[q][i][1] + v[q][i][2] * v[q][i][2] + v[q][i][3] * v[q][i][3];
      ss[q] = s_;
      if (r < ROWS) {
        const u32x4 a = av[q], bq = bv[q], zq = zv[q];
        float o[8]; float so = 0.f;
#pragma unroll
        for (int e = 0; e < 4; ++e) { o[2 * e] = bflo(a[e]) + bflo(bq[e]); o[2 * e + 1] = bfhi(a[e]) + bfhi(bq[e]); so += o[2 * e] * o[2 * e] + o[2 * e + 1] * o[2 * e + 1]; }
        so += __shfl_xor(so, 1); so += __shfl_xor(so, 2); so += __shfl_xor(so, 4); so += __shfl_xor(so, 8);
        const float rstd = rsqrtf(so * (1.0f / 128.0f) + 1e-6f);
        float y[8];
#pragma unroll
        for (int e = 0; e < 4; ++e) { y[2 * e] = o[2 * e] * rstd * og[2 * e] * siluf_(bflo(zq[e])); y[2 * e + 1] = o[2 * e + 1] * rstd * og[2 * e + 1] * siluf_(bfhi(zq[e])); }
        u32x4 w; w.x = cvt_pk_bf16(y[0], y[1]); w.y = cvt_pk_bf16(y[2], y[3]); w.z = cvt_pk_bf16(y[4], y[5]); w.w = cvt_pk_bf16(y[6], y[7]);
        *(u32x4*)(OF + (size_t)r * 512 + lane * 8) = w;
      }
    }
#pragma unroll
    for (int o = 32; o >= 1; o >>= 1) { ss[0] += __shfl_xor(ss[0], o); ss[1] += __shfl_xor(ss[1], o); }
#pragma unroll
    for (int q = 0; q < 2; ++q) {
      const int r = r0 + q * nw; if (r >= ROWS) continue;
      const int j = r < RLAT ? (r >> 12) : 8;
      const float* sh = modl + (size_t)(j * 9 + ishift) * 1024; const float* sc = modl + (size_t)(j * 9 + iscale) * 1024;
      const float rstd = rsqrtf(ss[q] * (1.0f / 1024.0f) + 1e-6f);
#pragma unroll
      for (int i = 0; i < 2; ++i) {
        const int c0 = lane * 8 + 512 * i; float o[8];
#pragma unroll
        for (int hh = 0; hh < 2; ++hh) { const f32x4 g = *(const f32x4*)(gain + c0 + 4 * hh), s1 = *(const f32x4*)(sc + c0 + 4 * hh), s0 = *(const f32x4*)(sh + c0 + 4 * hh); const f32x4 y = v[q][2 * i + hh] * rstd * g * (s1 + 1.0f) + s0;
          o[4 * hh] = y[0]; o[4 * hh + 1] = y[1]; o[4 * hh + 2] = y[2]; o[4 * hh + 3] = y[3]; }
        u32x4 w; w.x = cvt_pk_bf16(o[0], o[1]); w.y = cvt_pk_bf16(o[2], o[3]); w.z = cvt_pk_bf16(o[4], o[5]); w.w = cvt_pk_bf16(o[6], o[7]);
        *(u32x4*)(Hn + (size_t)r * DM + c0) = w;
      }
    }
  }
}

__device__ __forceinline__ void ofprep_phase(const Params& p, int l) {
  const int tid_ = otid(), lane = tid_ & 63, gw = blockIdx.x * 8 + (tid_ >> 6), nw = gridDim.x * 8;
  const bf16_t* O0 = (const bf16_t*)(lws(p.ws) + O_O); const bf16_t* O1 = O0 + (size_t)ROWS * 512; const bf16_t* Z = (const bf16_t*)(lws(p.ws) + O_Z); bf16_t* OF = (bf16_t*)(lws(p.ws) + O_OF);
  const float* og = p.o_gain + (size_t)l * 128 + (lane & 15) * 8;
  for (int r0 = gw; r0 < ROWS; r0 += 2 * nw) {
    u32x4 av[2], bv[2], zv[2];
#pragma unroll
    for (int q = 0; q < 2; ++q) { const int r = (r0 + q * nw) < ROWS ? (r0 + q * nw) : r0;
      av[q] = *(const u32x4*)(O0 + (size_t)r * 512 + lane * 8); bv[q] = *(const u32x4*)(O1 + (size_t)r * 512 + lane * 8); zv[q] = *(const u32x4*)(Z + (size_t)r * 512 + lane * 8); }
#pragma unroll
    for (int q = 0; q < 2; ++q) {
      const int r = r0 + q * nw; if (r >= ROWS) continue;
      const u32x4 a = av[q], bq = bv[q], zq = zv[q];
      float o[8]; float ss = 0.f;
#pragma unroll
      for (int e = 0; e < 4; ++e) { o[2 * e] = bflo(a[e]) + bflo(bq[e]); o[2 * e + 1] = bfhi(a[e]) + bfhi(bq[e]); ss += o[2 * e] * o[2 * e] + o[2 * e + 1] * o[2 * e + 1]; }
      ss += __shfl_xor(ss, 1); ss += __shfl_xor(ss, 2); ss += __shfl_xor(ss, 4); ss += __shfl_xor(ss, 8);
      const float rstd = rsqrtf(ss * (1.0f / 128.0f) + 1e-6f);
      float y[8];
#pragma unroll
      for (int e = 0; e < 4; ++e) { y[2 * e] = o[2 * e] * rstd * og[2 * e] * siluf_(bflo(zq[e])); y[2 * e + 1] = o[2 * e + 1] * rstd * og[2 * e + 1] * siluf_(bfhi(zq[e])); }
      u32x4 w; w.x = cvt_pk_bf16(y[0], y[1]); w.y = cvt_pk_bf16(y[2], y[3]); w.z = cvt_pk_bf16(y[4], y[5]); w.w = cvt_pk_bf16(y[6], y[7]);
      *(u32x4*)(OF + (size_t)r * 512 + lane * 8) = w;
    }
  }
}

#define XB_TMO      128
#define XB_XCNT(j)  (256  + 64 * (j))
#define XB_XSUB(j)  (1280 + 64 * (j))
#define XB_XGEN(j)  (2304 + 64 * (j))
#define XB_TOP      3328
#define XB_TOPGEN   3392
#define XCD_BAR_WORDS 3456
#define XB_SPIN_CAP (1u << 18)

__device__ __forceinline__ unsigned xb_ld(unsigned* p)              { return __hip_atomic_load(p, __ATOMIC_RELAXED, __HIP_MEMORY_SCOPE_AGENT); }
__device__ __forceinline__ unsigned xb_add(unsigned* p, unsigned v) { return __hip_atomic_fetch_add(p, v, __ATOMIC_RELAXED, __HIP_MEMORY_SCOPE_AGENT); }
__device__ __forceinline__ unsigned xb_xcc_id() { return (unsigned)__builtin_amdgcn_s_getreg((3 << 11) | 20) & 0xFu; }
#define XB_SPIN(cond, bar) do { unsigned _sp = 0; while (cond) { __builtin_amdgcn_s_sleep(1); \
    if ((++_sp & 255u) == 0u) { if (xb_ld(&(bar)[XB_TMO])) break; if (_sp > XB_SPIN_CAP) { atomicAdd(&(bar)[XB_TMO], 1u); break; } } } } while (0)

struct XcdBarrier {
    unsigned* bar; unsigned x;
    volatile LAS unsigned* st;
};

__device__ __forceinline__ XcdBarrier xcd_barrier_post(unsigned* bar, volatile LAS unsigned* st) {
    XcdBarrier b; b.bar = bar; b.x = xb_xcc_id(); b.st = st;
    if (threadIdx.x == 0) (void)xb_add(&bar[XB_XCNT(b.x)], 1u);
    return b;
}
__device__ __forceinline__ void xcd_barrier_complete(unsigned* bar, unsigned x, unsigned& nloc, unsigned& nx) {
    const unsigned G = gridDim.x * gridDim.y * gridDim.z;
    unsigned sum, cnt, mine, sp = 0u;
    for (;;) {
        sum = 0u; cnt = 0u; mine = 0u;
#pragma unroll
        for (unsigned j = 0; j < 16; ++j) { const unsigned c = xb_ld(&bar[XB_XCNT(j)]); sum += c; cnt += (c > 0u) ? 1u : 0u; mine = (j == x) ? c : mine; }
        if (sum == G) break;
        __builtin_amdgcn_s_sleep(1);
        if ((++sp & 255u) == 0u) { if (xb_ld(&bar[XB_TMO])) break; if (sp > XB_SPIN_CAP) { atomicAdd(&bar[XB_TMO], 1u); break; } }
    }
    nloc = mine > 0u ? mine : 1u; nx = cnt > 0u ? cnt : 1u;
}

__device__ __forceinline__ void xcd_barrier(const XcdBarrier& b) {
    asm volatile("s_waitcnt vmcnt(0)" ::: "memory");
    __syncthreads();
    if (threadIdx.x == 0) {
        unsigned* bar = b.bar;
        __builtin_amdgcn_s_waitcnt(0);
        unsigned nloc = b.st[0], nx = b.st[1];
        if (nloc == 0u) { xcd_barrier_complete(bar, b.x, nloc, nx); b.st[0] = nloc; b.st[1] = nx; }
        const unsigned old = xb_add(&bar[XB_XSUB(b.x)], 1u);
        const unsigned gen = old / nloc;
        if (old + 1u == (gen + 1u) * nloc) {
            __builtin_amdgcn_fence(__ATOMIC_RELEASE, "agent");
            asm volatile("s_waitcnt vmcnt(0)" ::: "memory");
            const unsigned og = xb_add(&bar[XB_TOP], 1u);
            const unsigned tg = og / nx;
            if (og + 1u == (tg + 1u) * nx) xb_add(&bar[XB_TOPGEN], 1u);
            else XB_SPIN(xb_ld(&bar[XB_TOPGEN]) == tg, bar);
            __builtin_amdgcn_fence(__ATOMIC_ACQUIRE, "agent");
            xb_add(&bar[XB_XGEN(b.x)], 1u);
            asm volatile("s_waitcnt vmcnt(0)" ::: "memory");
        } else {
            XB_SPIN(xb_ld(&bar[XB_XGEN(b.x)]) == gen, bar);
            __builtin_amdgcn_fence(__ATOMIC_ACQUIRE, "agent");
            asm volatile("s_waitcnt vmcnt(0)" ::: "memory");
        }
    }
    __syncthreads();
}


__device__ __forceinline__ float rdb(const bf16_t* s_, size_t n, size_t i) { float a = 0.f; for (size_t j = i; j < n; j += (size_t)RLAT * DM) a += __uint_as_float((unsigned)s_[j] << 16); return a; }
__device__ __forceinline__ float rdf(const float* s_, size_t n, size_t i) { float a = 0.f; for (size_t j = i; j < n; j += (size_t)RLAT * DM) a += s_[j]; return a; }
__device__ __forceinline__ void dump_phase(const Params& p, int which) {
  const size_t NO = (size_t)RLAT * DM; unsigned char* ws = lws(p.ws);
  for (size_t i = (size_t)blockIdx.x * NTHR + otid(); i < NO; i += (size_t)gridDim.x * NTHR) {
    float a = 0.f;
    if (which == 1) { a = rdb((const bf16_t*)(ws + O_QKV), (size_t)ROWS * 1536, i) + rdb((const bf16_t*)(ws + O_Z), (size_t)ROWS * 512, i) + rdb((const bf16_t*)(ws + O_PI), (size_t)ROWS * 256, i) + rdb((const bf16_t*)(ws + O_FI), (size_t)ROWS * 256, i) + rdf((const float*)(ws + O_AB), (size_t)ROWS * 16, i); }
    if (which == 2) { a = rdb((const bf16_t*)(ws + O_QN), (size_t)ROWS * 512, i) + rdb((const bf16_t*)(ws + O_KN), (size_t)ROWS * 512, i) + rdb((const bf16_t*)(ws + O_KNT), (size_t)ROWS * 512, i) + rdb((const bf16_t*)(ws + O_VNT), (size_t)ROWS * 512, i) + rdb((const bf16_t*)(ws + O_TT), (size_t)ROWS * 1024, i) + rdf((const float*)(ws + O_GC), (size_t)NCH * 4 * 2 * 64, i)
          + rdb((const bf16_t*)(ws + O_FBT), (size_t)NB * 256 * 4096, i) + rdf((const float*)(ws + O_UCS), (size_t)NB * CTX * 512, i); }
    if (which == 3) { a = rdb((const bf16_t*)(ws + O_O), (size_t)ROWS * 1024, i); }
    if (which == 4) { a = rdb((const bf16_t*)(ws + O_OF), (size_t)ROWS * 512, i) + rdb((const bf16_t*)(ws + O_HN), (size_t)ROWS * 1024, i); }
    if (which == 5) { a = rdb((const bf16_t*)(ws + O_MRG), (size_t)ROWS * 1024, i); }
    if ((__float_as_uint(a) & 0xffff0000u) == 0xaaaa0000u) a = 1234.5f;
    if (!(a == a) || fabsf(a) > 1e30f) a = 777.0f;
    a = a * 0.5f + 0.12345678f;
    p.out[i] = a;
  }
}
__global__ void __launch_bounds__(NTHR) fwd_megakernel(Params p) {
  ldsp L = (ldsp)g_shm;
  cg::grid_group grid = cg::this_grid();
  volatile LAS unsigned* xst = (volatile LAS unsigned*)(L + LDS_BYTES - 16);
  if (threadIdx.x < 4) xst[threadIdx.x] = 0u;
  if (threadIdx.x == 0) { const unsigned long long wa_ = (unsigned long long)p.ws; *(volatile LAS unsigned*)(L + LDS_BYTES - 32) = (unsigned)wa_; *(volatile LAS unsigned*)(L + LDS_BYTES - 28) = (unsigned)(wa_ >> 32); }
  __syncthreads();
  XcdBarrier xbar = xcd_barrier_post((unsigned*)(p.ws + O_BAR), xst);
#define GSYNC0() do { asm volatile("s_waitcnt vmcnt(0) lgkmcnt(0)" ::: "memory"); __builtin_amdgcn_fence(__ATOMIC_RELEASE, "agent"); grid.sync(); __builtin_amdgcn_fence(__ATOMIC_ACQUIRE, "agent"); } while (0)
#define GSYNC() xcd_barrier(xbar)
  const int G = gridDim.x, c = blockIdx.x;
#define X ((float*)(lws(p.ws) + O_X))
#define MOD ((const float*)(lws(p.ws) + O_MOD))
#define Hn ((bf16_t*)(lws(p.ws) + O_HN))
#ifndef NO_P0
  phase0(p, L);
#endif
  GSYNC0();
  for (int l = 0; l < DEPTH; ++l) {
    const float* modl = MOD + (size_t)l * 9 * 9216; const float* ng = p.norm_gain + (size_t)l * 3 * 1024; const int notlast = (l != DEPTH - 1) ? 1 : 0, nMx = notlast ? ROWS / 256 : RLAT / 256;
#ifndef PROBE_CONV
#define PROBE_CONV 1
#endif
    { int cur_ = 0;
      if (l == 0) { convert_ffn(p, p.w1gu, p.w1d, O_WGU, O_WD, L, cur_, c, G); convert_win(p, 0, L, cur_, c, G); }
      convert_mixer(p, l, L, cur_); }
    norm_phase(X, Hn, ng, modl, 0, 1, l > 0 ? (const float*)(lws(p.ws) + O_TT) : nullptr);
    GSYNC();
#ifndef PROBE_UP
#define PROBE_UP 1
#endif
    for (int rep_ = 0; rep_ < PROBE_UP; ++rep_)
    { pg8::PlainSched S{(const char*)Hn, (const char*)(lws(p.ws) + O_WGU), 2048, 2048, 16, ROWS / 256, 22, G, c}; EpiUp E{(bf16_t*)(lws(p.ws) + O_ACT)}; pg8::gemm_phase(L, S, E); }
    GSYNC();
    { pg8::ResSched S{(const char*)(lws(p.ws) + O_ACT), (const char*)(lws(p.ws) + O_WD), DFF * 2, DFF / 64, G, c, 0}; EpiResT<false> E{(float*)(p.ws + O_X), modl, 2, 0.5f}; pg8::gemm_phase(L, S, E); }
    if (1) { pg8::ResSched S{(const char*)(lws(p.ws) + O_ACT), (const char*)(lws(p.ws) + O_WD), DFF * 2, DFF / 64, G, c, 1}; EpiPart E{(float*)(lws(p.ws) + O_TT), modl, 2, 0.5f}; pg8::gemm_phase(L, S, E); }
    GSYNC();
#ifndef NO_MIXER
    norm_phase(X, Hn, ng + 1024, modl, 3, 4, (const float*)(lws(p.ws) + O_TT));
    GSYNC();
#ifndef PROBE_IN
#define PROBE_IN 1
#endif
    for (int rep_ = 0; rep_ < PROBE_IN; ++rep_)
    { pg8::PlainSched S{(const char*)Hn, (const char*)(lws(p.ws) + O_WIN), 2048, 2048, 16, ROWS / 256, NINP / 256, G, c};
      EpiIn E{(bf16_t*)(lws(p.ws) + O_QKV), (bf16_t*)(lws(p.ws) + O_Z), (bf16_t*)(lws(p.ws) + O_PI), (bf16_t*)(lws(p.ws) + O_FI), (float*)(lws(p.ws) + O_AB)}; pg8::gemm_phase(L, S, E); }
    GSYNC();
#ifndef PROBE_PREP
#define PROBE_PREP 1
#endif
    for (int rep_ = 0; rep_ < PROBE_PREP; ++rep_) {
    prep_phase(p, l, L);
    }
#ifndef NO_FPREP
    fourier_prep(p, L);
#endif
    GSYNC();
#if defined(DUMP) && DUMP == 2
    dump_phase(p, 2); return;
#endif
#ifndef PROBE_SCAN
#define PROBE_SCAN 1
#endif
#ifndef PROBE_OTHER
#define PROBE_OTHER 1
#endif
    for (int rep_ = 0; rep_ < PROBE_SCAN; ++rep_) {
#ifndef NO_SCAN
    if (c < 128) scan_phase(p, L, c);
#else
    if (c < 128) {}
#endif
    else for (int rep2_ = 0; rep2_ < PROBE_OTHER; ++rep2_) {
      __syncthreads();
      { FourSched S{(const char*)(lws(p.ws) + O_DFT), (const char*)(lws(p.ws) + O_FBT), c - 128}; EpiBf E{(bf16_t*)(lws(p.ws) + O_PPF) + 256, 512}; pg8::gemm_phase(L, S, E); }
      __syncthreads();
      ctx_fourier(p, L, c - 128, G - 128);
      pool_phase(p, L, c - 128, G - 128);
    }
    __syncthreads();
    }
    GSYNC();
#if defined(DUMP) && DUMP == 3
    dump_phase(p, 3); return;
#endif
#ifndef PROBE_OFP
#define PROBE_OFP 1
#endif
    ofprep_norm_phase(p, l, X, Hn, ng + 1024, modl, 3, 4);
    GSYNC();
#if defined(DUMP) && DUMP == 4
    dump_phase(p, 4); return;
#endif
#ifndef PROBE_MRG
#define PROBE_MRG 1
#endif
    for (int rep_ = 0; rep_ < PROBE_MRG; ++rep_)
    { MergeSched S{(const char*)Hn, (const char*)(lws(p.ws) + O_OF), (const char*)(lws(p.ws) + O_PPF), (const char*)(lws(p.ws) + O_WG), (const char*)(lws(p.ws) + O_WCAT), G, c, RLAT / 256};
      EpiMerge E{(unsigned*)(lws(p.ws) + O_SCR) + (size_t)c * 2 * 32768, (bf16_t*)(lws(p.ws) + O_MRG)}; pg8::gemm_phase(L, S, E); }
    if (notlast) { MergeCtxSched S{(const char*)Hn, (const char*)(lws(p.ws) + O_OF), (const char*)(lws(p.ws) + O_PPF), (const char*)(lws(p.ws) + O_WG), (const char*)(lws(p.ws) + O_WCAT), c};
      EpiMergeCtx E{(unsigned*)(lws(p.ws) + O_SCR) + (size_t)c * 2 * 32768, (bf16_t*)(lws(p.ws) + O_PARTM)}; pg8::gemm_phase(L, S, E); }
    if (notlast && c >= 96) {
      int cur_ = 0; convert_ffn(p, p.w2gu + (size_t)l * 1024 * 2 * DFF, p.w2d + (size_t)l * DFF * 1024, O_WGU2, O_WD2, L, cur_, c - 96, G - 96);
      convert_ffn(p, p.w1gu + (size_t)(l + 1) * 1024 * 2 * DFF, p.w1d + (size_t)(l + 1) * DFF * 1024, O_WGU, O_WD, L, cur_, c - 96, G - 96);
      convert_win(p, l + 1, L, cur_, c - 96, G - 96); }
    GSYNC();
#if defined(DUMP) && DUMP == 5
    dump_phase(p, 5); return;
#endif
    { pg8::ResSched S{(const char*)(lws(p.ws) + O_MRG), (const char*)(lws(p.ws) + O_WOUT), 2048, 16, G, c, 0}; EpiResT<false> E{(float*)(p.ws + O_X), modl, 5, 1.0f}; pg8::gemm_phase(L, S, E); }
    if (notlast) { pg8::ResSched S{(const char*)(lws(p.ws) + O_PARTM) - (size_t)128 * 256 * 6144, (const char*)(lws(p.ws) + O_WOUT3), 6144, 48, G, c, 1}; EpiPart E{(float*)(lws(p.ws) + O_TT), modl, 5, 1.0f}; pg8::gemm_phase(L, S, E); }
    GSYNC();
#endif
    if (!notlast) { int cur_ = 0; convert_ffn(p, p.w2gu + (size_t)l * 1024 * 2 * DFF, p.w2d + (size_t)l * DFF * 1024, O_WGU2, O_WD2, L, cur_, c, G); }
    norm_phase(X, Hn, ng + 2048, modl, 6, 7, notlast ? (const float*)(lws(p.ws) + O_TT) : nullptr);
    GSYNC();
    { pg8::PlainSched S{(const char*)Hn, (const char*)(lws(p.ws) + O_WGU2), 2048, 2048, 16, nMx, 22, G, c}; EpiUp E{(bf16_t*)(lws(p.ws) + O_ACT)}; pg8::gemm_phase(L, S, E); }
    GSYNC();
    { pg8::ResSched S{(const char*)(lws(p.ws) + O_ACT), (const char*)(lws(p.ws) + O_WD2), DFF * 2, DFF / 64, G, c, 0}; EpiResT<false> E{(float*)(p.ws + O_X), modl, 8, 0.5f}; pg8::gemm_phase(L, S, E); }
    if (notlast) { pg8::ResSched S{(const char*)(lws(p.ws) + O_ACT), (const char*)(lws(p.ws) + O_WD2), DFF * 2, DFF / 64, G, c, 1}; EpiPart E{(float*)(lws(p.ws) + O_TT), modl, 8, 0.5f}; pg8::gemm_phase(L, S, E); }
    GSYNC();
  }
  final_norm(X, p.out, p.final_gain);
}

extern "C" void kernel_launch(void* const* d_in, const int* in_sizes, int n_in, void* d_out, int out_size, void* d_ws, size_t ws_size, hipStream_t stream) {
  (void)in_sizes; (void)n_in; (void)out_size;
  if (ws_size < WS_NEED) { fprintf(stderr, "workspace too small: %zu < %zu\n", ws_size, (size_t)WS_NEED); return; }
  static int grid_blocks = 0;
  if (!grid_blocks) {
    (void)hipFuncSetAttribute((const void*)fwd_megakernel, hipFuncAttributeMaxDynamicSharedMemorySize, LDS_BYTES);
    int dev = 0, cus = 0, per_cu = 0; (void)hipGetDevice(&dev); (void)hipDeviceGetAttribute(&cus, hipDeviceAttributeMultiprocessorCount, dev);
    (void)hipOccupancyMaxActiveBlocksPerMultiprocessor(&per_cu, fwd_megakernel, NTHR, LDS_BYTES);
    grid_blocks = cus * (per_cu > 0 ? 1 : 0);
    if (grid_blocks != 256) fprintf(stderr, "unexpected grid %d (cus %d per_cu %d)\n", grid_blocks, cus, per_cu);
  }
  Params p{};
  const float** f = (const float**)&p;
  for (int i = 0; i < 22; ++i) f[i] = (const float*)d_in[i];
  p.out = (float*)d_out; p.ws = (unsigned char*)d_ws;
  (void)hipMemsetAsync((unsigned char*)d_ws + O_BAR, 0, 16384, stream);
  void* args[] = {&p};
  hipError_t e = hipLaunchCooperativeKernel((void*)fwd_megakernel, dim3(grid_blocks), dim3(NTHR), args, LDS_BYTES, stream);
  if (e != hipSuccess) fprintf(stderr, "cooperative launch failed: %s (grid %d)\n", hipGetErrorString(e), grid_blocks);
}
```
